# Optimizing an MI355X kernel written in HIP

```python
import math
import jax
import jax.numpy as jnp
from jax import lax
import numpy as np


D_MODEL = 1024
BATCH = 4
SEQ = 8192
DEPTH = 2

HEAD_DIM = 64
GROUP_HEADS = 4
GROUP_W = GROUP_HEADS * HEAD_DIM
N_GROUPS = 4
D_MIX = N_GROUPS * GROUP_W
NORM_EPS = 1e-6
NEG = -1e30
Q_BLOCK = 128

CMP_LEN = 32
CMP_STRIDE = 16
SEL_LEN = 64
SEL_TOPN = 16
WINDOW = 512
N_CMP_IN_SEL = (SEL_LEN - CMP_LEN) // CMP_STRIDE + 1
SEL_FORCE = 1e3
N_BUCKETS = 32
MAX_DISTANCE = 128

MLSTM_CHUNK = 64
GDN_CHUNK = 64
CONV_W = 4

Q_LORA = 256
KV_LORA = 128
QK_NOPE = 64
QK_ROPE = 32
V_HEAD = 64
ROPE_THETA = 10000.0

PEER_HEADS = 8
PEER_DK = 256
N_KEYS = 128
N_EXPERTS = N_KEYS * N_KEYS
PEER_TOPK = 16
PEER_CHUNK = 128

NSA_IN = GROUP_W + 6 * HEAD_DIM + 3 * GROUP_HEADS
MLSTM_IN = 4 * GROUP_W + 2 * GROUP_HEADS
GDN_IN = 4 * GROUP_W + 2 * GROUP_HEADS
MLA_IN = Q_LORA + KV_LORA + QK_ROPE
D_IN = NSA_IN + MLSTM_IN + GDN_IN + MLA_IN

kernel_name = 'hybrid_nsa_mlstm_gdn_mla_peer'


def _split(t, widths):
    outs = []
    start = 0
    for w in widths:
        outs.append(t[..., start:start + w])
        start += w
    return outs


def rms_norm(x, g):
    xf = x.astype(jnp.float32)
    y = xf * lax.rsqrt(jnp.mean(xf * xf, axis=-1, keepdims=True) + NORM_EPS)
    return (y * g.astype(jnp.float32)).astype(x.dtype)


def _heads(t):
    b, s, _ = t.shape
    return t.reshape(b, s, -1, HEAD_DIM).transpose(0, 2, 1, 3)


def _unheads(t):
    b, h, s, d = t.shape
    return t.transpose(0, 2, 1, 3).reshape(b, s, h * d)


def _chunk(t, size):
    sh = t.shape
    return t.reshape(sh[0], sh[1], sh[2] // size, size, *sh[3:])


def masked_softmax(s, mask):
    s = jnp.where(mask, s.astype(jnp.float32), NEG)
    p = jax.nn.softmax(s, axis=-1)
    return jnp.where(mask, p, 0.0)


def t5_bucket(dist):
    dist = jnp.maximum(dist, 0)
    max_exact = N_BUCKETS // 2
    d = jnp.maximum(dist, 1).astype(jnp.float32)
    large = max_exact + (jnp.log(d / max_exact) / math.log(MAX_DISTANCE / max_exact)
                         * (N_BUCKETS - max_exact)).astype(jnp.int32)
    large = jnp.minimum(large, N_BUCKETS - 1)
    return jnp.where(dist < max_exact, dist, large)


def t5_bias(dist, table, head_axis):
    return jnp.moveaxis(table[t5_bucket(dist)].astype(jnp.float32), -1, head_axis)


def apply_rope(t, cos, sin):
    t1, t2 = t[..., :QK_ROPE // 2], t[..., QK_ROPE // 2:]
    return jnp.concatenate([t1 * cos - t2 * sin, t2 * cos + t1 * sin], axis=-1)


def causal_conv(t, w):
    c = t.shape[-1]
    return lax.conv_general_dilated(t, w[:, None, :].astype(t.dtype), window_strides=(1,),
                                    padding=[(CONV_W - 1, 0)],
                                    dimension_numbers=('NWC', 'WIO', 'NWC'),
                                    feature_group_count=c)


def nsa_group(h, w_cmp_k, w_cmp_v, cmp_pos, t5_table):
    f32 = jnp.float32
    b, s, _ = h.shape
    q, kc, vc, ks, vs, kw, vw, gates = _split(h, (GROUP_W,) + (HEAD_DIM,) * 6 + (3 * GROUP_HEADS,))
    qh = _heads(q).astype(f32) * HEAD_DIM ** -0.5

    n_cmp = (s - CMP_LEN) // CMP_STRIDE + 1

    def compress(t, w):
        tr = t.reshape(b, s // CMP_STRIDE, CMP_STRIDE, HEAD_DIM)
        blocks = jnp.concatenate([tr[:, :-1], tr[:, 1:]], axis=2) + cmp_pos
        return (blocks.reshape(b, n_cmp, CMP_LEN * HEAD_DIM) @ w).astype(f32)

    k_cmp = compress(kc, w_cmp_k)
    v_cmp = compress(vc, w_cmp_v)
    cmp_end = jnp.arange(n_cmp) * CMP_STRIDE + CMP_LEN - 1

    n_sel = s // SEL_LEN
    top_n = min(SEL_TOPN, n_sel)
    ks_blk = ks.astype(f32).reshape(b, n_sel, SEL_LEN, HEAD_DIM)
    vs_blk = vs.astype(f32).reshape(b, n_sel, SEL_LEN, HEAD_DIM)
    sel_blk = jnp.arange(n_sel)
    n_pad = n_sel * (SEL_LEN // CMP_STRIDE) - n_cmp

    kw_pad = jnp.pad(kw.astype(f32), ((0, 0), (WINDOW, 0), (0, 0)))
    vw_pad = jnp.pad(vw.astype(f32), ((0, 0), (WINDOW, 0), (0, 0)))

    nb = s // Q_BLOCK
    q_blocks = jnp.moveaxis(qh.reshape(b, GROUP_HEADS, nb, Q_BLOCK, HEAD_DIM), 2, 0)

    def block(args):
        qb, bi = args
        t = bi * Q_BLOCK + jnp.arange(Q_BLOCK)
        dist_c = t[:, None] - cmp_end[None, :]
        s_c = jnp.einsum('bhqd,bnd->bhqn', qb, k_cmp) + t5_bias(dist_c, t5_table, 0)
        p_c = masked_softmax(s_c, dist_c >= 0)
        o_c = jnp.einsum('bhqn,bnd->bhqd', p_c, v_cmp)
        imp = jnp.pad(p_c.sum(axis=1), ((0, 0), (0, 0), (0, n_pad)))
        imp = imp.reshape(b, Q_BLOCK, n_sel, SEL_LEN // CMP_STRIDE)[..., :N_CMP_IN_SEL].sum(-1)
        cur = t // SEL_LEN
        forced = ((sel_blk[None, :] == 0) | (sel_blk[None, :] == cur[:, None])
                  | (sel_blk[None, :] == cur[:, None] - 1))
        score = jnp.where(sel_blk[None, :] <= cur[:, None],
                          imp + jnp.where(forced, SEL_FORCE, 0.0), NEG)
        top_s, idx = lax.top_k(score, top_n)
        kg = jax.vmap(lambda kb_, ib_: kb_[ib_])(ks_blk, idx)
        vg = jax.vmap(lambda vb_, ib_: vb_[ib_])(vs_blk, idx)
        tok = idx[..., None] * SEL_LEN + jnp.arange(SEL_LEN)
        dist_s = t[None, :, None, None] - tok
        m_s = (top_s > 0.5 * NEG)[..., None] & (dist_s >= 0)
        s_s = jnp.einsum('bhqd,bqnld->bhqnl', qb, kg) + t5_bias(dist_s, t5_table, 1)
        p_s = masked_softmax(s_s.reshape(b, GROUP_HEADS, Q_BLOCK, top_n * SEL_LEN),
                             m_s.reshape(b, 1, Q_BLOCK, top_n * SEL_LEN))
        o_s = jnp.einsum('bhqnl,bqnld->bhqd', p_s.reshape(s_s.shape), vg)
        kwb = lax.dynamic_slice_in_dim(kw_pad, bi * Q_BLOCK, Q_BLOCK + WINDOW, axis=1)
        vwb = lax.dynamic_slice_in_dim(vw_pad, bi * Q_BLOCK, Q_BLOCK + WINDOW, axis=1)
        src = bi * Q_BLOCK - WINDOW + jnp.arange(Q_BLOCK + WINDOW)
        dist_w = t[:, None] - src[None, :]
        m_w = (dist_w >= 0) & (dist_w < WINDOW) & (src[None, :] >= 0)
        s_w = jnp.einsum('bhqd,bkd->bhqk', qb, kwb) + t5_bias(dist_w, t5_table, 0)
        o_w = jnp.einsum('bhqk,bkd->bhqd', masked_softmax(s_w, m_w), vwb)
        return jnp.stack([o_c, o_s, o_w], axis=0)

    outs = lax.map(block, (q_blocks, jnp.arange(nb)))
    outs = outs.transpose(1, 2, 3, 0, 4, 5).reshape(3, b, GROUP_HEADS, s, HEAD_DIM)
    g = jax.nn.sigmoid(gates.astype(f32)).reshape(b, s, 3, GROUP_HEADS).transpose(2, 0, 3, 1)
    return _unheads((g[..., None] * outs).sum(0))


def mlstm_group(h, i_bias, f_bias, norm_g):
    f32 = jnp.float32
    b, s, _ = h.shape
    q, k, v, ig, fg, og = _split(h, (GROUP_W,) * 3 + (GROUP_HEADS, GROUP_HEADS, GROUP_W))
    qh = _heads(q).astype(f32)
    kh = _heads(k).astype(f32) * HEAD_DIM ** -0.5
    vh = _heads(v).astype(f32)
    i_pre = (ig + i_bias).astype(f32).transpose(0, 2, 1)
    log_f = jax.nn.log_sigmoid((fg + f_bias).astype(f32)).transpose(0, 2, 1)
    L = MLSTM_CHUNK
    tri = jnp.tril(jnp.ones((L, L), dtype=bool))

    def step(carry, xs):
        c_st, n_st, m_st = carry
        qc, kc, vc, ic, lf = xs
        bcum = jnp.cumsum(lf, axis=-1)
        log_d = jnp.where(tri, bcum[..., :, None] - bcum[..., None, :] + ic[..., None, :], -jnp.inf)
        m_inter = bcum + m_st[..., None]
        m_t = jnp.maximum(log_d.max(-1), m_inter)
        dmat = jnp.exp(log_d - m_t[..., None])
        inter = jnp.exp(m_inter - m_t)
        sqk = jnp.einsum('bhtd,bhsd->bhts', qc, kc) * dmat
        num = (jnp.einsum('bhts,bhse->bhte', sqk, vc)
               + inter[..., None] * jnp.einsum('bhek,bhtk->bhte', c_st, qc))
        den = sqk.sum(-1) + inter * jnp.einsum('bhk,bhtk->bht', n_st, qc)
        h_t = num / jnp.maximum(jnp.abs(den), jnp.exp(-m_t))[..., None]
        b_end = bcum[..., -1]
        log_w = b_end[..., None] - bcum + ic
        m_new = jnp.maximum(b_end + m_st, log_w.max(-1))
        w = jnp.exp(log_w - m_new[..., None])
        decay = jnp.exp(b_end + m_st - m_new)
        c_st = decay[..., None, None] * c_st + jnp.einsum('bhs,bhse,bhsk->bhek', w, vc, kc)
        n_st = decay[..., None] * n_st + jnp.einsum('bhs,bhsk->bhk', w, kc)
        return (c_st, n_st, m_new), h_t

    xs = (jnp.moveaxis(_chunk(qh, L), 2, 0), jnp.moveaxis(_chunk(kh, L), 2, 0),
          jnp.moveaxis(_chunk(vh, L), 2, 0), jnp.moveaxis(_chunk(i_pre, L), 2, 0),
          jnp.moveaxis(_chunk(log_f, L), 2, 0))
    init = (jnp.zeros((b, GROUP_HEADS, HEAD_DIM, HEAD_DIM), f32),
            jnp.zeros((b, GROUP_HEADS, HEAD_DIM), f32),
            jnp.zeros((b, GROUP_HEADS), f32))
    _, hs = lax.scan(step, init, xs)
    hs = jnp.moveaxis(hs, 0, 2).reshape(b, GROUP_HEADS, s, HEAD_DIM).transpose(0, 2, 1, 3)
    o = jax.nn.sigmoid(og.astype(f32)).reshape(b, s, GROUP_HEADS, HEAD_DIM)
    y = rms_norm(o * hs, norm_g.reshape(GROUP_HEADS, HEAD_DIM))
    return y.reshape(b, s, GROUP_W)


def gdn_group(h, conv_w, a_log, dt_bias, norm_g):
    f32 = jnp.float32
    b, s, _ = h.shape
    qkv, beta_pre, a_pre, z = _split(h, (3 * GROUP_W, GROUP_HEADS, GROUP_HEADS, GROUP_W))
    qkv = jax.nn.silu(causal_conv(qkv, conv_w))
    q, k, v = _split(qkv, (GROUP_W,) * 3)

    def l2n(t):
        return t * lax.rsqrt(jnp.sum(t * t, axis=-1, keepdims=True) + NORM_EPS)

    qh = l2n(_heads(q).astype(f32)) * HEAD_DIM ** -0.5
    kh = l2n(_heads(k).astype(f32))
    vh = _heads(v).astype(f32)
    beta = jax.nn.sigmoid(beta_pre.astype(f32)).transpose(0, 2, 1)
    g = (-jnp.exp(a_log.astype(f32)) * jax.nn.softplus((a_pre + dt_bias).astype(f32))).transpose(0, 2, 1)
    L = GDN_CHUNK
    qc, kc, vc = _chunk(qh, L), _chunk(kh, L), _chunk(vh, L)
    gc = jnp.cumsum(_chunk(g, L), axis=-1)
    bc = _chunk(beta, L)
    tri = jnp.tril(jnp.ones((L, L), dtype=bool))
    strict = jnp.tril(jnp.ones((L, L), dtype=bool), k=-1)
    decay = jnp.exp(jnp.where(tri, gc[..., :, None] - gc[..., None, :], -jnp.inf))
    kb = kc * bc[..., None]
    vb = vc * bc[..., None]
    a_mat = jnp.where(strict, jnp.einsum('bhnid,bhnjd->bhnij', kb, kc) * decay, 0.0)
    m_mat = a_mat + jnp.eye(L, dtype=f32)
    u = lax.linalg.triangular_solve(m_mat, vb, left_side=True, lower=True)
    w = lax.linalg.triangular_solve(m_mat, kb * jnp.exp(gc)[..., None], left_side=True, lower=True)
    attn_qk = jnp.einsum('bhnid,bhnjd->bhnij', qc, kc) * decay
    q_dec = qc * jnp.exp(gc)[..., None]
    k_dec = kc * jnp.exp(gc[..., -1:] - gc)[..., None]
    g_end = jnp.exp(gc[..., -1])

    def step(state, xs):
        qd, aqk, uc, wc, kd, ge = xs
        v_new = uc - jnp.einsum('bhlk,bhkv->bhlv', wc, state)
        o = jnp.einsum('bhlk,bhkv->bhlv', qd, state) + jnp.einsum('bhij,bhjv->bhiv', aqk, v_new)
        state = state * ge[..., None, None] + jnp.einsum('bhlk,bhlv->bhkv', kd, v_new)
        return state, o

    xs = (jnp.moveaxis(q_dec, 2, 0), jnp.moveaxis(attn_qk, 2, 0), jnp.moveaxis(u, 2, 0),
          jnp.moveaxis(w, 2, 0), jnp.moveaxis(k_dec, 2, 0), jnp.moveaxis(g_end, 2, 0))
    init = jnp.zeros((b, GROUP_HEADS, HEAD_DIM, HEAD_DIM), f32)
    _, os_ = lax.scan(step, init, xs)
    os_ = jnp.moveaxis(os_, 0, 2).reshape(b, GROUP_HEADS, s, HEAD_DIM).transpose(0, 2, 1, 3)
    zg = jax.nn.silu(z.astype(f32)).reshape(b, s, GROUP_HEADS, HEAD_DIM)
    return (rms_norm(os_, norm_g) * zg).reshape(b, s, GROUP_W)


def mla_group(h, positions, q_norm_g, kv_norm_g, w_uq, w_ukv):
    f32 = jnp.float32
    b, s, _ = h.shape
    c_q, c_kv, k_r = _split(h, (Q_LORA, KV_LORA, QK_ROPE))
    qf = (rms_norm(c_q, q_norm_g) @ w_uq).astype(f32).reshape(b, s, GROUP_HEADS, QK_NOPE + QK_ROPE)
    kvf = (rms_norm(c_kv, kv_norm_g) @ w_ukv).astype(f32).reshape(b, s, GROUP_HEADS, QK_NOPE + V_HEAD)
    inv_freq = ROPE_THETA ** (-jnp.arange(0, QK_ROPE, 2, dtype=f32) / QK_ROPE)
    ang = positions.astype(f32)[..., None] * inv_freq
    cos, sin = jnp.cos(ang), jnp.sin(ang)
    scale = (QK_NOPE + QK_ROPE) ** -0.5
    q_nope = qf[..., :QK_NOPE].transpose(0, 2, 1, 3) * scale
    q_rope = apply_rope(qf[..., QK_NOPE:], cos[:, :, None], sin[:, :, None]).transpose(0, 2, 1, 3) * scale
    k_nope = kvf[..., :QK_NOPE].transpose(0, 2, 1, 3)
    v = kvf[..., QK_NOPE:].transpose(0, 2, 1, 3)
    k_rope = apply_rope(k_r.astype(f32), cos, sin)
    nb = s // Q_BLOCK
    qn_b = jnp.moveaxis(q_nope.reshape(b, GROUP_HEADS, nb, Q_BLOCK, QK_NOPE), 2, 0)
    qr_b = jnp.moveaxis(q_rope.reshape(b, GROUP_HEADS, nb, Q_BLOCK, QK_ROPE), 2, 0)
    key_pos = jnp.arange(s)

    def block(args):
        qn, qr, bi = args
        t = bi * Q_BLOCK + jnp.arange(Q_BLOCK)
        sc = jnp.einsum('bhqd,bhkd->bhqk', qn, k_nope) + jnp.einsum('bhqr,bkr->bhqk', qr, k_rope)
        p = masked_softmax(sc, key_pos[None, :] <= t[:, None])
        return jnp.einsum('bhqk,bhkd->bhqd', p, v)

    o = lax.map(block, (qn_b, qr_b, jnp.arange(nb)))
    o = jnp.moveaxis(o, 0, 2).reshape(b, GROUP_HEADS, s, V_HEAD)
    return _unheads(o)


def hybrid_mixer(xn, positions, t5_table, w_in, w_out, nsa_w_cmp_k, nsa_w_cmp_v, nsa_cmp_pos,
                 mlstm_i_bias, mlstm_f_bias, mlstm_norm_g, gdn_conv_w, gdn_a_log, gdn_dt_bias,
                 gdn_norm_g, mla_q_norm_g, mla_kv_norm_g, mla_w_uq, mla_w_ukv):
    h = xn @ w_in
    h_nsa, h_ml, h_gdn, h_mla = _split(h, (NSA_IN, MLSTM_IN, GDN_IN, MLA_IN))
    o = jnp.concatenate([
        nsa_group(h_nsa, nsa_w_cmp_k, nsa_w_cmp_v, nsa_cmp_pos, t5_table).astype(xn.dtype),
        mlstm_group(h_ml, mlstm_i_bias, mlstm_f_bias, mlstm_norm_g).astype(xn.dtype),
        gdn_group(h_gdn, gdn_conv_w, gdn_a_log, gdn_dt_bias, gdn_norm_g).astype(xn.dtype),
        mla_group(h_mla, positions, mla_q_norm_g, mla_kv_norm_g, mla_w_uq, mla_w_ukv).astype(xn.dtype),
    ], axis=-1)
    return o @ w_out


def peer_ffn(xn, w_q, sub_keys, u_tab, v_tab):
    b, s, d = xn.shape
    half = PEER_DK // 2
    xt = xn.reshape(b * s // PEER_CHUNK, PEER_CHUNK, d)

    def chunk(xc):
        qh = (xc @ w_q).reshape(PEER_CHUNK, PEER_HEADS, 2, half)
        sc = jnp.einsum('tpcd,pcnd->tpcn', qh, sub_keys).astype(jnp.float32)
        s1, i1 = lax.top_k(sc[:, :, 0], PEER_TOPK)
        s2, i2 = lax.top_k(sc[:, :, 1], PEER_TOPK)
        cand = (s1[..., :, None] + s2[..., None, :]).reshape(PEER_CHUNK, PEER_HEADS, PEER_TOPK * PEER_TOPK)
        cidx = (i1[..., :, None] * N_KEYS + i2[..., None, :]).reshape(PEER_CHUNK, PEER_HEADS, PEER_TOPK * PEER_TOPK)
        top, pos = lax.top_k(cand, PEER_TOPK)
        eidx = jnp.take_along_axis(cidx, pos, axis=-1)
        gate = jax.nn.softmax(top, axis=-1)
        u = u_tab[eidx]
        v = v_tab[eidx]
        act = jax.nn.gelu(jnp.einsum('td,tpkd->tpk', xc, u).astype(jnp.float32), approximate=False)
        return jnp.einsum('tpk,tpkd->td', (gate * act).astype(xc.dtype), v)

    return lax.map(chunk, xt).reshape(b, s, d)


def setup_inputs(seed: int = 0) -> dict:
    key = jax.random.key(seed)
    ks = jax.random.split(key, 32)
    f32 = jnp.float32

    def nrm(k, shape, scale):
        return jax.random.normal(k, shape, f32) * scale

    dt = jnp.exp(jax.random.uniform(ks[16], (DEPTH, GROUP_HEADS), f32)
                 * (math.log(0.1) - math.log(0.001)) + math.log(0.001))
    return {
        'x': nrm(ks[0], (BATCH, SEQ, D_MODEL), 1.0),
        'positions': jnp.tile(jnp.arange(SEQ, dtype=jnp.int32)[None, :], (BATCH, 1)),
        't5_table': nrm(ks[1], (N_BUCKETS, GROUP_HEADS), 0.5),
        'norm1_g': 1.0 + nrm(ks[2], (DEPTH, D_MODEL), 0.02),
        'norm2_g': 1.0 + nrm(ks[3], (DEPTH, D_MODEL), 0.02),
        'final_norm_g': 1.0 + nrm(ks[4], (D_MODEL,), 0.02),
        'w_in': nrm(ks[5], (DEPTH, D_MODEL, D_IN), D_MODEL ** -0.5),
        'w_out': nrm(ks[6], (DEPTH, D_MIX, D_MODEL), D_MIX ** -0.5),
        'nsa_w_cmp_k': nrm(ks[7], (DEPTH, CMP_LEN * HEAD_DIM, HEAD_DIM), (CMP_LEN * HEAD_DIM) ** -0.5),
        'nsa_w_cmp_v': nrm(ks[8], (DEPTH, CMP_LEN * HEAD_DIM, HEAD_DIM), (CMP_LEN * HEAD_DIM) ** -0.5),
        'nsa_cmp_pos': nrm(ks[9], (DEPTH, CMP_LEN, HEAD_DIM), 0.1),
        'mlstm_i_bias': nrm(ks[10], (DEPTH, GROUP_HEADS), 0.1),
        'mlstm_f_bias': jnp.linspace(3.0, 6.0, GROUP_HEADS, dtype=f32)[None, :] + nrm(ks[11], (DEPTH, GROUP_HEADS), 0.1),
        'mlstm_norm_g': 1.0 + nrm(ks[12], (DEPTH, GROUP_W), 0.02),
        'gdn_conv_w': nrm(ks[13], (DEPTH, CONV_W, 3 * GROUP_W), CONV_W ** -0.5),
        'gdn_a_log': jnp.log(jax.random.uniform(ks[14], (DEPTH, GROUP_HEADS), f32, 1.0, 16.0)),
        'gdn_dt_bias': dt + jnp.log(-jnp.expm1(-dt)),
        'gdn_norm_g': 1.0 + nrm(ks[15], (DEPTH, HEAD_DIM), 0.02),
        'mla_q_norm_g': 1.0 + nrm(ks[17], (DEPTH, Q_LORA), 0.02),
        'mla_kv_norm_g': 1.0 + nrm(ks[18], (DEPTH, KV_LORA), 0.02),
        'mla_w_uq': nrm(ks[19], (DEPTH, Q_LORA, GROUP_HEADS * (QK_NOPE + QK_ROPE)), Q_LORA ** -0.5),
        'mla_w_ukv': nrm(ks[20], (DEPTH, KV_LORA, GROUP_HEADS * (QK_NOPE + V_HEAD)), KV_LORA ** -0.5),
        'peer_w_q': nrm(ks[21], (DEPTH, D_MODEL, PEER_HEADS * PEER_DK), D_MODEL ** -0.5),
        'peer_sub_keys': nrm(ks[22], (DEPTH, PEER_HEADS, 2, N_KEYS, PEER_DK // 2), (PEER_DK // 2) ** -0.5),
        'peer_u': nrm(ks[23], (DEPTH, N_EXPERTS, D_MODEL), D_MODEL ** -0.5),
        'peer_v': nrm(ks[24], (DEPTH, N_EXPERTS, D_MODEL), 0.2),
    }


def reference(x, positions, t5_table, norm1_g, norm2_g, final_norm_g, w_in, w_out,
              nsa_w_cmp_k, nsa_w_cmp_v, nsa_cmp_pos, mlstm_i_bias, mlstm_f_bias, mlstm_norm_g,
              gdn_conv_w, gdn_a_log, gdn_dt_bias, gdn_norm_g, mla_q_norm_g, mla_kv_norm_g,
              mla_w_uq, mla_w_ukv, peer_w_q, peer_sub_keys, peer_u, peer_v):
    h = x
    for l in range(DEPTH):
        xn = rms_norm(h, norm1_g[l])
        h = h + hybrid_mixer(xn, positions, t5_table, w_in[l], w_out[l], nsa_w_cmp_k[l],
                             nsa_w_cmp_v[l], nsa_cmp_pos[l], mlstm_i_bias[l], mlstm_f_bias[l],
                             mlstm_norm_g[l], gdn_conv_w[l], gdn_a_log[l], gdn_dt_bias[l],
                             gdn_norm_g[l], mla_q_norm_g[l], mla_kv_norm_g[l], mla_w_uq[l],
                             mla_w_ukv[l])
        h = h + peer_ffn(rms_norm(h, norm2_g[l]), peer_w_q[l], peer_sub_keys[l], peer_u[l], peer_v[l])
    return rms_norm(h, final_norm_g)
```

```cpp
#include <hip/hip_runtime.h>
#include <cstdio>
#include <cstdint>

namespace pg8 {
#define PG8_LAS __attribute__((address_space(3)))
typedef unsigned short bf16_t;
typedef short bf16x8 __attribute__((ext_vector_type(8)));
typedef float f32x4 __attribute__((ext_vector_type(4)));
typedef unsigned u32x4 __attribute__((ext_vector_type(4)));
constexpr int BM = 256, BK = 64, HALF = 128, HTB = HALF * BK * 2  , STAGE_BYTES = 8 * HTB, NXCD = 8, WGM = 8;

__host__ __device__ __forceinline__ int lds_byte(int r, int c) { const int st = (r >> 4) * 2 + (c >> 5), rr = r & 15, cc = c & 31, ob = rr * 64 + cc * 2; return st * 1024 + (ob ^ (((ob >> 9) & 1) << 5)); }
__host__ __device__ __forceinline__ void stage_rc(int b, int& R, int& C) { const int st = b / 1024, sb = b % 1024, swz = sb ^ (((sb >> 9) & 1) << 5); R = (st >> 1) * 16 + swz / 64; C = (st & 1) * 32 + (swz % 64) / 2; }
__host__ __device__ __forceinline__ int perm32(int rho) { const int n = rho >> 4, i = rho & 15; return 8 * (i >> 2) + 4 * n + (i & 3); }

struct Unit { int pm, pn; };
struct Gemm { const bf16_t* A; const bf16_t* Bt; int M, N, K; };

struct StaticOrder {
    int nM, nN, nwg, G, c;
    __host__ __device__ void init(int M, int N, int G_, int c_) { nM = M / BM; nN = N / BM; nwg = nM * nN; G = G_; c = c_; }
    __host__ __device__ bool next(int i, Unit& u) const {
        const long L = (long)i * G + c; if (L >= nwg) return false;
        int wgid = (int)L; { const int q = nwg / NXCD, r = nwg % NXCD, xcd = wgid % NXCD, off = wgid / NXCD; wgid = (xcd < r ? xcd * (q + 1) : r * (q + 1) + (xcd - r) * q) + off; }
        const int nig = WGM * nN, gid = wgid / nig, fm = gid * WGM, gsz = (nM - fm) < WGM ? (nM - fm) : WGM;
        u.pm = fm + ((wgid % nig) % gsz); u.pn = (wgid % nig) / gsz; return true;
    }
    __device__ __forceinline__ void a_ready(const Unit&) const {}
    __device__ __forceinline__ void done(const Unit&) const {}
};

typedef __bf16 pg8_bf16x2 __attribute__((ext_vector_type(2)));
typedef float pg8_f32x2 __attribute__((ext_vector_type(2)));
__device__ __forceinline__ unsigned cvt_pk_bf16(float lo, float hi) { const pg8_f32x2 v = {lo, hi}; const pg8_bf16x2 b = __builtin_convertvector(v, pg8_bf16x2); return __builtin_bit_cast(unsigned, b); }
typedef float f32x2 __attribute__((ext_vector_type(2)));
__device__ __forceinline__ f32x2 gelu_pk(f32x2 v) {
    const f32x2 av = __builtin_elementwise_abs(v), d = av * 0.2316418882f + 1.0f;
    f32x2 t; t.x = __builtin_amdgcn_rcpf(d.x); t.y = __builtin_amdgcn_rcpf(d.y);
    f32x2 q = t * 0.5307027145f + (-0.7265760135f); q = q * t + 0.7107068705f; q = q * t + (-0.142248368f); q = q * t + 0.127414796f; q = q * t;
    const f32x2 s = (v * v) * (-0.72134752044f);
    f32x2 e; e.x = __builtin_amdgcn_exp2f(s.x); e.y = __builtin_amdgcn_exp2f(s.y);
    const f32x2 m = v * (q * e), r = v - m;
    f32x2 o; o.x = v.x < 0.f ? m.x : r.x; o.y = v.y < 0.f ? m.y : r.y; return o;
}


template <int ACT  > struct EpiBf16 {
    static constexpr bool PERM = true, AFTER_DRAIN = false; static_assert(ACT == 0 || ACT == 1, "EpiBf16: ACT is 0 (none) or 1 (gelu_pk)");
    bf16_t* O; int ldc; const float* bias; int split_cols; size_t split_stride; float scale0;
    __device__ __forceinline__ void operator()(const f32x4 (&acc)[2][2][4][2], const Unit& u, int wr, int wc, int fr, int fq) const {
        const int row0 = u.pm * BM + wr * 64 + fr; int colt = u.pn * BM; bf16_t* base = O;
        float sc = 1.f; if (split_cols) { const int t = colt / split_cols; base += (size_t)t * split_stride; colt -= t * split_cols; if (t == 0) sc = scale0; }
        const int col0 = colt + wc * 32 + 8 * fq, bcol0 = u.pn * BM + wc * 32 + 8 * fq;
        f32x4 bv[2][2];
#pragma unroll
        for (int bj = 0; bj < 2; ++bj)
#pragma unroll
            for (int n = 0; n < 2; ++n) bv[bj][n] = bias ? *(const f32x4*)(bias + bcol0 + bj * HALF + 4 * n) : (f32x4){0.f, 0.f, 0.f, 0.f};
#pragma unroll
        for (int ai = 0; ai < 2; ++ai)
#pragma unroll
            for (int m = 0; m < 4; ++m) { bf16_t* rowp = base + (size_t)(row0 + ai * HALF + m * 16) * ldc + col0;
#pragma unroll
                for (int bj = 0; bj < 2; ++bj) { f32x4 v0 = acc[ai][bj][m][0] + bv[bj][0], v1 = acc[ai][bj][m][1] + bv[bj][1];
                    if (ACT == 1) { f32x2 a = gelu_pk((f32x2){v0[0], v0[1]}), b = gelu_pk((f32x2){v0[2], v0[3]}), c = gelu_pk((f32x2){v1[0], v1[1]}), d = gelu_pk((f32x2){v1[2], v1[3]});
                        v0 = (f32x4){a.x, a.y, b.x, b.y}; v1 = (f32x4){c.x, c.y, d.x, d.y}; }
                    v0 = v0 * sc; v1 = v1 * sc; u32x4 w; w.x = cvt_pk_bf16(v0[0], v0[1]); w.y = cvt_pk_bf16(v0[2], v0[3]); w.z = cvt_pk_bf16(v1[0], v1[1]); w.w = cvt_pk_bf16(v1[2], v1[3]);
                    *(u32x4*)(rowp + bj * HALF) = w; } }
    }
};

struct EpiHb {
    static constexpr bool PERM = true, AFTER_DRAIN = false;
    bf16_t* O; int ldc; int ncols;
    __device__ __forceinline__ void operator()(const f32x4 (&acc)[2][2][4][2], const Unit& u, int wr, int wc, int fr, int fq) const {
        const int row0 = u.pm * BM + wr * 64 + fr; const int col0 = u.pn * BM + wc * 32 + 8 * fq;
#pragma unroll
        for (int ai = 0; ai < 2; ++ai)
#pragma unroll
            for (int m = 0; m < 4; ++m) { bf16_t* rowp = O + (size_t)(row0 + ai * HALF + m * 16) * ldc + col0;
#pragma unroll
                for (int bj = 0; bj < 2; ++bj) { const f32x4 v0 = acc[ai][bj][m][0], v1 = acc[ai][bj][m][1];
                    u32x4 w; w.x = cvt_pk_bf16(v0[0], v0[1]); w.y = cvt_pk_bf16(v0[2], v0[3]); w.z = cvt_pk_bf16(v1[0], v1[1]); w.w = cvt_pk_bf16(v1[2], v1[3]);
                    if (col0 + bj * HALF < ncols) *(u32x4*)(rowp + bj * HALF) = w; } }
    }
};
struct EpiRes {
    static constexpr bool PERM = false, AFTER_DRAIN = false;
    float* C; const float* R; int ldc;
    __device__ __forceinline__ void operator()(const f32x4 (&acc)[2][2][4][2], const Unit& u, int wr, int wc, int fr, int fq) const {
        const int row0 = u.pm * BM + wr * 64 + fr, col0 = u.pn * BM + wc * 32 + 4 * fq;
#pragma unroll
        for (int ai = 0; ai < 2; ++ai)
#pragma unroll
            for (int m = 0; m < 4; ++m) { const size_t ro = (size_t)(row0 + ai * HALF + m * 16) * ldc + col0;
#pragma unroll
                for (int bj = 0; bj < 2; ++bj)
#pragma unroll
                    for (int n = 0; n < 2; ++n) { const f32x4 r = *(const f32x4*)(R + ro + bj * HALF + n * 16); *(f32x4*)(C + ro + bj * HALF + n * 16) = acc[ai][bj][m][n] + r; } }
    }
};


template <class Epi, class Sched, bool ALIGN_EPI = false, bool SP2 = false>
__device__ __forceinline__ void gemm_phase(PG8_LAS unsigned char* lds, const Gemm g, const Sched& S, const Epi& E, const int wave_in) {
    const int wid = wave_in, lane = (int)__builtin_amdgcn_mbcnt_hi(~0u, __builtin_amdgcn_mbcnt_lo(~0u, 0u)), tid = wid * 64 + lane, wr = wid >> 2, wc = wid & 3, fr = lane & 15, fq = lane >> 4;
    const int K = g.K, nt = K / BK;
    unsigned voffA[2], voffB[2];
#pragma unroll
    for (int i = 0; i < 2; ++i) { int R, C; stage_rc(tid * 16 + i * 8192, R, C); const int Rb = Epi::PERM ? ((R & ~31) + perm32(R & 31)) : R;
        voffA[i] = (unsigned)(R * K + C) * 2u; voffB[i] = (unsigned)(Rb * K + C) * 2u; }
    const size_t kstep = (size_t)(BK * 2);
    const size_t hstep = (size_t)HALF * K * 2;
    const size_t tstep = 2 * hstep;
    const unsigned ldsw = (unsigned)wid * 1024u;
    const int aoff = lds_byte(wr * 64 + fr, fq * 8), boff = lds_byte(wc * 32 + fr, fq * 8);
#define PG8_SA(b, h) (((b) * 2 + (h)) * HTB)
#define PG8_SB(b, h) ((4 + (b) * 2 + (h)) * HTB)
#define PG8_STAGE(bufoff, gbase, voff) do { _Pragma("unroll") for (int _i = 0; _i < 2; ++_i) \
        __builtin_amdgcn_global_load_lds((const unsigned*)((const char*)(gbase) + (voff)[_i]), (PG8_LAS unsigned*)(lds + (bufoff) + ldsw + _i * 8192), 16, 0, 0); } while (0)
#define PG8_LDA(dst, b, h) do { _Pragma("unroll") for (int m = 0; m < 4; ++m) _Pragma("unroll") for (int k = 0; k < 2; ++k) dst[m][k] = *(const PG8_LAS bf16x8*)(lds + PG8_SA(b, h) + aoff + m * 2048 + k * 1024); } while (0)
#define PG8_LDB(dst, b, h) do { _Pragma("unroll") for (int n = 0; n < 2; ++n) _Pragma("unroll") for (int k = 0; k < 2; ++k) dst[n][k] = *(const PG8_LAS bf16x8*)(lds + PG8_SB(b, h) + boff + n * 2048 + k * 1024); } while (0)
#define PG8_MMA(ai, bj, At, Bt) do { __builtin_amdgcn_s_setprio(1); _Pragma("unroll") for (int m = 0; m < 4; ++m) _Pragma("unroll") for (int n = 0; n < 2; ++n) _Pragma("unroll") for (int k = 0; k < 2; ++k) \
        acc[ai][bj][m][n] = __builtin_amdgcn_mfma_f32_16x16x32_bf16(Bt[n][k], At[m][k], acc[ai][bj][m][n], 0, 0, 0); __builtin_amdgcn_s_setprio(0); } while (0)
#define PG8_WAIT_V(n) asm volatile("s_waitcnt vmcnt(" #n ")" ::: "memory")
#define PG8_WAIT_L(n) asm volatile("s_waitcnt lgkmcnt(" #n ")" ::: "memory")
#define PG8_BAR __builtin_amdgcn_s_barrier()
#define PG8_SCHED __builtin_amdgcn_sched_barrier(0)
    Unit cur, nxt; int ui = 0;
    if (!S.next(0, cur)) return;
    f32x4 acc[2][2][4][2];
#pragma unroll
    for (int a = 0; a < 2; ++a)
#pragma unroll
        for (int b = 0; b < 2; ++b)
#pragma unroll
            for (int m = 0; m < 4; ++m)
#pragma unroll
                for (int n = 0; n < 2; ++n) acc[a][b][m][n] = (f32x4){0.f, 0.f, 0.f, 0.f};
    bf16x8 At[4][2], B0[2][2], B1[2][2];
    const char* cA = (const char*)g.A + (size_t)cur.pm * tstep; const char* cB = (const char*)g.Bt + (size_t)cur.pn * tstep;
    S.a_ready(cur);
    if constexpr (SP2) {
        PG8_STAGE(PG8_SB(0, 0), cB, voffB); PG8_STAGE(PG8_SB(0, 1), cB + hstep, voffB); PG8_STAGE(PG8_SA(0, 0), cA, voffA); PG8_STAGE(PG8_SA(0, 1), cA + hstep, voffA);
        if (wr == 1) PG8_BAR;
        PG8_WAIT_V(2); PG8_BAR;
        PG8_STAGE(PG8_SB(1, 0), cB + kstep, voffB); PG8_STAGE(PG8_SA(1, 0), cA + kstep, voffA); PG8_STAGE(PG8_SB(1, 1), cB + hstep + kstep, voffB);
        PG8_WAIT_V(6); PG8_BAR;
    } else {
        PG8_STAGE(PG8_SB(0, 0), cB, voffB); PG8_STAGE(PG8_SA(0, 0), cA, voffA); PG8_STAGE(PG8_SB(0, 1), cB + hstep, voffB); PG8_STAGE(PG8_SA(0, 1), cA + hstep, voffA);
        if (wr == 1) PG8_BAR;
        PG8_WAIT_V(4); PG8_BAR;
        PG8_STAGE(PG8_SB(1, 0), cB + kstep, voffB); PG8_STAGE(PG8_SA(1, 0), cA + kstep, voffA); PG8_STAGE(PG8_SB(1, 1), cB + hstep + kstep, voffB);
        PG8_WAIT_V(6); PG8_BAR;
    }
    for (;;) {
        const bool has_next = S.next(ui + 1, nxt);
        const char* nA = has_next ? (const char*)g.A + (size_t)nxt.pm * tstep : cA; const char* nB = has_next ? (const char*)g.Bt + (size_t)nxt.pn * tstep : cB;
        for (int t = 0; t < nt; t += 2) {
            const bool last = (t == nt - 2);
            const char* a1 = cA + (size_t)(t + 1) * kstep;
            const char* a2 = last ? nA : cA + (size_t)(t + 2) * kstep; const char* b2 = last ? nB : cB + (size_t)(t + 2) * kstep;
            const char* a3 = a2 + kstep; const char* b3 = b2 + kstep;
            if (last && has_next) S.a_ready(nxt);
            if constexpr (SP2) {
            PG8_LDB(B0, 0, 0); PG8_LDB(B1, 0, 1); PG8_SCHED; PG8_LDA(At, 0, 0); PG8_STAGE(PG8_SA(1, 1), a1 + hstep, voffA);
            PG8_WAIT_V(8); PG8_WAIT_L(0); PG8_BAR; PG8_MMA(0, 0, At, B0); PG8_MMA(0, 1, At, B1); PG8_BAR; PG8_SCHED;
            PG8_LDA(At, 0, 1); PG8_STAGE(PG8_SB(0, 0), b2, voffB); PG8_STAGE(PG8_SB(0, 1), b2 + hstep, voffB); PG8_STAGE(PG8_SA(0, 0), a2, voffA);
            PG8_WAIT_V(8); PG8_WAIT_L(0); PG8_BAR; PG8_MMA(1, 0, At, B0); PG8_MMA(1, 1, At, B1); PG8_BAR; PG8_SCHED;
            PG8_LDB(B0, 1, 0); PG8_LDB(B1, 1, 1); PG8_SCHED; PG8_LDA(At, 1, 0); PG8_STAGE(PG8_SA(0, 1), a2 + hstep, voffA);
            PG8_WAIT_V(8); PG8_WAIT_L(0); PG8_BAR; PG8_MMA(0, 0, At, B0); PG8_MMA(0, 1, At, B1); PG8_BAR; PG8_SCHED;
            PG8_LDA(At, 1, 1); PG8_STAGE(PG8_SB(1, 0), b3, voffB); PG8_STAGE(PG8_SB(1, 1), b3 + hstep, voffB); PG8_STAGE(PG8_SA(1, 0), a3, voffA);
            PG8_WAIT_V(8); PG8_WAIT_L(0); PG8_BAR; PG8_MMA(1, 0, At, B0); PG8_MMA(1, 1, At, B1); PG8_BAR; PG8_SCHED;
            } else {
            PG8_LDB(B0, 0, 0); PG8_SCHED; PG8_LDA(At, 0, 0); PG8_STAGE(PG8_SA(1, 1), a1 + hstep, voffA);
            PG8_WAIT_L(8); PG8_BAR; PG8_WAIT_L(0); PG8_MMA(0, 0, At, B0); PG8_BAR; PG8_SCHED;
            PG8_LDB(B1, 0, 1); PG8_STAGE(PG8_SB(0, 0), b2, voffB);
            PG8_BAR; PG8_WAIT_L(0); PG8_MMA(0, 1, At, B1); PG8_BAR;
            PG8_LDA(At, 0, 1); PG8_STAGE(PG8_SA(0, 0), a2, voffA);
            PG8_BAR; PG8_WAIT_L(0); PG8_MMA(1, 0, At, B0); PG8_BAR; PG8_SCHED;
            PG8_STAGE(PG8_SB(0, 1), b2 + hstep, voffB);
            PG8_WAIT_V(6); PG8_BAR; PG8_MMA(1, 1, At, B1); PG8_BAR;
            PG8_LDB(B0, 1, 0); PG8_SCHED; PG8_LDA(At, 1, 0); PG8_STAGE(PG8_SA(0, 1), a2 + hstep, voffA);
            PG8_WAIT_L(8); PG8_BAR; PG8_WAIT_L(0); PG8_MMA(0, 0, At, B0); PG8_BAR; PG8_SCHED;
            PG8_LDB(B1, 1, 1); PG8_STAGE(PG8_SB(1, 0), b3, voffB);
            PG8_BAR; PG8_WAIT_L(0); PG8_MMA(0, 1, At, B1); PG8_BAR;
            PG8_LDA(At, 1, 1); PG8_STAGE(PG8_SA(1, 0), a3, voffA);
            PG8_BAR; PG8_WAIT_L(0); PG8_MMA(1, 0, At, B0); PG8_BAR; PG8_SCHED;
            PG8_STAGE(PG8_SB(1, 1), b3 + hstep, voffB);
            PG8_WAIT_V(6); PG8_BAR; PG8_MMA(1, 1, At, B1); PG8_BAR;
            }
        }
        if constexpr (ALIGN_EPI) { if (wr == 0) PG8_BAR; }
        if constexpr (!Epi::AFTER_DRAIN) { E(acc, cur, wr, wc, fr, fq); S.done(cur); }
        if (!has_next) break;
#pragma unroll
        for (int a = 0; a < 2; ++a)
#pragma unroll
            for (int b = 0; b < 2; ++b)
#pragma unroll
                for (int m = 0; m < 4; ++m)
#pragma unroll
                    for (int n = 0; n < 2; ++n) acc[a][b][m][n] = (f32x4){0.f, 0.f, 0.f, 0.f};
        cur = nxt; cA = nA; cB = nB; ++ui;
        if constexpr (ALIGN_EPI) { if (wr == 1) PG8_BAR; }
    }
    PG8_WAIT_V(0);
    if constexpr (!ALIGN_EPI) { if (wr == 0) PG8_BAR; }
    PG8_BAR;
    if constexpr (Epi::AFTER_DRAIN) { E.fused(acc, cur, wr, wc, fr, fq, lds, wid, lane); S.done(cur); }
#undef PG8_SA
#undef PG8_SB
#undef PG8_STAGE
#undef PG8_LDA
#undef PG8_LDB
#undef PG8_MMA
#undef PG8_WAIT_V
#undef PG8_WAIT_L
#undef PG8_BAR
#undef PG8_SCHED
}
}

constexpr int NB = 4, SEQ = 8192, M_TOK = NB * SEQ, DM = 1024, DEPTH = 2;
constexpr int D_IN = 3132, HBP = 3136, N_IN_PAD = 3328;
constexpr float NORM_EPS = 1e-6f;
constexpr int HB_NSA_Q = 0, HB_NSA_KC = 256, HB_NSA_VC = 320, HB_NSA_KS = 384, HB_NSA_VS = 448, HB_NSA_KW = 512, HB_NSA_VW = 576;
constexpr int HB_ML_Q = 640, HB_ML_K = 896, HB_ML_V = 1152, HB_ML_OG = 1408;
constexpr int HB_GD_Q = 1664, HB_GD_K = 1920, HB_GD_V = 2176, HB_GD_Z = 2432;
constexpr int HB_MLA_CQ = 2688, HB_MLA_CKV = 2944, HB_MLA_KR = 3072;
constexpr int HB_NSA_G = 3104, HB_ML_IG = 3116, HB_ML_FG = 3120, HB_GD_BETA = 3124, HB_GD_A = 3128;
__host__ __device__ __forceinline__ int hb_src_col(int c) {
    if (c < 640) return c;
    if (c < 1408) return 652 + (c - 640);
    if (c < 1664) return 1428 + (c - 1408);
    if (c < 2432) return 1684 + (c - 1664);
    if (c < 2688) return 2460 + (c - 2432);
    if (c < 3104) return 2716 + (c - 2688);
    if (c < 3116) return 640 + (c - 3104);
    if (c < 3124) return 1420 + (c - 3116);
    return 2452 + (c - 3124);
}
constexpr int GRID_WG = 256;
constexpr size_t MiB = 1u << 20;
constexpr size_t WS_CTL = 0, CTL_ZERO_BYTES = 1 * MiB;
constexpr size_t WS_WIN = 1 * MiB, WIN_L = (size_t)N_IN_PAD * DM * 2;
constexpr size_t WS_WOUT = 14 * MiB, WOUT_L = (size_t)DM * DM * 2;
constexpr size_t WS_WQ = 18 * MiB, WQ_L = (size_t)2048 * DM * 2;
constexpr size_t WS_WSM = 26 * MiB, WSM_L = 1 * MiB;
constexpr size_t WSM_UQ = 0, WSM_UKV = 196608, WSM_CK = 327680, WSM_CV = 589824;
constexpr size_t WS_XN = 28 * MiB;
constexpr size_t WS_HB = 92 * MiB;
constexpr size_t WS_MLA_Q = 288 * MiB, WS_MLA_K = 312 * MiB, WS_MLA_VT = 336 * MiB;
constexpr size_t WS_NSA_VST = 352 * MiB, WS_NSA_VWT = 356 * MiB, WS_NSA_KCMP = 360 * MiB, WS_NSA_VCMPT = 360 * MiB + 512 * 1024;
constexpr size_t WS_ML_C = 361 * MiB, WS_ML_N = 393 * MiB, WS_ML_SC = 393 * MiB + 512 * 1024;
constexpr size_t WS_GD_W = 394 * MiB, WS_GD_UT = 410 * MiB, WS_GD_KDT = 426 * MiB, WS_GD_QD = 442 * MiB, WS_GD_AQK = 458 * MiB, WS_GD_ST = 474 * MiB, WS_GD_VNT = 490 * MiB, WS_GD_GE = 506 * MiB;
constexpr size_t WS_PKEYS = 507 * MiB;
constexpr size_t WS_NSA_KSW = 508 * MiB;
constexpr size_t WS_END = 512 * MiB;
constexpr size_t WS_PEER_QP = 92 * MiB, WS_PEER_U = 394 * MiB, WS_PEER_V = 410 * MiB;
constexpr size_t WS_PEER_X8 = 288 * MiB;
constexpr int CW_TMO = 0, CW_BAR = 4096, CW_Q = 16384, CW_TS = 65536;
constexpr int NWAVES = 8, WAVE_LDS = 18432, MISC_OFF = NWAVES * WAVE_LDS, LDS_BYTES = MISC_OFF + 1024;
static_assert(LDS_BYTES <= 163840 && MISC_OFF >= 131072, "LDS map");

#define GAS __attribute__((address_space(1)))
#define LAS __attribute__((address_space(3)))
typedef unsigned short bf16;
typedef unsigned v4u __attribute__((ext_vector_type(4)));
typedef unsigned v2u __attribute__((ext_vector_type(2)));
typedef float f32x4 __attribute__((ext_vector_type(4)));
typedef short bf16x8 __attribute__((ext_vector_type(8)));
#define RLX_AGENT __ATOMIC_RELAXED, __HIP_MEMORY_SCOPE_AGENT
#define LDS_WAIT() asm volatile("s_waitcnt lgkmcnt(0)" ::: "memory")
#define VM_WAIT() asm volatile("s_waitcnt vmcnt(0)" ::: "memory")
__device__ __forceinline__ unsigned f2bf(float f) { unsigned u = __builtin_bit_cast(unsigned, f); return (u + 0x7fffu + ((u >> 16) & 1u)) >> 16; }
typedef __bf16 bf16x2_hw __attribute__((ext_vector_type(2)));
typedef float f32x2_hw __attribute__((ext_vector_type(2)));
__device__ __forceinline__ unsigned pk2(float lo, float hi) { const f32x2_hw v = {lo, hi}; const bf16x2_hw b = __builtin_convertvector(v, bf16x2_hw); return __builtin_bit_cast(unsigned, b); }
__device__ __forceinline__ float bf2f(unsigned b) { return __builtin_bit_cast(float, b << 16); }
__device__ __forceinline__ float bflo(unsigned w) { return __builtin_bit_cast(float, w << 16); }
__device__ __forceinline__ float bfhi(unsigned w) { return __builtin_bit_cast(float, w & 0xffff0000u); }
typedef unsigned u32x2_t __attribute__((ext_vector_type(2)));
__device__ __forceinline__ float red4_max(float x) {
    auto s = __builtin_amdgcn_permlane16_swap(__float_as_uint(x), __float_as_uint(x), false, false);
    x = fmaxf(__uint_as_float(s[0]), __uint_as_float(s[1]));
    auto t = __builtin_amdgcn_permlane32_swap(__float_as_uint(x), __float_as_uint(x), false, false);
    return fmaxf(__uint_as_float(t[0]), __uint_as_float(t[1]));
}
__device__ __forceinline__ float red4_sum(float x) {
    auto s = __builtin_amdgcn_permlane16_swap(__float_as_uint(x), __float_as_uint(x), false, false);
    x = __uint_as_float(s[0]) + __uint_as_float(s[1]);
    auto t = __builtin_amdgcn_permlane32_swap(__float_as_uint(x), __float_as_uint(x), false, false);
    return __uint_as_float(t[0]) + __uint_as_float(t[1]);
}
template <int CTRL> __device__ __forceinline__ float dpp_mov(float x) { return __int_as_float(__builtin_amdgcn_mov_dpp(__float_as_int(x), CTRL, 0xf, 0xf, true)); }
__device__ __forceinline__ float wave_sum(float v) {
    v += dpp_mov<0xB1>(v); v += dpp_mov<0x4E>(v); v += dpp_mov<0x141>(v); v += dpp_mov<0x140>(v);
    return red4_sum(v);
}
__device__ __forceinline__ float wave_max(float v) {
    v = fmaxf(v, dpp_mov<0xB1>(v)); v = fmaxf(v, dpp_mov<0x4E>(v)); v = fmaxf(v, dpp_mov<0x141>(v)); v = fmaxf(v, dpp_mov<0x140>(v));
    return red4_max(v);
}
__device__ __forceinline__ int wave_pop(unsigned* ctr, int lane) {
    __builtin_amdgcn_wave_barrier();
    const unsigned v = __hip_atomic_fetch_add(ctr, (lane == 0) ? 1u : 0u, RLX_AGENT);
    const int r = (int)__builtin_amdgcn_readfirstlane(v);
    __builtin_amdgcn_wave_barrier();
    return r;
}
__device__ __forceinline__ f32x4 mfma16(bf16x8 a, bf16x8 b, f32x4 c) { return __builtin_amdgcn_mfma_f32_16x16x32_bf16(a, b, c, 0, 0, 0); }
__device__ __forceinline__ int lane_id() { return (int)__builtin_amdgcn_mbcnt_hi(~0u, __builtin_amdgcn_mbcnt_lo(~0u, 0u)); }
__device__ __forceinline__ int lane_id_v() { int l; asm volatile("v_mbcnt_lo_u32_b32 %0, -1, 0\n\tv_mbcnt_hi_u32_b32 %0, -1, %0" : "=v"(l)); return l; }
template <class T> __device__ __forceinline__ T* opaque(T* p) { asm volatile("" : "+s"(p)); return p; }
union Frag { bf16x8 v; v4u u; unsigned w[4]; };

constexpr int N_PHASES = 1 + 8 * DEPTH;
struct Args { const float* in[26]; float* out; unsigned char* ws; int ph_lo, ph_hi; };
enum { I_X = 0, I_POS, I_T5, I_N1G, I_N2G, I_FNG, I_WIN, I_WOUT, I_CMPK, I_CMPV, I_CMPPOS, I_ML_IB, I_ML_FB, I_ML_NG, I_GD_CONV, I_GD_ALOG, I_GD_DT, I_GD_NG,
       I_MLA_QNG, I_MLA_KVNG, I_MLA_WUQ, I_MLA_WUKV, I_PEER_WQ, I_PEER_KEYS, I_PEER_U, I_PEER_V };

#define XB_TMO      128
#define XB_XCNT(j)  (256  + 64 * (j))
#define XB_XSUB(j)  (1280 + 64 * (j))
#define XB_XGEN(j)  (2304 + 64 * (j))
#define XB_TOP      3328
#define XB_TOPGEN   3392
#define XCD_BAR_WORDS 3456
#define XB_SPIN_CAP (1u << 21)

__device__ __forceinline__ unsigned xb_ld(unsigned* p)              { return __hip_atomic_load(p, __ATOMIC_RELAXED, __HIP_MEMORY_SCOPE_AGENT); }
__device__ __forceinline__ unsigned xb_add(unsigned* p, unsigned v) { return __hip_atomic_fetch_add(p, v, __ATOMIC_RELAXED, __HIP_MEMORY_SCOPE_AGENT); }
__device__ __forceinline__ unsigned xb_xcc_id() { return (unsigned)__builtin_amdgcn_s_getreg((3 << 11) | 20) & 0xFu; }
#define XB_SPIN(cond, bar) do { unsigned _sp = 0; while (cond) { __builtin_amdgcn_s_sleep(1); \
    if ((++_sp & 255u) == 0u) { if (xb_ld(&(bar)[XB_TMO])) break; if (_sp > XB_SPIN_CAP) { atomicAdd(&(bar)[XB_TMO], 1u); break; } } } } while (0)

struct XcdBarrier {
    unsigned* bar; unsigned x;
    volatile LAS unsigned* st;
};

__device__ __forceinline__ XcdBarrier xcd_barrier_post(unsigned* bar, volatile LAS unsigned* st, const bool is_t0) {
    XcdBarrier b; b.bar = bar; b.x = xb_xcc_id(); b.st = st;
    if (is_t0) (void)xb_add(&bar[XB_XCNT(b.x)], 1u);
    return b;
}
__device__ __forceinline__ void xcd_barrier_complete(unsigned* bar, unsigned x, unsigned& nloc, unsigned& nx) {
    const unsigned G = gridDim.x * gridDim.y * gridDim.z;
    unsigned sum, cnt, mine, sp = 0u;
    for (;;) {
        sum = 0u; cnt = 0u; mine = 0u;
#pragma unroll
        for (unsigned j = 0; j < 16; ++j) { const unsigned c = xb_ld(&bar[XB_XCNT(j)]); sum += c; cnt += (c > 0u) ? 1u : 0u; mine = (j == x) ? c : mine; }
        if (sum == G) break;
        __builtin_amdgcn_s_sleep(1);
        if ((++sp & 255u) == 0u) { if (xb_ld(&bar[XB_TMO])) break; if (sp > XB_SPIN_CAP) { atomicAdd(&bar[XB_TMO], 1u); break; } }
    }
    nloc = mine > 0u ? mine : 1u; nx = cnt > 0u ? cnt : 1u;
}

__device__ __forceinline__ void xcd_barrier(const XcdBarrier& b, const bool is_t0) {
    asm volatile("s_waitcnt vmcnt(0)" ::: "memory");
    __syncthreads();
    if (is_t0) {
        unsigned* bar = b.bar;
        __builtin_amdgcn_s_waitcnt(0);
        unsigned nloc = b.st[0], nx = b.st[1];
        if (nloc == 0u) { xcd_barrier_complete(bar, b.x, nloc, nx); b.st[0] = nloc; b.st[1] = nx; }
        const unsigned old = xb_add(&bar[XB_XSUB(b.x)], 1u);
        const unsigned gen = old / nloc;
        if (old + 1u == (gen + 1u) * nloc) {
            __builtin_amdgcn_fence(__ATOMIC_RELEASE, "agent");
            asm volatile("s_waitcnt vmcnt(0)" ::: "memory");
            const unsigned og = xb_add(&bar[XB_TOP], 1u);
            const unsigned tg = og / nx;
            if (og + 1u == (tg + 1u) * nx) xb_add(&bar[XB_TOPGEN], 1u);
            else XB_SPIN(xb_ld(&bar[XB_TOPGEN]) == tg, bar);
            __builtin_amdgcn_fence(__ATOMIC_ACQUIRE, "agent");
            xb_add(&bar[XB_XGEN(b.x)], 1u);
            asm volatile("s_waitcnt vmcnt(0)" ::: "memory");
        } else {
            XB_SPIN(xb_ld(&bar[XB_XGEN(b.x)]) == gen, bar);
            __builtin_amdgcn_fence(__ATOMIC_ACQUIRE, "agent");
            asm volatile("s_waitcnt vmcnt(0)" ::: "memory");
        }
    }
    __syncthreads();
}

template <class Map>
__device__ __forceinline__ void tr_item(const float* src, int ldsrc, int nreal, Map map, bf16* dst, int K, LAS float* scr, int kb, int nb, int lane) {
    const int k0 = 64 * kb, n0 = 32 * nb;
    const int n = n0 + (lane & 31);
    const int sc = (n < nreal) ? map(n) : -1;
#pragma unroll 8
    for (int i = 0; i < 32; ++i) { const int kk = 2 * i + (lane >> 5); scr[kk * 33 + (lane & 31)] = (sc >= 0) ? src[(size_t)(k0 + kk) * ldsrc + sc] : 0.f; }
    LDS_WAIT();
    const int c = lane & 7;
#pragma unroll
    for (int j = 0; j < 4; ++j) { const int nn = (lane >> 3) + 8 * j; const LAS float* s = scr + (8 * c) * 33 + nn;
        v4u o; o.x = pk2(s[0 * 33], s[1 * 33]); o.y = pk2(s[2 * 33], s[3 * 33]); o.z = pk2(s[4 * 33], s[5 * 33]); o.w = pk2(s[6 * 33], s[7 * 33]);
        *(v4u*)(dst + (size_t)(n0 + nn) * K + k0 + 8 * c) = o; }
    LDS_WAIT();
}
struct MapId { __device__ __forceinline__ int operator()(int n) const { return n; } };
struct MapHb { __device__ __forceinline__ int operator()(int n) const { return hb_src_col(n); } };
__device__ __forceinline__ void rms_row_bf16(const float* xrow, const float* g, bf16* orow, int lane) {
    const f32x4* xr = (const f32x4*)xrow + lane; const f32x4* gr = (const f32x4*)g + lane;
    f32x4 v[4]; float s = 0.f;
#pragma unroll
    for (int j = 0; j < 4; ++j) { v[j] = xr[64 * j]; s += (v[j].x * v[j].x + v[j].y * v[j].y) + (v[j].z * v[j].z + v[j].w * v[j].w); }
    const float r = 1.0f / sqrtf(wave_sum(s) * (1.f / DM) + NORM_EPS);
    v2u* o8 = (v2u*)orow + lane;
#pragma unroll
    for (int j = 0; j < 4; ++j) { const f32x4 gg = gr[64 * j]; v2u o; o.x = pk2(v[j].x * r * gg.x, v[j].y * r * gg.y); o.y = pk2(v[j].z * r * gg.z, v[j].w * r * gg.w); o8[64 * j] = o; }
}
__device__ __forceinline__ void rms_row_f32(const float* xrow, const float* g, float* orow, int lane) {
    const f32x4* xr = (const f32x4*)xrow + lane; const f32x4* gr = (const f32x4*)g + lane;
    f32x4 v[4]; float s = 0.f;
#pragma unroll
    for (int j = 0; j < 4; ++j) { v[j] = xr[64 * j]; s += (v[j].x * v[j].x + v[j].y * v[j].y) + (v[j].z * v[j].z + v[j].w * v[j].w); }
    const float r = 1.0f / sqrtf(wave_sum(s) * (1.f / DM) + NORM_EPS);
    f32x4* o = (f32x4*)orow + lane;
#pragma unroll
    for (int j = 0; j < 4; ++j) { const f32x4 gg = gr[64 * j]; o[64 * j] = v[j] * r * gg; }
}

__device__ __forceinline__ void mla_prep_item(int it, int l, const Args& args, int lane) {
    unsigned char* ws = args.ws;
    const bf16* HB = (const bf16*)(ws + WS_HB);
    bf16* Qo = (bf16*)(ws + WS_MLA_Q); bf16* Ko = (bf16*)(ws + WS_MLA_K); bf16* VT = (bf16*)(ws + WS_MLA_VT);
    const bf16* uq_t = opaque((const bf16*)(ws + WS_WSM + l * WSM_L + WSM_UQ)); const bf16* ukv_t = opaque((const bf16*)(ws + WS_WSM + l * WSM_L + WSM_UKV));
    const int fr = lane & 15, fq = lane >> 4;
    const int tok0 = it * 16, b = tok0 / SEQ, s0 = tok0 % SEQ;
    const float* gq = opaque(args.in[I_MLA_QNG] + l * 256); const float* gkv = opaque(args.in[I_MLA_KVNG] + l * 128);
    const int* pos = (const int*)args.in[I_POS];
    float cs[4], sn[4];
    { const float pf_ = (float)pos[tok0 + fr];
#pragma unroll
      for (int i = 0; i < 4; ++i) { const float inv_freq = exp2f(-(float)(fq * 4 + i) * (13.287712379549449f / 16.0f));
          const float ang = pf_ * inv_freq; sincosf(ang, &sn[i], &cs[i]); } }
    const int blk32 = s0 >> 5, half = (s0 >> 4) & 1;
    const float qscale = 0.10206207261596577f * 1.4426950408889634f;
    {
        Frag a[8]; float ss = 0.f;
#pragma unroll
        for (int ks = 0; ks < 8; ++ks) { a[ks].u = *(const v4u*)(HB + (size_t)(tok0 + fr) * HBP + HB_MLA_CQ + ks * 32 + fq * 8);
#pragma unroll
            for (int j = 0; j < 4; ++j) { const float x0 = bflo(a[ks].w[j]), x1 = bfhi(a[ks].w[j]); ss += x0 * x0 + x1 * x1; } }
        ss = red4_sum(ss);
        const float r = 1.0f / sqrtf(ss * (1.f / 256.f) + NORM_EPS);
#pragma unroll
        for (int ks = 0; ks < 8; ++ks) { const float* gp = gq + ks * 32 + fq * 8;
#pragma unroll
            for (int j = 0; j < 4; ++j) a[ks].w[j] = pk2(bflo(a[ks].w[j]) * r * gp[2 * j], bfhi(a[ks].w[j]) * r * gp[2 * j + 1]); }
        for (int h = 0; h < 4; ++h) {
            f32x4 acc[6];
#pragma unroll
            for (int j = 0; j < 6; ++j) { acc[j] = (f32x4){0.f, 0.f, 0.f, 0.f};
#pragma unroll
                for (int ks = 0; ks < 8; ++ks) { Frag bq; bq.u = *(const v4u*)(uq_t + (size_t)(h * 96 + j * 16 + fr) * 256 + ks * 32 + fq * 8); acc[j] = mfma16(bq.v, a[ks].v, acc[j]); } }
            bf16* qrow = Qo + ((size_t)(b * 4 + h) * SEQ + s0 + fr) * 96 + fq * 4;
#pragma unroll
            for (int j = 0; j < 4; ++j) { v2u o; o.x = pk2(acc[j][0] * qscale, acc[j][1] * qscale); o.y = pk2(acc[j][2] * qscale, acc[j][3] * qscale); *(v2u*)(qrow + j * 16) = o; }
            { float r1[4], r2[4];
#pragma unroll
              for (int i = 0; i < 4; ++i) { const float t1 = acc[4][i], t2 = acc[5][i]; r1[i] = (t1 * cs[i] - t2 * sn[i]) * qscale; r2[i] = (t2 * cs[i] + t1 * sn[i]) * qscale; }
              v2u o1, o2; o1.x = pk2(r1[0], r1[1]); o1.y = pk2(r1[2], r1[3]); o2.x = pk2(r2[0], r2[1]); o2.y = pk2(r2[2], r2[3]); *(v2u*)(qrow + 64) = o1; *(v2u*)(qrow + 80) = o2; }
        }
    }
    {
        Frag a[4]; float ss = 0.f;
#pragma unroll
        for (int ks = 0; ks < 4; ++ks) { a[ks].u = *(const v4u*)(HB + (size_t)(tok0 + fr) * HBP + HB_MLA_CKV + ks * 32 + fq * 8);
#pragma unroll
            for (int j = 0; j < 4; ++j) { const float x0 = bflo(a[ks].w[j]), x1 = bfhi(a[ks].w[j]); ss += x0 * x0 + x1 * x1; } }
        ss = red4_sum(ss);
        const float r = 1.0f / sqrtf(ss * (1.f / 128.f) + NORM_EPS);
#pragma unroll
        for (int ks = 0; ks < 4; ++ks) { const float* gp = gkv + ks * 32 + fq * 8;
#pragma unroll
            for (int j = 0; j < 4; ++j) a[ks].w[j] = pk2(bflo(a[ks].w[j]) * r * gp[2 * j], bfhi(a[ks].w[j]) * r * gp[2 * j + 1]); }
        for (int h = 0; h < 4; ++h) {
            f32x4 acc[8];
#pragma unroll
            for (int j = 0; j < 8; ++j) { acc[j] = (f32x4){0.f, 0.f, 0.f, 0.f};
#pragma unroll
                for (int ks = 0; ks < 4; ++ks) { Frag bq; bq.u = *(const v4u*)(ukv_t + (size_t)(h * 128 + j * 16 + fr) * 128 + ks * 32 + fq * 8); acc[j] = (j < 4) ? mfma16(bq.v, a[ks].v, acc[j]) : mfma16(a[ks].v, bq.v, acc[j]); } }
            bf16* kblk = Ko + (size_t)(b * 4 + h) * SEQ * 96 + (size_t)blk32 * 3072;
#pragma unroll
            for (int j = 0; j < 4; ++j) { v2u o; o.x = pk2(acc[j][0], acc[j][1]); o.y = pk2(acc[j][2], acc[j][3]);
                *(v2u*)(kblk + ((half * 3 + (j >> 1)) * 64 + ((j & 1) * 2 + (fq >> 1)) * 16 + fr) * 8 + (fq & 1) * 4) = o; }
            bf16* vblk = VT + (size_t)(b * 4 + h) * 64 * SEQ + (size_t)blk32 * 2048;
#pragma unroll
            for (int j = 0; j < 4; ++j) { v2u o; o.x = pk2(acc[4 + j][0], acc[4 + j][1]); o.y = pk2(acc[4 + j][2], acc[4 + j][3]);
                *(v2u*)(vblk + (j * 64 + lane) * 8 + half * 4) = o; }
        }
        { const bf16* kr = HB + (size_t)(tok0 + fr) * HBP + HB_MLA_KR + fq * 4;
          const v2u a1 = *(const v2u*)kr, a2 = *(const v2u*)(kr + 16);
          const float t1[4] = {bflo(a1.x), bfhi(a1.x), bflo(a1.y), bfhi(a1.y)}, t2[4] = {bflo(a2.x), bfhi(a2.x), bflo(a2.y), bfhi(a2.y)};
          float r1[4], r2[4];
#pragma unroll
          for (int i = 0; i < 4; ++i) { r1[i] = t1[i] * cs[i] - t2[i] * sn[i]; r2[i] = t2[i] * cs[i] + t1[i] * sn[i]; }
          v2u o1, o2; o1.x = pk2(r1[0], r1[1]); o1.y = pk2(r1[2], r1[3]); o2.x = pk2(r2[0], r2[1]); o2.y = pk2(r2[2], r2[3]);
#pragma unroll
          for (int h = 0; h < 4; ++h) { bf16* kblk = Ko + (size_t)(b * 4 + h) * SEQ * 96 + (size_t)blk32 * 3072 + ((half * 3 + 2) * 64 + fr) * 8 + (fq & 1) * 4;
              *(v2u*)(kblk + (fq >> 1) * 128) = o1; *(v2u*)(kblk + (2 + (fq >> 1)) * 128) = o2; } }
    }
}
#define MLA_LOADK(KF, k0_) do { const bf16* kp_ = K + (size_t)((k0_) >> 5) * 3072 + lane * 8; _Pragma("unroll") for (int t = 0; t < 2; ++t) { _Pragma("unroll") for (int ks = 0; ks < 3; ++ks) KF[t][ks].u = *(const v4u*)(kp_ + (t * 3 + ks) * 512); } } while (0)
#define MLA_LOADV(VF, k0_) do { const bf16* vp_ = VT + (size_t)((k0_) >> 5) * 2048 + lane * 8; _Pragma("unroll") for (int dt = 0; dt < 4; ++dt) VF[dt].u = *(const v4u*)(vp_ + dt * 512); } while (0)
#define MLA_STEP_(KF, VF, k0_, DIAG) do { \
    Frag pf[4]; f32x4 sA_[4], sB_[4]; \
    _Pragma("unroll") for (int nt = 0; nt < 4; ++nt) { Frag q0, q1, q2; q0.u = *(const LAS v4u*)(ql + (nt * 16 + fr) * 104 + fq * 8); q1.u = *(const LAS v4u*)(ql + (nt * 16 + fr) * 104 + 32 + fq * 8); q2.u = *(const LAS v4u*)(ql + (nt * 16 + fr) * 104 + 64 + fq * 8); \
        f32x4 s0_ = {0.f, 0.f, 0.f, 0.f}, s1_ = {0.f, 0.f, 0.f, 0.f}; \
        s0_ = mfma16(KF[0][0].v, q0.v, s0_); s1_ = mfma16(KF[1][0].v, q0.v, s1_); s0_ = mfma16(KF[0][1].v, q1.v, s0_); s1_ = mfma16(KF[1][1].v, q1.v, s1_); s0_ = mfma16(KF[0][2].v, q2.v, s0_); s1_ = mfma16(KF[1][2].v, q2.v, s1_); \
        sA_[nt] = s0_; sB_[nt] = s1_; } \
      \
    _Pragma("unroll") for (int nt = 0; nt < 4; ++nt) { f32x4 s0_ = sA_[nt], s1_ = sB_[nt]; \
        if (DIAG) { _Pragma("unroll") for (int i = 0; i < 4; ++i) { if ((k0_) + fq * 4 + i > s0 + nt * 16 + fr) s0_[i] = -1e30f; if ((k0_) + 16 + fq * 4 + i > s0 + nt * 16 + fr) s1_[i] = -1e30f; } } \
        float mx = fmaxf(fmaxf(fmaxf(s0_[0], s0_[1]), fmaxf(s0_[2], s0_[3])), fmaxf(fmaxf(s1_[0], s1_[1]), fmaxf(s1_[2], s1_[3]))); \
        mx = red4_max(mx); \
        const float mn = fmaxf(mrun[nt], mx); \
        float p[8]; float ps = 0.f; \
        _Pragma("unroll") for (int i = 0; i < 4; ++i) { p[i] = __builtin_amdgcn_exp2f(s0_[i] - mn); p[4 + i] = __builtin_amdgcn_exp2f(s1_[i] - mn); ps += p[i] + p[4 + i]; } \
        if (__builtin_amdgcn_ballot_w64(mn > mrun[nt]) != 0ull) {         \
            const float alpha = __builtin_amdgcn_exp2f(mrun[nt] - mn); mrun[nt] = mn; lrun[nt] = lrun[nt] * alpha; \
            _Pragma("unroll") for (int dt = 0; dt < 4; ++dt) o[dt][nt] = o[dt][nt] * alpha; } \
        lrun[nt] += ps; \
        pf[nt].w[0] = pk2(p[0], p[1]); pf[nt].w[1] = pk2(p[2], p[3]); pf[nt].w[2] = pk2(p[4], p[5]); pf[nt].w[3] = pk2(p[6], p[7]); } \
    _Pragma("unroll") for (int dt = 0; dt < 4; ++dt) _Pragma("unroll") for (int nt = 0; nt < 4; ++nt) o[dt][nt] = mfma16(VF[dt].v, pf[nt].v, o[dt][nt]); __builtin_amdgcn_sched_barrier(0); } while (0)
__device__ __forceinline__ void mla_attn_item(int bh, int qt, const Args& args, LAS unsigned char* wlds, int lane) {
    unsigned char* ws = args.ws;
    const bf16* Q = (const bf16*)(ws + WS_MLA_Q) + (size_t)bh * SEQ * 96; const bf16* K = (const bf16*)(ws + WS_MLA_K) + (size_t)bh * SEQ * 96;
    const bf16* VT = (const bf16*)(ws + WS_MLA_VT) + (size_t)bh * 64 * SEQ; bf16* XN = (bf16*)(ws + WS_XN);
    const int fr = lane & 15, fq = lane >> 4, s0 = qt * 64, b = bh >> 2, h = bh & 3;
    LAS bf16* ql = (LAS bf16*)wlds;
#pragma unroll
    for (int i = 0; i < 12; ++i) { const int idx = i * 64 + lane, r = idx / 12, c = idx % 12; *(LAS v4u*)(ql + r * 104 + c * 8) = *(const v4u*)(Q + (size_t)(s0 + r) * 96 + c * 8); }
    LDS_WAIT();
    f32x4 o[4][4];
#pragma unroll
    for (int dt = 0; dt < 4; ++dt)
#pragma unroll
        for (int nt = 0; nt < 4; ++nt) o[dt][nt] = (f32x4){0.f, 0.f, 0.f, 0.f};
    float mrun[4], lrun[4];
#pragma unroll
    for (int nt = 0; nt < 4; ++nt) { mrun[nt] = -1e30f; lrun[nt] = 0.f; }
    const int nkb = (s0 + 64) / 32;
    Frag kA[2][3], kB[2][3], vv[4];
    MLA_LOADK(kA, 0);
    for (int kb = 0; kb < nkb - 2; kb += 2) {
        MLA_LOADV(vv, kb * 32); MLA_LOADK(kB, (kb + 1) * 32);
        MLA_STEP_(kA, vv, kb * 32, 0);
        MLA_LOADV(vv, (kb + 1) * 32); MLA_LOADK(kA, (kb + 2) * 32);
        MLA_STEP_(kB, vv, (kb + 1) * 32, 0);
    }
    { const int kb = nkb - 2;
        MLA_LOADV(vv, kb * 32); MLA_LOADK(kB, (kb + 1) * 32);
        MLA_STEP_(kA, vv, kb * 32, 1);
        MLA_LOADV(vv, (kb + 1) * 32);
        MLA_STEP_(kB, vv, (kb + 1) * 32, 1);
    }
#pragma unroll
    for (int nt = 0; nt < 4; ++nt) {
        float lt = lrun[nt]; lt = red4_sum(lt);
        const float inv = 1.0f / lt;
        bf16* orow = XN + (size_t)(b * SEQ + s0 + nt * 16 + fr) * DM + 768 + h * 64 + fq * 4;
#pragma unroll
        for (int dt = 0; dt < 4; ++dt) { v2u w; w.x = pk2(o[dt][nt][0] * inv, o[dt][nt][1] * inv); w.y = pk2(o[dt][nt][2] * inv, o[dt][nt][3] * inv); *(v2u*)(orow + dt * 16) = w; }
    }
    LDS_WAIT();
}

__device__ __forceinline__ void stage64(const bf16* HB, int tok0, int col0, LAS bf16* buf, int lane) {
#pragma unroll
    for (int i = 0; i < 8; ++i) { const int idx = i * 64 + lane, r = idx >> 3, c8 = idx & 7;
        const v4u v = *(const v4u*)(HB + (size_t)(tok0 + r) * HBP + col0 + c8 * 8); *(LAS v4u*)(buf + r * 72 + c8 * 8) = v; }
    LDS_WAIT();
}
__device__ __forceinline__ float log_sigmoid(float x) { return fminf(x, 0.f) - log1pf(expf(-fabsf(x))); }
__device__ __forceinline__ float wave_incl_sum(float v, int lane) {
#pragma unroll
    for (int o = 1; o < 64; o <<= 1) { const float t = __shfl_up(v, o); if (lane >= o) v += t; }
    return v;
}
__device__ __forceinline__ float wave_incl_max(float v, int lane) {
#pragma unroll
    for (int o = 1; o < 64; o <<= 1) { const float t = __shfl_up(v, o); if (lane >= o) v = fmaxf(v, t); }
    return v;
}
__device__ __forceinline__ void mlstm_prep_item(int it, int l, const Args& args, LAS unsigned char* wlds, int lane) {
    unsigned char* ws = args.ws; const bf16* HB = (const bf16*)(ws + WS_HB);
    const int bh = it >> 7, n = it & 127, b = bh >> 2, h = bh & 3, tok0 = b * SEQ + n * 64, fr = lane & 15, fq = lane >> 4;
    LAS bf16* buf = (LAS bf16*)wlds;
    const float ib = opaque(args.in[I_ML_IB] + l * 4)[h], fb = opaque(args.in[I_ML_FB] + l * 4)[h];
    const float ig = bf2f(HB[(size_t)(tok0 + lane) * HBP + HB_ML_IG + h]) + ib;
    const float lf = log_sigmoid(bf2f(HB[(size_t)(tok0 + lane) * HBP + HB_ML_FG + h]) + fb);
    const float bcum = wave_incl_sum(lf, lane), a = ig - bcum, amax = wave_max(a), bend = __shfl(bcum, 63);
    const float w = expf(a - amax);
    float wv[2][8];
#pragma unroll
    for (int ks = 0; ks < 2; ++ks)
#pragma unroll
        for (int j = 0; j < 8; ++j) wv[ks][j] = __shfl(w, ks * 32 + fq * 8 + j);
    stage64(HB, tok0, HB_ML_V + h * 64, buf, lane);
    Frag af[4][2];
#pragma unroll
    for (int mt = 0; mt < 4; ++mt)
#pragma unroll
        for (int ks = 0; ks < 2; ++ks)
#pragma unroll
            for (int j = 0; j < 4; ++j) { const int s = ks * 32 + fq * 8 + 2 * j, e = mt * 16 + fr;
                af[mt][ks].w[j] = pk2(bf2f(buf[s * 72 + e]) * wv[ks][2 * j], bf2f(buf[(s + 1) * 72 + e]) * wv[ks][2 * j + 1]); }
    LDS_WAIT();
    stage64(HB, tok0, HB_ML_K + h * 64, buf, lane);
    Frag bfm[4][2];
#pragma unroll
    for (int nt = 0; nt < 4; ++nt)
#pragma unroll
        for (int ks = 0; ks < 2; ++ks)
#pragma unroll
            for (int j = 0; j < 4; ++j) { const int s = ks * 32 + fq * 8 + 2 * j, kd = nt * 16 + fr;
                bfm[nt][ks].w[j] = pk2(bf2f(buf[s * 72 + kd]) * 0.125f, bf2f(buf[(s + 1) * 72 + kd]) * 0.125f); }
    LDS_WAIT();
    float* Cc = (float*)(ws + WS_ML_C) + (size_t)it * 4096;
#pragma unroll
    for (int mt = 0; mt < 4; ++mt)
#pragma unroll
        for (int nt = 0; nt < 4; ++nt) { f32x4 acc = {0.f, 0.f, 0.f, 0.f};
#pragma unroll
            for (int ks = 0; ks < 2; ++ks) acc = mfma16(af[mt][ks].v, bfm[nt][ks].v, acc);
#pragma unroll
            for (int i = 0; i < 4; ++i) Cc[(mt * 16 + fq * 4 + i) * 64 + nt * 16 + fr] = acc[i]; }
    {
        Frag an[2];
#pragma unroll
        for (int ks = 0; ks < 2; ++ks)
#pragma unroll
            for (int j = 0; j < 4; ++j) an[ks].w[j] = (fr == 0) ? pk2(wv[ks][2 * j], wv[ks][2 * j + 1]) : 0u;
        float* Nn = (float*)(ws + WS_ML_N) + (size_t)it * 64; float* dummy = (float*)(ws + WS_ML_SC) + (size_t)it * 4 + 3;
#pragma unroll
        for (int nt = 0; nt < 4; ++nt) { f32x4 acc = {0.f, 0.f, 0.f, 0.f}; acc = mfma16(an[0].v, bfm[nt][0].v, acc); acc = mfma16(an[1].v, bfm[nt][1].v, acc);
            float* dst = (fq == 0) ? (Nn + nt * 16 + fr) : dummy; *dst = acc[0]; } }
    { float* sc = (float*)(ws + WS_ML_SC) + (size_t)it * 4; sc[lane & 1] = (lane & 1) ? bend : bend + amax; }
}
__device__ __forceinline__ void mlstm_scan_item(int it, const Args& args, int lane) {
    unsigned char* ws = args.ws; const int bh = it >> 4, part = it & 15;
    float* Cb = (float*)(ws + WS_ML_C) + (size_t)bh * 128 * 4096 + part * 256 + lane;
    float* Nb = (float*)(ws + WS_ML_N) + (size_t)bh * 128 * 64 + lane;
    float* sc = (float*)(ws + WS_ML_SC) + (size_t)bh * 128 * 4;
    float c0 = 0.f, c1 = 0.f, c2 = 0.f, c3 = 0.f, nn = 0.f, m = 0.f;
    for (int n0 = 0; n0 < 128; n0 += 4) {
        float d[4][4], ml_[4], be_[4], dn_[4];
#pragma unroll
        for (int q = 0; q < 4; ++q) { const float* cp = Cb + (size_t)(n0 + q) * 4096; d[q][0] = cp[0]; d[q][1] = cp[64]; d[q][2] = cp[128]; d[q][3] = cp[192];
            ml_[q] = sc[(n0 + q) * 4 + 0]; be_[q] = sc[(n0 + q) * 4 + 1]; dn_[q] = (part == 0) ? Nb[(n0 + q) * 64] : 0.f; }
#pragma unroll
        for (int q = 0; q < 4; ++q) { float* cp = Cb + (size_t)(n0 + q) * 4096;
            const float mnew = fmaxf(be_[q] + m, ml_[q]), fc = expf(be_[q] + m - mnew), fd = expf(ml_[q] - mnew);
            cp[0] = c0; cp[64] = c1; cp[128] = c2; cp[192] = c3;
            c0 = fc * c0 + fd * d[q][0]; c1 = fc * c1 + fd * d[q][1]; c2 = fc * c2 + fd * d[q][2]; c3 = fc * c3 + fd * d[q][3];
            if (part == 0) { Nb[(n0 + q) * 64] = nn; nn = fc * nn + fd * dn_[q]; sc[(n0 + q) * 4 + 2] = m; }
            m = mnew; }
    }
}
__device__ __forceinline__ void mlstm_out_item(int it, int l, const Args& args, LAS unsigned char* wlds, int lane) {
    unsigned char* ws = args.ws; const bf16* HB = (const bf16*)(ws + WS_HB); bf16* XN = (bf16*)(ws + WS_XN);
    const int bh = it >> 7, n = it & 127, b = bh >> 2, h = bh & 3, tok0 = b * SEQ + n * 64, fr = lane & 15, fq = lane >> 4;
    LAS bf16* buf = (LAS bf16*)wlds;
    const float ib = opaque(args.in[I_ML_IB] + l * 4)[h], fb = opaque(args.in[I_ML_FB] + l * 4)[h];
    const float ig = bf2f(HB[(size_t)(tok0 + lane) * HBP + HB_ML_IG + h]) + ib;
    const float lf = log_sigmoid(bf2f(HB[(size_t)(tok0 + lane) * HBP + HB_ML_FG + h]) + fb);
    const float bcum = wave_incl_sum(lf, lane), a = ig - bcum, pmax = wave_incl_max(a, lane);
    const float* sc = (const float*)(ws + WS_ML_SC) + (size_t)it * 4;
    const float mst = sc[2];
    const float mt_ = bcum + fmaxf(pmax, mst);
    const float inter_l = expf(bcum + mst - mt_), emm_l = expf(-mt_), bm_l = bcum - mt_;
    stage64(HB, tok0, HB_ML_V + h * 64, buf, lane);
    Frag kf[4][2];
#pragma unroll
    for (int t = 0; t < 4; ++t)
#pragma unroll
        for (int ks = 0; ks < 2; ++ks) kf[t][ks].u = *(const v4u*)(HB + (size_t)(tok0 + t * 16 + fr) * HBP + HB_ML_K + h * 64 + ks * 32 + fq * 8);
    float as_[4][4];
#pragma unroll
    for (int mt = 0; mt < 4; ++mt)
#pragma unroll
        for (int i = 0; i < 4; ++i) as_[mt][i] = __shfl(a, mt * 16 + fq * 4 + i);
    const float* Cst = (const float*)(ws + WS_ML_C) + (size_t)it * 4096; const float* Nst = (const float*)(ws + WS_ML_N) + (size_t)it * 64;
    const float* ng = opaque(args.in[I_ML_NG] + l * 256) + h * 64;
    for (int nt = 0; nt < 4; ++nt) {
        const int tl = nt * 16 + fr;
        const float bm = __shfl(bm_l, tl), inter = __shfl(inter_l, tl), emm = __shfl(emm_l, tl);
        Frag q0, q1;
        q0.u = *(const v4u*)(HB + (size_t)(tok0 + tl) * HBP + HB_ML_Q + h * 64 + fq * 8); q1.u = *(const v4u*)(HB + (size_t)(tok0 + tl) * HBP + HB_ML_Q + h * 64 + 32 + fq * 8);
        f32x4 st[4]; float den = 0.f;
#pragma unroll
        for (int mt = 0; mt < 4; ++mt) { st[mt] = (f32x4){0.f, 0.f, 0.f, 0.f}; st[mt] = mfma16(kf[mt][0].v, q0.v, st[mt]); st[mt] = mfma16(kf[mt][1].v, q1.v, st[mt]);
#pragma unroll
            for (int i = 0; i < 4; ++i) { const int s = mt * 16 + fq * 4 + i; const float d = (s <= tl) ? expf(bm + as_[mt][i]) : 0.f; st[mt][i] = st[mt][i] * 0.125f * d; den += st[mt][i]; } }
        den = red4_sum(den);
        Frag pf[2];
#pragma unroll
        for (int k2 = 0; k2 < 2; ++k2) { pf[k2].w[0] = pk2(st[2 * k2][0], st[2 * k2][1]); pf[k2].w[1] = pk2(st[2 * k2][2], st[2 * k2][3]); pf[k2].w[2] = pk2(st[2 * k2 + 1][0], st[2 * k2 + 1][1]); pf[k2].w[3] = pk2(st[2 * k2 + 1][2], st[2 * k2 + 1][3]); }
        float nq = 0.f;
#pragma unroll
        for (int j = 0; j < 4; ++j) { nq += Nst[fq * 8 + 2 * j] * bflo(q0.w[j]) + Nst[fq * 8 + 2 * j + 1] * bfhi(q0.w[j]); nq += Nst[32 + fq * 8 + 2 * j] * bflo(q1.w[j]) + Nst[32 + fq * 8 + 2 * j + 1] * bfhi(q1.w[j]); }
        nq = red4_sum(nq);
        const float dent = den + inter * nq; const float rden = 1.0f / fmaxf(fabsf(dent), emm);
        f32x4 hv[4]; float ss = 0.f;
#pragma unroll
        for (int et = 0; et < 4; ++et) {
            f32x4 num = {0.f, 0.f, 0.f, 0.f}, cq = {0.f, 0.f, 0.f, 0.f};
#pragma unroll
            for (int k2 = 0; k2 < 2; ++k2) { Frag va; const int e = et * 16 + fr;
#pragma unroll
                for (int j = 0; j < 4; ++j) { const int sa = (2 * k2 + (j >> 1)) * 16 + fq * 4 + 2 * (j & 1); va.w[j] = (unsigned)buf[sa * 72 + e] | ((unsigned)buf[(sa + 1) * 72 + e] << 16); }
                num = mfma16(va.v, pf[k2].v, num); }
#pragma unroll
            for (int ks = 0; ks < 2; ++ks) { const float* cp = Cst + (size_t)(et * 16 + fr) * 64 + ks * 32 + fq * 8; const f32x4 c0 = *(const f32x4*)cp, c1 = *(const f32x4*)(cp + 4);
                Frag ca; ca.w[0] = pk2(c0[0], c0[1]); ca.w[1] = pk2(c0[2], c0[3]); ca.w[2] = pk2(c1[0], c1[1]); ca.w[3] = pk2(c1[2], c1[3]);
                cq = mfma16(ca.v, ks == 0 ? q0.v : q1.v, cq); }
            const v2u ogw = *(const v2u*)(HB + (size_t)(tok0 + tl) * HBP + HB_ML_OG + h * 64 + et * 16 + fq * 4);
            const float og[4] = {bflo(ogw.x), bfhi(ogw.x), bflo(ogw.y), bfhi(ogw.y)};
#pragma unroll
            for (int i = 0; i < 4; ++i) { const float hval = (num[i] + inter * cq[i]) * rden; const float o = hval / (1.0f + expf(-og[i])); hv[et][i] = o; ss += o * o; }
        }
        ss = red4_sum(ss);
        const float rn = 1.0f / sqrtf(ss * (1.f / 64.f) + NORM_EPS);
        bf16* orow = XN + (size_t)(tok0 + tl) * DM + 256 + h * 64 + fq * 4;
#pragma unroll
        for (int et = 0; et < 4; ++et) { const float* gp = ng + et * 16 + fq * 4; v2u w; w.x = pk2(hv[et][0] * rn * gp[0], hv[et][1] * rn * gp[1]); w.y = pk2(hv[et][2] * rn * gp[2], hv[et][3] * rn * gp[3]); *(v2u*)(orow + et * 16) = w; }
    }
    LDS_WAIT();
}

__device__ __forceinline__ float silu_f(float x) { return x / (1.0f + expf(-x)); }
template <int NORM>
__device__ __forceinline__ void gdn_conv_chunk(const bf16* HB, int tok0, bool first, int col0, const float* cw, int ch0, float nscale, LAS bf16* buf, int lane) {
#pragma unroll
    for (int i = 0; i < 9; ++i) { const int idx = i * 64 + lane, r = idx >> 3, c8 = idx & 7;
        if (idx < 67 * 8) { v4u v = {0u, 0u, 0u, 0u}; if (!(first && r < 3)) v = *(const v4u*)(HB + (size_t)(tok0 - 3 + r) * HBP + col0 + c8 * 8); *(LAS v4u*)(buf + r * 72 + c8 * 8) = v; } }
    LDS_WAIT();
    const float w0 = cw[ch0 + lane], w1 = cw[768 + ch0 + lane], w2 = cw[1536 + ch0 + lane], w3 = cw[2304 + ch0 + lane];
    float xm3 = bf2f(buf[0 * 72 + lane]), xm2 = bf2f(buf[1 * 72 + lane]), xm1 = bf2f(buf[2 * 72 + lane]);
#pragma unroll 4
    for (int t = 0; t < 64; ++t) {
        const float x0 = bf2f(buf[(t + 3) * 72 + lane]);
        float o = silu_f(w0 * xm3 + w1 * xm2 + w2 * xm1 + w3 * x0);
        xm3 = xm2; xm2 = xm1; xm1 = x0;
        if (NORM) { const float ss = wave_sum(o * o); o *= nscale / sqrtf(ss + NORM_EPS); }
        buf[t * 72 + lane] = (bf16)f2bf(o);
    }
    LDS_WAIT();
}
__device__ __forceinline__ void gdn_prep_item(int it, int l, const Args& args, LAS unsigned char* wlds, int lane) {
    unsigned char* ws = args.ws; const bf16* HB = (const bf16*)(ws + WS_HB);
    const int bh = it >> 7, n = it & 127, b = bh >> 2, h = bh & 3, tok0 = b * SEQ + n * 64, fr = lane & 15, fq = lane >> 4;
    LAS bf16* buf = (LAS bf16*)wlds; LAS float* sg = (LAS float*)(wlds + 16384);
    const float* cw = opaque(args.in[I_GD_CONV] + (size_t)l * 4 * 768);
    const float alog = opaque(args.in[I_GD_ALOG] + l * 4)[h], dtb = opaque(args.in[I_GD_DT] + l * 4)[h];
    const float beta_l = 1.0f / (1.0f + expf(-bf2f(HB[(size_t)(tok0 + lane) * HBP + HB_GD_BETA + h])));
    const float apre = bf2f(HB[(size_t)(tok0 + lane) * HBP + HB_GD_A + h]) + dtb;
    const float sp = fmaxf(apre, 0.f) + log1pf(expf(-fabsf(apre)));
    const float gc_l = wave_incl_sum(-expf(alog) * sp, lane);
    const float gend = __shfl(gc_l, 63);
    sg[lane] = gc_l; sg[64 + lane] = beta_l; sg[128 + lane] = expf(gc_l);
    LDS_WAIT();
    const size_t cb = (size_t)it * 4096;
    bf16* Wo = (bf16*)(ws + WS_GD_W) + cb; bf16* UTo = (bf16*)(ws + WS_GD_UT) + cb; bf16* KDTo = (bf16*)(ws + WS_GD_KDT) + cb; bf16* QDo = (bf16*)(ws + WS_GD_QD) + cb; bf16* AQKo = (bf16*)(ws + WS_GD_AQK) + cb;
    gdn_conv_chunk<1>(HB, tok0, n == 0, HB_GD_K + h * 64, cw, 256 + h * 64, 1.0f, buf, lane);
#pragma unroll
    for (int t8 = 0; t8 < 8; ++t8) { v4u o;
#pragma unroll
        for (int j = 0; j < 4; ++j) { const int t = t8 * 8 + 2 * j; o[j] = pk2(bf2f(buf[t * 72 + lane]) * expf(gend - sg[t]), bf2f(buf[(t + 1) * 72 + lane]) * expf(gend - sg[t + 1])); }
        *(v4u*)(KDTo + lane * 64 + t8 * 8) = o; }
    Frag kf[4][2];
#pragma unroll
    for (int t = 0; t < 4; ++t)
#pragma unroll
        for (int ks = 0; ks < 2; ++ks) kf[t][ks].u = *(const LAS v4u*)(buf + (t * 16 + fr) * 72 + ks * 32 + fq * 8);
    LDS_WAIT();
    gdn_conv_chunk<1>(HB, tok0, n == 0, HB_GD_Q + h * 64, cw, h * 64, 0.125f, buf, lane);
#pragma unroll 8
    for (int t = 0; t < 64; ++t) QDo[t * 64 + lane] = (bf16)f2bf(bf2f(buf[t * 72 + lane]) * sg[128 + t]);
    float gci[4][4], gcj[4];
#pragma unroll
    for (int mt = 0; mt < 4; ++mt)
#pragma unroll
        for (int ii = 0; ii < 4; ++ii) gci[mt][ii] = sg[mt * 16 + fq * 4 + ii];
#pragma unroll
    for (int nt = 0; nt < 4; ++nt) gcj[nt] = sg[nt * 16 + fr];
#pragma unroll
    for (int mt = 0; mt < 4; ++mt) {
        Frag q0, q1; q0.u = *(const LAS v4u*)(buf + (mt * 16 + fr) * 72 + fq * 8); q1.u = *(const LAS v4u*)(buf + (mt * 16 + fr) * 72 + 32 + fq * 8);
#pragma unroll
        for (int nt = 0; nt < 4; ++nt) { f32x4 acc = {0.f, 0.f, 0.f, 0.f};
            if (nt <= mt) { acc = mfma16(q0.v, kf[nt][0].v, acc); acc = mfma16(q1.v, kf[nt][1].v, acc); }
#pragma unroll
            for (int ii = 0; ii < 4; ++ii) { const int i = mt * 16 + fq * 4 + ii, j = nt * 16 + fr; const float vv = (nt <= mt && i >= j) ? acc[ii] * expf(gci[mt][ii] - gcj[nt]) : 0.f; AQKo[i * 64 + j] = (bf16)f2bf(vv); } } }
    LDS_WAIT();
    gdn_conv_chunk<0>(HB, tok0, n == 0, HB_GD_V + h * 64, cw, 512 + h * 64, 1.0f, buf, lane);
    LAS float* Xl = (LAS float*)wlds;
    { float xx[64];
#pragma unroll
      for (int t = 0; t < 64; ++t) xx[t] = bf2f(buf[t * 72 + lane]) * sg[64 + t];
      LDS_WAIT();
#pragma unroll
      for (int t = 0; t < 64; ++t) Xl[t * 64 + lane] = xx[t]; }
    float am[4][4][4];
#define GDN_SOLVE() do { _Pragma("unroll") for (int mt = 0; mt < 4; ++mt) { \
        _Pragma("unroll") for (int nt = 0; nt < mt; ++nt) { float xo[16]; \
            _Pragma("unroll") for (int jj = 0; jj < 16; ++jj) xo[jj] = Xl[(nt * 16 + jj) * 64 + lane]; \
            for (int fqp = 0; fqp < 4; ++fqp) { _Pragma("unroll") for (int ii = 0; ii < 4; ++ii) { const int i = mt * 16 + fqp * 4 + ii; float xi = Xl[i * 64 + lane]; \
                const float af = am[mt][nt][ii]; const int av = __builtin_bit_cast(int, af); \
                _Pragma("unroll") for (int jj = 0; jj < 16; ++jj) xi -= __builtin_bit_cast(float, __builtin_amdgcn_readlane(av, fqp * 16 + jj)) * xo[jj]; \
                Xl[i * 64 + lane] = xi; } } } \
        { float xd[16]; \
          _Pragma("unroll") for (int r = 0; r < 16; ++r) xd[r] = Xl[(mt * 16 + r) * 64 + lane]; \
          _Pragma("unroll") for (int r = 1; r < 16; ++r) { const float af = am[mt][mt][r & 3]; const int av = __builtin_bit_cast(int, af); \
              _Pragma("unroll") for (int jj = 0; jj < r; ++jj) xd[r] -= __builtin_bit_cast(float, __builtin_amdgcn_readlane(av, (r >> 2) * 16 + jj)) * xd[jj]; } \
          _Pragma("unroll") for (int r = 1; r < 16; ++r) Xl[(mt * 16 + r) * 64 + lane] = xd[r]; } } } while (0)
#pragma unroll
    for (int mt = 0; mt < 4; ++mt)
#pragma unroll
        for (int nt = 0; nt < 4; ++nt) { f32x4 acc = {0.f, 0.f, 0.f, 0.f};
            if (nt <= mt) { acc = mfma16(kf[mt][0].v, kf[nt][0].v, acc); acc = mfma16(kf[mt][1].v, kf[nt][1].v, acc); }
#pragma unroll
            for (int ii = 0; ii < 4; ++ii) { const int i = mt * 16 + fq * 4 + ii, j = nt * 16 + fr; am[mt][nt][ii] = (nt <= mt && i > j) ? acc[ii] * sg[64 + i] * expf(gci[mt][ii] - gcj[nt]) : 0.f; } }
    asm volatile("" ::: "memory");
    GDN_SOLVE();
#pragma unroll
    for (int t8 = 0; t8 < 8; ++t8) { v4u o;
#pragma unroll
        for (int j = 0; j < 4; ++j) o[j] = pk2(Xl[(t8 * 8 + 2 * j) * 64 + lane], Xl[(t8 * 8 + 2 * j + 1) * 64 + lane]);
        *(v4u*)(UTo + lane * 64 + t8 * 8) = o; }
    LDS_WAIT();
    gdn_conv_chunk<1>(HB, tok0, n == 0, HB_GD_K + h * 64, cw, 256 + h * 64, 1.0f, buf, lane);
    { float xx[64];
#pragma unroll
      for (int t = 0; t < 64; ++t) xx[t] = bf2f(buf[t * 72 + lane]) * sg[64 + t] * sg[128 + t];
      LDS_WAIT();
#pragma unroll
      for (int t = 0; t < 64; ++t) Xl[t * 64 + lane] = xx[t]; }
#pragma unroll
    for (int mt = 0; mt < 4; ++mt)
#pragma unroll
        for (int nt = 0; nt < 4; ++nt) { f32x4 acc = {0.f, 0.f, 0.f, 0.f};
            if (nt <= mt) { acc = mfma16(kf[mt][0].v, kf[nt][0].v, acc); acc = mfma16(kf[mt][1].v, kf[nt][1].v, acc); }
#pragma unroll
            for (int ii = 0; ii < 4; ++ii) { const int i = mt * 16 + fq * 4 + ii, j = nt * 16 + fr; am[mt][nt][ii] = (nt <= mt && i > j) ? acc[ii] * sg[64 + i] * expf(gci[mt][ii] - gcj[nt]) : 0.f; } }
    asm volatile("" ::: "memory");
    GDN_SOLVE();
#pragma unroll 8
    for (int t = 0; t < 64; ++t) Wo[t * 64 + lane] = (bf16)f2bf(Xl[t * 64 + lane]);
    ((float*)(ws + WS_GD_GE))[it] = expf(gend);
    LDS_WAIT();
}
__device__ __forceinline__ void gdn_scan_item(int it, const Args& args, int lane) {
    unsigned char* ws = args.ws; const int bh = it >> 2, vg = it & 3, fr = lane & 15, fq = lane >> 4;
    const bf16* Wb = (const bf16*)(ws + WS_GD_W); const bf16* UTb = (const bf16*)(ws + WS_GD_UT); const bf16* KDTb = (const bf16*)(ws + WS_GD_KDT);
    bf16* STb = (bf16*)(ws + WS_GD_ST); bf16* VNTb = (bf16*)(ws + WS_GD_VNT); const float* GE = (const float*)(ws + WS_GD_GE);
    f32x4 S[4];
#pragma unroll
    for (int mt = 0; mt < 4; ++mt) S[mt] = (f32x4){0.f, 0.f, 0.f, 0.f};
#define GDN_SCAN_LOAD(AW, AKD, UTV, GEV, nn) do { const size_t cb_ = (size_t)(bh * 128 + (nn)) * 4096; _Pragma("unroll") for (int mt = 0; mt < 4; ++mt) { _Pragma("unroll") for (int s = 0; s < 2; ++s) { \
        const bf16* wp = Wb + cb_ + (mt * 16 + fr) * 64 + (2 * s) * 16 + fq * 4; const v2u a0 = *(const v2u*)wp, a1 = *(const v2u*)(wp + 16); AW[mt][s].w[0] = a0.x; AW[mt][s].w[1] = a0.y; AW[mt][s].w[2] = a1.x; AW[mt][s].w[3] = a1.y; \
        const bf16* kp = KDTb + cb_ + (mt * 16 + fr) * 64 + (2 * s) * 16 + fq * 4; const v2u k0 = *(const v2u*)kp, k1 = *(const v2u*)(kp + 16); AKD[mt][s].w[0] = k0.x; AKD[mt][s].w[1] = k0.y; AKD[mt][s].w[2] = k1.x; AKD[mt][s].w[3] = k1.y; } \
        UTV[mt] = *(const v2u*)(UTb + cb_ + (vg * 16 + fr) * 64 + mt * 16 + fq * 4); } GEV = GE[bh * 128 + (nn)]; } while (0)
    Frag aw[4][2], akd[4][2], awn[4][2], akdn[4][2]; v2u ut[4], utn[4]; float ge, gen;
    GDN_SCAN_LOAD(aw, akd, ut, ge, 0);
    for (int n = 0; n < 128; ++n) {
        const size_t cb = (size_t)(bh * 128 + n) * 4096;
        { const int nn = (n + 1 < 128) ? n + 1 : n; GDN_SCAN_LOAD(awn, akdn, utn, gen, nn); }
        Frag bS[2];
#pragma unroll
        for (int s = 0; s < 2; ++s) { bS[s].w[0] = pk2(S[2 * s][0], S[2 * s][1]); bS[s].w[1] = pk2(S[2 * s][2], S[2 * s][3]); bS[s].w[2] = pk2(S[2 * s + 1][0], S[2 * s + 1][1]); bS[s].w[3] = pk2(S[2 * s + 1][2], S[2 * s + 1][3]); }
#pragma unroll
        for (int mt = 0; mt < 4; ++mt) { v2u o; o.x = pk2(S[mt][0], S[mt][1]); o.y = pk2(S[mt][2], S[mt][3]); *(v2u*)(STb + cb + (vg * 16 + fr) * 64 + mt * 16 + fq * 4) = o; }
        Frag bV[2]; unsigned vnw[4][2];
#pragma unroll
        for (int mt = 0; mt < 4; ++mt) { f32x4 acc = {0.f, 0.f, 0.f, 0.f}; acc = mfma16(aw[mt][0].v, bS[0].v, acc); acc = mfma16(aw[mt][1].v, bS[1].v, acc);
            const float v0 = bflo(ut[mt].x) - acc[0], v1 = bfhi(ut[mt].x) - acc[1], v2 = bflo(ut[mt].y) - acc[2], v3 = bfhi(ut[mt].y) - acc[3];
            vnw[mt][0] = pk2(v0, v1); vnw[mt][1] = pk2(v2, v3);
            v2u o; o.x = vnw[mt][0]; o.y = vnw[mt][1]; *(v2u*)(VNTb + cb + (vg * 16 + fr) * 64 + mt * 16 + fq * 4) = o; }
#pragma unroll
        for (int s = 0; s < 2; ++s) { bV[s].w[0] = vnw[2 * s][0]; bV[s].w[1] = vnw[2 * s][1]; bV[s].w[2] = vnw[2 * s + 1][0]; bV[s].w[3] = vnw[2 * s + 1][1]; }
#pragma unroll
        for (int mt = 0; mt < 4; ++mt) { f32x4 acc = S[mt] * ge; acc = mfma16(akd[mt][0].v, bV[0].v, acc); acc = mfma16(akd[mt][1].v, bV[1].v, acc); S[mt] = acc; }
#pragma unroll
        for (int mt = 0; mt < 4; ++mt) { aw[mt][0] = awn[mt][0]; aw[mt][1] = awn[mt][1]; akd[mt][0] = akdn[mt][0]; akd[mt][1] = akdn[mt][1]; ut[mt] = utn[mt]; }
        ge = gen;
    }
}
__device__ __forceinline__ void gdn_out_item(int it, int l, const Args& args, int lane) {
    unsigned char* ws = args.ws; const bf16* HB = (const bf16*)(ws + WS_HB); bf16* XN = (bf16*)(ws + WS_XN);
    const int bh = it >> 7, n = it & 127, b = bh >> 2, h = bh & 3, tok0 = b * SEQ + n * 64, fr = lane & 15, fq = lane >> 4;
    const size_t cb = (size_t)it * 4096;
    const bf16* ST = (const bf16*)(ws + WS_GD_ST) + cb; const bf16* VNT = (const bf16*)(ws + WS_GD_VNT) + cb; const bf16* QD = (const bf16*)(ws + WS_GD_QD) + cb; const bf16* AQK = (const bf16*)(ws + WS_GD_AQK) + cb;
    const float* ng = opaque(args.in[I_GD_NG] + l * 64);
    Frag sa[4][2], va[4][2];
#pragma unroll
    for (int vt = 0; vt < 4; ++vt)
#pragma unroll
        for (int ks = 0; ks < 2; ++ks) { sa[vt][ks].u = *(const v4u*)(ST + (vt * 16 + fr) * 64 + ks * 32 + fq * 8); va[vt][ks].u = *(const v4u*)(VNT + (vt * 16 + fr) * 64 + ks * 32 + fq * 8); }
    for (int lt = 0; lt < 4; ++lt) {
        const int tl = lt * 16 + fr;
        Frag qb[2], ab[2];
#pragma unroll
        for (int ks = 0; ks < 2; ++ks) { qb[ks].u = *(const v4u*)(QD + tl * 64 + ks * 32 + fq * 8); ab[ks].u = *(const v4u*)(AQK + tl * 64 + ks * 32 + fq * 8); }
        f32x4 o[4]; float ss = 0.f;
#pragma unroll
        for (int vt = 0; vt < 4; ++vt) { f32x4 acc = {0.f, 0.f, 0.f, 0.f};
#pragma unroll
            for (int ks = 0; ks < 2; ++ks) { acc = mfma16(sa[vt][ks].v, qb[ks].v, acc); acc = mfma16(va[vt][ks].v, ab[ks].v, acc); }
            o[vt] = acc; ss += acc[0] * acc[0] + acc[1] * acc[1] + acc[2] * acc[2] + acc[3] * acc[3]; }
        ss = red4_sum(ss);
        const float rn = 1.0f / sqrtf(ss * (1.f / 64.f) + NORM_EPS);
        bf16* orow = XN + (size_t)(tok0 + tl) * DM + 512 + h * 64 + fq * 4;
#pragma unroll
        for (int vt = 0; vt < 4; ++vt) { const v2u zw = *(const v2u*)(HB + (size_t)(tok0 + tl) * HBP + HB_GD_Z + h * 64 + vt * 16 + fq * 4);
            const float* gp = ng + vt * 16 + fq * 4;
            v2u w; w.x = pk2(o[vt][0] * rn * gp[0] * silu_f(bflo(zw.x)), o[vt][1] * rn * gp[1] * silu_f(bfhi(zw.x))); w.y = pk2(o[vt][2] * rn * gp[2] * silu_f(bflo(zw.y)), o[vt][3] * rn * gp[3] * silu_f(bfhi(zw.y)));
            *(v2u*)(orow + vt * 16) = w; }
    }
}

__device__ __forceinline__ void nsa_cmp_item(int it2, int l, const Args& args, int lane) {
    unsigned char* ws = args.ws; const bf16* HB = (const bf16*)(ws + WS_HB);
    const int it = it2 >> 1, nh = (it2 & 1) * 2;
    const int b = it >> 6, kind = (it >> 5) & 1, jt = it & 31, fr = lane & 15, fq = lane >> 4;
    const bf16* wt = opaque((const bf16*)(ws + WS_WSM + l * WSM_L + (kind ? WSM_CV : WSM_CK)));
    const float* pos = opaque(args.in[I_CMPPOS] + l * 2048);
    const int j = jt * 16 + fr, col = kind ? HB_NSA_VC : HB_NSA_KC;
    f32x4 acc[2];
#pragma unroll
    for (int nt = 0; nt < 2; ++nt) acc[nt] = (f32x4){0.f, 0.f, 0.f, 0.f};
#pragma unroll 4
    for (int ks = 0; ks < 64; ++ks) {
        const int i = ks >> 1, d0 = (ks & 1) * 32 + fq * 8;
        Frag a; a.u = (v4u){0u, 0u, 0u, 0u};
        if (j < 511) { const v4u x = *(const v4u*)(HB + (size_t)(b * SEQ + 16 * j + i) * HBP + col + d0); const float* pp = pos + i * 64 + d0;
#pragma unroll
            for (int q = 0; q < 4; ++q) a.w[q] = pk2(bflo(x[q]) + pp[2 * q], bfhi(x[q]) + pp[2 * q + 1]); }
#pragma unroll
        for (int nt = 0; nt < 2; ++nt) { Frag bw; bw.u = *(const v4u*)(wt + (size_t)((nh + nt) * 16 + fr) * 2048 + ks * 32 + fq * 8); acc[nt] = mfma16(a.v, bw.v, acc[nt]); }
    }
    if (kind == 0) { bf16* Ko = (bf16*)(ws + WS_NSA_KCMP) + (size_t)b * 512 * 64;
#pragma unroll
        for (int nt = 0; nt < 2; ++nt)
#pragma unroll
            for (int i = 0; i < 4; ++i) Ko[(jt * 16 + fq * 4 + i) * 64 + (nh + nt) * 16 + fr] = (bf16)f2bf(acc[nt][i]);
    } else { bf16* Vo = (bf16*)(ws + WS_NSA_VCMPT) + (size_t)b * 64 * 512;
#pragma unroll
        for (int nt = 0; nt < 2; ++nt) { v2u o; o.x = pk2(acc[nt][0], acc[nt][1]); o.y = pk2(acc[nt][2], acc[nt][3]); *(v2u*)(Vo + ((nh + nt) * 16 + fr) * 512 + jt * 16 + fq * 4) = o; } }
}
__device__ __forceinline__ void nsa_vt_item(int it, int l, const Args& args, LAS unsigned char* wlds, int lane) {
    unsigned char* ws = args.ws; const bf16* HB = (const bf16*)(ws + WS_HB);
    const int b = it >> 8, which = (it >> 7) & 1, n = it & 127;
    LAS bf16* buf = (LAS bf16*)wlds;
    stage64(HB, b * SEQ + n * 64, which ? HB_NSA_VW : HB_NSA_VS, buf, lane);
    if (which) {
        const int fr = lane & 15, fq = lane >> 4;
        bf16* vdst = (bf16*)(ws + WS_NSA_VWT) + ((size_t)(b * 256 + n * 2) * 4) * 512 + lane * 8;
        bf16* kdst = (bf16*)(ws + WS_WIN + l * WIN_L) + ((size_t)(b * 256 + n * 2) * 4) * 512 + lane * 8;
#pragma unroll
        for (int hb = 0; hb < 2; ++hb)
#pragma unroll
            for (int dt = 0; dt < 4; ++dt) { v4u o;
#pragma unroll
                for (int q = 0; q < 2; ++q) {
                    o[q] = (unsigned)buf[(hb * 32 + fq * 4 + 2 * q) * 72 + dt * 16 + fr] | ((unsigned)buf[(hb * 32 + fq * 4 + 2 * q + 1) * 72 + dt * 16 + fr] << 16);
                    o[2 + q] = (unsigned)buf[(hb * 32 + 16 + fq * 4 + 2 * q) * 72 + dt * 16 + fr] | ((unsigned)buf[(hb * 32 + 16 + fq * 4 + 2 * q + 1) * 72 + dt * 16 + fr] << 16); }
                *(v4u*)(vdst + (hb * 4 + dt) * 512) = o; }
#pragma unroll
        for (int hb = 0; hb < 2; ++hb)
#pragma unroll
            for (int tt = 0; tt < 2; ++tt)
#pragma unroll
                for (int ks = 0; ks < 2; ++ks) { const v4u x = *(const v4u*)(HB + (size_t)(b * SEQ + n * 64 + hb * 32 + tt * 16 + fr) * HBP + HB_NSA_KW + ks * 32 + fq * 8); *(v4u*)(kdst + (hb * 4 + tt * 2 + ks) * 512) = x; }
    } else {
        const int fr = lane & 15, fq = lane >> 4;
        bf16* vdst = (bf16*)(ws + WS_NSA_VST) + ((size_t)(b * 128 + n) * 8) * 512 + lane * 8;
        bf16* kdst = (bf16*)(ws + WS_NSA_KSW) + ((size_t)(b * 128 + n) * 8) * 512 + lane * 8;
#pragma unroll
        for (int dt = 0; dt < 4; ++dt)
#pragma unroll
            for (int k2 = 0; k2 < 2; ++k2) { v4u o;
#pragma unroll
                for (int q = 0; q < 2; ++q) {
                    o[q] = (unsigned)buf[(k2 * 32 + fq * 4 + 2 * q) * 72 + dt * 16 + fr] | ((unsigned)buf[(k2 * 32 + fq * 4 + 2 * q + 1) * 72 + dt * 16 + fr] << 16);
                    o[2 + q] = (unsigned)buf[(k2 * 32 + 16 + fq * 4 + 2 * q) * 72 + dt * 16 + fr] | ((unsigned)buf[(k2 * 32 + 16 + fq * 4 + 2 * q + 1) * 72 + dt * 16 + fr] << 16); }
                *(v4u*)(vdst + (dt * 2 + k2) * 512) = o; }
#pragma unroll
        for (int kt = 0; kt < 4; ++kt)
#pragma unroll
            for (int ks = 0; ks < 2; ++ks) { const v4u x = *(const v4u*)(HB + (size_t)(b * SEQ + n * 64 + kt * 16 + fr) * HBP + HB_NSA_KS + ks * 32 + fq * 8); *(v4u*)(kdst + (kt * 2 + ks) * 512) = x; }
    }
    LDS_WAIT();
}
__device__ __forceinline__ void nsa_lut_init(const float* t5, LAS float* lut, int lane) {
#pragma unroll
    for (int r = 0; r < 2; ++r) { const int k = r * 64 + lane, d = (k > 0) ? k - 1 : 0; int bk = d;
        if (d >= 16) { bk = 16 + (int)(logf((float)d / 16.0f) / 2.0794415f * 16.0f); bk = bk < 31 ? bk : 31; }
#pragma unroll
        for (int h = 0; h < 4; ++h) lut[h * 128 + k] = (k > 0) ? t5[bk * 4 + h] : -1e30f; }
    LDS_WAIT();
}
#define NSA_BIAS(dist, h, b31v) (lut[(h) * 128 + (((dist) < -1) ? 0 : (((dist) > 126) ? 127 : (dist) + 1))])
__device__ __forceinline__ void nsa_item(int b, int qt, int l, const Args& args, LAS unsigned char* wlds, int lane) {
    unsigned char* ws = args.ws; const bf16* HB = (const bf16*)(ws + WS_HB); bf16* XN = (bf16*)(ws + WS_XN);
    const int t0 = qt * 16, tok0 = b * SEQ + t0, cur = t0 >> 6, fr = lane & 15, fq = lane >> 4;
    LAS bf16* outb = (LAS bf16*)(wlds + 8192); LAS float* imp = (LAS float*)wlds; const LAS float* lut = (const LAS float*)(wlds + 16384);
    const float* t5 = opaque(args.in[I_T5]);
    const float L2E = 1.4426950408889634f;
    Frag qa[4][2];
#pragma unroll
    for (int h = 0; h < 4; ++h)
#pragma unroll
        for (int ks = 0; ks < 2; ++ks) qa[h][ks].u = *(const v4u*)(HB + (size_t)(tok0 + fr) * HBP + HB_NSA_Q + h * 64 + ks * 32 + fq * 8);
    const int tq = t0 + fr;
#pragma unroll
    for (int i = 0; i < 32; ++i) imp[i * 64 + lane] = 0.f;
    const bf16* KC = (const bf16*)(ws + WS_NSA_KCMP) + (size_t)b * 512 * 64; const bf16* VCT = (const bf16*)(ws + WS_NSA_VCMPT) + (size_t)b * 64 * 512;
    const int nblk = t0 >> 4, npair = (nblk + 31) >> 5;
    float mc[4], lc[4];
#pragma unroll
    for (int h = 0; h < 4; ++h) { mc[h] = -1e30f; lc[h] = 0.f; }
    Frag kc1[2];
#pragma unroll
    for (int ks = 0; ks < 2; ++ks) kc1[ks].u = *(const v4u*)(KC + (size_t)fr * 64 + ks * 32 + fq * 8);
    for (int kt = 0; kt < 2 * npair; ++kt) {
        Frag kf[2], kn1[2];
        { const int ktn = (kt + 1 < 2 * npair) ? kt + 1 : kt;
#pragma unroll
          for (int ks = 0; ks < 2; ++ks) kn1[ks].u = *(const v4u*)(KC + (size_t)(ktn * 16 + fr) * 64 + ks * 32 + fq * 8); }
        kf[0].u = kc1[0].u; kf[1].u = kc1[1].u;
#pragma unroll
        for (int h = 0; h < 4; ++h) { f32x4 acc = {0.f, 0.f, 0.f, 0.f}; acc = mfma16(kf[0].v, qa[h][0].v, acc); acc = mfma16(kf[1].v, qa[h][1].v, acc);
            float s[4]; float mx = -1e30f;
#pragma unroll
            for (int i = 0; i < 4; ++i) { const int dist = tq - (16 * (kt * 16 + fq * 4 + i) + 31); const float bb = NSA_BIAS(dist, h, 0); s[i] = acc[i] * 0.125f + bb; mx = fmaxf(mx, s[i]); }
            mx = red4_max(mx);
            const float mn = fmaxf(mc[h], mx); float ps = 0.f;
#pragma unroll
            for (int i = 0; i < 4; ++i) ps += __builtin_amdgcn_exp2f(__builtin_fmaf(s[i], L2E, -fmaxf(mn, -1e20f) * L2E));
            lc[h] = lc[h] * __builtin_amdgcn_exp2f((mc[h] - mn) * L2E) + ps; mc[h] = mn; }
        kc1[0].u = kn1[0].u; kc1[1].u = kn1[1].u;
    }
#pragma unroll
    for (int h = 0; h < 4; ++h) { float t = lc[h]; t = red4_sum(t); lc[h] = (t > 0.f) ? 1.0f / t : 0.f; }
    f32x4 oc[4][4];
#pragma unroll
    for (int dt = 0; dt < 4; ++dt)
#pragma unroll
        for (int h = 0; h < 4; ++h) oc[dt][h] = (f32x4){0.f, 0.f, 0.f, 0.f};
    for (int kp = 0; kp < npair; ++kp) {
        unsigned pw[4][4];
#pragma unroll
        for (int tt = 0; tt < 2; ++tt) { const int kt = kp * 2 + tt; Frag kf[2];
#pragma unroll
            for (int ks = 0; ks < 2; ++ks) kf[ks].u = *(const v4u*)(KC + (size_t)(kt * 16 + fr) * 64 + ks * 32 + fq * 8);
            float impv = 0.f;
#pragma unroll
            for (int h = 0; h < 4; ++h) { f32x4 acc = {0.f, 0.f, 0.f, 0.f}; acc = mfma16(kf[0].v, qa[h][0].v, acc); acc = mfma16(kf[1].v, qa[h][1].v, acc);
                float p[4];
#pragma unroll
                for (int i = 0; i < 4; ++i) { const int dist = tq - (16 * (kt * 16 + fq * 4 + i) + 31);
                    const float bb = NSA_BIAS(dist, h, 0); p[i] = __builtin_amdgcn_exp2f(__builtin_fmaf(acc[i] * 0.125f + bb, L2E, -fmaxf(mc[h], -1e20f) * L2E)) * lc[h]; }
                impv += p[0] + p[1] + p[2];
                pw[h][2 * tt] = pk2(p[0], p[1]); pw[h][2 * tt + 1] = pk2(p[2], p[3]); }
            imp[fr * 128 + kt * 4 + fq] = impv; __builtin_amdgcn_sched_barrier(0); }
#pragma unroll
        for (int dt = 0; dt < 4; ++dt) { const bf16* vp = VCT + (size_t)(dt * 16 + fr) * 512 + kp * 32 + fq * 4; const v2u lo2 = *(const v2u*)vp, hi2 = *(const v2u*)(vp + 16);
            Frag vf; vf.w[0] = lo2.x; vf.w[1] = lo2.y; vf.w[2] = hi2.x; vf.w[3] = hi2.y;
#pragma unroll
            for (int h = 0; h < 4; ++h) { Frag pf; pf.w[0] = pw[h][0]; pf.w[1] = pw[h][1]; pf.w[2] = pw[h][2]; pf.w[3] = pw[h][3]; oc[dt][h] = mfma16(vf.v, pf.v, oc[dt][h]); } }
    }
#pragma unroll
    for (int h = 0; h < 4; ++h) { const float gc_ = 1.0f / (1.0f + expf(-bf2f(HB[(size_t)(tok0 + fr) * HBP + HB_NSA_G + 0 + h])));
#pragma unroll
        for (int dt = 0; dt < 4; ++dt) { v2u w; w.x = pk2(oc[dt][h][0] * gc_, oc[dt][h][1] * gc_); w.y = pk2(oc[dt][h][2] * gc_, oc[dt][h][3] * gc_); *(LAS v2u*)(outb + fr * 256 + h * 64 + dt * 16 + fq * 4) = w; } }
    LDS_WAIT();
    unsigned taken = 0u;
    if (cur >= 16) {
        float cand[32];
#pragma unroll
        for (int k = 0; k < 32; ++k) { const int s = fq * 32 + k; cand[k] = (s >= 1 && s <= cur - 2) ? imp[fr * 128 + s] : -1.0f; }
        for (int r = 0; r < 13; ++r) {
            float bv = -1.0f; int bk = 0;
#pragma unroll
            for (int k = 0; k < 32; ++k) { const bool free_ = ((taken >> k) & 1u) == 0u; if (free_ && cand[k] > bv) { bv = cand[k]; bk = k; } }
            int bs = fq * 32 + bk;
#pragma unroll
            for (int o = 16; o <= 32; o <<= 1) { const float ov = __shfl_xor(bv, o); const int os = __shfl_xor(bs, o); if (ov > bv || (ov == bv && os < bs)) { bv = ov; bs = os; } }
            taken |= ((bs >> 5) == fq && bv >= 0.f) ? (1u << (bs & 31)) : 0u;
        }
        taken |= (fq == 0) ? 1u : 0u;
        taken |= ((cur >> 5) == fq) ? (1u << (cur & 31)) : 0u;
        taken |= (((cur - 1) >> 5) == fq) ? (1u << ((cur - 1) & 31)) : 0u;
    } else {
        taken = (fq == 0) ? ((2u << cur) - 1u) : 0u;
    }
    LDS_WAIT();
    const bf16* VST = (const bf16*)(ws + WS_NSA_VST) + (size_t)b * 128 * 4096; const bf16* KSW = (const bf16*)(ws + WS_NSA_KSW) + (size_t)b * 128 * 4096;
    { const int qi = fr >> 2, hh = fr & 3;
      LAS unsigned char* blist = (LAS unsigned char*)wlds;
#define NSA_SEL_LOADK(KF, sblk_) do { const bf16* kp_ = KSW + (size_t)(sblk_) * 4096 + lane * 8; \
        _Pragma("unroll") for (int kt = 0; kt < 4; ++kt) _Pragma("unroll") for (int ks = 0; ks < 2; ++ks) KF[kt][ks].u = *(const v4u*)(kp_ + (kt * 2 + ks) * 512); } while (0)
#define NSA_SEL_LOADV(VF, sblk_) do { const bf16* vp_ = VST + (size_t)(sblk_) * 4096 + lane * 8; \
        _Pragma("unroll") for (int dt = 0; dt < 4; ++dt) _Pragma("unroll") for (int k2 = 0; k2 < 2; ++k2) VF[dt][k2].u = *(const v4u*)(vp_ + (dt * 2 + k2) * 512); } while (0)
#define NSA_SEL_STEP_(KF, VF, sblk_, FAR) do { const int key0 = (sblk_) * 64; const unsigned mwd_ = ((sblk_) >> 5) == 0 ? mw0 : ((sblk_) >> 5) == 1 ? mw1 : ((sblk_) >> 5) == 2 ? mw2 : mw3; const float selm_ = (((mwd_ >> ((sblk_) & 31)) & 1u) != 0u) ? 0.f : -1e30f; \
        f32x4 sc[4]; float mx = -1e30f; const float c0_ = bfar_ + selm_;     \
        _Pragma("unroll") for (int kt = 0; kt < 4; ++kt) { f32x4 acc = {0.f, 0.f, 0.f, 0.f}; acc = mfma16(KF[kt][0].v, qs[0].v, acc); acc = mfma16(KF[kt][1].v, qs[1].v, acc); \
            _Pragma("unroll") for (int i = 0; i < 4; ++i) { if (FAR) sc[kt][i] = acc[i] * 0.125f + c0_; else { const int dist = tqs - (key0 + kt * 16 + fq * 4 + i); const float bb = NSA_BIAS(dist, hh, 0); sc[kt][i] = (acc[i] * 0.125f + bb) + selm_; } mx = fmaxf(mx, sc[kt][i]); } } \
        mx = red4_max(mx); \
        const float mn = fmaxf(ms, mx), alpha = __builtin_amdgcn_exp2f((ms - mn) * L2E), nml_ = -fmaxf(mn, -1e20f) * L2E; ms = mn; \
        float ps = 0.f; unsigned pw[4][2]; \
        _Pragma("unroll") for (int kt = 0; kt < 4; ++kt) { float p[4]; \
            _Pragma("unroll") for (int i = 0; i < 4; ++i) { p[i] = __builtin_amdgcn_exp2f(__builtin_fmaf(sc[kt][i], L2E, nml_)); ps += p[i]; } \
            pw[kt][0] = pk2(p[0], p[1]); pw[kt][1] = pk2(p[2], p[3]); } \
        if (__builtin_amdgcn_ballot_w64(alpha != 1.0f) != 0ull) { ls = ls * alpha; _Pragma("unroll") for (int dt = 0; dt < 4; ++dt) os_[dt] = os_[dt] * alpha; }     \
        ls += ps; \
        _Pragma("unroll") for (int dt = 0; dt < 4; ++dt) { \
            _Pragma("unroll") for (int k2 = 0; k2 < 2; ++k2) { Frag pf; pf.w[0] = pw[2 * k2][0]; pf.w[1] = pw[2 * k2][1]; pf.w[2] = pw[2 * k2 + 1][0]; pf.w[3] = pw[2 * k2 + 1][1]; os_[dt] = mfma16(VF[dt][k2].v, pf.v, os_[dt]); } } } while (0)
#define NSA_SEL_STEP(KF, VF, sblk_) do { if ((sblk_) * 64 + 189 <= t0 + g * 4) NSA_SEL_STEP_(KF, VF, sblk_, 1); else NSA_SEL_STEP_(KF, VF, sblk_, 0); } while (0)
    const float bfar_ = lut[hh * 128 + 127];
    for (int g = 0; g < 4; ++g) {
        const int tqs = t0 + g * 4 + qi;
        Frag qs[2];
#pragma unroll
        for (int ks = 0; ks < 2; ++ks) qs[ks].u = *(const v4u*)(HB + (size_t)(tok0 + g * 4 + qi) * HBP + HB_NSA_Q + hh * 64 + ks * 32 + fq * 8);
        f32x4 os_[4];
#pragma unroll
        for (int dt = 0; dt < 4; ++dt) os_[dt] = (f32x4){0.f, 0.f, 0.f, 0.f};
        float ms = -1e30f, ls = 0.f;
        const unsigned mw0 = (unsigned)__shfl((int)taken, (g * 4 + qi)), mw1 = (unsigned)__shfl((int)taken, (g * 4 + qi) + 16), mw2 = (unsigned)__shfl((int)taken, (g * 4 + qi) + 32), mw3 = (unsigned)__shfl((int)taken, (g * 4 + qi) + 48);
        int nb = 0;
        for (int wd = 0; wd < 4; ++wd) { unsigned uni = 0u;
#pragma unroll
            for (int q2 = 0; q2 < 4; ++q2) uni |= (unsigned)__shfl((int)taken, (g * 4 + q2) + 16 * wd);
            uni = (unsigned)__builtin_amdgcn_readfirstlane((int)uni);
            while (uni) { const int bit = __builtin_ctz(uni); uni &= uni - 1u; blist[nb] = (unsigned char)(wd * 32 + bit); ++nb; } }
        LDS_WAIT();
        Frag kA[4][2], kB[4][2], vv[4][2];
        { const int s0b = __builtin_amdgcn_readfirstlane((int)blist[0]); NSA_SEL_LOADK(kA, s0b); }
        for (int i = 0; i < nb; i += 2) {
            const int sa = __builtin_amdgcn_readfirstlane((int)blist[i]); const int sb = __builtin_amdgcn_readfirstlane((int)blist[(i + 1 < nb) ? i + 1 : i]);
            NSA_SEL_LOADV(vv, sa); NSA_SEL_LOADK(kB, sb);
            NSA_SEL_STEP(kA, vv, sa);
            if (i + 1 < nb) { const int sc2 = __builtin_amdgcn_readfirstlane((int)blist[(i + 2 < nb) ? i + 2 : i]); NSA_SEL_LOADV(vv, sb); NSA_SEL_LOADK(kA, sc2); NSA_SEL_STEP(kB, vv, sb); }
        }
        ls = red4_sum(ls);
        const float gsel = (1.0f / (1.0f + expf(-bf2f(HB[(size_t)(tok0 + g * 4 + qi) * HBP + HB_NSA_G + 4 + hh])))) / ls;
#pragma unroll
        for (int dt = 0; dt < 4; ++dt) { LAS v2u* op = (LAS v2u*)(outb + (g * 4 + qi) * 256 + hh * 64 + dt * 16 + fq * 4); const v2u a = *op; v2u w; w.x = pk2(bflo(a.x) + os_[dt][0] * gsel, bfhi(a.x) + os_[dt][1] * gsel); w.y = pk2(bflo(a.y) + os_[dt][2] * gsel, bfhi(a.y) + os_[dt][3] * gsel); *op = w; }
    } }
    LDS_WAIT();
#pragma unroll
    for (int h = 0; h < 4; ++h)
#pragma unroll
        for (int ks = 0; ks < 2; ++ks) qa[h][ks].u = *(const v4u*)(opaque(HB) + (size_t)(tok0 + fr) * HBP + HB_NSA_Q + h * 64 + ks * 32 + fq * 8);
    const bf16* VWT = (const bf16*)(ws + WS_NSA_VWT) + (size_t)b * 256 * 2048; const bf16* KWW = (const bf16*)(ws + WS_WIN + l * WIN_L) + (size_t)b * 256 * 2048;
    f32x4 ow[4][4];
#pragma unroll
    for (int dt = 0; dt < 4; ++dt)
#pragma unroll
        for (int h = 0; h < 4; ++h) ow[dt][h] = (f32x4){0.f, 0.f, 0.f, 0.f};
    float mw_[4], lw[4];
#pragma unroll
    for (int h = 0; h < 4; ++h) { mw_[h] = -1e30f; lw[h] = 0.f; }
    const int kstart = (t0 >= 512) ? ((t0 - 511) & ~31) : 0;
#define NSA_WIN_LOAD(KF, VF, k0_) do { _Pragma("unroll") for (int tt = 0; tt < 2; ++tt) _Pragma("unroll") for (int ks = 0; ks < 2; ++ks) KF[tt][ks].u = *(const v4u*)(KWW + (size_t)((k0_) >> 5) * 2048 + (tt * 2 + ks) * 512 + lane * 8); \
        _Pragma("unroll") for (int dt = 0; dt < 4; ++dt) VF[dt].u = *(const v4u*)(VWT + (size_t)((k0_) >> 5) * 2048 + dt * 512 + lane * 8); } while (0)
    Frag kf[2][2], vf[4];
    NSA_WIN_LOAD(kf, vf, kstart);
    for (int k0 = kstart; k0 < t0 + 16; k0 += 32) {
        Frag kn[2][2], vn[4];
        { const int k1 = (k0 + 32 < t0 + 16) ? k0 + 32 : k0; NSA_WIN_LOAD(kn, vn, k1); }
#pragma unroll
        for (int h = 0; h < 4; ++h) {
            float s[8]; float mx = -1e30f;
#pragma unroll
            for (int tt = 0; tt < 2; ++tt) { f32x4 acc = {0.f, 0.f, 0.f, 0.f}; acc = mfma16(kf[tt][0].v, qa[h][0].v, acc); acc = mfma16(kf[tt][1].v, qa[h][1].v, acc);
#pragma unroll
                for (int i = 0; i < 4; ++i) { const int dist = tq - (k0 + tt * 16 + fq * 4 + i); const float bb = NSA_BIAS(dist, h, 0); s[tt * 4 + i] = (acc[i] * 0.125f + bb) + ((dist < 512) ? 0.f : -1e30f); mx = fmaxf(mx, s[tt * 4 + i]); } }
            mx = red4_max(mx);
            const float mn = fmaxf(mw_[h], mx), alpha = __builtin_amdgcn_exp2f((mw_[h] - mn) * L2E); mw_[h] = mn;
            float p[8]; float ps = 0.f;
#pragma unroll
            for (int i = 0; i < 8; ++i) { p[i] = __builtin_amdgcn_exp2f(__builtin_fmaf(s[i], L2E, -fmaxf(mn, -1e20f) * L2E)); ps += p[i]; }
            lw[h] = lw[h] * alpha + ps;
            Frag pf; pf.w[0] = pk2(p[0], p[1]); pf.w[1] = pk2(p[2], p[3]); pf.w[2] = pk2(p[4], p[5]); pf.w[3] = pk2(p[6], p[7]);
#pragma unroll
            for (int dt = 0; dt < 4; ++dt) { ow[dt][h] = ow[dt][h] * alpha; ow[dt][h] = mfma16(vf[dt].v, pf.v, ow[dt][h]); }
            __builtin_amdgcn_sched_barrier(0);
        }
#pragma unroll
        for (int tt = 0; tt < 2; ++tt)
#pragma unroll
            for (int ks = 0; ks < 2; ++ks) kf[tt][ks].u = kn[tt][ks].u;
#pragma unroll
        for (int dt = 0; dt < 4; ++dt) vf[dt].u = vn[dt].u;
    }
#pragma unroll
    for (int h = 0; h < 4; ++h) { float t = lw[h]; t = red4_sum(t);
        const float gw_ = (1.0f / (1.0f + expf(-bf2f(HB[(size_t)(tok0 + fr) * HBP + HB_NSA_G + 8 + h])))) / t;
#pragma unroll
        for (int dt = 0; dt < 4; ++dt) { const v2u a = *(const LAS v2u*)(outb + fr * 256 + h * 64 + dt * 16 + fq * 4);
            v2u w; w.x = pk2(bflo(a.x) + ow[dt][h][0] * gw_, bfhi(a.x) + ow[dt][h][1] * gw_); w.y = pk2(bflo(a.y) + ow[dt][h][2] * gw_, bfhi(a.y) + ow[dt][h][3] * gw_); *(v2u*)(XN + (size_t)(tok0 + fr) * DM + h * 64 + dt * 16 + fq * 4) = w; } }
    LDS_WAIT();
}

#define PEER_SU 64.0f
#define PEER_SV 8.0f
#define PEER_SX 16.0f
typedef float f32x2v __attribute__((ext_vector_type(2)));
__device__ __forceinline__ float gelu_erf(float x) { return 0.5f * x * (1.0f + erff(x * 0.70710678118654752f)); }
template<int MODE> __device__ __forceinline__ void peer_item(int it, int l, const Args& args, LAS unsigned char* wlds, int lane) {
    unsigned char* ws = args.ws; const bf16* QP = (const bf16*)(ws + WS_PEER_QP);
    const int tok0 = it * 16, fr = lane & 15, fq = lane >> 4;
    LAS unsigned short* eidx = (LAS unsigned short*)wlds; LAS float* egate = (LAS float*)(wlds + 4096); LAS float* tkv = (LAS float*)(wlds + 12288);
    LAS float* cbuf = (LAS float*)(wlds + 16384); LAS unsigned char* ctab = (LAS unsigned char*)(wlds + 16384 + 512);
    const bf16* keys = opaque((const bf16*)(ws + WS_PKEYS) + (size_t)l * 8 * 2 * 128 * 128);
    if (MODE & 1) {
    { int c = 0, ij = 0xFF;
#pragma unroll
      for (int i = 0; i < 16; ++i)
#pragma unroll
          for (int j = 0; j < 16; ++j) if ((i + 1) * (j + 1) <= 16) { ij = (c == lane) ? ((i << 4) | j) : ij; ++c; }
      ctab[lane] = (unsigned char)ij; }
    LDS_WAIT();
    Frag qb[4], ka[8][4];
#define PA_LOAD(pc_) do { const bf16* kb_ = keys + (size_t)(pc_) * 128 * 128 + lane * 8;     \
        _Pragma("unroll") for (int ks = 0; ks < 4; ++ks) qb[ks].u = *(const v4u*)(QP + (size_t)(tok0 + fr) * 2048 + (pc_) * 128 + ks * 32 + fq * 8); \
        _Pragma("unroll") for (int mt = 0; mt < 8; ++mt) _Pragma("unroll") for (int ks = 0; ks < 4; ++ks) ka[mt][ks].u = *(const v4u*)(kb_ + (mt * 4 + ks) * 512); } while (0)
    PA_LOAD(0);
    for (int pc = 0; pc < 16; ++pc) {
        const int p = pc >> 1, c = pc & 1;
        {
            float sc[32];
#pragma unroll
            for (int mt = 0; mt < 8; ++mt) { f32x4 acc = {0.f, 0.f, 0.f, 0.f};
#pragma unroll
                for (int ks = 0; ks < 4; ++ks) acc = mfma16(ka[mt][ks].v, qb[ks].v, acc);
#pragma unroll
                for (int i = 0; i < 4; ++i) sc[mt * 4 + i] = __uint_as_float((__float_as_uint(acc[i]) & 0xFFFFFF80u) | (unsigned)(mt * 16 + fq * 4 + i)); }
            { const int pn = (pc < 15) ? pc + 1 : 15; PA_LOAD(pn); }
            __builtin_amdgcn_sched_barrier(0);
#pragma unroll
            for (int k = 2; k <= 32; k <<= 1)
#pragma unroll
                for (int j = k >> 1; j > 0; j >>= 1)
#pragma unroll
                    for (int i = 0; i < 32; ++i) { const int l2 = i ^ j; if (l2 > i) { const float a = sc[i], b2 = sc[l2]; const bool desc = (i & k) == 0; sc[i] = desc ? fmaxf(a, b2) : fminf(a, b2); sc[l2] = desc ? fminf(a, b2) : fmaxf(a, b2); } }
            for (int r = 0; r < 16; ++r) { const float w = red4_max(sc[0]); const bool own = (sc[0] == w);
#pragma unroll
                for (int k = 0; k < 15; ++k) sc[k] = own ? sc[k + 1] : sc[k];
                sc[15] = own ? -3.0e38f : sc[15];
                tkv[c * 256 + fr * 16 + r] = w; }
        }
        if (c == 0) continue;
        LDS_WAIT();
        float cs[16];
#pragma unroll
        for (int r = 0; r < 13; ++r) { const int cid = 4 * r + fq; const int ij = ctab[cid];
            const float v1 = tkv[fr * 16 + (ij >> 4)], v2 = tkv[256 + fr * 16 + (ij & 15)];
            cs[r] = (ij == 0xFF) ? -3.0e38f : __uint_as_float((__float_as_uint(v1 + v2) & 0xFFFFFFC0u) | (unsigned)cid); }
        cs[13] = -3.0e38f; cs[14] = -3.0e38f; cs[15] = -3.0e38f;
#pragma unroll
        for (int k = 2; k <= 16; k <<= 1)
#pragma unroll
            for (int j = k >> 1; j > 0; j >>= 1)
#pragma unroll
                for (int i = 0; i < 16; ++i) { const int l2 = i ^ j; if (l2 > i) { const float a = cs[i], b2 = cs[l2]; const bool desc = (i & k) == 0; cs[i] = desc ? fmaxf(a, b2) : fminf(a, b2); cs[l2] = desc ? fminf(a, b2) : fmaxf(a, b2); } }
        float top0 = 0.f, den = 0.f;
        for (int rr = 0; rr < 16; ++rr) { const float w = red4_max(cs[0]); const bool own = (cs[0] == w);
#pragma unroll
            for (int k = 0; k < 15; ++k) cs[k] = own ? cs[k + 1] : cs[k];
            cs[15] = own ? -3.0e38f : cs[15];
            const int ij = ctab[__float_as_uint(w) & 63u];
            const int i1 = (int)(__float_as_uint(tkv[fr * 16 + (ij >> 4)]) & 127u), i2 = (int)(__float_as_uint(tkv[256 + fr * 16 + (ij & 15)]) & 127u);
            if (rr == 0) top0 = w;
            const float ex = expf(w - top0); den += ex;
            eidx[fr * 128 + p * 16 + rr] = (unsigned short)(i1 * 128 + i2); egate[fr * 128 + p * 16 + rr] = ex; }
        LDS_WAIT();
        { const float rden = 1.0f / den;
#pragma unroll
          for (int rr = 0; rr < 16; ++rr) egate[fr * 128 + p * 16 + rr] *= rden; }
        LDS_WAIT();
    }
    }
    LDS_WAIT();
    if (!(MODE & 2)) return;
    const float* ngain = opaque((l + 1 < DEPTH) ? (args.in[I_N1G] + (l + 1) * DM) : args.in[I_FNG]);
    const unsigned char* U8 = (const unsigned char*)(ws + WS_PEER_U); const unsigned char* V8 = (const unsigned char*)(ws + WS_PEER_V); const unsigned char* X8 = (const unsigned char*)(ws + WS_PEER_X8);
#define PU_LOAD(S, ks_) do { XA[S] = *(const v4u*)(X8 + tok * DM + (ks_) * 64 + fq * 16); \
        _Pragma("unroll") for (int et = 0; et < 8; ++et) UB[S][et] = *(const v4u*)(U8 + (size_t)el[et] * DM + (ks_) * 64 + fq * 16); } while (0)
#define PU_MMA(S) do { const long xa0 = (long)(((unsigned long long)XA[S][1] << 32) | XA[S][0]), xa1 = (long)(((unsigned long long)XA[S][3] << 32) | XA[S][2]); \
        _Pragma("unroll") for (int et = 0; et < 8; ++et) { const long ub0 = (long)(((unsigned long long)UB[S][et][1] << 32) | UB[S][et][0]), ub1 = (long)(((unsigned long long)UB[S][et][3] << 32) | UB[S][et][2]); \
            acc[et] = __builtin_amdgcn_mfma_f32_16x16x32_fp8_fp8(xa0, ub0, acc[et], 0, 0, 0); acc[et] = __builtin_amdgcn_mfma_f32_16x16x32_fp8_fp8(xa1, ub1, acc[et], 0, 0, 0); } } while (0)
#define PV_LOAD(S, e_) do { _Pragma("unroll") for (int e2 = 0; e2 < 8; ++e2) { const int ex = eidx[t * 128 + (e_) + e2]; VV[S][e2] = *(const v4u*)(V8 + (size_t)ex * DM + lane * 16); } } while (0)
#define PV_FMA(S, e_) do { _Pragma("unroll") for (int e2 = 0; e2 < 8; ++e2) { const float ce = cbuf[(e_) + e2]; \
        _Pragma("unroll") for (int k = 0; k < 4; ++k) { const f32x2v lo2 = __builtin_amdgcn_cvt_pk_f32_fp8((int)VV[S][e2][k], false), hi2 = __builtin_amdgcn_cvt_pk_f32_fp8((int)VV[S][e2][k], true); \
            o[4 * k] += ce * lo2.x; o[4 * k + 1] += ce * lo2.y; o[4 * k + 2] += ce * hi2.x; o[4 * k + 3] += ce * hi2.y; } if (e2 & 1) __builtin_amdgcn_sched_barrier(0); } } while (0)
    for (int t = 0; t < 16; ++t) {
        const size_t tok = (size_t)(tok0 + t);
        const int lane_t = lane_id_v();
        const int lane = lane_t, fr = lane_t & 15, fq = lane_t >> 4;
        const int fr7 = fr & 7, hf = fr >> 3;
        v4u VV[2][8];
#pragma unroll
        for (int tp = 0; tp < 2; ++tp) {
            int el[8];
#pragma unroll
            for (int et = 0; et < 8; ++et) el[et] = eidx[t * 128 + (tp * 8 + et) * 8 + fr7];
            f32x4 acc[8];
#pragma unroll
            for (int et = 0; et < 8; ++et) acc[et] = (f32x4){0.f, 0.f, 0.f, 0.f};
#pragma unroll 2
            for (int ks = 0; ks < 8; ++ks) {
                v4u UB[8];
                const v4u XA = *(const v4u*)(X8 + tok * DM + ks * 128 + (fr & 1) * 64 + fq * 16);
#pragma unroll
                for (int et = 0; et < 8; ++et) UB[et] = *(const v4u*)(U8 + (size_t)el[et] * DM + ks * 128 + hf * 64 + fq * 16);
                const long xa0 = (long)(((unsigned long long)XA[1] << 32) | XA[0]), xa1 = (long)(((unsigned long long)XA[3] << 32) | XA[2]);
#pragma unroll
                for (int et = 0; et < 8; ++et) { const long ub0 = (long)(((unsigned long long)UB[et][1] << 32) | UB[et][0]), ub1 = (long)(((unsigned long long)UB[et][3] << 32) | UB[et][2]);
                    acc[et] = __builtin_amdgcn_mfma_f32_16x16x32_fp8_fp8(xa0, ub0, acc[et], 0, 0, 0); acc[et] = __builtin_amdgcn_mfma_f32_16x16x32_fp8_fp8(xa1, ub1, acc[et], 0, 0, 0); }
            }
            if (tp == 1) { PV_LOAD(0, 0); PV_LOAD(1, 8); }
#pragma unroll
            for (int et = 0; et < 8; ++et) { const float v = hf ? acc[et][1] : acc[et][0]; const float tv = v + dpp_mov<0x128>(v);     const int e = (tp * 8 + et) * 8 + fr7;
                const float c = egate[t * 128 + e] * gelu_erf(tv * (1.0f / (PEER_SX * PEER_SU))) * (1.0f / PEER_SV);
                cbuf[(fq == 0 && hf == 0) ? e : 192 + lane] = c; }
        }
        LDS_WAIT();
        float o[16];
#pragma unroll
        for (int k = 0; k < 16; ++k) o[k] = 0.f;
        for (int e = 0; e < 112; e += 16) {
            PV_FMA(0, e); PV_LOAD(0, e + 16);
            PV_FMA(1, e + 8); PV_LOAD(1, e + 24);
        }
        PV_FMA(0, 112); PV_FMA(1, 120);
        const int lane_e = lane_id_v();
        float* hrow = args.out + tok * DM + lane_e * 16; float ss = 0.f;
#pragma unroll
        for (int k4 = 0; k4 < 4; ++k4) { const f32x4 hv = *(const f32x4*)(hrow + 4 * k4);
#pragma unroll
            for (int k = 0; k < 4; ++k) { o[4 * k4 + k] += hv[k]; ss += o[4 * k4 + k] * o[4 * k4 + k]; } }
        const float rn = 1.0f / sqrtf(wave_sum(ss) * (1.f / DM) + NORM_EPS);
        const float* gp = ngain + lane_e * 16;
        if (l + 1 < DEPTH) {
#pragma unroll
            for (int k4 = 0; k4 < 4; ++k4) { f32x4 hv = {o[4 * k4], o[4 * k4 + 1], o[4 * k4 + 2], o[4 * k4 + 3]}; *(f32x4*)(hrow + 4 * k4) = hv; }
            bf16* xrow = (bf16*)(ws + WS_XN) + tok * DM + lane_e * 16; v4u w0, w1;
#pragma unroll
            for (int k = 0; k < 4; ++k) { w0[k] = pk2(o[2 * k] * rn * gp[2 * k], o[2 * k + 1] * rn * gp[2 * k + 1]); w1[k] = pk2(o[8 + 2 * k] * rn * gp[8 + 2 * k], o[8 + 2 * k + 1] * rn * gp[8 + 2 * k + 1]); }
            *(v4u*)xrow = w0; *(v4u*)(xrow + 8) = w1;
        } else {
#pragma unroll
            for (int k4 = 0; k4 < 4; ++k4) { f32x4 hv = {o[4 * k4] * rn * gp[4 * k4], o[4 * k4 + 1] * rn * gp[4 * k4 + 1], o[4 * k4 + 2] * rn * gp[4 * k4 + 2], o[4 * k4 + 3] * rn * gp[4 * k4 + 3]}; *(f32x4*)(hrow + 4 * k4) = hv; }
        }
        LDS_WAIT();
    }
}

#ifndef MK_SPLIT
#define MK_SPLIT 0
#endif

#define IN(k) (lo <= (k) && (k) < hi)
#define SEAM(k) do { if (IN(k) && IN((k) + 1)) xcd_barrier(bar, wave == 0 && lane_id_v() == 0); } while (0)
template <int l>
__device__ __forceinline__ void layer_phases(const Args& args, LAS unsigned char* lds, const XcdBarrier& bar, const int lo, const int hi, const int wave) {
    constexpr int G = GRID_WG; const int bx = blockIdx.x;
    const int gw = bx * NWAVES + wave, NGW = G * NWAVES, vw = wave * G + bx;
    unsigned char* ws = args.ws;
    unsigned* ctl = (unsigned*)(ws + WS_CTL);
    LAS unsigned char* wlds = lds + wave * WAVE_LDS;
    bf16* XN = (bf16*)(ws + WS_XN); bf16* HB = (bf16*)(ws + WS_HB);
    (void)gw; (void)NGW; (void)ctl; (void)wlds; (void)HB; (void)vw;
        const int pb = 1 + 8 * l;
        if (IN(pb + 0)) {
            const int lane = lane_id_v(); (void)lane;
            pg8::Gemm g{XN, (const bf16*)(ws + WS_WIN + l * WIN_L), M_TOK, N_IN_PAD, DM}; pg8::StaticOrder S; S.init(M_TOK, N_IN_PAD, G, bx);
            pg8::EpiHb E{HB, HBP, HBP};
            pg8::gemm_phase<pg8::EpiHb, pg8::StaticOrder, true, true>(lds, g, S, E, wave);
        }
        SEAM(pb + 0);
        if (IN(pb + 1)) {
            const int lane = lane_id_v(); (void)lane;
            { const int it = vw - 256; if (it >= 0 && it < 512) nsa_cmp_item(it, l, args, lane_id_v()); }
            for (int it = vw; it < 2048; it += NGW) { gdn_prep_item(it, l, args, wlds, lane_id_v()); }
            for (int it = vw; it < M_TOK / 16; it += NGW) { mla_prep_item(it, l, args, lane_id_v()); }
            for (int it = vw; it < 2048; it += NGW) { mlstm_prep_item(it, l, args, wlds, lane_id_v()); }
            { const int it = vw - 1024; if (it >= 0) nsa_vt_item(it, l, args, wlds, lane_id_v()); }
        }
        SEAM(pb + 1);
        if (IN(pb + 2)) {
            const int lane = lane_id_v(); (void)lane;
            nsa_lut_init(args.in[I_T5], (LAS float*)(wlds + 16384), lane);
            { const int it = vw - 256; if (it >= 0 && it < 64) gdn_scan_item(it, args, lane_id_v()); }
            { const int it = vw; if (it < 256) mlstm_scan_item(it, args, lane_id_v()); }
            for (int it = vw; it < 2048; it += NGW) { mla_attn_item(it & 15, 127 - (it >> 4), args, wlds, lane_id_v()); }
            { unsigned* qh = ctl + CW_Q + 64 * (l * 8 + (bx & 7));
              for (;;) { const int m = wave_pop(qh, lane_id_v()); if (m >= 256) break; const int j = 8 * m + (7 - (bx & 7)); nsa_item(j & 3, 511 - (j >> 2), l, args, wlds, lane_id_v()); } }
        }
        SEAM(pb + 2);
        if (IN(pb + 3)) {
            const int lane = lane_id_v(); (void)lane;
            for (int it = vw; it < 2048; it += NGW) { gdn_out_item(it, l, args, lane_id_v()); }
            for (int it = vw; it < 2048; it += NGW) { mlstm_out_item(it, l, args, wlds, lane_id_v()); }
            {
                const f32x4* su = (const f32x4*)(args.in[I_PEER_U] + (size_t)l * 16384 * DM); const f32x4* sv = (const f32x4*)(args.in[I_PEER_V] + (size_t)l * 16384 * DM);
                v4u* du = (v4u*)(ws + WS_PEER_U); v4u* dv = (v4u*)(ws + WS_PEER_V);
                unsigned* du32 = (unsigned*)du; unsigned* dv32 = (unsigned*)dv;
                for (size_t c = (size_t)gw; c < (size_t)16384 * DM / 1024; c += (size_t)NGW) {
                    f32x4 a[4], b2[4];
#pragma unroll
                    for (int q = 0; q < 4; ++q) { a[q] = su[c * 256 + q * 64 + lane]; b2[q] = sv[c * 256 + q * 64 + lane]; }
#pragma unroll
                    for (int q = 0; q < 4; ++q) {
                        int pa = __builtin_amdgcn_cvt_pk_fp8_f32(a[q][0] * PEER_SU, a[q][1] * PEER_SU, 0, false); pa = __builtin_amdgcn_cvt_pk_fp8_f32(a[q][2] * PEER_SU, a[q][3] * PEER_SU, pa, true);
                        int pb2 = __builtin_amdgcn_cvt_pk_fp8_f32(b2[q][0] * PEER_SV, b2[q][1] * PEER_SV, 0, false); pb2 = __builtin_amdgcn_cvt_pk_fp8_f32(b2[q][2] * PEER_SV, b2[q][3] * PEER_SV, pb2, true);
                        du32[c * 256 + q * 64 + lane] = (unsigned)pa; dv32[c * 256 + q * 64 + lane] = (unsigned)pb2; }
                }
            }
        }
        SEAM(pb + 3);
        if (IN(pb + 4)) {
            const int lane = lane_id_v(); (void)lane;
            pg8::Gemm g{XN, (const bf16*)(ws + WS_WOUT + l * WOUT_L), M_TOK, DM, DM}; pg8::StaticOrder S; S.init(M_TOK, DM, G, bx);
            pg8::EpiRes E{args.out, l == 0 ? args.in[I_X] : (const float*)args.out, DM};
            pg8::gemm_phase<pg8::EpiRes, pg8::StaticOrder, true, true>(lds, g, S, E, wave);
        }
        SEAM(pb + 4);
        if (IN(pb + 5)) {
            const int lane = lane_id_v(); (void)lane;
            {
                const float* g2 = args.in[I_N2G] + l * DM; unsigned char* X8 = ws + WS_PEER_X8;
                f32x4 gg[4];
#pragma unroll
                for (int j = 0; j < 4; ++j) gg[j] = ((const f32x4*)g2)[lane + 64 * j];
                for (int m0 = gw; m0 < M_TOK; m0 += 4 * NGW) {
                    f32x4 v[4][4]; float s[4];
#pragma unroll
                    for (int q = 0; q < 4; ++q) { const f32x4* xr = (const f32x4*)(args.out + (size_t)(m0 + q * NGW) * DM) + lane; s[q] = 0.f;
#pragma unroll
                        for (int j = 0; j < 4; ++j) { v[q][j] = xr[64 * j]; s[q] += (v[q][j].x * v[q][j].x + v[q][j].y * v[q][j].y) + (v[q][j].z * v[q][j].z + v[q][j].w * v[q][j].w); } }
#pragma unroll
                    for (int q = 0; q < 4; ++q) { const size_t m = (size_t)(m0 + q * NGW); const float r = 1.0f / sqrtf(wave_sum(s[q]) * (1.f / DM) + NORM_EPS);
#pragma unroll
                        for (int j = 0; j < 4; ++j) { const float y0 = v[q][j].x * r * gg[j].x, y1 = v[q][j].y * r * gg[j].y, y2 = v[q][j].z * r * gg[j].z, y3 = v[q][j].w * r * gg[j].w;
                            v2u o; o.x = pk2(y0, y1); o.y = pk2(y2, y3); ((v2u*)(XN + m * DM))[lane + 64 * j] = o;
                            int p8 = __builtin_amdgcn_cvt_pk_fp8_f32(y0 * PEER_SX, y1 * PEER_SX, 0, false); p8 = __builtin_amdgcn_cvt_pk_fp8_f32(y2 * PEER_SX, y3 * PEER_SX, p8, true);
                            ((int*)(X8 + m * DM))[lane + 64 * j] = p8; } }
                }
            }
        }
        SEAM(pb + 5);
        if (IN(pb + 6)) {
            const int lane = lane_id_v(); (void)lane;
            pg8::Gemm g{XN, (const bf16*)(ws + WS_WQ + l * WQ_L), M_TOK, 2048, DM}; pg8::StaticOrder S; S.init(M_TOK, 2048, G, bx);
            pg8::EpiBf16<0> E{(bf16*)(ws + WS_PEER_QP), 2048, nullptr, 0, 0, 1.f};
            pg8::gemm_phase<pg8::EpiBf16<0>, pg8::StaticOrder, true, true>(lds, g, S, E, wave);
        }
        SEAM(pb + 6);
        if (IN(pb + 7)) {
            const int lane = lane_id_v(); (void)lane;
            static_assert(G * NWAVES == M_TOK / 16, "one PEER item per wave");
            for (int it = vw; it < M_TOK / 16; it += NGW) { peer_item<1>(it, l, args, wlds, lane_id_v()); }
            for (int it = vw; it < M_TOK / 16; it += NGW) { peer_item<2>(it, l, args, wlds, lane_id_v()); }
        }
        SEAM(pb + 7);
}

__global__ void __launch_bounds__(NWAVES * 64, 2) fwd_kernel(Args args) {
    extern __shared__ __attribute__((aligned(16))) unsigned char lds_raw[];
    LAS unsigned char* lds = (LAS unsigned char*)lds_raw;
    volatile LAS unsigned* MISC = (volatile LAS unsigned*)(lds + MISC_OFF);
    const int wave = __builtin_amdgcn_readfirstlane((int)(threadIdx.x >> 6)); const int tid = wave * 64 + lane_id_v();
    constexpr int G = GRID_WG; const int bx = blockIdx.x;
    const int gw = bx * NWAVES + wave, NGW = G * NWAVES;
    unsigned char* ws = args.ws;
    unsigned* ctl = (unsigned*)(ws + WS_CTL);
    for (int u = tid; u < (LDS_BYTES - MISC_OFF) / 4; u += NWAVES * 64) MISC[u] = 0u;
    __syncthreads();
    XcdBarrier bar; bar.bar = ctl + CW_BAR; bar.x = 0; bar.st = nullptr;
    if (!MK_SPLIT) bar = xcd_barrier_post(ctl + CW_BAR, MISC + 8, tid == 0);
    const int lo = args.ph_lo, hi = args.ph_hi;
    LAS unsigned char* wlds = lds + wave * WAVE_LDS;
    bf16* XN = (bf16*)(ws + WS_XN); bf16* HB = (bf16*)(ws + WS_HB);

    if (IN(0)) {
        const int lane = lane_id_v();
        LAS float* scr = (LAS float*)wlds;
        constexpr int I_IN = (DM / 64) * (N_IN_PAD / 32), I_OUT = (DM / 64) * (DM / 32), I_Q = (DM / 64) * (2048 / 32);
        constexpr int I_UQ = (256 / 64) * (384 / 32), I_UKV = (128 / 64) * (512 / 32), I_CMP = (2048 / 64) * (64 / 32);
        constexpr int PER_L = I_IN + I_OUT + I_Q + I_UQ + I_UKV + 2 * I_CMP;
        for (int it = gw; it < DEPTH * PER_L; it += NGW) {
            const int l = it / PER_L; int r = it % PER_L;
            unsigned char* wsm = ws + WS_WSM + l * WSM_L;
            if (r < I_IN) { tr_item(args.in[I_WIN] + (size_t)l * DM * D_IN, D_IN, D_IN, MapHb(), (bf16*)(ws + WS_WIN + l * WIN_L), DM, scr, r / (N_IN_PAD / 32), r % (N_IN_PAD / 32), lane); continue; } r -= I_IN;
            if (r < I_OUT) { tr_item(args.in[I_WOUT] + (size_t)l * DM * DM, DM, DM, MapId(), (bf16*)(ws + WS_WOUT + l * WOUT_L), DM, scr, r / (DM / 32), r % (DM / 32), lane); continue; } r -= I_OUT;
            if (r < I_Q) { tr_item(args.in[I_PEER_WQ] + (size_t)l * DM * 2048, 2048, 2048, MapId(), (bf16*)(ws + WS_WQ + l * WQ_L), DM, scr, r / (2048 / 32), r % (2048 / 32), lane); continue; } r -= I_Q;
            if (r < I_UQ) { tr_item(args.in[I_MLA_WUQ] + (size_t)l * 256 * 384, 384, 384, MapId(), (bf16*)(wsm + WSM_UQ), 256, scr, r / (384 / 32), r % (384 / 32), lane); continue; } r -= I_UQ;
            if (r < I_UKV) { tr_item(args.in[I_MLA_WUKV] + (size_t)l * 128 * 512, 512, 512, MapId(), (bf16*)(wsm + WSM_UKV), 128, scr, r / (512 / 32), r % (512 / 32), lane); continue; } r -= I_UKV;
            if (r < I_CMP) { tr_item(args.in[I_CMPK] + (size_t)l * 2048 * 64, 64, 64, MapId(), (bf16*)(wsm + WSM_CK), 2048, scr, r / 2, r % 2, lane); continue; } r -= I_CMP;
            tr_item(args.in[I_CMPV] + (size_t)l * 2048 * 64, 64, 64, MapId(), (bf16*)(wsm + WSM_CV), 2048, scr, r / 2, r % 2, lane);
        }
        { const f32x4* ksrc = (const f32x4*)args.in[I_PEER_KEYS]; v2u* kdst = (v2u*)(ws + WS_PKEYS);
          for (int i = gw * 64 + lane; i < DEPTH * 16 * 128 * 128 / 4; i += NGW * 64) { const f32x4 a = ksrc[i]; v2u o; o.x = pk2(a[0], a[1]); o.y = pk2(a[2], a[3]);
              const int mat = i >> 12, m = (i >> 5) & 127, k4 = (i & 31) * 4;
              kdst[(size_t)mat * 4096 + ((((m >> 4) * 4 + (k4 >> 5)) * 64 + ((k4 >> 3) & 3) * 16 + (m & 15)) * 8 + (k4 & 7)) / 4] = o; } }
        for (int m0 = gw; m0 < M_TOK; m0 += 4 * NGW) {
            f32x4 v[4][4]; float s[4];
#pragma unroll
            for (int q = 0; q < 4; ++q) { const f32x4* xr = (const f32x4*)(args.in[I_X] + (size_t)(m0 + q * NGW) * DM) + lane; s[q] = 0.f;
#pragma unroll
                for (int j = 0; j < 4; ++j) { v[q][j] = xr[64 * j]; s[q] += (v[q][j].x * v[q][j].x + v[q][j].y * v[q][j].y) + (v[q][j].z * v[q][j].z + v[q][j].w * v[q][j].w); } }
#pragma unroll
            for (int q = 0; q < 4; ++q) { const float r = 1.0f / sqrtf(wave_sum(s[q]) * (1.f / DM) + NORM_EPS); v2u* o8 = (v2u*)(XN + (size_t)(m0 + q * NGW) * DM) + lane;
#pragma unroll
                for (int j = 0; j < 4; ++j) { const f32x4 gg = ((const f32x4*)args.in[I_N1G])[lane + 64 * j]; v2u o; o.x = pk2(v[q][j].x * r * gg.x, v[q][j].y * r * gg.y); o.y = pk2(v[q][j].z * r * gg.z, v[q][j].w * r * gg.w); o8[64 * j] = o; } }
        }
    }
    SEAM(0);

    layer_phases<0>(args, lds, bar, lo, hi, wave);
    layer_phases<1>(args, lds, bar, lo, hi, wave);
#undef IN
#undef SEAM
}

extern "C" void kernel_launch(void* const* d_in, const int* in_sizes, int n_in, void* d_out, int out_size, void* d_ws, size_t ws_size, hipStream_t stream) {
    static int grid = 0;
    if (grid == 0) {
        if (n_in != 26 || in_sizes[0] != M_TOK * DM || out_size != M_TOK * DM || ws_size < WS_END) { fprintf(stderr, "kernel_launch: unexpected shapes/workspace (n_in %d, ws %zu < %zu)\n", n_in, ws_size, (size_t)WS_END); grid = -1; return; }
        int dev = 0, cus = 0, per_cu = 0;
        if (hipGetDevice(&dev) != hipSuccess || hipDeviceGetAttribute(&cus, hipDeviceAttributeMultiprocessorCount, dev) != hipSuccess) { grid = -1; return; }
        if (hipFuncSetAttribute((const void*)fwd_kernel, hipFuncAttributeMaxDynamicSharedMemorySize, LDS_BYTES) != hipSuccess) { fprintf(stderr, "kernel_launch: hipFuncSetAttribute failed\n"); grid = -1; return; }
        if (hipOccupancyMaxActiveBlocksPerMultiprocessor(&per_cu, (const void*)fwd_kernel, NWAVES * 64, LDS_BYTES) != hipSuccess || per_cu < 1) { fprintf(stderr, "kernel_launch: occupancy query says %d blocks per CU\n", per_cu); }
        (void)hipGetLastError();
        if (cus < GRID_WG) { fprintf(stderr, "kernel_launch: %d CUs < %d workgroups: the grid would not be resident\n", cus, GRID_WG); grid = -1; return; }
        grid = GRID_WG;
    }
    if (grid < 0) return;
    if (hipMemsetAsync((char*)d_ws + WS_CTL, 0, CTL_ZERO_BYTES, stream) != hipSuccess) return;
    Args a{};
    for (int i = 0; i < 26; ++i) a.in[i] = (const float*)d_in[i];
    a.out = (float*)d_out; a.ws = (unsigned char*)d_ws;
#if MK_SPLIT
    for (int p = 0; p < N_PHASES; ++p) { a.ph_lo = p; a.ph_hi = p + 1; hipLaunchKernelGGL(fwd_kernel, dim3(grid), dim3(NWAVES * 64), LDS_BYTES, stream, a); }
#else
    a.ph_lo = 0; a.ph_hi = N_PHASES;
    hipLaunchKernelGGL(fwd_kernel, dim3(grid), dim3(NWAVES * 64), LDS_BYTES, stream, a);
#endif
    const hipError_t le = hipPeekAtLastError();
    if (le != hipSuccess) fprintf(stderr, "kernel_launch: launch failed: %s\n", hipGetErrorName(le));
}
```

```cpp
#include <hip/hip_runtime.h>
#include <cstdio>
#include <cstdint>

namespace pg8 {
#define PG8_LAS __attribute__((address_space(3)))
typedef unsigned short bf16_t;
typedef short bf16x8 __attribute__((ext_vector_type(8)));
typedef float f32x4 __attribute__((ext_vector_type(4)));
typedef unsigned u32x4 __attribute__((ext_vector_type(4)));
constexpr int BM = 256, BK = 64, HALF = 128, HTB = HALF * BK * 2  , STAGE_BYTES = 8 * HTB, NXCD = 8, WGM = 8;

__host__ __device__ __forceinline__ int lds_byte(int r, int c) { const int st = (r >> 4) * 2 + (c >> 5), rr = r & 15, cc = c & 31, ob = rr * 64 + cc * 2; return st * 1024 + (ob ^ (((ob >> 9) & 1) << 5)); }
__host__ __device__ __forceinline__ void stage_rc(int b, int& R, int& C) { const int st = b / 1024, sb = b % 1024, swz = sb ^ (((sb >> 9) & 1) << 5); R = (st >> 1) * 16 + swz / 64; C = (st & 1) * 32 + (swz % 64) / 2; }
__host__ __device__ __forceinline__ int perm32(int rho) { const int n = rho >> 4, i = rho & 15; return 8 * (i >> 2) + 4 * n + (i & 3); }

struct Unit { int pm, pn; };
struct Gemm { const bf16_t* A; const bf16_t* Bt; int M, N, K; };

struct StaticOrder {
    int nM, nN, nwg, G, c;
    __host__ __device__ void init(int M, int N, int G_, int c_) { nM = M / BM; nN = N / BM; nwg = nM * nN; G = G_; c = c_; }
    __host__ __device__ bool next(int i, Unit& u) const {
        const long L = (long)i * G + c; if (L >= nwg) return false;
        int wgid = (int)L; { const int q = nwg / NXCD, r = nwg % NXCD, xcd = wgid % NXCD, off = wgid / NXCD; wgid = (xcd < r ? xcd * (q + 1) : r * (q + 1) + (xcd - r) * q) + off; }
        const int nig = WGM * nN, gid = wgid / nig, fm = gid * WGM, gsz = (nM - fm) < WGM ? (nM - fm) : WGM;
        u.pm = fm + ((wgid % nig) % gsz); u.pn = (wgid % nig) / gsz; return true;
    }
    __device__ __forceinline__ void a_ready(const Unit&) const {}
    __device__ __forceinline__ void done(const Unit&) const {}
};

typedef __bf16 pg8_bf16x2 __attribute__((ext_vector_type(2)));
typedef float pg8_f32x2 __attribute__((ext_vector_type(2)));
__device__ __forceinline__ unsigned cvt_pk_bf16(float lo, float hi) { const pg8_f32x2 v = {lo, hi}; const pg8_bf16x2 b = __builtin_convertvector(v, pg8_bf16x2); return __builtin_bit_cast(unsigned, b); }
typedef float f32x2 __attribute__((ext_vector_type(2)));
__device__ __forceinline__ f32x2 gelu_pk(f32x2 v) {
    const f32x2 av = __builtin_elementwise_abs(v), d = av * 0.2316418882f + 1.0f;
    f32x2 t; t.x = __builtin_amdgcn_rcpf(d.x); t.y = __builtin_amdgcn_rcpf(d.y);
    f32x2 q = t * 0.5307027145f + (-0.7265760135f); q = q * t + 0.7107068705f; q = q * t + (-0.142248368f); q = q * t + 0.127414796f; q = q * t;
    const f32x2 s = (v * v) * (-0.72134752044f);
    f32x2 e; e.x = __builtin_amdgcn_exp2f(s.x); e.y = __builtin_amdgcn_exp2f(s.y);
    const f32x2 m = v * (q * e), r = v - m;
    f32x2 o; o.x = v.x < 0.f ? m.x : r.x; o.y = v.y < 0.f ? m.y : r.y; return o;
}


template <int ACT  > struct EpiBf16 {
    static constexpr bool PERM = true, AFTER_DRAIN = false; static_assert(ACT == 0 || ACT == 1, "EpiBf16: ACT is 0 (none) or 1 (gelu_pk)");
    bf16_t* O; int ldc; const float* bias; int split_cols; size_t split_stride; float scale0;
    __device__ __forceinline__ void operator()(const f32x4 (&acc)[2][2][4][2], const Unit& u, int wr, int wc, int fr, int fq) const {
        const int row0 = u.pm * BM + wr * 64 + fr; int colt = u.pn * BM; bf16_t* base = O;
        float sc = 1.f; if (split_cols) { const int t = colt / split_cols; base += (size_t)t * split_stride; colt -= t * split_cols; if (t == 0) sc = scale0; }
        const int col0 = colt + wc * 32 + 8 * fq, bcol0 = u.pn * BM + wc * 32 + 8 * fq;
        f32x4 bv[2][2];
#pragma unroll
        for (int bj = 0; bj < 2; ++bj)
#pragma unroll
            for (int n = 0; n < 2; ++n) bv[bj][n] = bias ? *(const f32x4*)(bias + bcol0 + bj * HALF + 4 * n) : (f32x4){0.f, 0.f, 0.f, 0.f};
#pragma unroll
        for (int ai = 0; ai < 2; ++ai)
#pragma unroll
            for (int m = 0; m < 4; ++m) { bf16_t* rowp = base + (size_t)(row0 + ai * HALF + m * 16) * ldc + col0;
#pragma unroll
                for (int bj = 0; bj < 2; ++bj) { f32x4 v0 = acc[ai][bj][m][0] + bv[bj][0], v1 = acc[ai][bj][m][1] + bv[bj][1];
                    if (ACT == 1) { f32x2 a = gelu_pk((f32x2){v0[0], v0[1]}), b = gelu_pk((f32x2){v0[2], v0[3]}), c = gelu_pk((f32x2){v1[0], v1[1]}), d = gelu_pk((f32x2){v1[2], v1[3]});
                        v0 = (f32x4){a.x, a.y, b.x, b.y}; v1 = (f32x4){c.x, c.y, d.x, d.y}; }
                    v0 = v0 * sc; v1 = v1 * sc; u32x4 w; w.x = cvt_pk_bf16(v0[0], v0[1]); w.y = cvt_pk_bf16(v0[2], v0[3]); w.z = cvt_pk_bf16(v1[0], v1[1]); w.w = cvt_pk_bf16(v1[2], v1[3]);
                    *(u32x4*)(rowp + bj * HALF) = w; } }
    }
};

struct EpiHb {
    static constexpr bool PERM = true, AFTER_DRAIN = false;
    bf16_t* O; int ldc; int ncols;
    __device__ __forceinline__ void operator()(const f32x4 (&acc)[2][2][4][2], const Unit& u, int wr, int wc, int fr, int fq) const {
        const int row0 = u.pm * BM + wr * 64 + fr; const int col0 = u.pn * BM + wc * 32 + 8 * fq;
#pragma unroll
        for (int ai = 0; ai < 2; ++ai)
#pragma unroll
            for (int m = 0; m < 4; ++m) { bf16_t* rowp = O + (size_t)(row0 + ai * HALF + m * 16) * ldc + col0;
#pragma unroll
                for (int bj = 0; bj < 2; ++bj) { const f32x4 v0 = acc[ai][bj][m][0], v1 = acc[ai][bj][m][1];
                    u32x4 w; w.x = cvt_pk_bf16(v0[0], v0[1]); w.y = cvt_pk_bf16(v0[2], v0[3]); w.z = cvt_pk_bf16(v1[0], v1[1]); w.w = cvt_pk_bf16(v1[2], v1[3]);
                    if (col0 + bj * HALF < ncols) *(u32x4*)(rowp + bj * HALF) = w; } }
    }
};
struct EpiRes {
    static constexpr bool PERM = false, AFTER_DRAIN = false;
    float* C; const float* R; int ldc;
    __device__ __forceinline__ void operator()(const f32x4 (&acc)[2][2][4][2], const Unit& u, int wr, int wc, int fr, int fq) const {
        const int row0 = u.pm * BM + wr * 64 + fr, col0 = u.pn * BM + wc * 32 + 4 * fq;
#pragma unroll
        for (int ai = 0; ai < 2; ++ai)
#pragma unroll
            for (int m = 0; m < 4; ++m) { const size_t ro = (size_t)(row0 + ai * HALF + m * 16) * ldc + col0;
#pragma unroll
                for (int bj = 0; bj < 2; ++bj)
#pragma unroll
                    for (int n = 0; n < 2; ++n) { const f32x4 r = *(const f32x4*)(R + ro + bj * HALF + n * 16); *(f32x4*)(C + ro + bj * HALF + n * 16) = acc[ai][bj][m][n] + r; } }
    }
};


template <class Epi, class Sched, bool ALIGN_EPI = false, bool SP2 = false>
__device__ __forceinline__ void gemm_phase(PG8_LAS unsigned char* lds, const Gemm g, const Sched& S, const Epi& E, const int wave_in) {
    const int wid = wave_in, lane = (int)__builtin_amdgcn_mbcnt_hi(~0u, __builtin_amdgcn_mbcnt_lo(~0u, 0u)), tid = wid * 64 + lane, wr = wid >> 2, wc = wid & 3, fr = lane & 15, fq = lane >> 4;
    const int K = g.K, nt = K / BK;
    unsigned voffA[2], voffB[2];
#pragma unroll
    for (int i = 0; i < 2; ++i) { int R, C; stage_rc(tid * 16 + i * 8192, R, C); const int Rb = Epi::PERM ? ((R & ~31) + perm32(R & 31)) : R;
        voffA[i] = (unsigned)(R * K + C) * 2u; voffB[i] = (unsigned)(Rb * K + C) * 2u; }
    const size_t kstep = (size_t)(BK * 2);
    const size_t hstep = (size_t)HALF * K * 2;
    const size_t tstep = 2 * hstep;
    const unsigned ldsw = (unsigned)wid * 1024u;
    const int aoff = lds_byte(wr * 64 + fr, fq * 8), boff = lds_byte(wc * 32 + fr, fq * 8);
#define PG8_SA(b, h) (((b) * 2 + (h)) * HTB)
#define PG8_SB(b, h) ((4 + (b) * 2 + (h)) * HTB)
#define PG8_STAGE(bufoff, gbase, voff) do { _Pragma("unroll") for (int _i = 0; _i < 2; ++_i) \
        __builtin_amdgcn_global_load_lds((const unsigned*)((const char*)(gbase) + (voff)[_i]), (PG8_LAS unsigned*)(lds + (bufoff) + ldsw + _i * 8192), 16, 0, 0); } while (0)
#define PG8_LDA(dst, b, h) do { _Pragma("unroll") for (int m = 0; m < 4; ++m) _Pragma("unroll") for (int k = 0; k < 2; ++k) dst[m][k] = *(const PG8_LAS bf16x8*)(lds + PG8_SA(b, h) + aoff + m * 2048 + k * 1024); } while (0)
#define PG8_LDB(dst, b, h) do { _Pragma("unroll") for (int n = 0; n < 2; ++n) _Pragma("unroll") for (int k = 0; k < 2; ++k) dst[n][k] = *(const PG8_LAS bf16x8*)(lds + PG8_SB(b, h) + boff + n * 2048 + k * 1024); } while (0)
#define PG8_MMA(ai, bj, At, Bt) do { __builtin_amdgcn_s_setprio(1); _Pragma("unroll") for (int m = 0; m < 4; ++m) _Pragma("unroll") for (int n = 0; n < 2; ++n) _Pragma("unroll") for (int k = 0; k < 2; ++k) \
        acc[ai][bj][m][n] = __builtin_amdgcn_mfma_f32_16x16x32_bf16(Bt[n][k], At[m][k], acc[ai][bj][m][n], 0, 0, 0); __builtin_amdgcn_s_setprio(0); } while (0)
#define PG8_WAIT_V(n) asm volatile("s_waitcnt vmcnt(" #n ")" ::: "memory")
#define PG8_WAIT_L(n) asm volatile("s_waitcnt lgkmcnt(" #n ")" ::: "memory")
#define PG8_BAR __builtin_amdgcn_s_barrier()
#define PG8_SCHED __builtin_amdgcn_sched_barrier(0)
    Unit cur, nxt; int ui = 0;
    if (!S.next(0, cur)) return;
    f32x4 acc[2][2][4][2];
#pragma unroll
    for (int a = 0; a < 2; ++a)
#pragma unroll
        for (int b = 0; b < 2; ++b)
#pragma unroll
            for (int m = 0; m < 4; ++m)
#pragma unroll
                for (int n = 0; n < 2; ++n) acc[a][b][m][n] = (f32x4){0.f, 0.f, 0.f, 0.f};
    bf16x8 At[4][2], B0[2][2], B1[2][2];
    const char* cA = (const char*)g.A + (size_t)cur.pm * tstep; const char* cB = (const char*)g.Bt + (size_t)cur.pn * tstep;
    S.a_ready(cur);
    if constexpr (SP2) {
        PG8_STAGE(PG8_SB(0, 0), cB, voffB); PG8_STAGE(PG8_SB(0, 1), cB + hstep, voffB); PG8_STAGE(PG8_SA(0, 0), cA, voffA); PG8_STAGE(PG8_SA(0, 1), cA + hstep, voffA);
        if (wr == 1) PG8_BAR;
        PG8_WAIT_V(2); PG8_BAR;
        PG8_STAGE(PG8_SB(1, 0), cB + kstep, voffB); PG8_STAGE(PG8_SA(1, 0), cA + kstep, voffA); PG8_STAGE(PG8_SB(1, 1), cB + hstep + kstep, voffB);
        PG8_WAIT_V(6); PG8_BAR;
    } else {
        PG8_STAGE(PG8_SB(0, 0), cB, voffB); PG8_STAGE(PG8_SA(0, 0), cA, voffA); PG8_STAGE(PG8_SB(0, 1), cB + hstep, voffB); PG8_STAGE(PG8_SA(0, 1), cA + hstep, voffA);
        if (wr == 1) PG8_BAR;
        PG8_WAIT_V(4); PG8_BAR;
        PG8_STAGE(PG8_SB(1, 0), cB + kstep, voffB); PG8_STAGE(PG8_SA(1, 0), cA + kstep, voffA); PG8_STAGE(PG8_SB(1, 1), cB + hstep + kstep, voffB);
        PG8_WAIT_V(6); PG8_BAR;
    }
    for (;;) {
        const bool has_next = S.next(ui + 1, nxt);
        const char* nA = has_next ? (const char*)g.A + (size_t)nxt.pm * tstep : cA; const char* nB = has_next ? (const char*)g.Bt + (size_t)nxt.pn * tstep : cB;
        for (int t = 0; t < nt; t += 2) {
            const bool last = (t == nt - 2);
            const char* a1 = cA + (size_t)(t + 1) * kstep;
            const char* a2 = last ? nA : cA + (size_t)(t + 2) * kstep; const char* b2 = last ? nB : cB + (size_t)(t + 2) * kstep;
            const char* a3 = a2 + kstep; const char* b3 = b2 + kstep;
            if (last && has_next) S.a_ready(nxt);
            if constexpr (SP2) {
            PG8_LDB(B0, 0, 0); PG8_LDB(B1, 0, 1); PG8_SCHED; PG8_LDA(At, 0, 0); PG8_STAGE(PG8_SA(1, 1), a1 + hstep, voffA);
            PG8_WAIT_V(8); PG8_WAIT_L(0); PG8_BAR; PG8_MMA(0, 0, At, B0); PG8_MMA(0, 1, At, B1); PG8_BAR; PG8_SCHED;
            PG8_LDA(At, 0, 1); PG8_STAGE(PG8_SB(0, 0), b2, voffB); PG8_STAGE(PG8_SB(0, 1), b2 + hstep, voffB); PG8_STAGE(PG8_SA(0, 0), a2, voffA);
            PG8_WAIT_V(8); PG8_WAIT_L(0); PG8_BAR; PG8_MMA(1, 0, At, B0); PG8_MMA(1, 1, At, B1); PG8_BAR; PG8_SCHED;
            PG8_LDB(B0, 1, 0); PG8_LDB(B1, 1, 1); PG8_SCHED; PG8_LDA(At, 1, 0); PG8_STAGE(PG8_SA(0, 1), a2 + hstep, voffA);
            PG8_WAIT_V(8); PG8_WAIT_L(0); PG8_BAR; PG8_MMA(0, 0, At, B0); PG8_MMA(0, 1, At, B1); PG8_BAR; PG8_SCHED;
            PG8_LDA(At, 1, 1); PG8_STAGE(PG8_SB(1, 0), b3, voffB); PG8_STAGE(PG8_SB(1, 1), b3 + hstep, voffB); PG8_STAGE(PG8_SA(1, 0), a3, voffA);
            PG8_WAIT_V(8); PG8_WAIT_L(0); PG8_BAR; PG8_MMA(1, 0, At, B0); PG8_MMA(1, 1, At, B1); PG8_BAR; PG8_SCHED;
            } else {
            PG8_LDB(B0, 0, 0); PG8_SCHED; PG8_LDA(At, 0, 0); PG8_STAGE(PG8_SA(1, 1), a1 + hstep, voffA);
            PG8_WAIT_L(8); PG8_BAR; PG8_WAIT_L(0); PG8_MMA(0, 0, At, B0); PG8_BAR; PG8_SCHED;
            PG8_LDB(B1, 0, 1); PG8_STAGE(PG8_SB(0, 0), b2, voffB);
            PG8_BAR; PG8_WAIT_L(0); PG8_MMA(0, 1, At, B1); PG8_BAR;
            PG8_LDA(At, 0, 1); PG8_STAGE(PG8_SA(0, 0), a2, voffA);
            PG8_BAR; PG8_WAIT_L(0); PG8_MMA(1, 0, At, B0); PG8_BAR; PG8_SCHED;
            PG8_STAGE(PG8_SB(0, 1), b2 + hstep, voffB);
            PG8_WAIT_V(6); PG8_BAR; PG8_MMA(1, 1, At, B1); PG8_BAR;
            PG8_LDB(B0, 1, 0); PG8_SCHED; PG8_LDA(At, 1, 0); PG8_STAGE(PG8_SA(0, 1), a2 + hstep, voffA);
            PG8_WAIT_L(8); PG8_BAR; PG8_WAIT_L(0); PG8_MMA(0, 0, At, B0); PG8_BAR; PG8_SCHED;
            PG8_LDB(B1, 1, 1); PG8_STAGE(PG8_SB(1, 0), b3, voffB);
            PG8_BAR; PG8_WAIT_L(0); PG8_MMA(0, 1, At, B1); PG8_BAR;
            PG8_LDA(At, 1, 1); PG8_STAGE(PG8_SA(1, 0), a3, voffA);
            PG8_BAR; PG8_WAIT_L(0); PG8_MMA(1, 0, At, B0); PG8_BAR; PG8_SCHED;
            PG8_STAGE(PG8_SB(1, 1), b3 + hstep, voffB);
            PG8_WAIT_V(6); PG8_BAR; PG8_MMA(1, 1, At, B1); PG8_BAR;
            }
        }
        if constexpr (ALIGN_EPI) { if (wr == 0) PG8_BAR; }
        if constexpr (!Epi::AFTER_DRAIN) { E(acc, cur, wr, wc, fr, fq); S.done(cur); }
        if (!has_next) break;
#pragma unroll
        for (int a = 0; a < 2; ++a)
#pragma unroll
            for (int b = 0; b < 2; ++b)
#pragma unroll
                for (int m = 0; m < 4; ++m)
#pragma unroll
                    for (int n = 0; n < 2; ++n) acc[a][b][m][n] = (f32x4){0.f, 0.f, 0.f, 0.f};
        cur = nxt; cA = nA; cB = nB; ++ui;
        if constexpr (ALIGN_EPI) { if (wr == 1) PG8_BAR; }
    }
    PG8_WAIT_V(0);
    if constexpr (!ALIGN_EPI) { if (wr == 0) PG8_BAR; }
    PG8_BAR;
    if constexpr (Epi::AFTER_DRAIN) { E.fused(acc, cur, wr, wc, fr, fq, lds, wid, lane); S.done(cur); }
#undef PG8_SA
#undef PG8_SB
#undef PG8_STAGE
#undef PG8_LDA
#undef PG8_LDB
#undef PG8_MMA
#undef PG8_WAIT_V
#undef PG8_WAIT_L
#undef PG8_BAR
#undef PG8_SCHED
}
}

constexpr int NB = 4, SEQ = 8192, M_TOK = NB * SEQ, DM = 1024, DEPTH = 2;
constexpr int D_IN = 3132, HBP = 3136, N_IN_PAD = 3328;
constexpr float NORM_EPS = 1e-6f;
constexpr int HB_NSA_Q = 0, HB_NSA_KC = 256, HB_NSA_VC = 320, HB_NSA_KS = 384, HB_NSA_VS = 448, HB_NSA_KW = 512, HB_NSA_VW = 576;
constexpr int HB_ML_Q = 640, HB_ML_K = 896, HB_ML_V = 1152, HB_ML_OG = 1408;
constexpr int HB_GD_Q = 1664, HB_GD_K = 1920, HB_GD_V = 2176, HB_GD_Z = 2432;
constexpr int HB_MLA_CQ = 2688, HB_MLA_CKV = 2944, HB_MLA_KR = 3072;
constexpr int HB_NSA_G = 3104, HB_ML_IG = 3116, HB_ML_FG = 3120, HB_GD_BETA = 3124, HB_GD_A = 3128;
__host__ __device__ __forceinline__ int hb_src_col(int c) {
    if (c < 640) return c;
    if (c < 1408) return 652 + (c - 640);
    if (c < 1664) return 1428 + (c - 1408);
    if (c < 2432) return 1684 + (c - 1664);
    if (c < 2688) return 2460 + (c - 2432);
    if (c < 3104) return 2716 + (c - 2688);
    if (c < 3116) return 640 + (c - 3104);
    if (c < 3124) return 1420 + (c - 3116);
    return 2452 + (c - 3124);
}
constexpr int GRID_WG = 256;
constexpr size_t MiB = 1u << 20;
constexpr size_t WS_CTL = 0, CTL_ZERO_BYTES = 1 * MiB;
constexpr size_t WS_WIN = 1 * MiB, WIN_L = (size_t)N_IN_PAD * DM * 2;
constexpr size_t WS_WOUT = 14 * MiB, WOUT_L = (size_t)DM * DM * 2;
constexpr size_t WS_WQ = 18 * MiB, WQ_L = (size_t)2048 * DM * 2;
constexpr size_t WS_WSM = 26 * MiB, WSM_L = 1 * MiB;
constexpr size_t WSM_UQ = 0, WSM_UKV = 196608, WSM_CK = 327680, WSM_CV = 589824;
constexpr size_t WS_XN = 28 * MiB;
constexpr size_t WS_HB = 92 * MiB;
constexpr size_t WS_MLA_Q = 288 * MiB, WS_MLA_K = 312 * MiB, WS_MLA_VT = 336 * MiB;
constexpr size_t WS_NSA_VST = 352 * MiB, WS_NSA_VWT = 356 * MiB, WS_NSA_KCMP = 360 * MiB, WS_NSA_VCMPT = 360 * MiB + 512 * 1024;
constexpr size_t WS_ML_C = 361 * MiB, WS_ML_N = 393 * MiB, WS_ML_SC = 393 * MiB + 512 * 1024;
constexpr size_t WS_GD_W = 394 * MiB, WS_GD_UT = 410 * MiB, WS_GD_KDT = 426 * MiB, WS_GD_QD = 442 * MiB, WS_GD_AQK = 458 * MiB, WS_GD_ST = 474 * MiB, WS_GD_VNT = 490 * MiB, WS_GD_GE = 506 * MiB;
constexpr size_t WS_PKEYS = 507 * MiB;
constexpr size_t WS_NSA_KSW = 508 * MiB;
constexpr size_t WS_END = 512 * MiB;
constexpr size_t WS_PEER_QP = 92 * MiB, WS_PEER_U = 394 * MiB, WS_PEER_V = 410 * MiB;
constexpr size_t WS_PEER_X8 = 288 * MiB;
constexpr int CW_TMO = 0, CW_BAR = 4096, CW_Q = 16384, CW_TS = 65536;
constexpr int NWAVES = 8, WAVE_LDS = 18432, MISC_OFF = NWAVES * WAVE_LDS, LDS_BYTES = MISC_OFF + 1024;
static_assert(LDS_BYTES <= 163840 && MISC_OFF >= 131072, "LDS map");

#define GAS __attribute__((address_space(1)))
#define LAS __attribute__((address_space(3)))
typedef unsigned short bf16;
typedef unsigned v4u __attribute__((ext_vector_type(4)));
typedef unsigned v2u __attribute__((ext_vector_type(2)));
typedef float f32x4 __attribute__((ext_vector_type(4)));
typedef short bf16x8 __attribute__((ext_vector_type(8)));
#define RLX_AGENT __ATOMIC_RELAXED, __HIP_MEMORY_SCOPE_AGENT
#define LDS_WAIT() asm volatile("s_waitcnt lgkmcnt(0)" ::: "memory")
#define VM_WAIT() asm volatile("s_waitcnt vmcnt(0)" ::: "memory")
__device__ __forceinline__ unsigned f2bf(float f) { unsigned u = __builtin_bit_cast(unsigned, f); return (u + 0x7fffu + ((u >> 16) & 1u)) >> 16; }
typedef __bf16 bf16x2_hw __attribute__((ext_vector_type(2)));
typedef float f32x2_hw __attribute__((ext_vector_type(2)));
__device__ __forceinline__ unsigned pk2(float lo, float hi) { const f32x2_hw v = {lo, hi}; const bf16x2_hw b = __builtin_convertvector(v, bf16x2_hw); return __builtin_bit_cast(unsigned, b); }
__device__ __forceinline__ float bf2f(unsigned b) { return __builtin_bit_cast(float, b << 16); }
__device__ __forceinline__ float bflo(unsigned w) { return __builtin_bit_cast(float, w << 16); }
__device__ __forceinline__ float bfhi(unsigned w) { return __builtin_bit_cast(float, w & 0xffff0000u); }
typedef unsigned u32x2_t __attribute__((ext_vector_type(2)));
__device__ __forceinline__ float red4_max(float x) {
    auto s = __builtin_amdgcn_permlane16_swap(__float_as_uint(x), __float_as_uint(x), false, false);
    x = fmaxf(__uint_as_float(s[0]), __uint_as_float(s[1]));
    auto t = __builtin_amdgcn_permlane32_swap(__float_as_uint(x), __float_as_uint(x), false, false);
    return fmaxf(__uint_as_float(t[0]), __uint_as_float(t[1]));
}
__device__ __forceinline__ float red4_sum(float x) {
    auto s = __builtin_amdgcn_permlane16_swap(__float_as_uint(x), __float_as_uint(x), false, false);
    x = __uint_as_float(s[0]) + __uint_as_float(s[1]);
    auto t = __builtin_amdgcn_permlane32_swap(__float_as_uint(x), __float_as_uint(x), false, false);
    return __uint_as_float(t[0]) + __uint_as_float(t[1]);
}
template <int CTRL> __device__ __forceinline__ float dpp_mov(float x) { return __int_as_float(__builtin_amdgcn_mov_dpp(__float_as_int(x), CTRL, 0xf, 0xf, true)); }
__device__ __forceinline__ float wave_sum(float v) {
    v += dpp_mov<0xB1>(v); v += dpp_mov<0x4E>(v); v += dpp_mov<0x141>(v); v += dpp_mov<0x140>(v);
    return red4_sum(v);
}
__device__ __forceinline__ float wave_max(float v) {
    v = fmaxf(v, dpp_mov<0xB1>(v)); v = fmaxf(v, dpp_mov<0x4E>(v)); v = fmaxf(v, dpp_mov<0x141>(v)); v = fmaxf(v, dpp_mov<0x140>(v));
    return red4_max(v);
}
__device__ __forceinline__ int wave_pop(unsigned* ctr, int lane) {
    __builtin_amdgcn_wave_barrier();
    const unsigned v = __hip_atomic_fetch_add(ctr, (lane == 0) ? 1u : 0u, RLX_AGENT);
    const int r = (int)__builtin_amdgcn_readfirstlane(v);
    __builtin_amdgcn_wave_barrier();
    return r;
}
__device__ __forceinline__ f32x4 mfma16(bf16x8 a, bf16x8 b, f32x4 c) { return __builtin_amdgcn_mfma_f32_16x16x32_bf16(a, b, c, 0, 0, 0); }
__device__ __forceinline__ int lane_id() { return (int)__builtin_amdgcn_mbcnt_hi(~0u, __builtin_amdgcn_mbcnt_lo(~0u, 0u)); }
__device__ __forceinline__ int lane_id_v() { int l; asm volatile("v_mbcnt_lo_u32_b32 %0, -1, 0\n\tv_mbcnt_hi_u32_b32 %0, -1, %0" : "=v"(l)); return l; }
template <class T> __device__ __forceinline__ T* opaque(T* p) { asm volatile("" : "+s"(p)); return p; }
union Frag { bf16x8 v; v4u u; unsigned w[4]; };

constexpr int N_PHASES = 1 + 8 * DEPTH;
struct Args { const float* in[26]; float* out; unsigned char* ws; int ph_lo, ph_hi; };
enum { I_X = 0, I_POS, I_T5, I_N1G, I_N2G, I_FNG, I_WIN, I_WOUT, I_CMPK, I_CMPV, I_CMPPOS, I_ML_IB, I_ML_FB, I_ML_NG, I_GD_CONV, I_GD_ALOG, I_GD_DT, I_GD_NG,
       I_MLA_QNG, I_MLA_KVNG, I_MLA_WUQ, I_MLA_WUKV, I_PEER_WQ, I_PEER_KEYS, I_PEER_U, I_PEER_V };

#define XB_TMO      128
#define XB_XCNT(j)  (256  + 64 * (j))
#define XB_XSUB(j)  (1280 + 64 * (j))
#define XB_XGEN(j)  (2304 + 64 * (j))
#define XB_TOP      3328
#define XB_TOPGEN   3392
#define XCD_BAR_WORDS 3456
#define XB_SPIN_CAP (1u << 21)

__device__ __forceinline__ unsigned xb_ld(unsigned* p)              { return __hip_atomic_load(p, __ATOMIC_RELAXED, __HIP_MEMORY_SCOPE_AGENT); }
__device__ __forceinline__ unsigned xb_add(unsigned* p, unsigned v) { return __hip_atomic_fetch_add(p, v, __ATOMIC_RELAXED, __HIP_MEMORY_SCOPE_AGENT); }
__device__ __forceinline__ unsigned xb_xcc_id() { return (unsigned)__builtin_amdgcn_s_getreg((3 << 11) | 20) & 0xFu; }
#define XB_SPIN(cond, bar) do { unsigned _sp = 0; while (cond) { __builtin_amdgcn_s_sleep(1); \
    if ((++_sp & 255u) == 0u) { if (xb_ld(&(bar)[XB_TMO])) break; if (_sp > XB_SPIN_CAP) { atomicAdd(&(bar)[XB_TMO], 1u); break; } } } } while (0)

struct XcdBarrier {
    unsigned* bar; unsigned x;
    volatile LAS unsigned* st;
};

__device__ __forceinline__ XcdBarrier xcd_barrier_post(unsigned* bar, volatile LAS unsigned* st, const bool is_t0) {
    XcdBarrier b; b.bar = bar; b.x = xb_xcc_id(); b.st = st;
    if (is_t0) (void)xb_add(&bar[XB_XCNT(b.x)], 1u);
    return b;
}
__device__ __forceinline__ void xcd_barrier_complete(unsigned* bar, unsigned x, unsigned& nloc, unsigned& nx) {
    const unsigned G = gridDim.x * gridDim.y * gridDim.z;
    unsigned sum, cnt, mine, sp = 0u;
    for (;;) {
        sum = 0u; cnt = 0u; mine = 0u;
#pragma unroll
        for (unsigned j = 0; j < 16; ++j) { const unsigned c = xb_ld(&bar[XB_XCNT(j)]); sum += c; cnt += (c > 0u) ? 1u : 0u; mine = (j == x) ? c : mine; }
        if (sum == G) break;
        __builtin_amdgcn_s_sleep(1);
        if ((++sp & 255u) == 0u) { if (xb_ld(&bar[XB_TMO])) break; if (sp > XB_SPIN_CAP) { atomicAdd(&bar[XB_TMO], 1u); break; } }
    }
    nloc = mine > 0u ? mine : 1u; nx = cnt > 0u ? cnt : 1u;
}

__device__ __forceinline__ void xcd_barrier(const XcdBarrier& b, const bool is_t0) {
    asm volatile("s_waitcnt vmcnt(0)" ::: "memory");
    __syncthreads();
    if (is_t0) {
        unsigned* bar = b.bar;
        __builtin_amdgcn_s_waitcnt(0);
        unsigned nloc = b.st[0], nx = b.st[1];
        if (nloc == 0u) { xcd_barrier_complete(bar, b.x, nloc, nx); b.st[0] = nloc; b.st[1] = nx; }
        const unsigned old = xb_add(&bar[XB_XSUB(b.x)], 1u);
        const unsigned gen = old / nloc;
        if (old + 1u == (gen + 1u) * nloc) {
            __builtin_amdgcn_fence(__ATOMIC_RELEASE, "agent");
            asm volatile("s_waitcnt vmcnt(0)" ::: "memory");
            const unsigned og = xb_add(&bar[XB_TOP], 1u);
            const unsigned tg = og / nx;
            if (og + 1u == (tg + 1u) * nx) xb_add(&bar[XB_TOPGEN], 1u);
            else XB_SPIN(xb_ld(&bar[XB_TOPGEN]) == tg, bar);
            __builtin_amdgcn_fence(__ATOMIC_ACQUIRE, "agent");
            xb_add(&bar[XB_XGEN(b.x)], 1u);
            asm volatile("s_waitcnt vmcnt(0)" ::: "memory");
        } else {
            XB_SPIN(xb_ld(&bar[XB_XGEN(b.x)]) == gen, bar);
            __builtin_amdgcn_fence(__ATOMIC_ACQUIRE, "agent");
            asm volatile("s_waitcnt vmcnt(0)" ::: "memory");
        }
    }
    __syncthreads();
}

template <class Map>
__device__ __forceinline__ void tr_item(const float* src, int ldsrc, int nreal, Map map, bf16* dst, int K, LAS float* scr, int kb, int nb, int lane) {
    const int k0 = 64 * kb, n0 = 32 * nb;
    const int n = n0 + (lane & 31);
    const int sc = (n < nreal) ? map(n) : -1;
#pragma unroll 8
    for (int i = 0; i < 32; ++i) { const int kk = 2 * i + (lane >> 5); scr[kk * 33 + (lane & 31)] = (sc >= 0) ? src[(size_t)(k0 + kk) * ldsrc + sc] : 0.f; }
    LDS_WAIT();
    const int c = lane & 7;
#pragma unroll
    for (int j = 0; j < 4; ++j) { const int nn = (lane >> 3) + 8 * j; const LAS float* s = scr + (8 * c) * 33 + nn;
        v4u o; o.x = pk2(s[0 * 33], s[1 * 33]); o.y = pk2(s[2 * 33], s[3 * 33]); o.z = pk2(s[4 * 33], s[5 * 33]); o.w = pk2(s[6 * 33], s[7 * 33]);
        *(v4u*)(dst + (size_t)(n0 + nn) * K + k0 + 8 * c) = o; }
    LDS_WAIT();
}
struct MapId { __device__ __forceinline__ int operator()(int n) const { return n; } };
struct MapHb { __device__ __forceinline__ int operator()(int n) const { return hb_src_col(n); } };
__device__ __forceinline__ void rms_row_bf16(const float* xrow, const float* g, bf16* orow, int lane) {
    const f32x4* xr = (const f32x4*)xrow + lane; const f32x4* gr = (const f32x4*)g + lane;
    f32x4 v[4]; float s = 0.f;
#pragma unroll
    for (int j = 0; j < 4; ++j) { v[j] = xr[64 * j]; s += (v[j].x * v[j].x + v[j].y * v[j].y) + (v[j].z * v[j].z + v[j].w * v[j].w); }
    const float r = 1.0f / sqrtf(wave_sum(s) * (1.f / DM) + NORM_EPS);
    v2u* o8 = (v2u*)orow + lane;
#pragma unroll
    for (int j = 0; j < 4; ++j) { const f32x4 gg = gr[64 * j]; v2u o; o.x = pk2(v[j].x * r * gg.x, v[j].y * r * gg.y); o.y = pk2(v[j].z * r * gg.z, v[j].w * r * gg.w); o8[64 * j] = o; }
}
__device__ __forceinline__ void rms_row_f32(const float* xrow, const float* g, float* orow, int lane) {
    const f32x4* xr = (const f32x4*)xrow + lane; const f32x4* gr = (const f32x4*)g + lane;
    f32x4 v[4]; float s = 0.f;
#pragma unroll
    for (int j = 0; j < 4; ++j) { v[j] = xr[64 * j]; s += (v[j].x * v[j].x + v[j].y * v[j].y) + (v[j].z * v[j].z + v[j].w * v[j].w); }
    const float r = 1.0f / sqrtf(wave_sum(s) * (1.f / DM) + NORM_EPS);
    f32x4* o = (f32x4*)orow + lane;
#pragma unroll
    for (int j = 0; j < 4; ++j) { const f32x4 gg = gr[64 * j]; o[64 * j] = v[j] * r * gg; }
}

__device__ __forceinline__ void mla_prep_item(int it, int l, const Args& args, int lane) {
    unsigned char* ws = args.ws;
    const bf16* HB = (const bf16*)(ws + WS_HB);
    bf16* Qo = (bf16*)(ws + WS_MLA_Q); bf16* Ko = (bf16*)(ws + WS_MLA_K); bf16* VT = (bf16*)(ws + WS_MLA_VT);
    const bf16* uq_t = opaque((const bf16*)(ws + WS_WSM + l * WSM_L + WSM_UQ)); const bf16* ukv_t = opaque((const bf16*)(ws + WS_WSM + l * WSM_L + WSM_UKV));
    const int fr = lane & 15, fq = lane >> 4;
    const int tok0 = it * 16, b = tok0 / SEQ, s0 = tok0 % SEQ;
    const float* gq = opaque(args.in[I_MLA_QNG] + l * 256); const float* gkv = opaque(args.in[I_MLA_KVNG] + l * 128);
    const int* pos = (const int*)args.in[I_POS];
    float cs[4], sn[4];
    { const float pf_ = (float)pos[tok0 + fr];
#pragma unroll
      for (int i = 0; i < 4; ++i) { const float inv_freq = exp2f(-(float)(fq * 4 + i) * (13.287712379549449f / 16.0f));
          const float ang = pf_ * inv_freq; sincosf(ang, &sn[i], &cs[i]); } }
    const int blk32 = s0 >> 5, half = (s0 >> 4) & 1;
    const float qscale = 0.10206207261596577f * 1.4426950408889634f;
    {
        Frag a[8]; float ss = 0.f;
#pragma unroll
        for (int ks = 0; ks < 8; ++ks) { a[ks].u = *(const v4u*)(HB + (size_t)(tok0 + fr) * HBP + HB_MLA_CQ + ks * 32 + fq * 8);
#pragma unroll
            for (int j = 0; j < 4; ++j) { const float x0 = bflo(a[ks].w[j]), x1 = bfhi(a[ks].w[j]); ss += x0 * x0 + x1 * x1; } }
        ss = red4_sum(ss);
        const float r = 1.0f / sqrtf(ss * (1.f / 256.f) + NORM_EPS);
#pragma unroll
        for (int ks = 0; ks < 8; ++ks) { const float* gp = gq + ks * 32 + fq * 8;
#pragma unroll
            for (int j = 0; j < 4; ++j) a[ks].w[j] = pk2(bflo(a[ks].w[j]) * r * gp[2 * j], bfhi(a[ks].w[j]) * r * gp[2 * j + 1]); }
        for (int h = 0; h < 4; ++h) {
            f32x4 acc[6];
#pragma unroll
            for (int j = 0; j < 6; ++j) { acc[j] = (f32x4){0.f, 0.f, 0.f, 0.f};
#pragma unroll
                for (int ks = 0; ks < 8; ++ks) { Frag bq; bq.u = *(const v4u*)(uq_t + (size_t)(h * 96 + j * 16 + fr) * 256 + ks * 32 + fq * 8); acc[j] = mfma16(bq.v, a[ks].v, acc[j]); } }
            bf16* qrow = Qo + ((size_t)(b * 4 + h) * SEQ + s0 + fr) * 96 + fq * 4;
#pragma unroll
            for (int j = 0; j < 4; ++j) { v2u o; o.x = pk2(acc[j][0] * qscale, acc[j][1] * qscale); o.y = pk2(acc[j][2] * qscale, acc[j][3] * qscale); *(v2u*)(qrow + j * 16) = o; }
            { float r1[4], r2[4];
#pragma unroll
              for (int i = 0; i < 4; ++i) { const float t1 = acc[4][i], t2 = acc[5][i]; r1[i] = (t1 * cs[i] - t2 * sn[i]) * qscale; r2[i] = (t2 * cs[i] + t1 * sn[i]) * qscale; }
              v2u o1, o2; o1.x = pk2(r1[0], r1[1]); o1.y = pk2(r1[2], r1[3]); o2.x = pk2(r2[0], r2[1]); o2.y = pk2(r2[2], r2[3]); *(v2u*)(qrow + 64) = o1; *(v2u*)(qrow + 80) = o2; }
        }
    }
    {
        Frag a[4]; float ss = 0.f;
#pragma unroll
        for (int ks = 0; ks < 4; ++ks) { a[ks].u = *(const v4u*)(HB + (size_t)(tok0 + fr) * HBP + HB_MLA_CKV + ks * 32 + fq * 8);
#pragma unroll
            for (int j = 0; j < 4; ++j) { const float x0 = bflo(a[ks].w[j]), x1 = bfhi(a[ks].w[j]); ss += x0 * x0 + x1 * x1; } }
        ss = red4_sum(ss);
        const float r = 1.0f / sqrtf(ss * (1.f / 128.f) + NORM_EPS);
#pragma unroll
        for (int ks = 0; ks < 4; ++ks) { const float* gp = gkv + ks * 32 + fq * 8;
#pragma unroll
            for (int j = 0; j < 4; ++j) a[ks].w[j] = pk2(bflo(a[ks].w[j]) * r * gp[2 * j], bfhi(a[ks].w[j]) * r * gp[2 * j + 1]); }
        for (int h = 0; h < 4; ++h) {
            f32x4 acc[8];
#pragma unroll
            for (int j = 0; j < 8; ++j) { acc[j] = (f32x4){0.f, 0.f, 0.f, 0.f};
#pragma unroll
                for (int ks = 0; ks < 4; ++ks) { Frag bq; bq.u = *(const v4u*)(ukv_t + (size_t)(h * 128 + j * 16 + fr) * 128 + ks * 32 + fq * 8); acc[j] = (j < 4) ? mfma16(bq.v, a[ks].v, acc[j]) : mfma16(a[ks].v, bq.v, acc[j]); } }
            bf16* kblk = Ko + (size_t)(b * 4 + h) * SEQ * 96 + (size_t)blk32 * 3072;
#pragma unroll
            for (int j = 0; j < 4; ++j) { v2u o; o.x = pk2(acc[j][0], acc[j][1]); o.y = pk2(acc[j][2], acc[j][3]);
                *(v2u*)(kblk + ((half * 3 + (j >> 1)) * 64 + ((j & 1) * 2 + (fq >> 1)) * 16 + fr) * 8 + (fq & 1) * 4) = o; }
            bf16* vblk = VT + (size_t)(b * 4 + h) * 64 * SEQ + (size_t)blk32 * 2048;
#pragma unroll
            for (int j = 0; j < 4; ++j) { v2u o; o.x = pk2(acc[4 + j][0], acc[4 + j][1]); o.y = pk2(acc[4 + j][2], acc[4 + j][3]);
                *(v2u*)(vblk + (j * 64 + lane) * 8 + half * 4) = o; }
        }
        { const bf16* kr = HB + (size_t)(tok0 + fr) * HBP + HB_MLA_KR + fq * 4;
          const v2u a1 = *(const v2u*)kr, a2 = *(const v2u*)(kr + 16);
          const float t1[4] = {bflo(a1.x), bfhi(a1.x), bflo(a1.y), bfhi(a1.y)}, t2[4] = {bflo(a2.x), bfhi(a2.x), bflo(a2.y), bfhi(a2.y)};
          float r1[4], r2[4];
#pragma unroll
          for (int i = 0; i < 4; ++i) { r1[i] = t1[i] * cs[i] - t2[i] * sn[i]; r2[i] = t2[i] * cs[i] + t1[i] * sn[i]; }
          v2u o1, o2; o1.x = pk2(r1[0], r1[1]); o1.y = pk2(r1[2], r1[3]); o2.x = pk2(r2[0], r2[1]); o2.y = pk2(r2[2], r2[3]);
#pragma unroll
          for (int h = 0; h < 4; ++h) { bf16* kblk = Ko + (size_t)(b * 4 + h) * SEQ * 96 + (size_t)blk32 * 3072 + ((half * 3 + 2) * 64 + fr) * 8 + (fq & 1) * 4;
              *(v2u*)(kblk + (fq >> 1) * 128) = o1; *(v2u*)(kblk + (2 + (fq >> 1)) * 128) = o2; } }
    }
}
#define MLA_LOADK(KF, k0_) do { const bf16* kp_ = K + (size_t)((k0_) >> 5) * 3072 + lane * 8; _Pragma("unroll") for (int t = 0; t < 2; ++t) { _Pragma("unroll") for (int ks = 0; ks < 3; ++ks) KF[t][ks].u = *(const v4u*)(kp_ + (t * 3 + ks) * 512); } } while (0)
#define MLA_LOADV(VF, k0_) do { const bf16* vp_ = VT + (size_t)((k0_) >> 5) * 2048 + lane * 8; _Pragma("unroll") for (int dt = 0; dt < 4; ++dt) VF[dt].u = *(const v4u*)(vp_ + dt * 512); } while (0)
#define MLA_STEP_(KF, VF, k0_, DIAG) do { \
    Frag pf[4]; f32x4 sA_[4], sB_[4]; \
    _Pragma("unroll") for (int nt = 0; nt < 4; ++nt) { Frag q0, q1, q2; q0.u = *(const LAS v4u*)(ql + (nt * 16 + fr) * 104 + fq * 8); q1.u = *(const LAS v4u*)(ql + (nt * 16 + fr) * 104 + 32 + fq * 8); q2.u = *(const LAS v4u*)(ql + (nt * 16 + fr) * 104 + 64 + fq * 8); \
        f32x4 s0_ = {0.f, 0.f, 0.f, 0.f}, s1_ = {0.f, 0.f, 0.f, 0.f}; \
        s0_ = mfma16(KF[0][0].v, q0.v, s0_); s1_ = mfma16(KF[1][0].v, q0.v, s1_); s0_ = mfma16(KF[0][1].v, q1.v, s0_); s1_ = mfma16(KF[1][1].v, q1.v, s1_); s0_ = mfma16(KF[0][2].v, q2.v, s0_); s1_ = mfma16(KF[1][2].v, q2.v, s1_); \
        sA_[nt] = s0_; sB_[nt] = s1_; } \
      \
    _Pragma("unroll") for (int nt = 0; nt < 4; ++nt) { f32x4 s0_ = sA_[nt], s1_ = sB_[nt]; \
        if (DIAG) { _Pragma("unroll") for (int i = 0; i < 4; ++i) { if ((k0_) + fq * 4 + i > s0 + nt * 16 + fr) s0_[i] = -1e30f; if ((k0_) + 16 + fq * 4 + i > s0 + nt * 16 + fr) s1_[i] = -1e30f; } } \
        float mx = fmaxf(fmaxf(fmaxf(s0_[0], s0_[1]), fmaxf(s0_[2], s0_[3])), fmaxf(fmaxf(s1_[0], s1_[1]), fmaxf(s1_[2], s1_[3]))); \
        mx = red4_max(mx); \
        const float mn = fmaxf(mrun[nt], mx); \
        float p[8]; float ps = 0.f; \
        _Pragma("unroll") for (int i = 0; i < 4; ++i) { p[i] = __builtin_amdgcn_exp2f(s0_[i] - mn); p[4 + i] = __builtin_amdgcn_exp2f(s1_[i] - mn); ps += p[i] + p[4 + i]; } \
        if (__builtin_amdgcn_ballot_w64(mn > mrun[nt]) != 0ull) {         \
            const float alpha = __builtin_amdgcn_exp2f(mrun[nt] - mn); mrun[nt] = mn; lrun[nt] = lrun[nt] * alpha; \
            _Pragma("unroll") for (int dt = 0; dt < 4; ++dt) o[dt][nt] = o[dt][nt] * alpha; } \
        lrun[nt] += ps; \
        pf[nt].w[0] = pk2(p[0], p[1]); pf[nt].w[1] = pk2(p[2], p[3]); pf[nt].w[2] = pk2(p[4], p[5]); pf[nt].w[3] = pk2(p[6], p[7]); } \
    _Pragma("unroll") for (int dt = 0; dt < 4; ++dt) _Pragma("unroll") for (int nt = 0; nt < 4; ++nt) o[dt][nt] = mfma16(VF[dt].v, pf[nt].v, o[dt][nt]); __builtin_amdgcn_sched_barrier(0); } while (0)
__device__ __forceinline__ void mla_attn_item(int bh, int qt, const Args& args, LAS unsigned char* wlds, int lane) {
    unsigned char* ws = args.ws;
    const bf16* Q = (const bf16*)(ws + WS_MLA_Q) + (size_t)bh * SEQ * 96; const bf16* K = (const bf16*)(ws + WS_MLA_K) + (size_t)bh * SEQ * 96;
    const bf16* VT = (const bf16*)(ws + WS_MLA_VT) + (size_t)bh * 64 * SEQ; bf16* XN = (bf16*)(ws + WS_XN);
    const int fr = lane & 15, fq = lane >> 4, s0 = qt * 64, b = bh >> 2, h = bh & 3;
    LAS bf16* ql = (LAS bf16*)wlds;
#pragma unroll
    for (int i = 0; i < 12; ++i) { const int idx = i * 64 + lane, r = idx / 12, c = idx % 12; *(LAS v4u*)(ql + r * 104 + c * 8) = *(const v4u*)(Q + (size_t)(s0 + r) * 96 + c * 8); }
    LDS_WAIT();
    f32x4 o[4][4];
#pragma unroll
    for (int dt = 0; dt < 4; ++dt)
#pragma unroll
        for (int nt = 0; nt < 4; ++nt) o[dt][nt] = (f32x4){0.f, 0.f, 0.f, 0.f};
    float mrun[4], lrun[4];
#pragma unroll
    for (int nt = 0; nt < 4; ++nt) { mrun[nt] = -1e30f; lrun[nt] = 0.f; }
    const int nkb = (s0 + 64) / 32;
    Frag kA[2][3], kB[2][3], vv[4];
    MLA_LOADK(kA, 0);
    for (int kb = 0; kb < nkb - 2; kb += 2) {
        MLA_LOADV(vv, kb * 32); MLA_LOADK(kB, (kb + 1) * 32);
        MLA_STEP_(kA, vv, kb * 32, 0);
        MLA_LOADV(vv, (kb + 1) * 32); MLA_LOADK(kA, (kb + 2) * 32);
        MLA_STEP_(kB, vv, (kb + 1) * 32, 0);
    }
    { const int kb = nkb - 2;
        MLA_LOADV(vv, kb * 32); MLA_LOADK(kB, (kb + 1) * 32);
        MLA_STEP_(kA, vv, kb * 32, 1);
        MLA_LOADV(vv, (kb + 1) * 32);
        MLA_STEP_(kB, vv, (kb + 1) * 32, 1);
    }
#pragma unroll
    for (int nt = 0; nt < 4; ++nt) {
        float lt = lrun[nt]; lt = red4_sum(lt);
        const float inv = 1.0f / lt;
        bf16* orow = XN + (size_t)(b * SEQ + s0 + nt * 16 + fr) * DM + 768 + h * 64 + fq * 4;
#pragma unroll
        for (int dt = 0; dt < 4; ++dt) { v2u w; w.x = pk2(o[dt][nt][0] * inv, o[dt][nt][1] * inv); w.y = pk2(o[dt][nt][2] * inv, o[dt][nt][3] * inv); *(v2u*)(orow + dt * 16) = w; }
    }
    LDS_WAIT();
}

__device__ __forceinline__ void stage64(const bf16* HB, int tok0, int col0, LAS bf16* buf, int lane) {
#pragma unroll
    for (int i = 0; i < 8; ++i) { const int idx = i * 64 + lane, r = idx >> 3, c8 = idx & 7;
        const v4u v = *(const v4u*)(HB + (size_t)(tok0 + r) * HBP + col0 + c8 * 8); *(LAS v4u*)(buf + r * 72 + c8 * 8) = v; }
    LDS_WAIT();
}
__device__ __forceinline__ float log_sigmoid(float x) { return fminf(x, 0.f) - log1pf(expf(-fabsf(x))); }
__device__ __forceinline__ float wave_incl_sum(float v, int lane) {
#pragma unroll
    for (int o = 1; o < 64; o <<= 1) { const float t = __shfl_up(v, o); if (lane >= o) v += t; }
    return v;
}
__device__ __forceinline__ float wave_incl_max(float v, int lane) {
#pragma unroll
    for (int o = 1; o < 64; o <<= 1) { const float t = __shfl_up(v, o); if (lane >= o) v = fmaxf(v, t); }
    return v;
}
__device__ __forceinline__ void mlstm_prep_item(int it, int l, const Args& args, LAS unsigned char* wlds, int lane) {
    unsigned char* ws = args.ws; const bf16* HB = (const bf16*)(ws + WS_HB);
    const int bh = it >> 7, n = it & 127, b = bh >> 2, h = bh & 3, tok0 = b * SEQ + n * 64, fr = lane & 15, fq = lane >> 4;
    LAS bf16* buf = (LAS bf16*)wlds;
    const float ib = opaque(args.in[I_ML_IB] + l * 4)[h], fb = opaque(args.in[I_ML_FB] + l * 4)[h];
    const float ig = bf2f(HB[(size_t)(tok0 + lane) * HBP + HB_ML_IG + h]) + ib;
    const float lf = log_sigmoid(bf2f(HB[(size_t)(tok0 + lane) * HBP + HB_ML_FG + h]) + fb);
    const float bcum = wave_incl_sum(lf, lane), a = ig - bcum, amax = wave_max(a), bend = __shfl(bcum, 63);
    const float w = expf(a - amax);
    float wv[2][8];
#pragma unroll
    for (int ks = 0; ks < 2; ++ks)
#pragma unroll
        for (int j = 0; j < 8; ++j) wv[ks][j] = __shfl(w, ks * 32 + fq * 8 + j);
    stage64(HB, tok0, HB_ML_V + h * 64, buf, lane);
    Frag af[4][2];
#pragma unroll
    for (int mt = 0; mt < 4; ++mt)
#pragma unroll
        for (int ks = 0; ks < 2; ++ks)
#pragma unroll
            for (int j = 0; j < 4; ++j) { const int s = ks * 32 + fq * 8 + 2 * j, e = mt * 16 + fr;
                af[mt][ks].w[j] = pk2(bf2f(buf[s * 72 + e]) * wv[ks][2 * j], bf2f(buf[(s + 1) * 72 + e]) * wv[ks][2 * j + 1]); }
    LDS_WAIT();
    stage64(HB, tok0, HB_ML_K + h * 64, buf, lane);
    Frag bfm[4][2];
#pragma unroll
    for (int nt = 0; nt < 4; ++nt)
#pragma unroll
        for (int ks = 0; ks < 2; ++ks)
#pragma unroll
            for (int j = 0; j < 4; ++j) { const int s = ks * 32 + fq * 8 + 2 * j, kd = nt * 16 + fr;
                bfm[nt][ks].w[j] = pk2(bf2f(buf[s * 72 + kd]) * 0.125f, bf2f(buf[(s + 1) * 72 + kd]) * 0.125f); }
    LDS_WAIT();
    float* Cc = (float*)(ws + WS_ML_C) + (size_t)it * 4096;
#pragma unroll
    for (int mt = 0; mt < 4; ++mt)
#pragma unroll
        for (int nt = 0; nt < 4; ++nt) { f32x4 acc = {0.f, 0.f, 0.f, 0.f};
#pragma unroll
            for (int ks = 0; ks < 2; ++ks) acc = mfma16(af[mt][ks].v, bfm[nt][ks].v, acc);
#pragma unroll
            for (int i = 0; i < 4; ++i) Cc[(mt * 16 + fq * 4 + i) * 64 + nt * 16 + fr] = acc[i]; }
    {
        Frag an[2];
#pragma unroll
        for (int ks = 0; ks < 2; ++ks)
#pragma unroll
            for (int j = 0; j < 4; ++j) an[ks].w[j] = (fr == 0) ? pk2(wv[ks][2 * j], wv[ks][2 * j + 1]) : 0u;
        float* Nn = (float*)(ws + WS_ML_N) + (size_t)it * 64; float* dummy = (float*)(ws + WS_ML_SC) + (size_t)it * 4 + 3;
#pragma unroll
        for (int nt = 0; nt < 4; ++nt) { f32x4 acc = {0.f, 0.f, 0.f, 0.f}; acc = mfma16(an[0].v, bfm[nt][0].v, acc); acc = mfma16(an[1].v, bfm[nt][1].v, acc);
            float* dst = (fq == 0) ? (Nn + nt * 16 + fr) : dummy; *dst = acc[0]; } }
    { float* sc = (float*)(ws + WS_ML_SC) + (size_t)it * 4; sc[lane & 1] = (lane & 1) ? bend : bend + amax; }
}
__device__ __forceinline__ void mlstm_scan_item(int it, const Args& args, int lane) {
    unsigned char* ws = args.ws; const int bh = it >> 4, part = it & 15;
    float* Cb = (float*)(ws + WS_ML_C) + (size_t)bh * 128 * 4096 + part * 256 + lane;
    float* Nb = (float*)(ws + WS_ML_N) + (size_t)bh * 128 * 64 + lane;
    float* sc = (float*)(ws + WS_ML_SC) + (size_t)bh * 128 * 4;
    float c0 = 0.f, c1 = 0.f, c2 = 0.f, c3 = 0.f, nn = 0.f, m = 0.f;
    for (int n0 = 0; n0 < 128; n0 += 4) {
        float d[4][4], ml_[4], be_[4], dn_[4];
#pragma unroll
        for (int q = 0; q < 4; ++q) { const float* cp = Cb + (size_t)(n0 + q) * 4096; d[q][0] = cp[0]; d[q][1] = cp[64]; d[q][2] = cp[128]; d[q][3] = cp[192];
            ml_[q] = sc[(n0 + q) * 4 + 0]; be_[q] = sc[(n0 + q) * 4 + 1]; dn_[q] = (part == 0) ? Nb[(n0 + q) * 64] : 0.f; }
#pragma unroll
        for (int q = 0; q < 4; ++q) { float* cp = Cb + (size_t)(n0 + q) * 4096;
            const float mnew = fmaxf(be_[q] + m, ml_[q]), fc = expf(be_[q] + m - mnew), fd = expf(ml_[q] - mnew);
            cp[0] = c0; cp[64] = c1; cp[128] = c2; cp[192] = c3;
            c0 = fc * c0 + fd * d[q][0]; c1 = fc * c1 + fd * d[q][1]; c2 = fc * c2 + fd * d[q][2]; c3 = fc * c3 + fd * d[q][3];
            if (part == 0) { Nb[(n0 + q) * 64] = nn; nn = fc * nn + fd * dn_[q]; sc[(n0 + q) * 4 + 2] = m; }
            m = mnew; }
    }
}
__device__ __forceinline__ void mlstm_out_item(int it, int l, const Args& args, LAS unsigned char* wlds, int lane) {
    unsigned char* ws = args.ws; const bf16* HB = (const bf16*)(ws + WS_HB); bf16* XN = (bf16*)(ws + WS_XN);
    const int bh = it >> 7, n = it & 127, b = bh >> 2, h = bh & 3, tok0 = b * SEQ + n * 64, fr = lane & 15, fq = lane >> 4;
    LAS bf16* buf = (LAS bf16*)wlds;
    const float ib = opaque(args.in[I_ML_IB] + l * 4)[h], fb = opaque(args.in[I_ML_FB] + l * 4)[h];
    const float ig = bf2f(HB[(size_t)(tok0 + lane) * HBP + HB_ML_IG + h]) + ib;
    const float lf = log_sigmoid(bf2f(HB[(size_t)(tok0 + lane) * HBP + HB_ML_FG + h]) + fb);
    const float bcum = wave_incl_sum(lf, lane), a = ig - bcum, pmax = wave_incl_max(a, lane);
    const float* sc = (const float*)(ws + WS_ML_SC) + (size_t)it * 4;
    const float mst = sc[2];
    const float mt_ = bcum + fmaxf(pmax, mst);
    const float inter_l = expf(bcum + mst - mt_), emm_l = expf(-mt_), bm_l = bcum - mt_;
    stage64(HB, tok0, HB_ML_V + h * 64, buf, lane);
    Frag kf[4][2];
#pragma unroll
    for (int t = 0; t < 4; ++t)
#pragma unroll
        for (int ks = 0; ks < 2; ++ks) kf[t][ks].u = *(const v4u*)(HB + (size_t)(tok0 + t * 16 + fr) * HBP + HB_ML_K + h * 64 + ks * 32 + fq * 8);
    float as_[4][4];
#pragma unroll
    for (int mt = 0; mt < 4; ++mt)
#pragma unroll
        for (int i = 0; i < 4; ++i) as_[mt][i] = __shfl(a, mt * 16 + fq * 4 + i);
    const float* Cst = (const float*)(ws + WS_ML_C) + (size_t)it * 4096; const float* Nst = (const float*)(ws + WS_ML_N) + (size_t)it * 64;
    const float* ng = opaque(args.in[I_ML_NG] + l * 256) + h * 64;
    for (int nt = 0; nt < 4; ++nt) {
        const int tl = nt * 16 + fr;
        const float bm = __shfl(bm_l, tl), inter = __shfl(inter_l, tl), emm = __shfl(emm_l, tl);
        Frag q0, q1;
        q0.u = *(const v4u*)(HB + (size_t)(tok0 + tl) * HBP + HB_ML_Q + h * 64 + fq * 8); q1.u = *(const v4u*)(HB + (size_t)(tok0 + tl) * HBP + HB_ML_Q + h * 64 + 32 + fq * 8);
        f32x4 st[4]; float den = 0.f;
#pragma unroll
        for (int mt = 0; mt < 4; ++mt) { st[mt] = (f32x4){0.f, 0.f, 0.f, 0.f}; st[mt] = mfma16(kf[mt][0].v, q0.v, st[mt]); st[mt] = mfma16(kf[mt][1].v, q1.v, st[mt]);
#pragma unroll
            for (int i = 0; i < 4; ++i) { const int s = mt * 16 + fq * 4 + i; const float d = (s <= tl) ? expf(bm + as_[mt][i]) : 0.f; st[mt][i] = st[mt][i] * 0.125f * d; den += st[mt][i]; } }
        den = red4_sum(den);
        Frag pf[2];
#pragma unroll
        for (int k2 = 0; k2 < 2; ++k2) { pf[k2].w[0] = pk2(st[2 * k2][0], st[2 * k2][1]); pf[k2].w[1] = pk2(st[2 * k2][2], st[2 * k2][3]); pf[k2].w[2] = pk2(st[2 * k2 + 1][0], st[2 * k2 + 1][1]); pf[k2].w[3] = pk2(st[2 * k2 + 1][2], st[2 * k2 + 1][3]); }
        float nq = 0.f;
#pragma unroll
        for (int j = 0; j < 4; ++j) { nq += Nst[fq * 8 + 2 * j] * bflo(q0.w[j]) + Nst[fq * 8 + 2 * j + 1] * bfhi(q0.w[j]); nq += Nst[32 + fq * 8 + 2 * j] * bflo(q1.w[j]) + Nst[32 + fq * 8 + 2 * j + 1] * bfhi(q1.w[j]); }
        nq = red4_sum(nq);
        const float dent = den + inter * nq; const float rden = 1.0f / fmaxf(fabsf(dent), emm);
        f32x4 hv[4]; float ss = 0.f;
#pragma unroll
        for (int et = 0; et < 4; ++et) {
            f32x4 num = {0.f, 0.f, 0.f, 0.f}, cq = {0.f, 0.f, 0.f, 0.f};
#pragma unroll
            for (int k2 = 0; k2 < 2; ++k2) { Frag va; const int e = et * 16 + fr;
#pragma unroll
                for (int j = 0; j < 4; ++j) { const int sa = (2 * k2 + (j >> 1)) * 16 + fq * 4 + 2 * (j & 1); va.w[j] = (unsigned)buf[sa * 72 + e] | ((unsigned)buf[(sa + 1) * 72 + e] << 16); }
                num = mfma16(va.v, pf[k2].v, num); }
#pragma unroll
            for (int ks = 0; ks < 2; ++ks) { const float* cp = Cst + (size_t)(et * 16 + fr) * 64 + ks * 32 + fq * 8; const f32x4 c0 = *(const f32x4*)cp, c1 = *(const f32x4*)(cp + 4);
                Frag ca; ca.w[0] = pk2(c0[0], c0[1]); ca.w[1] = pk2(c0[2], c0[3]); ca.w[2] = pk2(c1[0], c1[1]); ca.w[3] = pk2(c1[2], c1[3]);
                cq = mfma16(ca.v, ks == 0 ? q0.v : q1.v, cq); }
            const v2u ogw = *(const v2u*)(HB + (size_t)(tok0 + tl) * HBP + HB_ML_OG + h * 64 + et * 16 + fq * 4);
            const float og[4] = {bflo(ogw.x), bfhi(ogw.x), bflo(ogw.y), bfhi(ogw.y)};
#pragma unroll
            for (int i = 0; i < 4; ++i) { const float hval = (num[i] + inter * cq[i]) * rden; const float o = hval / (1.0f + expf(-og[i])); hv[et][i] = o; ss += o * o; }
        }
        ss = red4_sum(ss);
        const float rn = 1.0f / sqrtf(ss * (1.f / 64.f) + NORM_EPS);
        bf16* orow = XN + (size_t)(tok0 + tl) * DM + 256 + h * 64 + fq * 4;
#pragma unroll
        for (int et = 0; et < 4; ++et) { const float* gp = ng + et * 16 + fq * 4; v2u w; w.x = pk2(hv[et][0] * rn * gp[0], hv[et][1] * rn * gp[1]); w.y = pk2(hv[et][2] * rn * gp[2], hv[et][3] * rn * gp[3]); *(v2u*)(orow + et * 16) = w; }
    }
    LDS_WAIT();
}

__device__ __forceinline__ float silu_f(float x) { return x * __builtin_amdgcn_rcpf(1.0f + __builtin_amdgcn_exp2f(-1.4426950408889634f * x)); }
template <int NORM>
__device__ __forceinline__ void gdn_conv_chunk(const bf16* HB, int tok0, bool first, int col0, const float* cw, int ch0, float nscale, LAS bf16* buf, int lane) {
#pragma unroll
    for (int i = 0; i < 9; ++i) { const int idx = i * 64 + lane, r = idx >> 3, c8 = idx & 7;
        if (idx < 67 * 8) { v4u v = {0u, 0u, 0u, 0u}; if (!(first && r < 3)) v = *(const v4u*)(HB + (size_t)(tok0 - 3 + r) * HBP + col0 + c8 * 8); *(LAS v4u*)(buf + r * 72 + c8 * 8) = v; } }
    LDS_WAIT();
    const float w0 = cw[ch0 + lane], w1 = cw[768 + ch0 + lane], w2 = cw[1536 + ch0 + lane], w3 = cw[2304 + ch0 + lane];
    float xm3 = bf2f(buf[0 * 72 + lane]), xm2 = bf2f(buf[1 * 72 + lane]), xm1 = bf2f(buf[2 * 72 + lane]);
#pragma unroll 4
    for (int t = 0; t < 64; ++t) {
        const float x0 = bf2f(buf[(t + 3) * 72 + lane]);
        float o = silu_f(w0 * xm3 + w1 * xm2 + w2 * xm1 + w3 * x0);
        xm3 = xm2; xm2 = xm1; xm1 = x0;
        if (NORM) { const float ss = wave_sum(o * o); o *= nscale / sqrtf(ss + NORM_EPS); }
        buf[t * 72 + lane] = (bf16)f2bf(o);
    }
    LDS_WAIT();
}
__device__ __forceinline__ void gdn_prep_item(int it, int l, const Args& args, LAS unsigned char* wlds, int lane) {
    unsigned char* ws = args.ws; const bf16* HB = (const bf16*)(ws + WS_HB);
    const int bh = it >> 7, n = it & 127, b = bh >> 2, h = bh & 3, tok0 = b * SEQ + n * 64, fr = lane & 15, fq = lane >> 4;
    LAS bf16* buf = (LAS bf16*)wlds; LAS float* sg = (LAS float*)(wlds + 16384);
    const float* cw = opaque(args.in[I_GD_CONV] + (size_t)l * 4 * 768);
    const float alog = opaque(args.in[I_GD_ALOG] + l * 4)[h], dtb = opaque(args.in[I_GD_DT] + l * 4)[h];
    const float beta_l = 1.0f / (1.0f + expf(-bf2f(HB[(size_t)(tok0 + lane) * HBP + HB_GD_BETA + h])));
    const float apre = bf2f(HB[(size_t)(tok0 + lane) * HBP + HB_GD_A + h]) + dtb;
    const float sp = fmaxf(apre, 0.f) + log1pf(expf(-fabsf(apre)));
    const float gc_l = wave_incl_sum(-expf(alog) * sp, lane);
    const float gend = __shfl(gc_l, 63);
    sg[lane] = gc_l; sg[64 + lane] = beta_l; sg[128 + lane] = expf(gc_l);
    LDS_WAIT();
    const size_t cb = (size_t)it * 4096;
    bf16* Wo = (bf16*)(ws + WS_GD_W) + cb; bf16* UTo = (bf16*)(ws + WS_GD_UT) + cb; bf16* KDTo = (bf16*)(ws + WS_GD_KDT) + cb; bf16* QDo = (bf16*)(ws + WS_GD_QD) + cb; bf16* AQKo = (bf16*)(ws + WS_GD_AQK) + cb;
    gdn_conv_chunk<1>(HB, tok0, n == 0, HB_GD_K + h * 64, cw, 256 + h * 64, 1.0f, buf, lane);
#pragma unroll
    for (int t8 = 0; t8 < 8; ++t8) { v4u o;
#pragma unroll
        for (int j = 0; j < 4; ++j) { const int t = t8 * 8 + 2 * j; o[j] = pk2(bf2f(buf[t * 72 + lane]) * expf(gend - sg[t]), bf2f(buf[(t + 1) * 72 + lane]) * expf(gend - sg[t + 1])); }
        *(v4u*)(KDTo + lane * 64 + t8 * 8) = o; }
    Frag kf[4][2];
#pragma unroll
    for (int t = 0; t < 4; ++t)
#pragma unroll
        for (int ks = 0; ks < 2; ++ks) kf[t][ks].u = *(const LAS v4u*)(buf + (t * 16 + fr) * 72 + ks * 32 + fq * 8);
    LDS_WAIT();
    gdn_conv_chunk<1>(HB, tok0, n == 0, HB_GD_Q + h * 64, cw, h * 64, 0.125f, buf, lane);
#pragma unroll 8
    for (int t = 0; t < 64; ++t) QDo[t * 64 + lane] = (bf16)f2bf(bf2f(buf[t * 72 + lane]) * sg[128 + t]);
    float gci[4][4], gcj[4];
#pragma unroll
    for (int mt = 0; mt < 4; ++mt)
#pragma unroll
        for (int ii = 0; ii < 4; ++ii) gci[mt][ii] = sg[mt * 16 + fq * 4 + ii];
#pragma unroll
    for (int nt = 0; nt < 4; ++nt) gcj[nt] = sg[nt * 16 + fr];
#pragma unroll
    for (int mt = 0; mt < 4; ++mt) {
        Frag q0, q1; q0.u = *(const LAS v4u*)(buf + (mt * 16 + fr) * 72 + fq * 8); q1.u = *(const LAS v4u*)(buf + (mt * 16 + fr) * 72 + 32 + fq * 8);
#pragma unroll
        for (int nt = 0; nt < 4; ++nt) { f32x4 acc = {0.f, 0.f, 0.f, 0.f};
            if (nt <= mt) { acc = mfma16(q0.v, kf[nt][0].v, acc); acc = mfma16(q1.v, kf[nt][1].v, acc); }
#pragma unroll
            for (int ii = 0; ii < 4; ++ii) { const int i = mt * 16 + fq * 4 + ii, j = nt * 16 + fr; const float vv = (nt <= mt && i >= j) ? acc[ii] * expf(gci[mt][ii] - gcj[nt]) : 0.f; AQKo[i * 64 + j] = (bf16)f2bf(vv); } } }
    LDS_WAIT();
    gdn_conv_chunk<0>(HB, tok0, n == 0, HB_GD_V + h * 64, cw, 512 + h * 64, 1.0f, buf, lane);
    LAS float* Xl = (LAS float*)wlds;
    { float xx[64];
#pragma unroll
      for (int t = 0; t < 64; ++t) xx[t] = bf2f(buf[t * 72 + lane]) * sg[64 + t];
      LDS_WAIT();
#pragma unroll
      for (int t = 0; t < 64; ++t) Xl[t * 64 + lane] = xx[t]; }
    float am[4][4][4];
#define GDN_SOLVE() do { _Pragma("unroll") for (int mt = 0; mt < 4; ++mt) { \
        _Pragma("unroll") for (int nt = 0; nt < mt; ++nt) { float xo[16]; \
            _Pragma("unroll") for (int jj = 0; jj < 16; ++jj) xo[jj] = Xl[(nt * 16 + jj) * 64 + lane]; \
            for (int fqp = 0; fqp < 4; ++fqp) { _Pragma("unroll") for (int ii = 0; ii < 4; ++ii) { const int i = mt * 16 + fqp * 4 + ii; float xi = Xl[i * 64 + lane]; \
                const float af = am[mt][nt][ii]; const int av = __builtin_bit_cast(int, af); \
                _Pragma("unroll") for (int jj = 0; jj < 16; ++jj) xi -= __builtin_bit_cast(float, __builtin_amdgcn_readlane(av, fqp * 16 + jj)) * xo[jj]; \
                Xl[i * 64 + lane] = xi; } } } \
        { float xd[16]; \
          _Pragma("unroll") for (int r = 0; r < 16; ++r) xd[r] = Xl[(mt * 16 + r) * 64 + lane]; \
          _Pragma("unroll") for (int r = 1; r < 16; ++r) { const float af = am[mt][mt][r & 3]; const int av = __builtin_bit_cast(int, af); \
              _Pragma("unroll") for (int jj = 0; jj < r; ++jj) xd[r] -= __builtin_bit_cast(float, __builtin_amdgcn_readlane(av, (r >> 2) * 16 + jj)) * xd[jj]; } \
          _Pragma("unroll") for (int r = 1; r < 16; ++r) Xl[(mt * 16 + r) * 64 + lane] = xd[r]; } } } while (0)
#pragma unroll
    for (int mt = 0; mt < 4; ++mt)
#pragma unroll
        for (int nt = 0; nt < 4; ++nt) { f32x4 acc = {0.f, 0.f, 0.f, 0.f};
            if (nt <= mt) { acc = mfma16(kf[mt][0].v, kf[nt][0].v, acc); acc = mfma16(kf[mt][1].v, kf[nt][1].v, acc); }
#pragma unroll
            for (int ii = 0; ii < 4; ++ii) { const int i = mt * 16 + fq * 4 + ii, j = nt * 16 + fr; am[mt][nt][ii] = (nt <= mt && i > j) ? acc[ii] * sg[64 + i] * expf(gci[mt][ii] - gcj[nt]) : 0.f; } }
    asm volatile("" ::: "memory");
    GDN_SOLVE();
#pragma unroll
    for (int t8 = 0; t8 < 8; ++t8) { v4u o;
#pragma unroll
        for (int j = 0; j < 4; ++j) o[j] = pk2(Xl[(t8 * 8 + 2 * j) * 64 + lane], Xl[(t8 * 8 + 2 * j + 1) * 64 + lane]);
        *(v4u*)(UTo + lane * 64 + t8 * 8) = o; }
    LDS_WAIT();
    gdn_conv_chunk<1>(HB, tok0, n == 0, HB_GD_K + h * 64, cw, 256 + h * 64, 1.0f, buf, lane);
    { float xx[64];
#pragma unroll
      for (int t = 0; t < 64; ++t) xx[t] = bf2f(buf[t * 72 + lane]) * sg[64 + t] * sg[128 + t];
      LDS_WAIT();
#pragma unroll
      for (int t = 0; t < 64; ++t) Xl[t * 64 + lane] = xx[t]; }
#pragma unroll
    for (int mt = 0; mt < 4; ++mt)
#pragma unroll
        for (int nt = 0; nt < 4; ++nt) { f32x4 acc = {0.f, 0.f, 0.f, 0.f};
            if (nt <= mt) { acc = mfma16(kf[mt][0].v, kf[nt][0].v, acc); acc = mfma16(kf[mt][1].v, kf[nt][1].v, acc); }
#pragma unroll
            for (int ii = 0; ii < 4; ++ii) { const int i = mt * 16 + fq * 4 + ii, j = nt * 16 + fr; am[mt][nt][ii] = (nt <= mt && i > j) ? acc[ii] * sg[64 + i] * expf(gci[mt][ii] - gcj[nt]) : 0.f; } }
    asm volatile("" ::: "memory");
    GDN_SOLVE();
#pragma unroll 8
    for (int t = 0; t < 64; ++t) Wo[t * 64 + lane] = (bf16)f2bf(Xl[t * 64 + lane]);
    ((float*)(ws + WS_GD_GE))[it] = expf(gend);
    LDS_WAIT();
}
__device__ __forceinline__ void gdn_scan_item(int it, const Args& args, int lane) {
    unsigned char* ws = args.ws; const int bh = it >> 2, vg = it & 3, fr = lane & 15, fq = lane >> 4;
    const bf16* Wb = (const bf16*)(ws + WS_GD_W); const bf16* UTb = (const bf16*)(ws + WS_GD_UT); const bf16* KDTb = (const bf16*)(ws + WS_GD_KDT);
    bf16* STb = (bf16*)(ws + WS_GD_ST); bf16* VNTb = (bf16*)(ws + WS_GD_VNT); const float* GE = (const float*)(ws + WS_GD_GE);
    f32x4 S[4];
#pragma unroll
    for (int mt = 0; mt < 4; ++mt) S[mt] = (f32x4){0.f, 0.f, 0.f, 0.f};
#define GDN_SCAN_LOAD(AW, AKD, UTV, GEV, nn) do { const size_t cb_ = (size_t)(bh * 128 + (nn)) * 4096; _Pragma("unroll") for (int mt = 0; mt < 4; ++mt) { _Pragma("unroll") for (int s = 0; s < 2; ++s) { \
        const bf16* wp = Wb + cb_ + (mt * 16 + fr) * 64 + (2 * s) * 16 + fq * 4; const v2u a0 = *(const v2u*)wp, a1 = *(const v2u*)(wp + 16); AW[mt][s].w[0] = a0.x; AW[mt][s].w[1] = a0.y; AW[mt][s].w[2] = a1.x; AW[mt][s].w[3] = a1.y; \
        const bf16* kp = KDTb + cb_ + (mt * 16 + fr) * 64 + (2 * s) * 16 + fq * 4; const v2u k0 = *(const v2u*)kp, k1 = *(const v2u*)(kp + 16); AKD[mt][s].w[0] = k0.x; AKD[mt][s].w[1] = k0.y; AKD[mt][s].w[2] = k1.x; AKD[mt][s].w[3] = k1.y; } \
        UTV[mt] = *(const v2u*)(UTb + cb_ + (vg * 16 + fr) * 64 + mt * 16 + fq * 4); } GEV = GE[bh * 128 + (nn)]; } while (0)
    Frag aw[4][2], akd[4][2], awn[4][2], akdn[4][2]; v2u ut[4], utn[4]; float ge, gen;
    GDN_SCAN_LOAD(aw, akd, ut, ge, 0);
    for (int n = 0; n < 128; ++n) {
        const size_t cb = (size_t)(bh * 128 + n) * 4096;
        { const int nn = (n + 1 < 128) ? n + 1 : n; GDN_SCAN_LOAD(awn, akdn, utn, gen, nn); }
        Frag bS[2];
#pragma unroll
        for (int s = 0; s < 2; ++s) { bS[s].w[0] = pk2(S[2 * s][0], S[2 * s][1]); bS[s].w[1] = pk2(S[2 * s][2], S[2 * s][3]); bS[s].w[2] = pk2(S[2 * s + 1][0], S[2 * s + 1][1]); bS[s].w[3] = pk2(S[2 * s + 1][2], S[2 * s + 1][3]); }
#pragma unroll
        for (int mt = 0; mt < 4; ++mt) { v2u o; o.x = pk2(S[mt][0], S[mt][1]); o.y = pk2(S[mt][2], S[mt][3]); *(v2u*)(STb + cb + (vg * 16 + fr) * 64 + mt * 16 + fq * 4) = o; }
        Frag bV[2]; unsigned vnw[4][2];
#pragma unroll
        for (int mt = 0; mt < 4; ++mt) { f32x4 acc = {0.f, 0.f, 0.f, 0.f}; acc = mfma16(aw[mt][0].v, bS[0].v, acc); acc = mfma16(aw[mt][1].v, bS[1].v, acc);
            const float v0 = bflo(ut[mt].x) - acc[0], v1 = bfhi(ut[mt].x) - acc[1], v2 = bflo(ut[mt].y) - acc[2], v3 = bfhi(ut[mt].y) - acc[3];
            vnw[mt][0] = pk2(v0, v1); vnw[mt][1] = pk2(v2, v3);
            v2u o; o.x = vnw[mt][0]; o.y = vnw[mt][1]; *(v2u*)(VNTb + cb + (vg * 16 + fr) * 64 + mt * 16 + fq * 4) = o; }
#pragma unroll
        for (int s = 0; s < 2; ++s) { bV[s].w[0] = vnw[2 * s][0]; bV[s].w[1] = vnw[2 * s][1]; bV[s].w[2] = vnw[2 * s + 1][0]; bV[s].w[3] = vnw[2 * s + 1][1]; }
#pragma unroll
        for (int mt = 0; mt < 4; ++mt) { f32x4 acc = S[mt] * ge; acc = mfma16(akd[mt][0].v, bV[0].v, acc); acc = mfma16(akd[mt][1].v, bV[1].v, acc); S[mt] = acc; }
#pragma unroll
        for (int mt = 0; mt < 4; ++mt) { aw[mt][0] = awn[mt][0]; aw[mt][1] = awn[mt][1]; akd[mt][0] = akdn[mt][0]; akd[mt][1] = akdn[mt][1]; ut[mt] = utn[mt]; }
        ge = gen;
    }
}
__device__ __forceinline__ void gdn_out_item(int it, int l, const Args& args, int lane) {
    unsigned char* ws = args.ws; const bf16* HB = (const bf16*)(ws + WS_HB); bf16* XN = (bf16*)(ws + WS_XN);
    const int bh = it >> 7, n = it & 127, b = bh >> 2, h = bh & 3, tok0 = b * SEQ + n * 64, fr = lane & 15, fq = lane >> 4;
    const size_t cb = (size_t)it * 4096;
    const bf16* ST = (const bf16*)(ws + WS_GD_ST) + cb; const bf16* VNT = (const bf16*)(ws + WS_GD_VNT) + cb; const bf16* QD = (const bf16*)(ws + WS_GD_QD) + cb; const bf16* AQK = (const bf16*)(ws + WS_GD_AQK) + cb;
    const float* ng = opaque(args.in[I_GD_NG] + l * 64);
    Frag sa[4][2], va[4][2];
#pragma unroll
    for (int vt = 0; vt < 4; ++vt)
#pragma unroll
        for (int ks = 0; ks < 2; ++ks) { sa[vt][ks].u = *(const v4u*)(ST + (vt * 16 + fr) * 64 + ks * 32 + fq * 8); va[vt][ks].u = *(const v4u*)(VNT + (vt * 16 + fr) * 64 + ks * 32 + fq * 8); }
    for (int lt = 0; lt < 4; ++lt) {
        const int tl = lt * 16 + fr;
        Frag qb[2], ab[2];
#pragma unroll
        for (int ks = 0; ks < 2; ++ks) { qb[ks].u = *(const v4u*)(QD + tl * 64 + ks * 32 + fq * 8); ab[ks].u = *(const v4u*)(AQK + tl * 64 + ks * 32 + fq * 8); }
        f32x4 o[4]; float ss = 0.f;
#pragma unroll
        for (int vt = 0; vt < 4; ++vt) { f32x4 acc = {0.f, 0.f, 0.f, 0.f};
#pragma unroll
            for (int ks = 0; ks < 2; ++ks) { acc = mfma16(sa[vt][ks].v, qb[ks].v, acc); acc = mfma16(va[vt][ks].v, ab[ks].v, acc); }
            o[vt] = acc; ss += acc[0] * acc[0] + acc[1] * acc[1] + acc[2] * acc[2] + acc[3] * acc[3]; }
        ss = red4_sum(ss);
        const float rn = 1.0f / sqrtf(ss * (1.f / 64.f) + NORM_EPS);
        bf16* orow = XN + (size_t)(tok0 + tl) * DM + 512 + h * 64 + fq * 4;
#pragma unroll
        for (int vt = 0; vt < 4; ++vt) { const v2u zw = *(const v2u*)(HB + (size_t)(tok0 + tl) * HBP + HB_GD_Z + h * 64 + vt * 16 + fq * 4);
            const float* gp = ng + vt * 16 + fq * 4;
            v2u w; w.x = pk2(o[vt][0] * rn * gp[0] * silu_f(bflo(zw.x)), o[vt][1] * rn * gp[1] * silu_f(bfhi(zw.x))); w.y = pk2(o[vt][2] * rn * gp[2] * silu_f(bflo(zw.y)), o[vt][3] * rn * gp[3] * silu_f(bfhi(zw.y)));
            *(v2u*)(orow + vt * 16) = w; }
    }
}

__device__ __forceinline__ void nsa_cmp_item(int it2, int l, const Args& args, int lane) {
    unsigned char* ws = args.ws; const bf16* HB = (const bf16*)(ws + WS_HB);
    const int it = it2 >> 1, nh = (it2 & 1) * 2;
    const int b = it >> 6, kind = (it >> 5) & 1, jt = it & 31, fr = lane & 15, fq = lane >> 4;
    const bf16* wt = opaque((const bf16*)(ws + WS_WSM + l * WSM_L + (kind ? WSM_CV : WSM_CK)));
    const float* pos = opaque(args.in[I_CMPPOS] + l * 2048);
    const int j = jt * 16 + fr, col = kind ? HB_NSA_VC : HB_NSA_KC;
    f32x4 acc[2];
#pragma unroll
    for (int nt = 0; nt < 2; ++nt) acc[nt] = (f32x4){0.f, 0.f, 0.f, 0.f};
#pragma unroll 4
    for (int ks = 0; ks < 64; ++ks) {
        const int i = ks >> 1, d0 = (ks & 1) * 32 + fq * 8;
        Frag a; a.u = (v4u){0u, 0u, 0u, 0u};
        if (j < 511) { const v4u x = *(const v4u*)(HB + (size_t)(b * SEQ + 16 * j + i) * HBP + col + d0); const float* pp = pos + i * 64 + d0;
#pragma unroll
            for (int q = 0; q < 4; ++q) a.w[q] = pk2(bflo(x[q]) + pp[2 * q], bfhi(x[q]) + pp[2 * q + 1]); }
#pragma unroll
        for (int nt = 0; nt < 2; ++nt) { Frag bw; bw.u = *(const v4u*)(wt + (size_t)((nh + nt) * 16 + fr) * 2048 + ks * 32 + fq * 8); acc[nt] = mfma16(a.v, bw.v, acc[nt]); }
    }
    if (kind == 0) { bf16* Ko = (bf16*)(ws + WS_NSA_KCMP) + (size_t)b * 512 * 64;
#pragma unroll
        for (int nt = 0; nt < 2; ++nt)
#pragma unroll
            for (int i = 0; i < 4; ++i) Ko[(jt * 16 + fq * 4 + i) * 64 + (nh + nt) * 16 + fr] = (bf16)f2bf(acc[nt][i]);
    } else { bf16* Vo = (bf16*)(ws + WS_NSA_VCMPT) + (size_t)b * 64 * 512;
#pragma unroll
        for (int nt = 0; nt < 2; ++nt) { v2u o; o.x = pk2(acc[nt][0], acc[nt][1]); o.y = pk2(acc[nt][2], acc[nt][3]); *(v2u*)(Vo + ((nh + nt) * 16 + fr) * 512 + jt * 16 + fq * 4) = o; } }
}
__device__ __forceinline__ void nsa_vt_item(int it, int l, const Args& args, LAS unsigned char* wlds, int lane) {
    unsigned char* ws = args.ws; const bf16* HB = (const bf16*)(ws + WS_HB);
    const int b = it >> 8, which = (it >> 7) & 1, n = it & 127;
    LAS bf16* buf = (LAS bf16*)wlds;
    stage64(HB, b * SEQ + n * 64, which ? HB_NSA_VW : HB_NSA_VS, buf, lane);
    if (which) {
        const int fr = lane & 15, fq = lane >> 4;
        bf16* vdst = (bf16*)(ws + WS_NSA_VWT) + ((size_t)(b * 256 + n * 2) * 4) * 512 + lane * 8;
        bf16* kdst = (bf16*)(ws + WS_WIN + l * WIN_L) + ((size_t)(b * 256 + n * 2) * 4) * 512 + lane * 8;
#pragma unroll
        for (int hb = 0; hb < 2; ++hb)
#pragma unroll
            for (int dt = 0; dt < 4; ++dt) { v4u o;
#pragma unroll
                for (int q = 0; q < 2; ++q) {
                    o[q] = (unsigned)buf[(hb * 32 + fq * 4 + 2 * q) * 72 + dt * 16 + fr] | ((unsigned)buf[(hb * 32 + fq * 4 + 2 * q + 1) * 72 + dt * 16 + fr] << 16);
                    o[2 + q] = (unsigned)buf[(hb * 32 + 16 + fq * 4 + 2 * q) * 72 + dt * 16 + fr] | ((unsigned)buf[(hb * 32 + 16 + fq * 4 + 2 * q + 1) * 72 + dt * 16 + fr] << 16); }
                *(v4u*)(vdst + (hb * 4 + dt) * 512) = o; }
#pragma unroll
        for (int hb = 0; hb < 2; ++hb)
#pragma unroll
            for (int tt = 0; tt < 2; ++tt)
#pragma unroll
                for (int ks = 0; ks < 2; ++ks) { const v4u x = *(const v4u*)(HB + (size_t)(b * SEQ + n * 64 + hb * 32 + tt * 16 + fr) * HBP + HB_NSA_KW + ks * 32 + fq * 8); *(v4u*)(kdst + (hb * 4 + tt * 2 + ks) * 512) = x; }
    } else {
        const int fr = lane & 15, fq = lane >> 4;
        bf16* vdst = (bf16*)(ws + WS_NSA_VST) + ((size_t)(b * 128 + n) * 8) * 512 + lane * 8;
        bf16* kdst = (bf16*)(ws + WS_NSA_KSW) + ((size_t)(b * 128 + n) * 8) * 512 + lane * 8;
#pragma unroll
        for (int dt = 0; dt < 4; ++dt)
#pragma unroll
            for (int k2 = 0; k2 < 2; ++k2) { v4u o;
#pragma unroll
                for (int q = 0; q < 2; ++q) {
                    o[q] = (unsigned)buf[(k2 * 32 + fq * 4 + 2 * q) * 72 + dt * 16 + fr] | ((unsigned)buf[(k2 * 32 + fq * 4 + 2 * q + 1) * 72 + dt * 16 + fr] << 16);
                    o[2 + q] = (unsigned)buf[(k2 * 32 + 16 + fq * 4 + 2 * q) * 72 + dt * 16 + fr] | ((unsigned)buf[(k2 * 32 + 16 + fq * 4 + 2 * q + 1) * 72 + dt * 16 + fr] << 16); }
                *(v4u*)(vdst + (dt * 2 + k2) * 512) = o; }
#pragma unroll
        for (int kt = 0; kt < 4; ++kt)
#pragma unroll
            for (int ks = 0; ks < 2; ++ks) { const v4u x = *(const v4u*)(HB + (size_t)(b * SEQ + n * 64 + kt * 16 + fr) * HBP + HB_NSA_KS + ks * 32 + fq * 8); *(v4u*)(kdst + (kt * 2 + ks) * 512) = x; }
    }
    LDS_WAIT();
}
__device__ __forceinline__ void nsa_lut_init(const float* t5, LAS float* lut, int lane) {
#pragma unroll
    for (int r = 0; r < 2; ++r) { const int k = r * 64 + lane, d = (k > 0) ? k - 1 : 0; int bk = d;
        if (d >= 16) { bk = 16 + (int)(logf((float)d / 16.0f) / 2.0794415f * 16.0f); bk = bk < 31 ? bk : 31; }
#pragma unroll
        for (int h = 0; h < 4; ++h) lut[h * 128 + k] = (k > 0) ? t5[bk * 4 + h] : -1e30f; }
    LDS_WAIT();
}
#define NSA_BIAS(dist, h, b31v) (lut[(h) * 128 + (((dist) < -1) ? 0 : (((dist) > 126) ? 127 : (dist) + 1))])
__device__ __forceinline__ void nsa_item(int b, int qt, int l, const Args& args, LAS unsigned char* wlds, int lane) {
    unsigned char* ws = args.ws; const bf16* HB = (const bf16*)(ws + WS_HB); bf16* XN = (bf16*)(ws + WS_XN);
    const int t0 = qt * 16, tok0 = b * SEQ + t0, cur = t0 >> 6, fr = lane & 15, fq = lane >> 4;
    LAS bf16* outb = (LAS bf16*)(wlds + 8192); LAS float* imp = (LAS float*)wlds; const LAS float* lut = (const LAS float*)(wlds + 16384);
    const float* t5 = opaque(args.in[I_T5]);
    const float L2E = 1.4426950408889634f;
    Frag qa[4][2];
#pragma unroll
    for (int h = 0; h < 4; ++h)
#pragma unroll
        for (int ks = 0; ks < 2; ++ks) qa[h][ks].u = *(const v4u*)(HB + (size_t)(tok0 + fr) * HBP + HB_NSA_Q + h * 64 + ks * 32 + fq * 8);
    const int tq = t0 + fr;
#pragma unroll
    for (int i = 0; i < 32; ++i) imp[i * 64 + lane] = 0.f;
    const bf16* KC = (const bf16*)(ws + WS_NSA_KCMP) + (size_t)b * 512 * 64; const bf16* VCT = (const bf16*)(ws + WS_NSA_VCMPT) + (size_t)b * 64 * 512;
    const int nblk = t0 >> 4, npair = (nblk + 31) >> 5;
    float mc[4], lc[4];
#pragma unroll
    for (int h = 0; h < 4; ++h) { mc[h] = -1e30f; lc[h] = 0.f; }
    Frag kc1[2];
#pragma unroll
    for (int ks = 0; ks < 2; ++ks) kc1[ks].u = *(const v4u*)(KC + (size_t)fr * 64 + ks * 32 + fq * 8);
    for (int kt = 0; kt < 2 * npair; ++kt) {
        Frag kf[2], kn1[2];
        { const int ktn = (kt + 1 < 2 * npair) ? kt + 1 : kt;
#pragma unroll
          for (int ks = 0; ks < 2; ++ks) kn1[ks].u = *(const v4u*)(KC + (size_t)(ktn * 16 + fr) * 64 + ks * 32 + fq * 8); }
        kf[0].u = kc1[0].u; kf[1].u = kc1[1].u;
#pragma unroll
        for (int h = 0; h < 4; ++h) { f32x4 acc = {0.f, 0.f, 0.f, 0.f}; acc = mfma16(kf[0].v, qa[h][0].v, acc); acc = mfma16(kf[1].v, qa[h][1].v, acc);
            float s[4]; float mx = -1e30f;
#pragma unroll
            for (int i = 0; i < 4; ++i) { const int dist = tq - (16 * (kt * 16 + fq * 4 + i) + 31); const float bb = NSA_BIAS(dist, h, 0); s[i] = acc[i] * 0.125f + bb; mx = fmaxf(mx, s[i]); }
            mx = red4_max(mx);
            const float mn = fmaxf(mc[h], mx); float ps = 0.f;
#pragma unroll
            for (int i = 0; i < 4; ++i) ps += __builtin_amdgcn_exp2f((s[i] - fmaxf(mn, -1e20f)) * L2E);
            lc[h] = lc[h] * __builtin_amdgcn_exp2f((mc[h] - mn) * L2E) + ps; mc[h] = mn; }
        kc1[0].u = kn1[0].u; kc1[1].u = kn1[1].u;
    }
#pragma unroll
    for (int h = 0; h < 4; ++h) { float t = lc[h]; t = red4_sum(t); lc[h] = (t > 0.f) ? 1.0f / t : 0.f; }
    f32x4 oc[4][4];
#pragma unroll
    for (int dt = 0; dt < 4; ++dt)
#pragma unroll
        for (int h = 0; h < 4; ++h) oc[dt][h] = (f32x4){0.f, 0.f, 0.f, 0.f};
    for (int kp = 0; kp < npair; ++kp) {
        unsigned pw[4][4];
#pragma unroll
        for (int tt = 0; tt < 2; ++tt) { const int kt = kp * 2 + tt; Frag kf[2];
#pragma unroll
            for (int ks = 0; ks < 2; ++ks) kf[ks].u = *(const v4u*)(KC + (size_t)(kt * 16 + fr) * 64 + ks * 32 + fq * 8);
            float impv = 0.f;
#pragma unroll
            for (int h = 0; h < 4; ++h) { f32x4 acc = {0.f, 0.f, 0.f, 0.f}; acc = mfma16(kf[0].v, qa[h][0].v, acc); acc = mfma16(kf[1].v, qa[h][1].v, acc);
                float p[4];
#pragma unroll
                for (int i = 0; i < 4; ++i) { const int dist = tq - (16 * (kt * 16 + fq * 4 + i) + 31);
                    const float bb = NSA_BIAS(dist, h, 0); p[i] = __builtin_amdgcn_exp2f(((acc[i] * 0.125f + bb) - fmaxf(mc[h], -1e20f)) * L2E) * lc[h]; }
                impv += p[0] + p[1] + p[2];
                pw[h][2 * tt] = pk2(p[0], p[1]); pw[h][2 * tt + 1] = pk2(p[2], p[3]); }
            imp[fr * 128 + kt * 4 + fq] = impv; __builtin_amdgcn_sched_barrier(0); }
#pragma unroll
        for (int dt = 0; dt < 4; ++dt) { const bf16* vp = VCT + (size_t)(dt * 16 + fr) * 512 + kp * 32 + fq * 4; const v2u lo2 = *(const v2u*)vp, hi2 = *(const v2u*)(vp + 16);
            Frag vf; vf.w[0] = lo2.x; vf.w[1] = lo2.y; vf.w[2] = hi2.x; vf.w[3] = hi2.y;
#pragma unroll
            for (int h = 0; h < 4; ++h) { Frag pf; pf.w[0] = pw[h][0]; pf.w[1] = pw[h][1]; pf.w[2] = pw[h][2]; pf.w[3] = pw[h][3]; oc[dt][h] = mfma16(vf.v, pf.v, oc[dt][h]); } }
    }
#pragma unroll
    for (int h = 0; h < 4; ++h) { const float gc_ = 1.0f / (1.0f + expf(-bf2f(HB[(size_t)(tok0 + fr) * HBP + HB_NSA_G + 0 + h])));
#pragma unroll
        for (int dt = 0; dt < 4; ++dt) { v2u w; w.x = pk2(oc[dt][h][0] * gc_, oc[dt][h][1] * gc_); w.y = pk2(oc[dt][h][2] * gc_, oc[dt][h][3] * gc_); *(LAS v2u*)(outb + fr * 256 + h * 64 + dt * 16 + fq * 4) = w; } }
    LDS_WAIT();
    unsigned taken = 0u;
    if (cur >= 16) {
        float cand[32];
#pragma unroll
        for (int k = 0; k < 32; ++k) { const int s = fq * 32 + k; cand[k] = (s >= 1 && s <= cur - 2) ? imp[fr * 128 + s] : -1.0f; }
        for (int r = 0; r < 13; ++r) {
            float bv = -1.0f; int bk = 0;
#pragma unroll
            for (int k = 0; k < 32; ++k) { const bool free_ = ((taken >> k) & 1u) == 0u; if (free_ && cand[k] > bv) { bv = cand[k]; bk = k; } }
            int bs = fq * 32 + bk;
#pragma unroll
            for (int o = 16; o <= 32; o <<= 1) { const float ov = __shfl_xor(bv, o); const int os = __shfl_xor(bs, o); if (ov > bv || (ov == bv && os < bs)) { bv = ov; bs = os; } }
            taken |= ((bs >> 5) == fq && bv >= 0.f) ? (1u << (bs & 31)) : 0u;
        }
        taken |= (fq == 0) ? 1u : 0u;
        taken |= ((cur >> 5) == fq) ? (1u << (cur & 31)) : 0u;
        taken |= (((cur - 1) >> 5) == fq) ? (1u << ((cur - 1) & 31)) : 0u;
    } else {
        taken = (fq == 0) ? ((2u << cur) - 1u) : 0u;
    }
    LDS_WAIT();
    const bf16* VST = (const bf16*)(ws + WS_NSA_VST) + (size_t)b * 128 * 4096; const bf16* KSW = (const bf16*)(ws + WS_NSA_KSW) + (size_t)b * 128 * 4096;
    { const int qi = fr >> 2, hh = fr & 3;
      LAS unsigned char* blist = (LAS unsigned char*)wlds;
#define NSA_SEL_LOADK(KF, sblk_) do { const bf16* kp_ = KSW + (size_t)(sblk_) * 4096 + lane * 8; \
        _Pragma("unroll") for (int kt = 0; kt < 4; ++kt) _Pragma("unroll") for (int ks = 0; ks < 2; ++ks) KF[kt][ks].u = *(const v4u*)(kp_ + (kt * 2 + ks) * 512); } while (0)
#define NSA_SEL_LOADV(VF, sblk_) do { const bf16* vp_ = VST + (size_t)(sblk_) * 4096 + lane * 8; \
        _Pragma("unroll") for (int dt = 0; dt < 4; ++dt) _Pragma("unroll") for (int k2 = 0; k2 < 2; ++k2) VF[dt][k2].u = *(const v4u*)(vp_ + (dt * 2 + k2) * 512); } while (0)
#define NSA_SEL_STEP_(KF, VF, sblk_, FAR) do { const int key0 = (sblk_) * 64; const unsigned mwd_ = ((sblk_) >> 5) == 0 ? mw0 : ((sblk_) >> 5) == 1 ? mw1 : ((sblk_) >> 5) == 2 ? mw2 : mw3; const float selm_ = (((mwd_ >> ((sblk_) & 31)) & 1u) != 0u) ? 0.f : -1e30f; \
        f32x4 sc[4]; float mx = -1e30f; const float c0_ = bfar_ + selm_;     \
        _Pragma("unroll") for (int kt = 0; kt < 4; ++kt) { f32x4 acc = {0.f, 0.f, 0.f, 0.f}; acc = mfma16(KF[kt][0].v, qs[0].v, acc); acc = mfma16(KF[kt][1].v, qs[1].v, acc); \
            _Pragma("unroll") for (int i = 0; i < 4; ++i) { if (FAR) sc[kt][i] = acc[i] * 0.125f + c0_; else { const int dist = tqs - (key0 + kt * 16 + fq * 4 + i); const float bb = NSA_BIAS(dist, hh, 0); sc[kt][i] = (acc[i] * 0.125f + bb) + selm_; } mx = fmaxf(mx, sc[kt][i]); } } \
        mx = red4_max(mx); \
        const float mn = fmaxf(ms, mx), alpha = __builtin_amdgcn_exp2f((ms - mn) * L2E), nml_ = -fmaxf(mn, -1e20f) * L2E; ms = mn; \
        float ps = 0.f; unsigned pw[4][2]; \
        _Pragma("unroll") for (int kt = 0; kt < 4; ++kt) { float p[4]; \
            _Pragma("unroll") for (int i = 0; i < 4; ++i) { p[i] = __builtin_amdgcn_exp2f(__builtin_fmaf(sc[kt][i], L2E, nml_)); ps += p[i]; } \
            pw[kt][0] = pk2(p[0], p[1]); pw[kt][1] = pk2(p[2], p[3]); } \
        if (__builtin_amdgcn_ballot_w64(alpha != 1.0f) != 0ull) { ls = ls * alpha; _Pragma("unroll") for (int dt = 0; dt < 4; ++dt) os_[dt] = os_[dt] * alpha; }     \
        ls += ps; \
        _Pragma("unroll") for (int dt = 0; dt < 4; ++dt) { \
            _Pragma("unroll") for (int k2 = 0; k2 < 2; ++k2) { Frag pf; pf.w[0] = pw[2 * k2][0]; pf.w[1] = pw[2 * k2][1]; pf.w[2] = pw[2 * k2 + 1][0]; pf.w[3] = pw[2 * k2 + 1][1]; os_[dt] = mfma16(VF[dt][k2].v, pf.v, os_[dt]); } } } while (0)
#define NSA_SEL_STEP(KF, VF, sblk_) do { if ((sblk_) * 64 + 189 <= t0 + g * 4) NSA_SEL_STEP_(KF, VF, sblk_, 1); else NSA_SEL_STEP_(KF, VF, sblk_, 0); } while (0)
    const float bfar_ = lut[hh * 128 + 127];
    for (int g = 0; g < 4; ++g) {
        const int tqs = t0 + g * 4 + qi;
        Frag qs[2];
#pragma unroll
        for (int ks = 0; ks < 2; ++ks) qs[ks].u = *(const v4u*)(HB + (size_t)(tok0 + g * 4 + qi) * HBP + HB_NSA_Q + hh * 64 + ks * 32 + fq * 8);
        f32x4 os_[4];
#pragma unroll
        for (int dt = 0; dt < 4; ++dt) os_[dt] = (f32x4){0.f, 0.f, 0.f, 0.f};
        float ms = -1e30f, ls = 0.f;
        const unsigned mw0 = (unsigned)__shfl((int)taken, (g * 4 + qi)), mw1 = (unsigned)__shfl((int)taken, (g * 4 + qi) + 16), mw2 = (unsigned)__shfl((int)taken, (g * 4 + qi) + 32), mw3 = (unsigned)__shfl((int)taken, (g * 4 + qi) + 48);
        int nb = 0;
        for (int wd = 0; wd < 4; ++wd) { unsigned uni = 0u;
#pragma unroll
            for (int q2 = 0; q2 < 4; ++q2) uni |= (unsigned)__shfl((int)taken, (g * 4 + q2) + 16 * wd);
            uni = (unsigned)__builtin_amdgcn_readfirstlane((int)uni);
            while (uni) { const int bit = __builtin_ctz(uni); uni &= uni - 1u; blist[nb] = (unsigned char)(wd * 32 + bit); ++nb; } }
        LDS_WAIT();
        Frag kA[4][2], kB[4][2], vv[4][2];
        { const int s0b = __builtin_amdgcn_readfirstlane((int)blist[0]); NSA_SEL_LOADK(kA, s0b); }
        for (int i = 0; i < nb; i += 2) {
            const int sa = __builtin_amdgcn_readfirstlane((int)blist[i]); const int sb = __builtin_amdgcn_readfirstlane((int)blist[(i + 1 < nb) ? i + 1 : i]);
            NSA_SEL_LOADV(vv, sa); NSA_SEL_LOADK(kB, sb);
            NSA_SEL_STEP(kA, vv, sa);
            if (i + 1 < nb) { const int sc2 = __builtin_amdgcn_readfirstlane((int)blist[(i + 2 < nb) ? i + 2 : i]); NSA_SEL_LOADV(vv, sb); NSA_SEL_LOADK(kA, sc2); NSA_SEL_STEP(kB, vv, sb); }
        }
        ls = red4_sum(ls);
        const float gsel = (1.0f / (1.0f + expf(-bf2f(HB[(size_t)(tok0 + g * 4 + qi) * HBP + HB_NSA_G + 4 + hh])))) / ls;
#pragma unroll
        for (int dt = 0; dt < 4; ++dt) { LAS v2u* op = (LAS v2u*)(outb + (g * 4 + qi) * 256 + hh * 64 + dt * 16 + fq * 4); const v2u a = *op; v2u w; w.x = pk2(bflo(a.x) + os_[dt][0] * gsel, bfhi(a.x) + os_[dt][1] * gsel); w.y = pk2(bflo(a.y) + os_[dt][2] * gsel, bfhi(a.y) + os_[dt][3] * gsel); *op = w; }
    } }
    LDS_WAIT();
#pragma unroll
    for (int h = 0; h < 4; ++h)
#pragma unroll
        for (int ks = 0; ks < 2; ++ks) qa[h][ks].u = *(const v4u*)(opaque(HB) + (size_t)(tok0 + fr) * HBP + HB_NSA_Q + h * 64 + ks * 32 + fq * 8);
    const bf16* VWT = (const bf16*)(ws + WS_NSA_VWT) + (size_t)b * 256 * 2048; const bf16* KWW = (const bf16*)(ws + WS_WIN + l * WIN_L) + (size_t)b * 256 * 2048;
    f32x4 ow[4][4];
#pragma unroll
    for (int dt = 0; dt < 4; ++dt)
#pragma unroll
        for (int h = 0; h < 4; ++h) ow[dt][h] = (f32x4){0.f, 0.f, 0.f, 0.f};
    float mw_[4], lw[4];
#pragma unroll
    for (int h = 0; h < 4; ++h) { mw_[h] = -1e30f; lw[h] = 0.f; }
    const int kstart = (t0 >= 512) ? ((t0 - 511) & ~31) : 0;
#define NSA_WIN_LOAD(KF, VF, k0_) do { _Pragma("unroll") for (int tt = 0; tt < 2; ++tt) _Pragma("unroll") for (int ks = 0; ks < 2; ++ks) KF[tt][ks].u = *(const v4u*)(KWW + (size_t)((k0_) >> 5) * 2048 + (tt * 2 + ks) * 512 + lane * 8); \
        _Pragma("unroll") for (int dt = 0; dt < 4; ++dt) VF[dt].u = *(const v4u*)(VWT + (size_t)((k0_) >> 5) * 2048 + dt * 512 + lane * 8); } while (0)
    Frag kf[2][2], vf[4];
    NSA_WIN_LOAD(kf, vf, kstart);
    for (int k0 = kstart; k0 < t0 + 16; k0 += 32) {
        Frag kn[2][2], vn[4];
        { const int k1 = (k0 + 32 < t0 + 16) ? k0 + 32 : k0; NSA_WIN_LOAD(kn, vn, k1); }
#pragma unroll
        for (int h = 0; h < 4; ++h) {
            float s[8]; float mx = -1e30f;
#pragma unroll
            for (int tt = 0; tt < 2; ++tt) { f32x4 acc = {0.f, 0.f, 0.f, 0.f}; acc = mfma16(kf[tt][0].v, qa[h][0].v, acc); acc = mfma16(kf[tt][1].v, qa[h][1].v, acc);
#pragma unroll
                for (int i = 0; i < 4; ++i) { const int dist = tq - (k0 + tt * 16 + fq * 4 + i); const float bb = NSA_BIAS(dist, h, 0); s[tt * 4 + i] = (acc[i] * 0.125f + bb) + ((dist < 512) ? 0.f : -1e30f); mx = fmaxf(mx, s[tt * 4 + i]); } }
            mx = red4_max(mx);
            const float mn = fmaxf(mw_[h], mx), alpha = __builtin_amdgcn_exp2f((mw_[h] - mn) * L2E); mw_[h] = mn;
            float p[8]; float ps = 0.f;
#pragma unroll
            for (int i = 0; i < 8; ++i) { p[i] = __builtin_amdgcn_exp2f((s[i] - fmaxf(mn, -1e20f)) * L2E); ps += p[i]; }
            lw[h] = lw[h] * alpha + ps;
            Frag pf; pf.w[0] = pk2(p[0], p[1]); pf.w[1] = pk2(p[2], p[3]); pf.w[2] = pk2(p[4], p[5]); pf.w[3] = pk2(p[6], p[7]);
#pragma unroll
            for (int dt = 0; dt < 4; ++dt) { ow[dt][h] = ow[dt][h] * alpha; ow[dt][h] = mfma16(vf[dt].v, pf.v, ow[dt][h]); }
            __builtin_amdgcn_sched_barrier(0);
        }
#pragma unroll
        for (int tt = 0; tt < 2; ++tt)
#pragma unroll
            for (int ks = 0; ks < 2; ++ks) kf[tt][ks].u = kn[tt][ks].u;
#pragma unroll
        for (int dt = 0; dt < 4; ++dt) vf[dt].u = vn[dt].u;
    }
#pragma unroll
    for (int h = 0; h < 4; ++h) { float t = lw[h]; t = red4_sum(t);
        const float gw_ = (1.0f / (1.0f + expf(-bf2f(HB[(size_t)(tok0 + fr) * HBP + HB_NSA_G + 8 + h])))) / t;
#pragma unroll
        for (int dt = 0; dt < 4; ++dt) { const v2u a = *(const LAS v2u*)(outb + fr * 256 + h * 64 + dt * 16 + fq * 4);
            v2u w; w.x = pk2(bflo(a.x) + ow[dt][h][0] * gw_, bfhi(a.x) + ow[dt][h][1] * gw_); w.y = pk2(bflo(a.y) + ow[dt][h][2] * gw_, bfhi(a.y) + ow[dt][h][3] * gw_); *(v2u*)(XN + (size_t)(tok0 + fr) * DM + h * 64 + dt * 16 + fq * 4) = w; } }
    LDS_WAIT();
}

#define PEER_SU 64.0f
#define PEER_SV 8.0f
#define PEER_SX 16.0f
typedef float f32x2v __attribute__((ext_vector_type(2)));
__device__ __forceinline__ float gelu_erf(float x) { return 0.5f * x * (1.0f + erff(x * 0.70710678118654752f)); }
template<int MODE> __device__ __forceinline__ void peer_item(int it, int l, const Args& args, LAS unsigned char* wlds, int lane) {
    unsigned char* ws = args.ws; const bf16* QP = (const bf16*)(ws + WS_PEER_QP);
    const int tok0 = it * 16, fr = lane & 15, fq = lane >> 4;
    LAS unsigned short* eidx = (LAS unsigned short*)wlds; LAS float* egate = (LAS float*)(wlds + 4096); LAS float* tkv = (LAS float*)(wlds + 12288);
    LAS float* cbuf = (LAS float*)(wlds + 16384); LAS unsigned char* ctab = (LAS unsigned char*)(wlds + 16384 + 512);
    const bf16* keys = opaque((const bf16*)(ws + WS_PKEYS) + (size_t)l * 8 * 2 * 128 * 128);
    if (MODE & 1) {
    { int c = 0, ij = 0xFF;
#pragma unroll
      for (int i = 0; i < 16; ++i)
#pragma unroll
          for (int j = 0; j < 16; ++j) if ((i + 1) * (j + 1) <= 16) { ij = (c == lane) ? ((i << 4) | j) : ij; ++c; }
      ctab[lane] = (unsigned char)ij; }
    LDS_WAIT();
    Frag qb[4], ka[8][4];
#define PA_LOAD(pc_) do { const bf16* kb_ = keys + (size_t)(pc_) * 128 * 128 + lane * 8;     \
        _Pragma("unroll") for (int ks = 0; ks < 4; ++ks) qb[ks].u = *(const v4u*)(QP + (size_t)(tok0 + fr) * 2048 + (pc_) * 128 + ks * 32 + fq * 8); \
        _Pragma("unroll") for (int mt = 0; mt < 8; ++mt) _Pragma("unroll") for (int ks = 0; ks < 4; ++ks) ka[mt][ks].u = *(const v4u*)(kb_ + (mt * 4 + ks) * 512); } while (0)
    PA_LOAD(0);
    for (int pc = 0; pc < 16; ++pc) {
        const int p = pc >> 1, c = pc & 1;
        {
            float sc[32];
#pragma unroll
            for (int mt = 0; mt < 8; ++mt) { f32x4 acc = {0.f, 0.f, 0.f, 0.f};
#pragma unroll
                for (int ks = 0; ks < 4; ++ks) acc = mfma16(ka[mt][ks].v, qb[ks].v, acc);
#pragma unroll
                for (int i = 0; i < 4; ++i) sc[mt * 4 + i] = __uint_as_float((__float_as_uint(acc[i]) & 0xFFFFFF80u) | (unsigned)(mt * 16 + fq * 4 + i)); }
            { const int pn = (pc < 15) ? pc + 1 : 15; PA_LOAD(pn); }
            __builtin_amdgcn_sched_barrier(0);
#pragma unroll
            for (int k = 2; k <= 32; k <<= 1)
#pragma unroll
                for (int j = k >> 1; j > 0; j >>= 1)
#pragma unroll
                    for (int i = 0; i < 32; ++i) { const int l2 = i ^ j; if (l2 > i) { const float a = sc[i], b2 = sc[l2]; const bool desc = (i & k) == 0; sc[i] = desc ? fmaxf(a, b2) : fminf(a, b2); sc[l2] = desc ? fminf(a, b2) : fmaxf(a, b2); } }
            for (int r = 0; r < 16; ++r) { const float w = red4_max(sc[0]); const bool own = (sc[0] == w);
#pragma unroll
                for (int k = 0; k < 15; ++k) sc[k] = own ? sc[k + 1] : sc[k];
                sc[15] = own ? -3.0e38f : sc[15];
                tkv[c * 256 + fr * 16 + r] = w; }
        }
        if (c == 0) continue;
        LDS_WAIT();
        float cs[16];
#pragma unroll
        for (int r = 0; r < 13; ++r) { const int cid = 4 * r + fq; const int ij = ctab[cid];
            const float v1 = tkv[fr * 16 + (ij >> 4)], v2 = tkv[256 + fr * 16 + (ij & 15)];
            cs[r] = (ij == 0xFF) ? -3.0e38f : __uint_as_float((__float_as_uint(v1 + v2) & 0xFFFFFFC0u) | (unsigned)cid); }
        cs[13] = -3.0e38f; cs[14] = -3.0e38f; cs[15] = -3.0e38f;
#pragma unroll
        for (int k = 2; k <= 16; k <<= 1)
#pragma unroll
            for (int j = k >> 1; j > 0; j >>= 1)
#pragma unroll
                for (int i = 0; i < 16; ++i) { const int l2 = i ^ j; if (l2 > i) { const float a = cs[i], b2 = cs[l2]; const bool desc = (i & k) == 0; cs[i] = desc ? fmaxf(a, b2) : fminf(a, b2); cs[l2] = desc ? fminf(a, b2) : fmaxf(a, b2); } }
        float top0 = 0.f, den = 0.f;
        for (int rr = 0; rr < 16; ++rr) { const float w = red4_max(cs[0]); const bool own = (cs[0] == w);
#pragma unroll
            for (int k = 0; k < 15; ++k) cs[k] = own ? cs[k + 1] : cs[k];
            cs[15] = own ? -3.0e38f : cs[15];
            const int ij = ctab[__float_as_uint(w) & 63u];
            const int i1 = (int)(__float_as_uint(tkv[fr * 16 + (ij >> 4)]) & 127u), i2 = (int)(__float_as_uint(tkv[256 + fr * 16 + (ij & 15)]) & 127u);
            if (rr == 0) top0 = w;
            const float ex = __builtin_amdgcn_exp2f((w - top0) * 1.4426950408889634f); den += ex;
            eidx[fr * 128 + p * 16 + rr] = (unsigned short)(i1 * 128 + i2); egate[fr * 128 + p * 16 + rr] = ex; }
        LDS_WAIT();
        { const float rden = 1.0f / den;
#pragma unroll
          for (int rr = 0; rr < 16; ++rr) egate[fr * 128 + p * 16 + rr] *= rden; }
        LDS_WAIT();
    }
    }
    LDS_WAIT();
    if (!(MODE & 2)) return;
    const float* ngain = opaque((l + 1 < DEPTH) ? (args.in[I_N1G] + (l + 1) * DM) : args.in[I_FNG]);
    const unsigned char* U8 = (const unsigned char*)(ws + WS_PEER_U); const unsigned char* V8 = (const unsigned char*)(ws + WS_PEER_V); const unsigned char* X8 = (const unsigned char*)(ws + WS_PEER_X8);
#define PU_LOAD(S, ks_) do { XA[S] = *(const v4u*)(X8 + tok * DM + (ks_) * 64 + fq * 16); \
        _Pragma("unroll") for (int et = 0; et < 8; ++et) UB[S][et] = *(const v4u*)(U8 + (size_t)el[et] * DM + (ks_) * 64 + fq * 16); } while (0)
#define PU_MMA(S) do { const long xa0 = (long)(((unsigned long long)XA[S][1] << 32) | XA[S][0]), xa1 = (long)(((unsigned long long)XA[S][3] << 32) | XA[S][2]); \
        _Pragma("unroll") for (int et = 0; et < 8; ++et) { const long ub0 = (long)(((unsigned long long)UB[S][et][1] << 32) | UB[S][et][0]), ub1 = (long)(((unsigned long long)UB[S][et][3] << 32) | UB[S][et][2]); \
            acc[et] = __builtin_amdgcn_mfma_f32_16x16x32_fp8_fp8(xa0, ub0, acc[et], 0, 0, 0); acc[et] = __builtin_amdgcn_mfma_f32_16x16x32_fp8_fp8(xa1, ub1, acc[et], 0, 0, 0); } } while (0)
#define PV_LOAD(S, e_) do { _Pragma("unroll") for (int e2 = 0; e2 < 8; ++e2) { const int ex = eidx[t * 128 + (e_) + e2]; VV[S][e2] = *(const v4u*)(V8 + (size_t)ex * DM + lane * 16); } } while (0)
#define PV_FMA(S, e_) do { _Pragma("unroll") for (int e2 = 0; e2 < 8; ++e2) { const float ce = cbuf[(e_) + e2]; \
        _Pragma("unroll") for (int k = 0; k < 4; ++k) { const f32x2v lo2 = __builtin_amdgcn_cvt_pk_f32_fp8((int)VV[S][e2][k], false), hi2 = __builtin_amdgcn_cvt_pk_f32_fp8((int)VV[S][e2][k], true); \
            o[4 * k] += ce * lo2.x; o[4 * k + 1] += ce * lo2.y; o[4 * k + 2] += ce * hi2.x; o[4 * k + 3] += ce * hi2.y; } if (e2 & 1) __builtin_amdgcn_sched_barrier(0); } } while (0)
    for (int t = 0; t < 16; ++t) {
        const size_t tok = (size_t)(tok0 + t);
        const int lane_t = lane_id_v();
        const int lane = lane_t, fr = lane_t & 15, fq = lane_t >> 4;
        const int fr7 = fr & 7, hf = fr >> 3;
        v4u VV[2][8];
#pragma unroll
        for (int tp = 0; tp < 2; ++tp) {
            int el[8];
#pragma unroll
            for (int et = 0; et < 8; ++et) el[et] = eidx[t * 128 + (tp * 8 + et) * 8 + fr7];
            f32x4 acc[8];
#pragma unroll
            for (int et = 0; et < 8; ++et) acc[et] = (f32x4){0.f, 0.f, 0.f, 0.f};
#pragma unroll 2
            for (int ks = 0; ks < 8; ++ks) {
                v4u UB[8];
                const v4u XA = *(const v4u*)(X8 + tok * DM + ks * 128 + (fr & 1) * 64 + fq * 16);
#pragma unroll
                for (int et = 0; et < 8; ++et) UB[et] = *(const v4u*)(U8 + (size_t)el[et] * DM + ks * 128 + hf * 64 + fq * 16);
                const long xa0 = (long)(((unsigned long long)XA[1] << 32) | XA[0]), xa1 = (long)(((unsigned long long)XA[3] << 32) | XA[2]);
#pragma unroll
                for (int et = 0; et < 8; ++et) { const long ub0 = (long)(((unsigned long long)UB[et][1] << 32) | UB[et][0]), ub1 = (long)(((unsigned long long)UB[et][3] << 32) | UB[et][2]);
                    acc[et] = __builtin_amdgcn_mfma_f32_16x16x32_fp8_fp8(xa0, ub0, acc[et], 0, 0, 0); acc[et] = __builtin_amdgcn_mfma_f32_16x16x32_fp8_fp8(xa1, ub1, acc[et], 0, 0, 0); }
            }
            if (tp == 1) { PV_LOAD(0, 0); PV_LOAD(1, 8); }
#pragma unroll
            for (int et = 0; et < 8; ++et) { const float v = hf ? acc[et][1] : acc[et][0]; const float tv = v + dpp_mov<0x128>(v);     const int e = (tp * 8 + et) * 8 + fr7;
                const float c = egate[t * 128 + e] * gelu_erf(tv * (1.0f / (PEER_SX * PEER_SU))) * (1.0f / PEER_SV);
                cbuf[(fq == 0 && hf == 0) ? e : 192 + lane] = c; }
        }
        LDS_WAIT();
        float o[16];
#pragma unroll
        for (int k = 0; k < 16; ++k) o[k] = 0.f;
        for (int e = 0; e < 112; e += 16) {
            PV_FMA(0, e); PV_LOAD(0, e + 16);
            PV_FMA(1, e + 8); PV_LOAD(1, e + 24);
        }
        PV_FMA(0, 112); PV_FMA(1, 120);
        const int lane_e = lane_id_v();
        float* hrow = args.out + tok * DM + lane_e * 16; float ss = 0.f;
#pragma unroll
        for (int k4 = 0; k4 < 4; ++k4) { const f32x4 hv = *(const f32x4*)(hrow + 4 * k4);
#pragma unroll
            for (int k = 0; k < 4; ++k) { o[4 * k4 + k] += hv[k]; ss += o[4 * k4 + k] * o[4 * k4 + k]; } }
        const float rn = 1.0f / sqrtf(wave_sum(ss) * (1.f / DM) + NORM_EPS);
        const float* gp = ngain + lane_e * 16;
        if (l + 1 < DEPTH) {
#pragma unroll
            for (int k4 = 0; k4 < 4; ++k4) { f32x4 hv = {o[4 * k4], o[4 * k4 + 1], o[4 * k4 + 2], o[4 * k4 + 3]}; *(f32x4*)(hrow + 4 * k4) = hv; }
            bf16* xrow = (bf16*)(ws + WS_XN) + tok * DM + lane_e * 16; v4u w0, w1;
#pragma unroll
            for (int k = 0; k < 4; ++k) { w0[k] = pk2(o[2 * k] * rn * gp[2 * k], o[2 * k + 1] * rn * gp[2 * k + 1]); w1[k] = pk2(o[8 + 2 * k] * rn * gp[8 + 2 * k], o[8 + 2 * k + 1] * rn * gp[8 + 2 * k + 1]); }
            *(v4u*)xrow = w0; *(v4u*)(xrow + 8) = w1;
        } else {
#pragma unroll
            for (int k4 = 0; k4 < 4; ++k4) { f32x4 hv = {o[4 * k4] * rn * gp[4 * k4], o[4 * k4 + 1] * rn * gp[4 * k4 + 1], o[4 * k4 + 2] * rn * gp[4 * k4 + 2], o[4 * k4 + 3] * rn * gp[4 * k4 + 3]}; *(f32x4*)(hrow + 4 * k4) = hv; }
        }
        LDS_WAIT();
    }
}

#ifndef MK_SPLIT
#define MK_SPLIT 0
#endif

#define IN(k) (lo <= (k) && (k) < hi)
#define SEAM(k) do { if (IN(k) && IN((k) + 1)) xcd_barrier(bar, wave == 0 && lane_id_v() == 0); } while (0)
template <int l>
__device__ __forceinline__ void layer_phases(const Args& args, LAS unsigned char* lds, const XcdBarrier& bar, const int lo, const int hi, const int wave) {
    constexpr int G = GRID_WG; const int bx = blockIdx.x;
    const int gw = bx * NWAVES + wave, NGW = G * NWAVES, vw = wave * G + bx;
    unsigned char* ws = args.ws;
    unsigned* ctl = (unsigned*)(ws + WS_CTL);
    LAS unsigned char* wlds = lds + wave * WAVE_LDS;
    bf16* XN = (bf16*)(ws + WS_XN); bf16* HB = (bf16*)(ws + WS_HB);
    (void)gw; (void)NGW; (void)ctl; (void)wlds; (void)HB; (void)vw;
        const int pb = 1 + 8 * l;
        if (IN(pb + 0)) {
            const int lane = lane_id_v(); (void)lane;
            pg8::Gemm g{XN, (const bf16*)(ws + WS_WIN + l * WIN_L), M_TOK, N_IN_PAD, DM}; pg8::StaticOrder S; S.init(M_TOK, N_IN_PAD, G, bx);
            pg8::EpiHb E{HB, HBP, HBP};
            pg8::gemm_phase<pg8::EpiHb, pg8::StaticOrder, true, true>(lds, g, S, E, wave);
        }
        SEAM(pb + 0);
        if (IN(pb + 1)) {
            const int lane = lane_id_v(); (void)lane;
            { const int it = vw - 256; if (it >= 0 && it < 512) nsa_cmp_item(it, l, args, lane_id_v()); }
            for (int it = vw; it < 2048; it += NGW) { gdn_prep_item(it, l, args, wlds, lane_id_v()); }
            for (int it = vw; it < M_TOK / 16; it += NGW) { mla_prep_item(it, l, args, lane_id_v()); }
            for (int it = vw; it < 2048; it += NGW) { mlstm_prep_item(it, l, args, wlds, lane_id_v()); }
            { const int it = vw - 1024; if (it >= 0) nsa_vt_item(it, l, args, wlds, lane_id_v()); }
        }
        SEAM(pb + 1);
        if (IN(pb + 2)) {
            const int lane = lane_id_v(); (void)lane;
            nsa_lut_init(args.in[I_T5], (LAS float*)(wlds + 16384), lane);
            { const int it = vw - 256; if (it >= 0 && it < 64) gdn_scan_item(it, args, lane_id_v()); }
            { const int it = vw; if (it < 256) mlstm_scan_item(it, args, lane_id_v()); }
            for (int it = vw; it < 2048; it += NGW) { mla_attn_item(it & 15, 127 - (it >> 4), args, wlds, lane_id_v()); }
            { unsigned* qh = ctl + CW_Q + 64 * (l * 8 + (bx & 7));
              for (;;) { const int m = wave_pop(qh, lane_id_v()); if (m >= 256) break; const int j = 8 * m + (7 - (bx & 7)); nsa_item(j & 3, 511 - (j >> 2), l, args, wlds, lane_id_v()); } }
        }
        SEAM(pb + 2);
        if (IN(pb + 3)) {
            const int lane = lane_id_v(); (void)lane;
            for (int it = vw; it < 2048; it += NGW) { gdn_out_item(it, l, args, lane_id_v()); }
            for (int it = vw; it < 2048; it += NGW) { mlstm_out_item(it, l, args, wlds, lane_id_v()); }
            {
                const f32x4* su = (const f32x4*)(args.in[I_PEER_U] + (size_t)l * 16384 * DM); const f32x4* sv = (const f32x4*)(args.in[I_PEER_V] + (size_t)l * 16384 * DM);
                v4u* du = (v4u*)(ws + WS_PEER_U); v4u* dv = (v4u*)(ws + WS_PEER_V);
                unsigned* du32 = (unsigned*)du; unsigned* dv32 = (unsigned*)dv;
                for (size_t c = (size_t)gw; c < (size_t)16384 * DM / 1024; c += (size_t)NGW) {
                    f32x4 a[4], b2[4];
#pragma unroll
                    for (int q = 0; q < 4; ++q) { a[q] = su[c * 256 + q * 64 + lane]; b2[q] = sv[c * 256 + q * 64 + lane]; }
#pragma unroll
                    for (int q = 0; q < 4; ++q) {
                        int pa = __builtin_amdgcn_cvt_pk_fp8_f32(a[q][0] * PEER_SU, a[q][1] * PEER_SU, 0, false); pa = __builtin_amdgcn_cvt_pk_fp8_f32(a[q][2] * PEER_SU, a[q][3] * PEER_SU, pa, true);
                        int pb2 = __builtin_amdgcn_cvt_pk_fp8_f32(b2[q][0] * PEER_SV, b2[q][1] * PEER_SV, 0, false); pb2 = __builtin_amdgcn_cvt_pk_fp8_f32(b2[q][2] * PEER_SV, b2[q][3] * PEER_SV, pb2, true);
                        du32[c * 256 + q * 64 + lane] = (unsigned)pa; dv32[c * 256 + q * 64 + lane] = (unsigned)pb2; }
                }
            }
        }
        SEAM(pb + 3);
        if (IN(pb + 4)) {
            const int lane = lane_id_v(); (void)lane;
            pg8::Gemm g{XN, (const bf16*)(ws + WS_WOUT + l * WOUT_L), M_TOK, DM, DM}; pg8::StaticOrder S; S.init(M_TOK, DM, G, bx);
            pg8::EpiRes E{args.out, l == 0 ? args.in[I_X] : (const float*)args.out, DM};
            pg8::gemm_phase<pg8::EpiRes, pg8::StaticOrder, true, true>(lds, g, S, E, wave);
        }
        SEAM(pb + 4);
        if (IN(pb + 5)) {
            const int lane = lane_id_v(); (void)lane;
            {
                const float* g2 = args.in[I_N2G] + l * DM; unsigned char* X8 = ws + WS_PEER_X8;
                f32x4 gg[4];
#pragma unroll
                for (int j = 0; j < 4; ++j) gg[j] = ((const f32x4*)g2)[lane + 64 * j];
                for (int m0 = gw; m0 < M_TOK; m0 += 4 * NGW) {
                    f32x4 v[4][4]; float s[4];
#pragma unroll
                    for (int q = 0; q < 4; ++q) { const f32x4* xr = (const f32x4*)(args.out + (size_t)(m0 + q * NGW) * DM) + lane; s[q] = 0.f;
#pragma unroll
                        for (int j = 0; j < 4; ++j) { v[q][j] = xr[64 * j]; s[q] += (v[q][j].x * v[q][j].x + v[q][j].y * v[q][j].y) + (v[q][j].z * v[q][j].z + v[q][j].w * v[q][j].w); } }
#pragma unroll
                    for (int q = 0; q < 4; ++q) { const size_t m = (size_t)(m0 + q * NGW); const float r = 1.0f / sqrtf(wave_sum(s[q]) * (1.f / DM) + NORM_EPS);
#pragma unroll
                        for (int j = 0; j < 4; ++j) { const float y0 = v[q][j].x * r * gg[j].x, y1 = v[q][j].y * r * gg[j].y, y2 = v[q][j].z * r * gg[j].z, y3 = v[q][j].w * r * gg[j].w;
                            v2u o; o.x = pk2(y0, y1); o.y = pk2(y2, y3); ((v2u*)(XN + m * DM))[lane + 64 * j] = o;
                            int p8 = __builtin_amdgcn_cvt_pk_fp8_f32(y0 * PEER_SX, y1 * PEER_SX, 0, false); p8 = __builtin_amdgcn_cvt_pk_fp8_f32(y2 * PEER_SX, y3 * PEER_SX, p8, true);
                            ((int*)(X8 + m * DM))[lane + 64 * j] = p8; } }
                }
            }
        }
        SEAM(pb + 5);
        if (IN(pb + 6)) {
            const int lane = lane_id_v(); (void)lane;
            pg8::Gemm g{XN, (const bf16*)(ws + WS_WQ + l * WQ_L), M_TOK, 2048, DM}; pg8::StaticOrder S; S.init(M_TOK, 2048, G, bx);
            pg8::EpiBf16<0> E{(bf16*)(ws + WS_PEER_QP), 2048, nullptr, 0, 0, 1.f};
            pg8::gemm_phase<pg8::EpiBf16<0>, pg8::StaticOrder, true, true>(lds, g, S, E, wave);
        }
        SEAM(pb + 6);
        if (IN(pb + 7)) {
            const int lane = lane_id_v(); (void)lane;
            static_assert(G * NWAVES == M_TOK / 16, "one PEER item per wave");
            for (int it = vw; it < M_TOK / 16; it += NGW) { peer_item<1>(it, l, args, wlds, lane_id_v()); }
            for (int it = vw; it < M_TOK / 16; it += NGW) { peer_item<2>(it, l, args, wlds, lane_id_v()); }
        }
        SEAM(pb + 7);
}

__global__ void __launch_bounds__(NWAVES * 64, 2) fwd_kernel(Args args) {
    extern __shared__ __attribute__((aligned(16))) unsigned char lds_raw[];
    LAS unsigned char* lds = (LAS unsigned char*)lds_raw;
    volatile LAS unsigned* MISC = (volatile LAS unsigned*)(lds + MISC_OFF);
    const int wave = __builtin_amdgcn_readfirstlane((int)(threadIdx.x >> 6)); const int tid = wave * 64 + lane_id_v();
    constexpr int G = GRID_WG; const int bx = blockIdx.x;
    const int gw = bx * NWAVES + wave, NGW = G * NWAVES;
    unsigned char* ws = args.ws;
    unsigned* ctl = (unsigned*)(ws + WS_CTL);
    for (int u = tid; u < (LDS_BYTES - MISC_OFF) / 4; u += NWAVES * 64) MISC[u] = 0u;
    __syncthreads();
    XcdBarrier bar; bar.bar = ctl + CW_BAR; bar.x = 0; bar.st = nullptr;
    if (!MK_SPLIT) bar = xcd_barrier_post(ctl + CW_BAR, MISC + 8, tid == 0);
    const int lo = args.ph_lo, hi = args.ph_hi;
    LAS unsigned char* wlds = lds + wave * WAVE_LDS;
    bf16* XN = (bf16*)(ws + WS_XN); bf16* HB = (bf16*)(ws + WS_HB);

    if (IN(0)) {
        const int lane = lane_id_v();
        LAS float* scr = (LAS float*)wlds;
        constexpr int I_IN = (DM / 64) * (N_IN_PAD / 32), I_OUT = (DM / 64) * (DM / 32), I_Q = (DM / 64) * (2048 / 32);
        constexpr int I_UQ = (256 / 64) * (384 / 32), I_UKV = (128 / 64) * (512 / 32), I_CMP = (2048 / 64) * (64 / 32);
        constexpr int PER_L = I_IN + I_OUT + I_Q + I_UQ + I_UKV + 2 * I_CMP;
        for (int it = gw; it < DEPTH * PER_L; it += NGW) {
            const int l = it / PER_L; int r = it % PER_L;
            unsigned char* wsm = ws + WS_WSM + l * WSM_L;
            if (r < I_IN) { tr_item(args.in[I_WIN] + (size_t)l * DM * D_IN, D_IN, D_IN, MapHb(), (bf16*)(ws + WS_WIN + l * WIN_L), DM, scr, r / (N_IN_PAD / 32), r % (N_IN_PAD / 32), lane); continue; } r -= I_IN;
            if (r < I_OUT) { tr_item(args.in[I_WOUT] + (size_t)l * DM * DM, DM, DM, MapId(), (bf16*)(ws + WS_WOUT + l * WOUT_L), DM, scr, r / (DM / 32), r % (DM / 32), lane); continue; } r -= I_OUT;
            if (r < I_Q) { tr_item(args.in[I_PEER_WQ] + (size_t)l * DM * 2048, 2048, 2048, MapId(), (bf16*)(ws + WS_WQ + l * WQ_L), DM, scr, r / (2048 / 32), r % (2048 / 32), lane); continue; } r -= I_Q;
            if (r < I_UQ) { tr_item(args.in[I_MLA_WUQ] + (size_t)l * 256 * 384, 384, 384, MapId(), (bf16*)(wsm + WSM_UQ), 256, scr, r / (384 / 32), r % (384 / 32), lane); continue; } r -= I_UQ;
            if (r < I_UKV) { tr_item(args.in[I_MLA_WUKV] + (size_t)l * 128 * 512, 512, 512, MapId(), (bf16*)(wsm + WSM_UKV), 128, scr, r / (512 / 32), r % (512 / 32), lane); continue; } r -= I_UKV;
            if (r < I_CMP) { tr_item(args.in[I_CMPK] + (size_t)l * 2048 * 64, 64, 64, MapId(), (bf16*)(wsm + WSM_CK), 2048, scr, r / 2, r % 2, lane); continue; } r -= I_CMP;
            tr_item(args.in[I_CMPV] + (size_t)l * 2048 * 64, 64, 64, MapId(), (bf16*)(wsm + WSM_CV), 2048, scr, r / 2, r % 2, lane);
        }
        { const f32x4* ksrc = (const f32x4*)args.in[I_PEER_KEYS]; v2u* kdst = (v2u*)(ws + WS_PKEYS);
          for (int i = gw * 64 + lane; i < DEPTH * 16 * 128 * 128 / 4; i += NGW * 64) { const f32x4 a = ksrc[i]; v2u o; o.x = pk2(a[0], a[1]); o.y = pk2(a[2], a[3]);
              const int mat = i >> 12, m = (i >> 5) & 127, k4 = (i & 31) * 4;
              kdst[(size_t)mat * 4096 + ((((m >> 4) * 4 + (k4 >> 5)) * 64 + ((k4 >> 3) & 3) * 16 + (m & 15)) * 8 + (k4 & 7)) / 4] = o; } }
        for (int m0 = gw; m0 < M_TOK; m0 += 4 * NGW) {
            f32x4 v[4][4]; float s[4];
#pragma unroll
            for (int q = 0; q < 4; ++q) { const f32x4* xr = (const f32x4*)(args.in[I_X] + (size_t)(m0 + q * NGW) * DM) + lane; s[q] = 0.f;
#pragma unroll
                for (int j = 0; j < 4; ++j) { v[q][j] = xr[64 * j]; s[q] += (v[q][j].x * v[q][j].x + v[q][j].y * v[q][j].y) + (v[q][j].z * v[q][j].z + v[q][j].w * v[q][j].w); } }
#pragma unroll
            for (int q = 0; q < 4; ++q) { const float r = 1.0f / sqrtf(wave_sum(s[q]) * (1.f / DM) + NORM_EPS); v2u* o8 = (v2u*)(XN + (size_t)(m0 + q * NGW) * DM) + lane;
#pragma unroll
                for (int j = 0; j < 4; ++j) { const f32x4 gg = ((const f32x4*)args.in[I_N1G])[lane + 64 * j]; v2u o; o.x = pk2(v[q][j].x * r * gg.x, v[q][j].y * r * gg.y); o.y = pk2(v[q][j].z * r * gg.z, v[q][j].w * r * gg.w); o8[64 * j] = o; } }
        }
    }
    SEAM(0);

    layer_phases<0>(args, lds, bar, lo, hi, wave);
    layer_phases<1>(args, lds, bar, lo, hi, wave);
#undef IN
#undef SEAM
}

extern "C" void kernel_launch(void* const* d_in, const int* in_sizes, int n_in, void* d_out, int out_size, void* d_ws, size_t ws_size, hipStream_t stream) {
    static int grid = 0;
    if (grid == 0) {
        if (n_in != 26 || in_sizes[0] != M_TOK * DM || out_size != M_TOK * DM || ws_size < WS_END) { fprintf(stderr, "kernel_launch: unexpected shapes/workspace (n_in %d, ws %zu < %zu)\n", n_in, ws_size, (size_t)WS_END); grid = -1; return; }
        int dev = 0, cus = 0, per_cu = 0;
        if (hipGetDevice(&dev) != hipSuccess || hipDeviceGetAttribute(&cus, hipDeviceAttributeMultiprocessorCount, dev) != hipSuccess) { grid = -1; return; }
        if (hipFuncSetAttribute((const void*)fwd_kernel, hipFuncAttributeMaxDynamicSharedMemorySize, LDS_BYTES) != hipSuccess) { fprintf(stderr, "kernel_launch: hipFuncSetAttribute failed\n"); grid = -1; return; }
        if (hipOccupancyMaxActiveBlocksPerMultiprocessor(&per_cu, (const void*)fwd_kernel, NWAVES * 64, LDS_BYTES) != hipSuccess || per_cu < 1) { fprintf(stderr, "kernel_launch: occupancy query says %d blocks per CU\n", per_cu); }
        (void)hipGetLastError();
        if (cus < GRID_WG) { fprintf(stderr, "kernel_launch: %d CUs < %d workgroups: the grid would not be resident\n", cus, GRID_WG); grid = -1; return; }
        grid = GRID_WG;
    }
    if (grid < 0) return;
    if (hipMemsetAsync((char*)d_ws + WS_CTL, 0, CTL_ZERO_BYTES, stream) != hipSuccess) return;
    Args a{};
    for (int i = 0; i < 26; ++i) a.in[i] = (const float*)d_in[i];
    a.out = (float*)d_out; a.ws = (unsigned char*)d_ws;
#if MK_SPLIT
    for (int p = 0; p < N_PHASES; ++p) { a.ph_lo = p; a.ph_hi = p + 1; hipLaunchKernelGGL(fwd_kernel, dim3(grid), dim3(NWAVES * 64), LDS_BYTES, stream, a); }
#else
    a.ph_lo = 0; a.ph_hi = N_PHASES;
    hipLaunchKernelGGL(fwd_kernel, dim3(grid), dim3(NWAVES * 64), LDS_BYTES, stream, a);
#endif
    const hipError_t le = hipPeekAtLastError();
    if (le != hipSuccess) fprintf(stderr, "kernel_launch: launch failed: %s\n", hipGetErrorName(le));
}
```

```cpp
#include <hip/hip_runtime.h>
#include <cstdio>
#include <cstdint>

namespace pg8 {
#define PG8_LAS __attribute__((address_space(3)))
typedef unsigned short bf16_t;
typedef short bf16x8 __attribute__((ext_vector_type(8)));
typedef float f32x4 __attribute__((ext_vector_type(4)));
typedef unsigned u32x4 __attribute__((ext_vector_type(4)));
constexpr int BM = 256, BK = 64, HALF = 128, HTB = HALF * BK * 2  , STAGE_BYTES = 8 * HTB, NXCD = 8, WGM = 8;

__host__ __device__ __forceinline__ int lds_byte(int r, int c) { const int st = (r >> 4) * 2 + (c >> 5), rr = r & 15, cc = c & 31, ob = rr * 64 + cc * 2; return st * 1024 + (ob ^ (((ob >> 9) & 1) << 5)); }
__host__ __device__ __forceinline__ void stage_rc(int b, int& R, int& C) { const int st = b / 1024, sb = b % 1024, swz = sb ^ (((sb >> 9) & 1) << 5); R = (st >> 1) * 16 + swz / 64; C = (st & 1) * 32 + (swz % 64) / 2; }
__host__ __device__ __forceinline__ int perm32(int rho) { const int n = rho >> 4, i = rho & 15; return 8 * (i >> 2) + 4 * n + (i & 3); }

struct Unit { int pm, pn; };
struct Gemm { const bf16_t* A; const bf16_t* Bt; int M, N, K; };

struct StaticOrder {
    int nM, nN, nwg, G, c;
    __host__ __device__ void init(int M, int N, int G_, int c_) { nM = M / BM; nN = N / BM; nwg = nM * nN; G = G_; c = c_; }
    __host__ __device__ bool next(int i, Unit& u) const {
        const long L = (long)i * G + c; if (L >= nwg) return false;
        int wgid = (int)L; { const int q = nwg / NXCD, r = nwg % NXCD, xcd = wgid % NXCD, off = wgid / NXCD; wgid = (xcd < r ? xcd * (q + 1) : r * (q + 1) + (xcd - r) * q) + off; }
        const int nig = WGM * nN, gid = wgid / nig, fm = gid * WGM, gsz = (nM - fm) < WGM ? (nM - fm) : WGM;
        u.pm = fm + ((wgid % nig) % gsz); u.pn = (wgid % nig) / gsz; return true;
    }
    __device__ __forceinline__ void a_ready(const Unit&) const {}
    __device__ __forceinline__ void done(const Unit&) const {}
};

typedef __bf16 pg8_bf16x2 __attribute__((ext_vector_type(2)));
typedef float pg8_f32x2 __attribute__((ext_vector_type(2)));
__device__ __forceinline__ unsigned cvt_pk_bf16(float lo, float hi) { const pg8_f32x2 v = {lo, hi}; const pg8_bf16x2 b = __builtin_convertvector(v, pg8_bf16x2); return __builtin_bit_cast(unsigned, b); }
typedef float f32x2 __attribute__((ext_vector_type(2)));
__device__ __forceinline__ f32x2 gelu_pk(f32x2 v) {
    const f32x2 av = __builtin_elementwise_abs(v), d = av * 0.2316418882f + 1.0f;
    f32x2 t; t.x = __builtin_amdgcn_rcpf(d.x); t.y = __builtin_amdgcn_rcpf(d.y);
    f32x2 q = t * 0.5307027145f + (-0.7265760135f); q = q * t + 0.7107068705f; q = q * t + (-0.142248368f); q = q * t + 0.127414796f; q = q * t;
    const f32x2 s = (v * v) * (-0.72134752044f);
    f32x2 e; e.x = __builtin_amdgcn_exp2f(s.x); e.y = __builtin_amdgcn_exp2f(s.y);
    const f32x2 m = v * (q * e), r = v - m;
    f32x2 o; o.x = v.x < 0.f ? m.x : r.x; o.y = v.y < 0.f ? m.y : r.y; return o;
}


template <int ACT  > struct EpiBf16 {
    static constexpr bool PERM = true, AFTER_DRAIN = false; static_assert(ACT == 0 || ACT == 1, "EpiBf16: ACT is 0 (none) or 1 (gelu_pk)");
    bf16_t* O; int ldc; const float* bias; int split_cols; size_t split_stride; float scale0;
    __device__ __forceinline__ void operator()(const f32x4 (&acc)[2][2][4][2], const Unit& u, int wr, int wc, int fr, int fq) const {
        const int row0 = u.pm * BM + wr * 64 + fr; int colt = u.pn * BM; bf16_t* base = O;
        float sc = 1.f; if (split_cols) { const int t = colt / split_cols; base += (size_t)t * split_stride; colt -= t * split_cols; if (t == 0) sc = scale0; }
        const int col0 = colt + wc * 32 + 8 * fq, bcol0 = u.pn * BM + wc * 32 + 8 * fq;
        f32x4 bv[2][2];
#pragma unroll
        for (int bj = 0; bj < 2; ++bj)
#pragma unroll
            for (int n = 0; n < 2; ++n) bv[bj][n] = bias ? *(const f32x4*)(bias + bcol0 + bj * HALF + 4 * n) : (f32x4){0.f, 0.f, 0.f, 0.f};
#pragma unroll
        for (int ai = 0; ai < 2; ++ai)
#pragma unroll
            for (int m = 0; m < 4; ++m) { bf16_t* rowp = base + (size_t)(row0 + ai * HALF + m * 16) * ldc + col0;
#pragma unroll
                for (int bj = 0; bj < 2; ++bj) { f32x4 v0 = acc[ai][bj][m][0] + bv[bj][0], v1 = acc[ai][bj][m][1] + bv[bj][1];
                    if (ACT == 1) { f32x2 a = gelu_pk((f32x2){v0[0], v0[1]}), b = gelu_pk((f32x2){v0[2], v0[3]}), c = gelu_pk((f32x2){v1[0], v1[1]}), d = gelu_pk((f32x2){v1[2], v1[3]});
                        v0 = (f32x4){a.x, a.y, b.x, b.y}; v1 = (f32x4){c.x, c.y, d.x, d.y}; }
                    v0 = v0 * sc; v1 = v1 * sc; u32x4 w; w.x = cvt_pk_bf16(v0[0], v0[1]); w.y = cvt_pk_bf16(v0[2], v0[3]); w.z = cvt_pk_bf16(v1[0], v1[1]); w.w = cvt_pk_bf16(v1[2], v1[3]);
                    *(u32x4*)(rowp + bj * HALF) = w; } }
    }
};

struct EpiHb {
    static constexpr bool PERM = true, AFTER_DRAIN = false;
    bf16_t* O; int ldc; int ncols;
    __device__ __forceinline__ void operator()(const f32x4 (&acc)[2][2][4][2], const Unit& u, int wr, int wc, int fr, int fq) const {
        const int row0 = u.pm * BM + wr * 64 + fr; const int col0 = u.pn * BM + wc * 32 + 8 * fq;
#pragma unroll
        for (int ai = 0; ai < 2; ++ai)
#pragma unroll
            for (int m = 0; m < 4; ++m) { bf16_t* rowp = O + (size_t)(row0 + ai * HALF + m * 16) * ldc + col0;
#pragma unroll
                for (int bj = 0; bj < 2; ++bj) { const f32x4 v0 = acc[ai][bj][m][0], v1 = acc[ai][bj][m][1];
                    u32x4 w; w.x = cvt_pk_bf16(v0[0], v0[1]); w.y = cvt_pk_bf16(v0[2], v0[3]); w.z = cvt_pk_bf16(v1[0], v1[1]); w.w = cvt_pk_bf16(v1[2], v1[3]);
                    if (col0 + bj * HALF < ncols) *(u32x4*)(rowp + bj * HALF) = w; } }
    }
};
struct EpiRes {
    static constexpr bool PERM = false, AFTER_DRAIN = false;
    float* C; const float* R; int ldc;
    __device__ __forceinline__ void operator()(const f32x4 (&acc)[2][2][4][2], const Unit& u, int wr, int wc, int fr, int fq) const {
        const int row0 = u.pm * BM + wr * 64 + fr, col0 = u.pn * BM + wc * 32 + 4 * fq;
#pragma unroll
        for (int ai = 0; ai < 2; ++ai)
#pragma unroll
            for (int m = 0; m < 4; ++m) { const size_t ro = (size_t)(row0 + ai * HALF + m * 16) * ldc + col0;
#pragma unroll
                for (int bj = 0; bj < 2; ++bj)
#pragma unroll
                    for (int n = 0; n < 2; ++n) { const f32x4 r = *(const f32x4*)(R + ro + bj * HALF + n * 16); *(f32x4*)(C + ro + bj * HALF + n * 16) = acc[ai][bj][m][n] + r; } }
    }
};


template <class Epi, class Sched, bool ALIGN_EPI = false, bool SP2 = false>
__device__ __forceinline__ void gemm_phase(PG8_LAS unsigned char* lds, const Gemm g, const Sched& S, const Epi& E, const int wave_in) {
    const int wid = wave_in, lane = (int)__builtin_amdgcn_mbcnt_hi(~0u, __builtin_amdgcn_mbcnt_lo(~0u, 0u)), tid = wid * 64 + lane, wr = wid >> 2, wc = wid & 3, fr = lane & 15, fq = lane >> 4;
    const int K = g.K, nt = K / BK;
    unsigned voffA[2], voffB[2];
#pragma unroll
    for (int i = 0; i < 2; ++i) { int R, C; stage_rc(tid * 16 + i * 8192, R, C); const int Rb = Epi::PERM ? ((R & ~31) + perm32(R & 31)) : R;
        voffA[i] = (unsigned)(R * K + C) * 2u; voffB[i] = (unsigned)(Rb * K + C) * 2u; }
    const size_t kstep = (size_t)(BK * 2);
    const size_t hstep = (size_t)HALF * K * 2;
    const size_t tstep = 2 * hstep;
    const unsigned ldsw = (unsigned)wid * 1024u;
    const int aoff = lds_byte(wr * 64 + fr, fq * 8), boff = lds_byte(wc * 32 + fr, fq * 8);
#define PG8_SA(b, h) (((b) * 2 + (h)) * HTB)
#define PG8_SB(b, h) ((4 + (b) * 2 + (h)) * HTB)
#define PG8_STAGE(bufoff, gbase, voff) do { _Pragma("unroll") for (int _i = 0; _i < 2; ++_i) \
        __builtin_amdgcn_global_load_lds((const unsigned*)((const char*)(gbase) + (voff)[_i]), (PG8_LAS unsigned*)(lds + (bufoff) + ldsw + _i * 8192), 16, 0, 0); } while (0)
#define PG8_LDA(dst, b, h) do { _Pragma("unroll") for (int m = 0; m < 4; ++m) _Pragma("unroll") for (int k = 0; k < 2; ++k) dst[m][k] = *(const PG8_LAS bf16x8*)(lds + PG8_SA(b, h) + aoff + m * 2048 + k * 1024); } while (0)
#define PG8_LDB(dst, b, h) do { _Pragma("unroll") for (int n = 0; n < 2; ++n) _Pragma("unroll") for (int k = 0; k < 2; ++k) dst[n][k] = *(const PG8_LAS bf16x8*)(lds + PG8_SB(b, h) + boff + n * 2048 + k * 1024); } while (0)
#define PG8_MMA(ai, bj, At, Bt) do { __builtin_amdgcn_s_setprio(1); _Pragma("unroll") for (int m = 0; m < 4; ++m) _Pragma("unroll") for (int n = 0; n < 2; ++n) _Pragma("unroll") for (int k = 0; k < 2; ++k) \
        acc[ai][bj][m][n] = __builtin_amdgcn_mfma_f32_16x16x32_bf16(Bt[n][k], At[m][k], acc[ai][bj][m][n], 0, 0, 0); __builtin_amdgcn_s_setprio(0); } while (0)
#define PG8_WAIT_V(n) asm volatile("s_waitcnt vmcnt(" #n ")" ::: "memory")
#define PG8_WAIT_L(n) asm volatile("s_waitcnt lgkmcnt(" #n ")" ::: "memory")
#define PG8_BAR __builtin_amdgcn_s_barrier()
#define PG8_SCHED __builtin_amdgcn_sched_barrier(0)
    Unit cur, nxt; int ui = 0;
    if (!S.next(0, cur)) return;
    f32x4 acc[2][2][4][2];
#pragma unroll
    for (int a = 0; a < 2; ++a)
#pragma unroll
        for (int b = 0; b < 2; ++b)
#pragma unroll
            for (int m = 0; m < 4; ++m)
#pragma unroll
                for (int n = 0; n < 2; ++n) acc[a][b][m][n] = (f32x4){0.f, 0.f, 0.f, 0.f};
    bf16x8 At[4][2], B0[2][2], B1[2][2];
    const char* cA = (const char*)g.A + (size_t)cur.pm * tstep; const char* cB = (const char*)g.Bt + (size_t)cur.pn * tstep;
    S.a_ready(cur);
    if constexpr (SP2) {
        PG8_STAGE(PG8_SB(0, 0), cB, voffB); PG8_STAGE(PG8_SB(0, 1), cB + hstep, voffB); PG8_STAGE(PG8_SA(0, 0), cA, voffA); PG8_STAGE(PG8_SA(0, 1), cA + hstep, voffA);
        if (wr == 1) PG8_BAR;
        PG8_WAIT_V(2); PG8_BAR;
        PG8_STAGE(PG8_SB(1, 0), cB + kstep, voffB); PG8_STAGE(PG8_SA(1, 0), cA + kstep, voffA); PG8_STAGE(PG8_SB(1, 1), cB + hstep + kstep, voffB);
        PG8_WAIT_V(6); PG8_BAR;
    } else {
        PG8_STAGE(PG8_SB(0, 0), cB, voffB); PG8_STAGE(PG8_SA(0, 0), cA, voffA); PG8_STAGE(PG8_SB(0, 1), cB + hstep, voffB); PG8_STAGE(PG8_SA(0, 1), cA + hstep, voffA);
        if (wr == 1) PG8_BAR;
        PG8_WAIT_V(4); PG8_BAR;
        PG8_STAGE(PG8_SB(1, 0), cB + kstep, voffB); PG8_STAGE(PG8_SA(1, 0), cA + kstep, voffA); PG8_STAGE(PG8_SB(1, 1), cB + hstep + kstep, voffB);
        PG8_WAIT_V(6); PG8_BAR;
    }
    for (;;) {
        const bool has_next = S.next(ui + 1, nxt);
        const char* nA = has_next ? (const char*)g.A + (size_t)nxt.pm * tstep : cA; const char* nB = has_next ? (const char*)g.Bt + (size_t)nxt.pn * tstep : cB;
        for (int t = 0; t < nt; t += 2) {
            const bool last = (t == nt - 2);
            const char* a1 = cA + (size_t)(t + 1) * kstep;
            const char* a2 = last ? nA : cA + (size_t)(t + 2) * kstep; const char* b2 = last ? nB : cB + (size_t)(t + 2) * kstep;
            const char* a3 = a2 + kstep; const char* b3 = b2 + kstep;
            if (last && has_next) S.a_ready(nxt);
            if constexpr (SP2) {
            PG8_LDB(B0, 0, 0); PG8_LDB(B1, 0, 1); PG8_SCHED; PG8_LDA(At, 0, 0); PG8_STAGE(PG8_SA(1, 1), a1 + hstep, voffA);
            PG8_WAIT_V(8); PG8_WAIT_L(0); PG8_BAR; PG8_MMA(0, 0, At, B0); PG8_MMA(0, 1, At, B1); PG8_BAR; PG8_SCHED;
            PG8_LDA(At, 0, 1); PG8_STAGE(PG8_SB(0, 0), b2, voffB); PG8_STAGE(PG8_SB(0, 1), b2 + hstep, voffB); PG8_STAGE(PG8_SA(0, 0), a2, voffA);
            PG8_WAIT_V(8); PG8_WAIT_L(0); PG8_BAR; PG8_MMA(1, 0, At, B0); PG8_MMA(1, 1, At, B1); PG8_BAR; PG8_SCHED;
            PG8_LDB(B0, 1, 0); PG8_LDB(B1, 1, 1); PG8_SCHED; PG8_LDA(At, 1, 0); PG8_STAGE(PG8_SA(0, 1), a2 + hstep, voffA);
            PG8_WAIT_V(8); PG8_WAIT_L(0); PG8_BAR; PG8_MMA(0, 0, At, B0); PG8_MMA(0, 1, At, B1); PG8_BAR; PG8_SCHED;
            PG8_LDA(At, 1, 1); PG8_STAGE(PG8_SB(1, 0), b3, voffB); PG8_STAGE(PG8_SB(1, 1), b3 + hstep, voffB); PG8_STAGE(PG8_SA(1, 0), a3, voffA);
            PG8_WAIT_V(8); PG8_WAIT_L(0); PG8_BAR; PG8_MMA(1, 0, At, B0); PG8_MMA(1, 1, At, B1); PG8_BAR; PG8_SCHED;
            } else {
            PG8_LDB(B0, 0, 0); PG8_SCHED; PG8_LDA(At, 0, 0); PG8_STAGE(PG8_SA(1, 1), a1 + hstep, voffA);
            PG8_WAIT_L(8); PG8_BAR; PG8_WAIT_L(0); PG8_MMA(0, 0, At, B0); PG8_BAR; PG8_SCHED;
            PG8_LDB(B1, 0, 1); PG8_STAGE(PG8_SB(0, 0), b2, voffB);
            PG8_BAR; PG8_WAIT_L(0); PG8_MMA(0, 1, At, B1); PG8_BAR;
            PG8_LDA(At, 0, 1); PG8_STAGE(PG8_SA(0, 0), a2, voffA);
            PG8_BAR; PG8_WAIT_L(0); PG8_MMA(1, 0, At, B0); PG8_BAR; PG8_SCHED;
            PG8_STAGE(PG8_SB(0, 1), b2 + hstep, voffB);
            PG8_WAIT_V(6); PG8_BAR; PG8_MMA(1, 1, At, B1); PG8_BAR;
            PG8_LDB(B0, 1, 0); PG8_SCHED; PG8_LDA(At, 1, 0); PG8_STAGE(PG8_SA(0, 1), a2 + hstep, voffA);
            PG8_WAIT_L(8); PG8_BAR; PG8_WAIT_L(0); PG8_MMA(0, 0, At, B0); PG8_BAR; PG8_SCHED;
            PG8_LDB(B1, 1, 1); PG8_STAGE(PG8_SB(1, 0), b3, voffB);
            PG8_BAR; PG8_WAIT_L(0); PG8_MMA(0, 1, At, B1); PG8_BAR;
            PG8_LDA(At, 1, 1); PG8_STAGE(PG8_SA(1, 0), a3, voffA);
            PG8_BAR; PG8_WAIT_L(0); PG8_MMA(1, 0, At, B0); PG8_BAR; PG8_SCHED;
            PG8_STAGE(PG8_SB(1, 1), b3 + hstep, voffB);
            PG8_WAIT_V(6); PG8_BAR; PG8_MMA(1, 1, At, B1); PG8_BAR;
            }
        }
        if constexpr (ALIGN_EPI) { if (wr == 0) PG8_BAR; }
        if constexpr (!Epi::AFTER_DRAIN) { E(acc, cur, wr, wc, fr, fq); S.done(cur); }
        if (!has_next) break;
#pragma unroll
        for (int a = 0; a < 2; ++a)
#pragma unroll
            for (int b = 0; b < 2; ++b)
#pragma unroll
                for (int m = 0; m < 4; ++m)
#pragma unroll
                    for (int n = 0; n < 2; ++n) acc[a][b][m][n] = (f32x4){0.f, 0.f, 0.f, 0.f};
        cur = nxt; cA = nA; cB = nB; ++ui;
        if constexpr (ALIGN_EPI) { if (wr == 1) PG8_BAR; }
    }
    PG8_WAIT_V(0);
    if constexpr (!ALIGN_EPI) { if (wr == 0) PG8_BAR; }
    PG8_BAR;
    if constexpr (Epi::AFTER_DRAIN) { E.fused(acc, cur, wr, wc, fr, fq, lds, wid, lane); S.done(cur); }
#undef PG8_SA
#undef PG8_SB
#undef PG8_STAGE
#undef PG8_LDA
#undef PG8_LDB
#undef PG8_MMA
#undef PG8_WAIT_V
#undef PG8_WAIT_L
#undef PG8_BAR
#undef PG8_SCHED
}
}

constexpr int NB = 4, SEQ = 8192, M_TOK = NB * SEQ, DM = 1024, DEPTH = 2;
constexpr int D_IN = 3132, HBP = 3136, N_IN_PAD = 3328;
constexpr float NORM_EPS = 1e-6f;
constexpr int HB_NSA_Q = 0, HB_NSA_KC = 256, HB_NSA_VC = 320, HB_NSA_KS = 384, HB_NSA_VS = 448, HB_NSA_KW = 512, HB_NSA_VW = 576;
constexpr int HB_ML_Q = 640, HB_ML_K = 896, HB_ML_V = 1152, HB_ML_OG = 1408;
constexpr int HB_GD_Q = 1664, HB_GD_K = 1920, HB_GD_V = 2176, HB_GD_Z = 2432;
constexpr int HB_MLA_CQ = 2688, HB_MLA_CKV = 2944, HB_MLA_KR = 3072;
constexpr int HB_NSA_G = 3104, HB_ML_IG = 3116, HB_ML_FG = 3120, HB_GD_BETA = 3124, HB_GD_A = 3128;
__host__ __device__ __forceinline__ int hb_src_col(int c) {
    if (c < 640) return c;
    if (c < 1408) return 652 + (c - 640);
    if (c < 1664) return 1428 + (c - 1408);
    if (c < 2432) return 1684 + (c - 1664);
    if (c < 2688) return 2460 + (c - 2432);
    if (c < 3104) return 2716 + (c - 2688);
    if (c < 3116) return 640 + (c - 3104);
    if (c < 3124) return 1420 + (c - 3116);
    return 2452 + (c - 3124);
}
constexpr int GRID_WG = 256;
constexpr size_t MiB = 1u << 20;
constexpr size_t WS_CTL = 0, CTL_ZERO_BYTES = 1 * MiB;
constexpr size_t WS_WIN = 1 * MiB, WIN_L = (size_t)N_IN_PAD * DM * 2;
constexpr size_t WS_WOUT = 14 * MiB, WOUT_L = (size_t)DM * DM * 2;
constexpr size_t WS_WQ = 18 * MiB, WQ_L = (size_t)2048 * DM * 2;
constexpr size_t WS_WSM = 26 * MiB, WSM_L = 1 * MiB;
constexpr size_t WSM_UQ = 0, WSM_UKV = 196608, WSM_CK = 327680, WSM_CV = 589824;
constexpr size_t WS_XN = 28 * MiB;
constexpr size_t WS_HB = 92 * MiB;
constexpr size_t WS_MLA_Q = 288 * MiB, WS_MLA_K = 312 * MiB, WS_MLA_VT = 336 * MiB;
constexpr size_t WS_NSA_VST = 352 * MiB, WS_NSA_VWT = 356 * MiB, WS_NSA_KCMP = 360 * MiB, WS_NSA_VCMPT = 360 * MiB + 512 * 1024;
constexpr size_t WS_ML_C = 361 * MiB, WS_ML_N = 393 * MiB, WS_ML_SC = 393 * MiB + 512 * 1024;
constexpr size_t WS_GD_W = 394 * MiB, WS_GD_UT = 410 * MiB, WS_GD_KDT = 426 * MiB, WS_GD_QD = 442 * MiB, WS_GD_AQK = 458 * MiB, WS_GD_ST = 474 * MiB, WS_GD_VNT = 490 * MiB, WS_GD_GE = 506 * MiB;
constexpr size_t WS_PKEYS = 507 * MiB;
constexpr size_t WS_NSA_KSW = 508 * MiB;
constexpr size_t WS_END = 512 * MiB;
constexpr size_t WS_PEER_QP = 92 * MiB, WS_PEER_U = 394 * MiB, WS_PEER_V = 410 * MiB;
constexpr size_t WS_PEER_X8 = 288 * MiB;
constexpr int CW_TMO = 0, CW_BAR = 4096, CW_Q = 16384, CW_TS = 65536;
constexpr int NWAVES = 8, WAVE_LDS = 18432, MISC_OFF = NWAVES * WAVE_LDS, LDS_BYTES = MISC_OFF + 1024;
static_assert(LDS_BYTES <= 163840 && MISC_OFF >= 131072, "LDS map");

#define GAS __attribute__((address_space(1)))
#define LAS __attribute__((address_space(3)))
typedef unsigned short bf16;
typedef unsigned v4u __attribute__((ext_vector_type(4)));
typedef unsigned v2u __attribute__((ext_vector_type(2)));
typedef float f32x4 __attribute__((ext_vector_type(4)));
typedef short bf16x8 __attribute__((ext_vector_type(8)));
#define RLX_AGENT __ATOMIC_RELAXED, __HIP_MEMORY_SCOPE_AGENT
#define LDS_WAIT() asm volatile("s_waitcnt lgkmcnt(0)" ::: "memory")
#define VM_WAIT() asm volatile("s_waitcnt vmcnt(0)" ::: "memory")
__device__ __forceinline__ unsigned f2bf(float f) { unsigned u = __builtin_bit_cast(unsigned, f); return (u + 0x7fffu + ((u >> 16) & 1u)) >> 16; }
typedef __bf16 bf16x2_hw __attribute__((ext_vector_type(2)));
typedef float f32x2_hw __attribute__((ext_vector_type(2)));
__device__ __forceinline__ unsigned pk2(float lo, float hi) { const f32x2_hw v = {lo, hi}; const bf16x2_hw b = __builtin_convertvector(v, bf16x2_hw); return __builtin_bit_cast(unsigned, b); }
__device__ __forceinline__ float bf2f(unsigned b) { return __builtin_bit_cast(float, b << 16); }
__device__ __forceinline__ float bflo(unsigned w) { return __builtin_bit_cast(float, w << 16); }
__device__ __forceinline__ float bfhi(unsigned w) { return __builtin_bit_cast(float, w & 0xffff0000u); }
typedef unsigned u32x2_t __attribute__((ext_vector_type(2)));
__device__ __forceinline__ float red4_max(float x) {
    auto s = __builtin_amdgcn_permlane16_swap(__float_as_uint(x), __float_as_uint(x), false, false);
    x = fmaxf(__uint_as_float(s[0]), __uint_as_float(s[1]));
    auto t = __builtin_amdgcn_permlane32_swap(__float_as_uint(x), __float_as_uint(x), false, false);
    return fmaxf(__uint_as_float(t[0]), __uint_as_float(t[1]));
}
__device__ __forceinline__ float red4_sum(float x) {
    auto s = __builtin_amdgcn_permlane16_swap(__float_as_uint(x), __float_as_uint(x), false, false);
    x = __uint_as_float(s[0]) + __uint_as_float(s[1]);
    auto t = __builtin_amdgcn_permlane32_swap(__float_as_uint(x), __float_as_uint(x), false, false);
    return __uint_as_float(t[0]) + __uint_as_float(t[1]);
}
template <int CTRL> __device__ __forceinline__ float dpp_mov(float x) { return __int_as_float(__builtin_amdgcn_mov_dpp(__float_as_int(x), CTRL, 0xf, 0xf, true)); }
__device__ __forceinline__ float wave_sum(float v) {
    v += dpp_mov<0xB1>(v); v += dpp_mov<0x4E>(v); v += dpp_mov<0x141>(v); v += dpp_mov<0x140>(v);
    return red4_sum(v);
}
__device__ __forceinline__ float wave_max(float v) {
    v = fmaxf(v, dpp_mov<0xB1>(v)); v = fmaxf(v, dpp_mov<0x4E>(v)); v = fmaxf(v, dpp_mov<0x141>(v)); v = fmaxf(v, dpp_mov<0x140>(v));
    return red4_max(v);
}
__device__ __forceinline__ int wave_pop(unsigned* ctr, int lane) {
    __builtin_amdgcn_wave_barrier();
    const unsigned v = __hip_atomic_fetch_add(ctr, (lane == 0) ? 1u : 0u, RLX_AGENT);
    const int r = (int)__builtin_amdgcn_readfirstlane(v);
    __builtin_amdgcn_wave_barrier();
    return r;
}
__device__ __forceinline__ float fexp(float x) { return __builtin_amdgcn_exp2f(x * 1.4426950408889634f); }
__device__ __forceinline__ f32x4 mfma16(bf16x8 a, bf16x8 b, f32x4 c) { return __builtin_amdgcn_mfma_f32_16x16x32_bf16(a, b, c, 0, 0, 0); }
__device__ __forceinline__ int lane_id() { return (int)__builtin_amdgcn_mbcnt_hi(~0u, __builtin_amdgcn_mbcnt_lo(~0u, 0u)); }
__device__ __forceinline__ int lane_id_v() { int l; asm volatile("v_mbcnt_lo_u32_b32 %0, -1, 0\n\tv_mbcnt_hi_u32_b32 %0, -1, %0" : "=v"(l)); return l; }
template <class T> __device__ __forceinline__ T* opaque(T* p) { asm volatile("" : "+s"(p)); return p; }
union Frag { bf16x8 v; v4u u; unsigned w[4]; };

constexpr int N_PHASES = 1 + 8 * DEPTH;
struct Args { const float* in[26]; float* out; unsigned char* ws; int ph_lo, ph_hi; };
enum { I_X = 0, I_POS, I_T5, I_N1G, I_N2G, I_FNG, I_WIN, I_WOUT, I_CMPK, I_CMPV, I_CMPPOS, I_ML_IB, I_ML_FB, I_ML_NG, I_GD_CONV, I_GD_ALOG, I_GD_DT, I_GD_NG,
       I_MLA_QNG, I_MLA_KVNG, I_MLA_WUQ, I_MLA_WUKV, I_PEER_WQ, I_PEER_KEYS, I_PEER_U, I_PEER_V };

#define XB_TMO      128
#define XB_XCNT(j)  (256  + 64 * (j))
#define XB_XSUB(j)  (1280 + 64 * (j))
#define XB_XGEN(j)  (2304 + 64 * (j))
#define XB_TOP      3328
#define XB_TOPGEN   3392
#define XCD_BAR_WORDS 3456
#define XB_SPIN_CAP (1u << 21)

__device__ __forceinline__ unsigned xb_ld(unsigned* p)              { return __hip_atomic_load(p, __ATOMIC_RELAXED, __HIP_MEMORY_SCOPE_AGENT); }
__device__ __forceinline__ unsigned xb_add(unsigned* p, unsigned v) { return __hip_atomic_fetch_add(p, v, __ATOMIC_RELAXED, __HIP_MEMORY_SCOPE_AGENT); }
__device__ __forceinline__ unsigned xb_xcc_id() { return (unsigned)__builtin_amdgcn_s_getreg((3 << 11) | 20) & 0xFu; }
#define XB_SPIN(cond, bar) do { unsigned _sp = 0; while (cond) { __builtin_amdgcn_s_sleep(1); \
    if ((++_sp & 255u) == 0u) { if (xb_ld(&(bar)[XB_TMO])) break; if (_sp > XB_SPIN_CAP) { atomicAdd(&(bar)[XB_TMO], 1u); break; } } } } while (0)

struct XcdBarrier {
    unsigned* bar; unsigned x;
    volatile LAS unsigned* st;
};

__device__ __forceinline__ XcdBarrier xcd_barrier_post(unsigned* bar, volatile LAS unsigned* st, const bool is_t0) {
    XcdBarrier b; b.bar = bar; b.x = xb_xcc_id(); b.st = st;
    if (is_t0) (void)xb_add(&bar[XB_XCNT(b.x)], 1u);
    return b;
}
__device__ __forceinline__ void xcd_barrier_complete(unsigned* bar, unsigned x, unsigned& nloc, unsigned& nx) {
    const unsigned G = gridDim.x * gridDim.y * gridDim.z;
    unsigned sum, cnt, mine, sp = 0u;
    for (;;) {
        sum = 0u; cnt = 0u; mine = 0u;
#pragma unroll
        for (unsigned j = 0; j < 16; ++j) { const unsigned c = xb_ld(&bar[XB_XCNT(j)]); sum += c; cnt += (c > 0u) ? 1u : 0u; mine = (j == x) ? c : mine; }
        if (sum == G) break;
        __builtin_amdgcn_s_sleep(1);
        if ((++sp & 255u) == 0u) { if (xb_ld(&bar[XB_TMO])) break; if (sp > XB_SPIN_CAP) { atomicAdd(&bar[XB_TMO], 1u); break; } }
    }
    nloc = mine > 0u ? mine : 1u; nx = cnt > 0u ? cnt : 1u;
}

__device__ __forceinline__ void xcd_barrier(const XcdBarrier& b, const bool is_t0) {
    asm volatile("s_waitcnt vmcnt(0)" ::: "memory");
    __syncthreads();
    if (is_t0) {
        unsigned* bar = b.bar;
        __builtin_amdgcn_s_waitcnt(0);
        unsigned nloc = b.st[0], nx = b.st[1];
        if (nloc == 0u) { xcd_barrier_complete(bar, b.x, nloc, nx); b.st[0] = nloc; b.st[1] = nx; }
        const unsigned old = xb_add(&bar[XB_XSUB(b.x)], 1u);
        const unsigned gen = old / nloc;
        if (old + 1u == (gen + 1u) * nloc) {
            __builtin_amdgcn_fence(__ATOMIC_RELEASE, "agent");
            asm volatile("s_waitcnt vmcnt(0)" ::: "memory");
            const unsigned og = xb_add(&bar[XB_TOP], 1u);
            const unsigned tg = og / nx;
            if (og + 1u == (tg + 1u) * nx) xb_add(&bar[XB_TOPGEN], 1u);
            else XB_SPIN(xb_ld(&bar[XB_TOPGEN]) == tg, bar);
            __builtin_amdgcn_fence(__ATOMIC_ACQUIRE, "agent");
            xb_add(&bar[XB_XGEN(b.x)], 1u);
            asm volatile("s_waitcnt vmcnt(0)" ::: "memory");
        } else {
            XB_SPIN(xb_ld(&bar[XB_XGEN(b.x)]) == gen, bar);
            __builtin_amdgcn_fence(__ATOMIC_ACQUIRE, "agent");
            asm volatile("s_waitcnt vmcnt(0)" ::: "memory");
        }
    }
    __syncthreads();
}

template <class Map>
__device__ __forceinline__ void tr_item(const float* src, int ldsrc, int nreal, Map map, bf16* dst, int K, LAS float* scr, int kb, int nb, int lane) {
    const int k0 = 64 * kb, n0 = 32 * nb;
    const int n = n0 + (lane & 31);
    const int sc = (n < nreal) ? map(n) : -1;
#pragma unroll 8
    for (int i = 0; i < 32; ++i) { const int kk = 2 * i + (lane >> 5); scr[kk * 33 + (lane & 31)] = (sc >= 0) ? src[(size_t)(k0 + kk) * ldsrc + sc] : 0.f; }
    LDS_WAIT();
    const int c = lane & 7;
#pragma unroll
    for (int j = 0; j < 4; ++j) { const int nn = (lane >> 3) + 8 * j; const LAS float* s = scr + (8 * c) * 33 + nn;
        v4u o; o.x = pk2(s[0 * 33], s[1 * 33]); o.y = pk2(s[2 * 33], s[3 * 33]); o.z = pk2(s[4 * 33], s[5 * 33]); o.w = pk2(s[6 * 33], s[7 * 33]);
        *(v4u*)(dst + (size_t)(n0 + nn) * K + k0 + 8 * c) = o; }
    LDS_WAIT();
}
struct MapId { __device__ __forceinline__ int operator()(int n) const { return n; } };
struct MapHb { __device__ __forceinline__ int operator()(int n) const { return hb_src_col(n); } };
__device__ __forceinline__ void rms_row_bf16(const float* xrow, const float* g, bf16* orow, int lane) {
    const f32x4* xr = (const f32x4*)xrow + lane; const f32x4* gr = (const f32x4*)g + lane;
    f32x4 v[4]; float s = 0.f;
#pragma unroll
    for (int j = 0; j < 4; ++j) { v[j] = xr[64 * j]; s += (v[j].x * v[j].x + v[j].y * v[j].y) + (v[j].z * v[j].z + v[j].w * v[j].w); }
    const float r = 1.0f / sqrtf(wave_sum(s) * (1.f / DM) + NORM_EPS);
    v2u* o8 = (v2u*)orow + lane;
#pragma unroll
    for (int j = 0; j < 4; ++j) { const f32x4 gg = gr[64 * j]; v2u o; o.x = pk2(v[j].x * r * gg.x, v[j].y * r * gg.y); o.y = pk2(v[j].z * r * gg.z, v[j].w * r * gg.w); o8[64 * j] = o; }
}
__device__ __forceinline__ void rms_row_f32(const float* xrow, const float* g, float* orow, int lane) {
    const f32x4* xr = (const f32x4*)xrow + lane; const f32x4* gr = (const f32x4*)g + lane;
    f32x4 v[4]; float s = 0.f;
#pragma unroll
    for (int j = 0; j < 4; ++j) { v[j] = xr[64 * j]; s += (v[j].x * v[j].x + v[j].y * v[j].y) + (v[j].z * v[j].z + v[j].w * v[j].w); }
    const float r = 1.0f / sqrtf(wave_sum(s) * (1.f / DM) + NORM_EPS);
    f32x4* o = (f32x4*)orow + lane;
#pragma unroll
    for (int j = 0; j < 4; ++j) { const f32x4 gg = gr[64 * j]; o[64 * j] = v[j] * r * gg; }
}

__device__ __forceinline__ void mla_prep_item(int it, int l, const Args& args, int lane) {
    unsigned char* ws = args.ws;
    const bf16* HB = (const bf16*)(ws + WS_HB);
    bf16* Qo = (bf16*)(ws + WS_MLA_Q); bf16* Ko = (bf16*)(ws + WS_MLA_K); bf16* VT = (bf16*)(ws + WS_MLA_VT);
    const bf16* uq_t = opaque((const bf16*)(ws + WS_WSM + l * WSM_L + WSM_UQ)); const bf16* ukv_t = opaque((const bf16*)(ws + WS_WSM + l * WSM_L + WSM_UKV));
    const int fr = lane & 15, fq = lane >> 4;
    const int tok0 = it * 16, b = tok0 / SEQ, s0 = tok0 % SEQ;
    const float* gq = opaque(args.in[I_MLA_QNG] + l * 256); const float* gkv = opaque(args.in[I_MLA_KVNG] + l * 128);
    const int* pos = (const int*)args.in[I_POS];
    float cs[4], sn[4];
    { const float pf_ = (float)pos[tok0 + fr];
#pragma unroll
      for (int i = 0; i < 4; ++i) { const float inv_freq = exp2f(-(float)(fq * 4 + i) * (13.287712379549449f / 16.0f));
          const float ang = pf_ * inv_freq; sincosf(ang, &sn[i], &cs[i]); } }
    const int blk32 = s0 >> 5, half = (s0 >> 4) & 1;
    const float qscale = 0.10206207261596577f * 1.4426950408889634f;
    {
        Frag a[8]; float ss = 0.f;
#pragma unroll
        for (int ks = 0; ks < 8; ++ks) { a[ks].u = *(const v4u*)(HB + (size_t)(tok0 + fr) * HBP + HB_MLA_CQ + ks * 32 + fq * 8);
#pragma unroll
            for (int j = 0; j < 4; ++j) { const float x0 = bflo(a[ks].w[j]), x1 = bfhi(a[ks].w[j]); ss += x0 * x0 + x1 * x1; } }
        ss = red4_sum(ss);
        const float r = 1.0f / sqrtf(ss * (1.f / 256.f) + NORM_EPS);
#pragma unroll
        for (int ks = 0; ks < 8; ++ks) { const float* gp = gq + ks * 32 + fq * 8;
#pragma unroll
            for (int j = 0; j < 4; ++j) a[ks].w[j] = pk2(bflo(a[ks].w[j]) * r * gp[2 * j], bfhi(a[ks].w[j]) * r * gp[2 * j + 1]); }
        for (int h = 0; h < 4; ++h) {
            f32x4 acc[6];
#pragma unroll
            for (int j = 0; j < 6; ++j) { acc[j] = (f32x4){0.f, 0.f, 0.f, 0.f};
#pragma unroll
                for (int ks = 0; ks < 8; ++ks) { Frag bq; bq.u = *(const v4u*)(uq_t + (size_t)(h * 96 + j * 16 + fr) * 256 + ks * 32 + fq * 8); acc[j] = mfma16(bq.v, a[ks].v, acc[j]); } }
            bf16* qrow = Qo + ((size_t)(b * 4 + h) * SEQ + s0 + fr) * 96 + fq * 4;
#pragma unroll
            for (int j = 0; j < 4; ++j) { v2u o; o.x = pk2(acc[j][0] * qscale, acc[j][1] * qscale); o.y = pk2(acc[j][2] * qscale, acc[j][3] * qscale); *(v2u*)(qrow + j * 16) = o; }
            { float r1[4], r2[4];
#pragma unroll
              for (int i = 0; i < 4; ++i) { const float t1 = acc[4][i], t2 = acc[5][i]; r1[i] = (t1 * cs[i] - t2 * sn[i]) * qscale; r2[i] = (t2 * cs[i] + t1 * sn[i]) * qscale; }
              v2u o1, o2; o1.x = pk2(r1[0], r1[1]); o1.y = pk2(r1[2], r1[3]); o2.x = pk2(r2[0], r2[1]); o2.y = pk2(r2[2], r2[3]); *(v2u*)(qrow + 64) = o1; *(v2u*)(qrow + 80) = o2; }
        }
    }
    {
        Frag a[4]; float ss = 0.f;
#pragma unroll
        for (int ks = 0; ks < 4; ++ks) { a[ks].u = *(const v4u*)(HB + (size_t)(tok0 + fr) * HBP + HB_MLA_CKV + ks * 32 + fq * 8);
#pragma unroll
            for (int j = 0; j < 4; ++j) { const float x0 = bflo(a[ks].w[j]), x1 = bfhi(a[ks].w[j]); ss += x0 * x0 + x1 * x1; } }
        ss = red4_sum(ss);
        const float r = 1.0f / sqrtf(ss * (1.f / 128.f) + NORM_EPS);
#pragma unroll
        for (int ks = 0; ks < 4; ++ks) { const float* gp = gkv + ks * 32 + fq * 8;
#pragma unroll
            for (int j = 0; j < 4; ++j) a[ks].w[j] = pk2(bflo(a[ks].w[j]) * r * gp[2 * j], bfhi(a[ks].w[j]) * r * gp[2 * j + 1]); }
        for (int h = 0; h < 4; ++h) {
            f32x4 acc[8];
#pragma unroll
            for (int j = 0; j < 8; ++j) { acc[j] = (f32x4){0.f, 0.f, 0.f, 0.f};
#pragma unroll
                for (int ks = 0; ks < 4; ++ks) { Frag bq; bq.u = *(const v4u*)(ukv_t + (size_t)(h * 128 + j * 16 + fr) * 128 + ks * 32 + fq * 8); acc[j] = (j < 4) ? mfma16(bq.v, a[ks].v, acc[j]) : mfma16(a[ks].v, bq.v, acc[j]); } }
            bf16* kblk = Ko + (size_t)(b * 4 + h) * SEQ * 96 + (size_t)blk32 * 3072;
#pragma unroll
            for (int j = 0; j < 4; ++j) { v2u o; o.x = pk2(acc[j][0], acc[j][1]); o.y = pk2(acc[j][2], acc[j][3]);
                *(v2u*)(kblk + ((half * 3 + (j >> 1)) * 64 + ((j & 1) * 2 + (fq >> 1)) * 16 + fr) * 8 + (fq & 1) * 4) = o; }
            bf16* vblk = VT + (size_t)(b * 4 + h) * 64 * SEQ + (size_t)blk32 * 2048;
#pragma unroll
            for (int j = 0; j < 4; ++j) { v2u o; o.x = pk2(acc[4 + j][0], acc[4 + j][1]); o.y = pk2(acc[4 + j][2], acc[4 + j][3]);
                *(v2u*)(vblk + (j * 64 + lane) * 8 + half * 4) = o; }
        }
        { const bf16* kr = HB + (size_t)(tok0 + fr) * HBP + HB_MLA_KR + fq * 4;
          const v2u a1 = *(const v2u*)kr, a2 = *(const v2u*)(kr + 16);
          const float t1[4] = {bflo(a1.x), bfhi(a1.x), bflo(a1.y), bfhi(a1.y)}, t2[4] = {bflo(a2.x), bfhi(a2.x), bflo(a2.y), bfhi(a2.y)};
          float r1[4], r2[4];
#pragma unroll
          for (int i = 0; i < 4; ++i) { r1[i] = t1[i] * cs[i] - t2[i] * sn[i]; r2[i] = t2[i] * cs[i] + t1[i] * sn[i]; }
          v2u o1, o2; o1.x = pk2(r1[0], r1[1]); o1.y = pk2(r1[2], r1[3]); o2.x = pk2(r2[0], r2[1]); o2.y = pk2(r2[2], r2[3]);
#pragma unroll
          for (int h = 0; h < 4; ++h) { bf16* kblk = Ko + (size_t)(b * 4 + h) * SEQ * 96 + (size_t)blk32 * 3072 + ((half * 3 + 2) * 64 + fr) * 8 + (fq & 1) * 4;
              *(v2u*)(kblk + (fq >> 1) * 128) = o1; *(v2u*)(kblk + (2 + (fq >> 1)) * 128) = o2; } }
    }
}
#define MLA_LOADK(KF, k0_) do { const bf16* kp_ = K + (size_t)((k0_) >> 5) * 3072 + lane * 8; _Pragma("unroll") for (int t = 0; t < 2; ++t) { _Pragma("unroll") for (int ks = 0; ks < 3; ++ks) KF[t][ks].u = *(const v4u*)(kp_ + (t * 3 + ks) * 512); } } while (0)
#define MLA_LOADV(VF, k0_) do { const bf16* vp_ = VT + (size_t)((k0_) >> 5) * 2048 + lane * 8; _Pragma("unroll") for (int dt = 0; dt < 4; ++dt) VF[dt].u = *(const v4u*)(vp_ + dt * 512); } while (0)
#define MLA_STEP_(KF, VF, k0_, DIAG) do { \
    Frag pf[4]; f32x4 sA_[4], sB_[4]; \
    _Pragma("unroll") for (int nt = 0; nt < 4; ++nt) { Frag q0, q1, q2; q0.u = *(const LAS v4u*)(ql + (nt * 16 + fr) * 104 + fq * 8); q1.u = *(const LAS v4u*)(ql + (nt * 16 + fr) * 104 + 32 + fq * 8); q2.u = *(const LAS v4u*)(ql + (nt * 16 + fr) * 104 + 64 + fq * 8); \
        f32x4 s0_ = {0.f, 0.f, 0.f, 0.f}, s1_ = {0.f, 0.f, 0.f, 0.f}; \
        s0_ = mfma16(KF[0][0].v, q0.v, s0_); s1_ = mfma16(KF[1][0].v, q0.v, s1_); s0_ = mfma16(KF[0][1].v, q1.v, s0_); s1_ = mfma16(KF[1][1].v, q1.v, s1_); s0_ = mfma16(KF[0][2].v, q2.v, s0_); s1_ = mfma16(KF[1][2].v, q2.v, s1_); \
        sA_[nt] = s0_; sB_[nt] = s1_; } \
      \
    _Pragma("unroll") for (int nt = 0; nt < 4; ++nt) { f32x4 s0_ = sA_[nt], s1_ = sB_[nt]; \
        if (DIAG) { _Pragma("unroll") for (int i = 0; i < 4; ++i) { if ((k0_) + fq * 4 + i > s0 + nt * 16 + fr) s0_[i] = -1e30f; if ((k0_) + 16 + fq * 4 + i > s0 + nt * 16 + fr) s1_[i] = -1e30f; } } \
        float mx = fmaxf(fmaxf(fmaxf(s0_[0], s0_[1]), fmaxf(s0_[2], s0_[3])), fmaxf(fmaxf(s1_[0], s1_[1]), fmaxf(s1_[2], s1_[3]))); \
        mx = red4_max(mx); \
        const float mn = fmaxf(mrun[nt], mx); \
        float p[8]; float ps = 0.f; \
        _Pragma("unroll") for (int i = 0; i < 4; ++i) { p[i] = __builtin_amdgcn_exp2f(s0_[i] - mn); p[4 + i] = __builtin_amdgcn_exp2f(s1_[i] - mn); ps += p[i] + p[4 + i]; } \
        if (__builtin_amdgcn_ballot_w64(mn > mrun[nt]) != 0ull) {         \
            const float alpha = __builtin_amdgcn_exp2f(mrun[nt] - mn); mrun[nt] = mn; lrun[nt] = lrun[nt] * alpha; \
            _Pragma("unroll") for (int dt = 0; dt < 4; ++dt) o[dt][nt] = o[dt][nt] * alpha; } \
        lrun[nt] += ps; \
        pf[nt].w[0] = pk2(p[0], p[1]); pf[nt].w[1] = pk2(p[2], p[3]); pf[nt].w[2] = pk2(p[4], p[5]); pf[nt].w[3] = pk2(p[6], p[7]); } \
    _Pragma("unroll") for (int dt = 0; dt < 4; ++dt) _Pragma("unroll") for (int nt = 0; nt < 4; ++nt) o[dt][nt] = mfma16(VF[dt].v, pf[nt].v, o[dt][nt]); __builtin_amdgcn_sched_barrier(0); } while (0)
__device__ __forceinline__ void mla_attn_item(int bh, int qt, const Args& args, LAS unsigned char* wlds, int lane) {
    unsigned char* ws = args.ws;
    const bf16* Q = (const bf16*)(ws + WS_MLA_Q) + (size_t)bh * SEQ * 96; const bf16* K = (const bf16*)(ws + WS_MLA_K) + (size_t)bh * SEQ * 96;
    const bf16* VT = (const bf16*)(ws + WS_MLA_VT) + (size_t)bh * 64 * SEQ; bf16* XN = (bf16*)(ws + WS_XN);
    const int fr = lane & 15, fq = lane >> 4, s0 = qt * 64, b = bh >> 2, h = bh & 3;
    LAS bf16* ql = (LAS bf16*)wlds;
#pragma unroll
    for (int i = 0; i < 12; ++i) { const int idx = i * 64 + lane, r = idx / 12, c = idx % 12; *(LAS v4u*)(ql + r * 104 + c * 8) = *(const v4u*)(Q + (size_t)(s0 + r) * 96 + c * 8); }
    LDS_WAIT();
    f32x4 o[4][4];
#pragma unroll
    for (int dt = 0; dt < 4; ++dt)
#pragma unroll
        for (int nt = 0; nt < 4; ++nt) o[dt][nt] = (f32x4){0.f, 0.f, 0.f, 0.f};
    float mrun[4], lrun[4];
#pragma unroll
    for (int nt = 0; nt < 4; ++nt) { mrun[nt] = -1e30f; lrun[nt] = 0.f; }
    const int nkb = (s0 + 64) / 32;
    Frag kA[2][3], kB[2][3], vv[4];
    MLA_LOADK(kA, 0);
    for (int kb = 0; kb < nkb - 2; kb += 2) {
        MLA_LOADV(vv, kb * 32); MLA_LOADK(kB, (kb + 1) * 32);
        MLA_STEP_(kA, vv, kb * 32, 0);
        MLA_LOADV(vv, (kb + 1) * 32); MLA_LOADK(kA, (kb + 2) * 32);
        MLA_STEP_(kB, vv, (kb + 1) * 32, 0);
    }
    { const int kb = nkb - 2;
        MLA_LOADV(vv, kb * 32); MLA_LOADK(kB, (kb + 1) * 32);
        MLA_STEP_(kA, vv, kb * 32, 1);
        MLA_LOADV(vv, (kb + 1) * 32);
        MLA_STEP_(kB, vv, (kb + 1) * 32, 1);
    }
#pragma unroll
    for (int nt = 0; nt < 4; ++nt) {
        float lt = lrun[nt]; lt = red4_sum(lt);
        const float inv = 1.0f / lt;
        bf16* orow = XN + (size_t)(b * SEQ + s0 + nt * 16 + fr) * DM + 768 + h * 64 + fq * 4;
#pragma unroll
        for (int dt = 0; dt < 4; ++dt) { v2u w; w.x = pk2(o[dt][nt][0] * inv, o[dt][nt][1] * inv); w.y = pk2(o[dt][nt][2] * inv, o[dt][nt][3] * inv); *(v2u*)(orow + dt * 16) = w; }
    }
    LDS_WAIT();
}

__device__ __forceinline__ void stage64(const bf16* HB, int tok0, int col0, LAS bf16* buf, int lane) {
#pragma unroll
    for (int i = 0; i < 8; ++i) { const int idx = i * 64 + lane, r = idx >> 3, c8 = idx & 7;
        const v4u v = *(const v4u*)(HB + (size_t)(tok0 + r) * HBP + col0 + c8 * 8); *(LAS v4u*)(buf + r * 72 + c8 * 8) = v; }
    LDS_WAIT();
}
__device__ __forceinline__ float log_sigmoid(float x) { return fminf(x, 0.f) - log1pf(expf(-fabsf(x))); }
__device__ __forceinline__ float wave_incl_sum(float v, int lane) {
#pragma unroll
    for (int o = 1; o < 64; o <<= 1) { const float t = __shfl_up(v, o); if (lane >= o) v += t; }
    return v;
}
__device__ __forceinline__ float wave_incl_max(float v, int lane) {
#pragma unroll
    for (int o = 1; o < 64; o <<= 1) { const float t = __shfl_up(v, o); if (lane >= o) v = fmaxf(v, t); }
    return v;
}
__device__ __forceinline__ void mlstm_prep_item(int it, int l, const Args& args, LAS unsigned char* wlds, int lane) {
    unsigned char* ws = args.ws; const bf16* HB = (const bf16*)(ws + WS_HB);
    const int bh = it >> 7, n = it & 127, b = bh >> 2, h = bh & 3, tok0 = b * SEQ + n * 64, fr = lane & 15, fq = lane >> 4;
    LAS bf16* buf = (LAS bf16*)wlds;
    const float ib = opaque(args.in[I_ML_IB] + l * 4)[h], fb = opaque(args.in[I_ML_FB] + l * 4)[h];
    const float ig = bf2f(HB[(size_t)(tok0 + lane) * HBP + HB_ML_IG + h]) + ib;
    const float lf = log_sigmoid(bf2f(HB[(size_t)(tok0 + lane) * HBP + HB_ML_FG + h]) + fb);
    const float bcum = wave_incl_sum(lf, lane), a = ig - bcum, amax = wave_max(a), bend = __shfl(bcum, 63);
    const float w = fexp(a - amax);
    float wv[2][8];
#pragma unroll
    for (int ks = 0; ks < 2; ++ks)
#pragma unroll
        for (int j = 0; j < 8; ++j) wv[ks][j] = __shfl(w, ks * 32 + fq * 8 + j);
    stage64(HB, tok0, HB_ML_V + h * 64, buf, lane);
    Frag af[4][2];
#pragma unroll
    for (int mt = 0; mt < 4; ++mt)
#pragma unroll
        for (int ks = 0; ks < 2; ++ks)
#pragma unroll
            for (int j = 0; j < 4; ++j) { const int s = ks * 32 + fq * 8 + 2 * j, e = mt * 16 + fr;
                af[mt][ks].w[j] = pk2(bf2f(buf[s * 72 + e]) * wv[ks][2 * j], bf2f(buf[(s + 1) * 72 + e]) * wv[ks][2 * j + 1]); }
    LDS_WAIT();
    stage64(HB, tok0, HB_ML_K + h * 64, buf, lane);
    Frag bfm[4][2];
#pragma unroll
    for (int nt = 0; nt < 4; ++nt)
#pragma unroll
        for (int ks = 0; ks < 2; ++ks)
#pragma unroll
            for (int j = 0; j < 4; ++j) { const int s = ks * 32 + fq * 8 + 2 * j, kd = nt * 16 + fr;
                bfm[nt][ks].w[j] = pk2(bf2f(buf[s * 72 + kd]) * 0.125f, bf2f(buf[(s + 1) * 72 + kd]) * 0.125f); }
    LDS_WAIT();
    float* Cc = (float*)(ws + WS_ML_C) + (size_t)it * 4096;
#pragma unroll
    for (int mt = 0; mt < 4; ++mt)
#pragma unroll
        for (int nt = 0; nt < 4; ++nt) { f32x4 acc = {0.f, 0.f, 0.f, 0.f};
#pragma unroll
            for (int ks = 0; ks < 2; ++ks) acc = mfma16(af[mt][ks].v, bfm[nt][ks].v, acc);
#pragma unroll
            for (int i = 0; i < 4; ++i) Cc[(mt * 16 + fq * 4 + i) * 64 + nt * 16 + fr] = acc[i]; }
    {
        Frag an[2];
#pragma unroll
        for (int ks = 0; ks < 2; ++ks)
#pragma unroll
            for (int j = 0; j < 4; ++j) an[ks].w[j] = (fr == 0) ? pk2(wv[ks][2 * j], wv[ks][2 * j + 1]) : 0u;
        float* Nn = (float*)(ws + WS_ML_N) + (size_t)it * 64; float* dummy = (float*)(ws + WS_ML_SC) + (size_t)it * 4 + 3;
#pragma unroll
        for (int nt = 0; nt < 4; ++nt) { f32x4 acc = {0.f, 0.f, 0.f, 0.f}; acc = mfma16(an[0].v, bfm[nt][0].v, acc); acc = mfma16(an[1].v, bfm[nt][1].v, acc);
            float* dst = (fq == 0) ? (Nn + nt * 16 + fr) : dummy; *dst = acc[0]; } }
    { float* sc = (float*)(ws + WS_ML_SC) + (size_t)it * 4; sc[lane & 1] = (lane & 1) ? bend : bend + amax; }
}
__device__ __forceinline__ void mlstm_scan_item(int it, const Args& args, int lane) {
    unsigned char* ws = args.ws; const int bh = it >> 4, part = it & 15;
    float* Cb = (float*)(ws + WS_ML_C) + (size_t)bh * 128 * 4096 + part * 256 + lane;
    float* Nb = (float*)(ws + WS_ML_N) + (size_t)bh * 128 * 64 + lane;
    float* sc = (float*)(ws + WS_ML_SC) + (size_t)bh * 128 * 4;
    float c0 = 0.f, c1 = 0.f, c2 = 0.f, c3 = 0.f, nn = 0.f, m = 0.f;
    for (int n0 = 0; n0 < 128; n0 += 4) {
        float d[4][4], ml_[4], be_[4], dn_[4];
#pragma unroll
        for (int q = 0; q < 4; ++q) { const float* cp = Cb + (size_t)(n0 + q) * 4096; d[q][0] = cp[0]; d[q][1] = cp[64]; d[q][2] = cp[128]; d[q][3] = cp[192];
            ml_[q] = sc[(n0 + q) * 4 + 0]; be_[q] = sc[(n0 + q) * 4 + 1]; dn_[q] = (part == 0) ? Nb[(n0 + q) * 64] : 0.f; }
#pragma unroll
        for (int q = 0; q < 4; ++q) { float* cp = Cb + (size_t)(n0 + q) * 4096;
            const float mnew = fmaxf(be_[q] + m, ml_[q]), fc = fexp(be_[q] + m - mnew), fd = fexp(ml_[q] - mnew);
            cp[0] = c0; cp[64] = c1; cp[128] = c2; cp[192] = c3;
            c0 = fc * c0 + fd * d[q][0]; c1 = fc * c1 + fd * d[q][1]; c2 = fc * c2 + fd * d[q][2]; c3 = fc * c3 + fd * d[q][3];
            if (part == 0) { Nb[(n0 + q) * 64] = nn; nn = fc * nn + fd * dn_[q]; sc[(n0 + q) * 4 + 2] = m; }
            m = mnew; }
    }
}
__device__ __forceinline__ void mlstm_out_item(int it, int l, const Args& args, LAS unsigned char* wlds, int lane) {
    unsigned char* ws = args.ws; const bf16* HB = (const bf16*)(ws + WS_HB); bf16* XN = (bf16*)(ws + WS_XN);
    const int bh = it >> 7, n = it & 127, b = bh >> 2, h = bh & 3, tok0 = b * SEQ + n * 64, fr = lane & 15, fq = lane >> 4;
    LAS bf16* buf = (LAS bf16*)wlds;
    const float ib = opaque(args.in[I_ML_IB] + l * 4)[h], fb = opaque(args.in[I_ML_FB] + l * 4)[h];
    const float ig = bf2f(HB[(size_t)(tok0 + lane) * HBP + HB_ML_IG + h]) + ib;
    const float lf = log_sigmoid(bf2f(HB[(size_t)(tok0 + lane) * HBP + HB_ML_FG + h]) + fb);
    const float bcum = wave_incl_sum(lf, lane), a = ig - bcum, pmax = wave_incl_max(a, lane);
    const float* sc = (const float*)(ws + WS_ML_SC) + (size_t)it * 4;
    const float mst = sc[2];
    const float mt_ = bcum + fmaxf(pmax, mst);
    const float inter_l = fexp(bcum + mst - mt_), emm_l = fexp(-mt_), bm_l = bcum - mt_;
    stage64(HB, tok0, HB_ML_V + h * 64, buf, lane);
    Frag kf[4][2];
#pragma unroll
    for (int t = 0; t < 4; ++t)
#pragma unroll
        for (int ks = 0; ks < 2; ++ks) kf[t][ks].u = *(const v4u*)(HB + (size_t)(tok0 + t * 16 + fr) * HBP + HB_ML_K + h * 64 + ks * 32 + fq * 8);
    float as_[4][4];
#pragma unroll
    for (int mt = 0; mt < 4; ++mt)
#pragma unroll
        for (int i = 0; i < 4; ++i) as_[mt][i] = __shfl(a, mt * 16 + fq * 4 + i);
    const float* Cst = (const float*)(ws + WS_ML_C) + (size_t)it * 4096; const float* Nst = (const float*)(ws + WS_ML_N) + (size_t)it * 64;
    const float* ng = opaque(args.in[I_ML_NG] + l * 256) + h * 64;
    for (int nt = 0; nt < 4; ++nt) {
        const int tl = nt * 16 + fr;
        const float bm = __shfl(bm_l, tl), inter = __shfl(inter_l, tl), emm = __shfl(emm_l, tl);
        Frag q0, q1;
        q0.u = *(const v4u*)(HB + (size_t)(tok0 + tl) * HBP + HB_ML_Q + h * 64 + fq * 8); q1.u = *(const v4u*)(HB + (size_t)(tok0 + tl) * HBP + HB_ML_Q + h * 64 + 32 + fq * 8);
        f32x4 st[4]; float den = 0.f;
#pragma unroll
        for (int mt = 0; mt < 4; ++mt) { st[mt] = (f32x4){0.f, 0.f, 0.f, 0.f}; st[mt] = mfma16(kf[mt][0].v, q0.v, st[mt]); st[mt] = mfma16(kf[mt][1].v, q1.v, st[mt]);
#pragma unroll
            for (int i = 0; i < 4; ++i) { const int s = mt * 16 + fq * 4 + i; const float d = (s <= tl) ? fexp(bm + as_[mt][i]) : 0.f; st[mt][i] = st[mt][i] * 0.125f * d; den += st[mt][i]; } }
        den = red4_sum(den);
        Frag pf[2];
#pragma unroll
        for (int k2 = 0; k2 < 2; ++k2) { pf[k2].w[0] = pk2(st[2 * k2][0], st[2 * k2][1]); pf[k2].w[1] = pk2(st[2 * k2][2], st[2 * k2][3]); pf[k2].w[2] = pk2(st[2 * k2 + 1][0], st[2 * k2 + 1][1]); pf[k2].w[3] = pk2(st[2 * k2 + 1][2], st[2 * k2 + 1][3]); }
        float nq = 0.f;
#pragma unroll
        for (int j = 0; j < 4; ++j) { nq += Nst[fq * 8 + 2 * j] * bflo(q0.w[j]) + Nst[fq * 8 + 2 * j + 1] * bfhi(q0.w[j]); nq += Nst[32 + fq * 8 + 2 * j] * bflo(q1.w[j]) + Nst[32 + fq * 8 + 2 * j + 1] * bfhi(q1.w[j]); }
        nq = red4_sum(nq);
        const float dent = den + inter * nq; const float rden = 1.0f / fmaxf(fabsf(dent), emm);
        f32x4 hv[4]; float ss = 0.f;
#pragma unroll
        for (int et = 0; et < 4; ++et) {
            f32x4 num = {0.f, 0.f, 0.f, 0.f}, cq = {0.f, 0.f, 0.f, 0.f};
#pragma unroll
            for (int k2 = 0; k2 < 2; ++k2) { Frag va; const int e = et * 16 + fr;
#pragma unroll
                for (int j = 0; j < 4; ++j) { const int sa = (2 * k2 + (j >> 1)) * 16 + fq * 4 + 2 * (j & 1); va.w[j] = (unsigned)buf[sa * 72 + e] | ((unsigned)buf[(sa + 1) * 72 + e] << 16); }
                num = mfma16(va.v, pf[k2].v, num); }
#pragma unroll
            for (int ks = 0; ks < 2; ++ks) { const float* cp = Cst + (size_t)(et * 16 + fr) * 64 + ks * 32 + fq * 8; const f32x4 c0 = *(const f32x4*)cp, c1 = *(const f32x4*)(cp + 4);
                Frag ca; ca.w[0] = pk2(c0[0], c0[1]); ca.w[1] = pk2(c0[2], c0[3]); ca.w[2] = pk2(c1[0], c1[1]); ca.w[3] = pk2(c1[2], c1[3]);
                cq = mfma16(ca.v, ks == 0 ? q0.v : q1.v, cq); }
            const v2u ogw = *(const v2u*)(HB + (size_t)(tok0 + tl) * HBP + HB_ML_OG + h * 64 + et * 16 + fq * 4);
            const float og[4] = {bflo(ogw.x), bfhi(ogw.x), bflo(ogw.y), bfhi(ogw.y)};
#pragma unroll
            for (int i = 0; i < 4; ++i) { const float hval = (num[i] + inter * cq[i]) * rden; const float o = hval / (1.0f + fexp(-og[i])); hv[et][i] = o; ss += o * o; }
        }
        ss = red4_sum(ss);
        const float rn = 1.0f / sqrtf(ss * (1.f / 64.f) + NORM_EPS);
        bf16* orow = XN + (size_t)(tok0 + tl) * DM + 256 + h * 64 + fq * 4;
#pragma unroll
        for (int et = 0; et < 4; ++et) { const float* gp = ng + et * 16 + fq * 4; v2u w; w.x = pk2(hv[et][0] * rn * gp[0], hv[et][1] * rn * gp[1]); w.y = pk2(hv[et][2] * rn * gp[2], hv[et][3] * rn * gp[3]); *(v2u*)(orow + et * 16) = w; }
    }
    LDS_WAIT();
}

__device__ __forceinline__ float silu_f(float x) { return x * __builtin_amdgcn_rcpf(1.0f + __builtin_amdgcn_exp2f(-1.4426950408889634f * x)); }
template <int NORM>
__device__ __forceinline__ void gdn_conv_chunk(const bf16* HB, int tok0, bool first, int col0, const float* cw, int ch0, float nscale, LAS bf16* buf, int lane) {
#pragma unroll
    for (int i = 0; i < 9; ++i) { const int idx = i * 64 + lane, r = idx >> 3, c8 = idx & 7;
        if (idx < 67 * 8) { v4u v = {0u, 0u, 0u, 0u}; if (!(first && r < 3)) v = *(const v4u*)(HB + (size_t)(tok0 - 3 + r) * HBP + col0 + c8 * 8); *(LAS v4u*)(buf + r * 72 + c8 * 8) = v; } }
    LDS_WAIT();
    const float w0 = cw[ch0 + lane], w1 = cw[768 + ch0 + lane], w2 = cw[1536 + ch0 + lane], w3 = cw[2304 + ch0 + lane];
    float xm3 = bf2f(buf[0 * 72 + lane]), xm2 = bf2f(buf[1 * 72 + lane]), xm1 = bf2f(buf[2 * 72 + lane]);
#pragma unroll 4
    for (int t = 0; t < 64; ++t) {
        const float x0 = bf2f(buf[(t + 3) * 72 + lane]);
        float o = silu_f(w0 * xm3 + w1 * xm2 + w2 * xm1 + w3 * x0);
        xm3 = xm2; xm2 = xm1; xm1 = x0;
        if (NORM) { const float ss = wave_sum(o * o); o *= nscale / sqrtf(ss + NORM_EPS); }
        buf[t * 72 + lane] = (bf16)f2bf(o);
    }
    LDS_WAIT();
}
__device__ __forceinline__ void gdn_prep_item(int it, int l, const Args& args, LAS unsigned char* wlds, int lane) {
    unsigned char* ws = args.ws; const bf16* HB = (const bf16*)(ws + WS_HB);
    const int bh = it >> 7, n = it & 127, b = bh >> 2, h = bh & 3, tok0 = b * SEQ + n * 64, fr = lane & 15, fq = lane >> 4;
    LAS bf16* buf = (LAS bf16*)wlds; LAS float* sg = (LAS float*)(wlds + 16384);
    const float* cw = opaque(args.in[I_GD_CONV] + (size_t)l * 4 * 768);
    const float alog = opaque(args.in[I_GD_ALOG] + l * 4)[h], dtb = opaque(args.in[I_GD_DT] + l * 4)[h];
    const float beta_l = 1.0f / (1.0f + fexp(-bf2f(HB[(size_t)(tok0 + lane) * HBP + HB_GD_BETA + h])));
    const float apre = bf2f(HB[(size_t)(tok0 + lane) * HBP + HB_GD_A + h]) + dtb;
    const float sp = fmaxf(apre, 0.f) + log1pf(expf(-fabsf(apre)));
    const float gc_l = wave_incl_sum(-fexp(alog) * sp, lane);
    const float gend = __shfl(gc_l, 63);
    sg[lane] = gc_l; sg[64 + lane] = beta_l; sg[128 + lane] = fexp(gc_l);
    LDS_WAIT();
    const size_t cb = (size_t)it * 4096;
    bf16* Wo = (bf16*)(ws + WS_GD_W) + cb; bf16* UTo = (bf16*)(ws + WS_GD_UT) + cb; bf16* KDTo = (bf16*)(ws + WS_GD_KDT) + cb; bf16* QDo = (bf16*)(ws + WS_GD_QD) + cb; bf16* AQKo = (bf16*)(ws + WS_GD_AQK) + cb;
    gdn_conv_chunk<1>(HB, tok0, n == 0, HB_GD_K + h * 64, cw, 256 + h * 64, 1.0f, buf, lane);
#pragma unroll
    for (int t8 = 0; t8 < 8; ++t8) { v4u o;
#pragma unroll
        for (int j = 0; j < 4; ++j) { const int t = t8 * 8 + 2 * j; o[j] = pk2(bf2f(buf[t * 72 + lane]) * fexp(gend - sg[t]), bf2f(buf[(t + 1) * 72 + lane]) * fexp(gend - sg[t + 1])); }
        *(v4u*)(KDTo + lane * 64 + t8 * 8) = o; }
    Frag kf[4][2];
#pragma unroll
    for (int t = 0; t < 4; ++t)
#pragma unroll
        for (int ks = 0; ks < 2; ++ks) kf[t][ks].u = *(const LAS v4u*)(buf + (t * 16 + fr) * 72 + ks * 32 + fq * 8);
    LDS_WAIT();
    gdn_conv_chunk<1>(HB, tok0, n == 0, HB_GD_Q + h * 64, cw, h * 64, 0.125f, buf, lane);
#pragma unroll 8
    for (int t = 0; t < 64; ++t) QDo[t * 64 + lane] = (bf16)f2bf(bf2f(buf[t * 72 + lane]) * sg[128 + t]);
    float gci[4][4], gcj[4];
#pragma unroll
    for (int mt = 0; mt < 4; ++mt)
#pragma unroll
        for (int ii = 0; ii < 4; ++ii) gci[mt][ii] = sg[mt * 16 + fq * 4 + ii];
#pragma unroll
    for (int nt = 0; nt < 4; ++nt) gcj[nt] = sg[nt * 16 + fr];
#pragma unroll
    for (int mt = 0; mt < 4; ++mt) {
        Frag q0, q1; q0.u = *(const LAS v4u*)(buf + (mt * 16 + fr) * 72 + fq * 8); q1.u = *(const LAS v4u*)(buf + (mt * 16 + fr) * 72 + 32 + fq * 8);
#pragma unroll
        for (int nt = 0; nt < 4; ++nt) { f32x4 acc = {0.f, 0.f, 0.f, 0.f};
            if (nt <= mt) { acc = mfma16(q0.v, kf[nt][0].v, acc); acc = mfma16(q1.v, kf[nt][1].v, acc); }
#pragma unroll
            for (int ii = 0; ii < 4; ++ii) { const int i = mt * 16 + fq * 4 + ii, j = nt * 16 + fr; const float vv = (nt <= mt && i >= j) ? acc[ii] * fexp(gci[mt][ii] - gcj[nt]) : 0.f; AQKo[i * 64 + j] = (bf16)f2bf(vv); } } }
    LDS_WAIT();
    gdn_conv_chunk<0>(HB, tok0, n == 0, HB_GD_V + h * 64, cw, 512 + h * 64, 1.0f, buf, lane);
    LAS float* Xl = (LAS float*)wlds;
    { float xx[64];
#pragma unroll
      for (int t = 0; t < 64; ++t) xx[t] = bf2f(buf[t * 72 + lane]) * sg[64 + t];
      LDS_WAIT();
#pragma unroll
      for (int t = 0; t < 64; ++t) Xl[t * 64 + lane] = xx[t]; }
    float am[4][4][4];
#define GDN_SOLVE() do { _Pragma("unroll") for (int mt = 0; mt < 4; ++mt) { \
        _Pragma("unroll") for (int nt = 0; nt < mt; ++nt) { float xo[16]; \
            _Pragma("unroll") for (int jj = 0; jj < 16; ++jj) xo[jj] = Xl[(nt * 16 + jj) * 64 + lane]; \
            for (int fqp = 0; fqp < 4; ++fqp) { _Pragma("unroll") for (int ii = 0; ii < 4; ++ii) { const int i = mt * 16 + fqp * 4 + ii; float xi = Xl[i * 64 + lane]; \
                const float af = am[mt][nt][ii]; const int av = __builtin_bit_cast(int, af); \
                _Pragma("unroll") for (int jj = 0; jj < 16; ++jj) xi -= __builtin_bit_cast(float, __builtin_amdgcn_readlane(av, fqp * 16 + jj)) * xo[jj]; \
                Xl[i * 64 + lane] = xi; } } } \
        { float xd[16]; \
          _Pragma("unroll") for (int r = 0; r < 16; ++r) xd[r] = Xl[(mt * 16 + r) * 64 + lane]; \
          _Pragma("unroll") for (int r = 1; r < 16; ++r) { const float af = am[mt][mt][r & 3]; const int av = __builtin_bit_cast(int, af); \
              _Pragma("unroll") for (int jj = 0; jj < r; ++jj) xd[r] -= __builtin_bit_cast(float, __builtin_amdgcn_readlane(av, (r >> 2) * 16 + jj)) * xd[jj]; } \
          _Pragma("unroll") for (int r = 1; r < 16; ++r) Xl[(mt * 16 + r) * 64 + lane] = xd[r]; } } } while (0)
#pragma unroll
    for (int mt = 0; mt < 4; ++mt)
#pragma unroll
        for (int nt = 0; nt < 4; ++nt) { f32x4 acc = {0.f, 0.f, 0.f, 0.f};
            if (nt <= mt) { acc = mfma16(kf[mt][0].v, kf[nt][0].v, acc); acc = mfma16(kf[mt][1].v, kf[nt][1].v, acc); }
#pragma unroll
            for (int ii = 0; ii < 4; ++ii) { const int i = mt * 16 + fq * 4 + ii, j = nt * 16 + fr; am[mt][nt][ii] = (nt <= mt && i > j) ? acc[ii] * sg[64 + i] * fexp(gci[mt][ii] - gcj[nt]) : 0.f; } }
    asm volatile("" ::: "memory");
    GDN_SOLVE();
#pragma unroll
    for (int t8 = 0; t8 < 8; ++t8) { v4u o;
#pragma unroll
        for (int j = 0; j < 4; ++j) o[j] = pk2(Xl[(t8 * 8 + 2 * j) * 64 + lane], Xl[(t8 * 8 + 2 * j + 1) * 64 + lane]);
        *(v4u*)(UTo + lane * 64 + t8 * 8) = o; }
    LDS_WAIT();
    gdn_conv_chunk<1>(HB, tok0, n == 0, HB_GD_K + h * 64, cw, 256 + h * 64, 1.0f, buf, lane);
    { float xx[64];
#pragma unroll
      for (int t = 0; t < 64; ++t) xx[t] = bf2f(buf[t * 72 + lane]) * sg[64 + t] * sg[128 + t];
      LDS_WAIT();
#pragma unroll
      for (int t = 0; t < 64; ++t) Xl[t * 64 + lane] = xx[t]; }
#pragma unroll
    for (int mt = 0; mt < 4; ++mt)
#pragma unroll
        for (int nt = 0; nt < 4; ++nt) { f32x4 acc = {0.f, 0.f, 0.f, 0.f};
            if (nt <= mt) { acc = mfma16(kf[mt][0].v, kf[nt][0].v, acc); acc = mfma16(kf[mt][1].v, kf[nt][1].v, acc); }
#pragma unroll
            for (int ii = 0; ii < 4; ++ii) { const int i = mt * 16 + fq * 4 + ii, j = nt * 16 + fr; am[mt][nt][ii] = (nt <= mt && i > j) ? acc[ii] * sg[64 + i] * fexp(gci[mt][ii] - gcj[nt]) : 0.f; } }
    asm volatile("" ::: "memory");
    GDN_SOLVE();
#pragma unroll 8
    for (int t = 0; t < 64; ++t) Wo[t * 64 + lane] = (bf16)f2bf(Xl[t * 64 + lane]);
    ((float*)(ws + WS_GD_GE))[it] = fexp(gend);
    LDS_WAIT();
}
__device__ __forceinline__ void gdn_scan_item(int it, const Args& args, int lane) {
    unsigned char* ws = args.ws; const int bh = it >> 2, vg = it & 3, fr = lane & 15, fq = lane >> 4;
    const bf16* Wb = (const bf16*)(ws + WS_GD_W); const bf16* UTb = (const bf16*)(ws + WS_GD_UT); const bf16* KDTb = (const bf16*)(ws + WS_GD_KDT);
    bf16* STb = (bf16*)(ws + WS_GD_ST); bf16* VNTb = (bf16*)(ws + WS_GD_VNT); const float* GE = (const float*)(ws + WS_GD_GE);
    f32x4 S[4];
#pragma unroll
    for (int mt = 0; mt < 4; ++mt) S[mt] = (f32x4){0.f, 0.f, 0.f, 0.f};
#define GDN_SCAN_LOAD(AW, AKD, UTV, GEV, nn) do { const size_t cb_ = (size_t)(bh * 128 + (nn)) * 4096; _Pragma("unroll") for (int mt = 0; mt < 4; ++mt) { _Pragma("unroll") for (int s = 0; s < 2; ++s) { \
        const bf16* wp = Wb + cb_ + (mt * 16 + fr) * 64 + (2 * s) * 16 + fq * 4; const v2u a0 = *(const v2u*)wp, a1 = *(const v2u*)(wp + 16); AW[mt][s].w[0] = a0.x; AW[mt][s].w[1] = a0.y; AW[mt][s].w[2] = a1.x; AW[mt][s].w[3] = a1.y; \
        const bf16* kp = KDTb + cb_ + (mt * 16 + fr) * 64 + (2 * s) * 16 + fq * 4; const v2u k0 = *(const v2u*)kp, k1 = *(const v2u*)(kp + 16); AKD[mt][s].w[0] = k0.x; AKD[mt][s].w[1] = k0.y; AKD[mt][s].w[2] = k1.x; AKD[mt][s].w[3] = k1.y; } \
        UTV[mt] = *(const v2u*)(UTb + cb_ + (vg * 16 + fr) * 64 + mt * 16 + fq * 4); } GEV = GE[bh * 128 + (nn)]; } while (0)
    Frag aw[4][2], akd[4][2], awn[4][2], akdn[4][2]; v2u ut[4], utn[4]; float ge, gen;
    GDN_SCAN_LOAD(aw, akd, ut, ge, 0);
    for (int n = 0; n < 128; ++n) {
        const size_t cb = (size_t)(bh * 128 + n) * 4096;
        { const int nn = (n + 1 < 128) ? n + 1 : n; GDN_SCAN_LOAD(awn, akdn, utn, gen, nn); }
        Frag bS[2];
#pragma unroll
        for (int s = 0; s < 2; ++s) { bS[s].w[0] = pk2(S[2 * s][0], S[2 * s][1]); bS[s].w[1] = pk2(S[2 * s][2], S[2 * s][3]); bS[s].w[2] = pk2(S[2 * s + 1][0], S[2 * s + 1][1]); bS[s].w[3] = pk2(S[2 * s + 1][2], S[2 * s + 1][3]); }
#pragma unroll
        for (int mt = 0; mt < 4; ++mt) { v2u o; o.x = pk2(S[mt][0], S[mt][1]); o.y = pk2(S[mt][2], S[mt][3]); *(v2u*)(STb + cb + (vg * 16 + fr) * 64 + mt * 16 + fq * 4) = o; }
        Frag bV[2]; unsigned vnw[4][2];
#pragma unroll
        for (int mt = 0; mt < 4; ++mt) { f32x4 acc = {0.f, 0.f, 0.f, 0.f}; acc = mfma16(aw[mt][0].v, bS[0].v, acc); acc = mfma16(aw[mt][1].v, bS[1].v, acc);
            const float v0 = bflo(ut[mt].x) - acc[0], v1 = bfhi(ut[mt].x) - acc[1], v2 = bflo(ut[mt].y) - acc[2], v3 = bfhi(ut[mt].y) - acc[3];
            vnw[mt][0] = pk2(v0, v1); vnw[mt][1] = pk2(v2, v3);
            v2u o; o.x = vnw[mt][0]; o.y = vnw[mt][1]; *(v2u*)(VNTb + cb + (vg * 16 + fr) * 64 + mt * 16 + fq * 4) = o; }
#pragma unroll
        for (int s = 0; s < 2; ++s) { bV[s].w[0] = vnw[2 * s][0]; bV[s].w[1] = vnw[2 * s][1]; bV[s].w[2] = vnw[2 * s + 1][0]; bV[s].w[3] = vnw[2 * s + 1][1]; }
#pragma unroll
        for (int mt = 0; mt < 4; ++mt) { f32x4 acc = S[mt] * ge; acc = mfma16(akd[mt][0].v, bV[0].v, acc); acc = mfma16(akd[mt][1].v, bV[1].v, acc); S[mt] = acc; }
#pragma unroll
        for (int mt = 0; mt < 4; ++mt) { aw[mt][0] = awn[mt][0]; aw[mt][1] = awn[mt][1]; akd[mt][0] = akdn[mt][0]; akd[mt][1] = akdn[mt][1]; ut[mt] = utn[mt]; }
        ge = gen;
    }
}
__device__ __forceinline__ void gdn_out_item(int it, int l, const Args& args, int lane) {
    unsigned char* ws = args.ws; const bf16* HB = (const bf16*)(ws + WS_HB); bf16* XN = (bf16*)(ws + WS_XN);
    const int bh = it >> 7, n = it & 127, b = bh >> 2, h = bh & 3, tok0 = b * SEQ + n * 64, fr = lane & 15, fq = lane >> 4;
    const size_t cb = (size_t)it * 4096;
    const bf16* ST = (const bf16*)(ws + WS_GD_ST) + cb; const bf16* VNT = (const bf16*)(ws + WS_GD_VNT) + cb; const bf16* QD = (const bf16*)(ws + WS_GD_QD) + cb; const bf16* AQK = (const bf16*)(ws + WS_GD_AQK) + cb;
    const float* ng = opaque(args.in[I_GD_NG] + l * 64);
    Frag sa[4][2], va[4][2];
#pragma unroll
    for (int vt = 0; vt < 4; ++vt)
#pragma unroll
        for (int ks = 0; ks < 2; ++ks) { sa[vt][ks].u = *(const v4u*)(ST + (vt * 16 + fr) * 64 + ks * 32 + fq * 8); va[vt][ks].u = *(const v4u*)(VNT + (vt * 16 + fr) * 64 + ks * 32 + fq * 8); }
    for (int lt = 0; lt < 4; ++lt) {
        const int tl = lt * 16 + fr;
        Frag qb[2], ab[2];
#pragma unroll
        for (int ks = 0; ks < 2; ++ks) { qb[ks].u = *(const v4u*)(QD + tl * 64 + ks * 32 + fq * 8); ab[ks].u = *(const v4u*)(AQK + tl * 64 + ks * 32 + fq * 8); }
        f32x4 o[4]; float ss = 0.f;
#pragma unroll
        for (int vt = 0; vt < 4; ++vt) { f32x4 acc = {0.f, 0.f, 0.f, 0.f};
#pragma unroll
            for (int ks = 0; ks < 2; ++ks) { acc = mfma16(sa[vt][ks].v, qb[ks].v, acc); acc = mfma16(va[vt][ks].v, ab[ks].v, acc); }
            o[vt] = acc; ss += acc[0] * acc[0] + acc[1] * acc[1] + acc[2] * acc[2] + acc[3] * acc[3]; }
        ss = red4_sum(ss);
        const float rn = 1.0f / sqrtf(ss * (1.f / 64.f) + NORM_EPS);
        bf16* orow = XN + (size_t)(tok0 + tl) * DM + 512 + h * 64 + fq * 4;
#pragma unroll
        for (int vt = 0; vt < 4; ++vt) { const v2u zw = *(const v2u*)(HB + (size_t)(tok0 + tl) * HBP + HB_GD_Z + h * 64 + vt * 16 + fq * 4);
            const float* gp = ng + vt * 16 + fq * 4;
            v2u w; w.x = pk2(o[vt][0] * rn * gp[0] * silu_f(bflo(zw.x)), o[vt][1] * rn * gp[1] * silu_f(bfhi(zw.x))); w.y = pk2(o[vt][2] * rn * gp[2] * silu_f(bflo(zw.y)), o[vt][3] * rn * gp[3] * silu_f(bfhi(zw.y)));
            *(v2u*)(orow + vt * 16) = w; }
    }
}

__device__ __forceinline__ void nsa_cmp_item(int it2, int l, const Args& args, int lane) {
    unsigned char* ws = args.ws; const bf16* HB = (const bf16*)(ws + WS_HB);
    const int it = it2 >> 1, nh = (it2 & 1) * 2;
    const int b = it >> 6, kind = (it >> 5) & 1, jt = it & 31, fr = lane & 15, fq = lane >> 4;
    const bf16* wt = opaque((const bf16*)(ws + WS_WSM + l * WSM_L + (kind ? WSM_CV : WSM_CK)));
    const float* pos = opaque(args.in[I_CMPPOS] + l * 2048);
    const int j = jt * 16 + fr, col = kind ? HB_NSA_VC : HB_NSA_KC;
    f32x4 acc[2];
#pragma unroll
    for (int nt = 0; nt < 2; ++nt) acc[nt] = (f32x4){0.f, 0.f, 0.f, 0.f};
#pragma unroll 4
    for (int ks = 0; ks < 64; ++ks) {
        const int i = ks >> 1, d0 = (ks & 1) * 32 + fq * 8;
        Frag a; a.u = (v4u){0u, 0u, 0u, 0u};
        if (j < 511) { const v4u x = *(const v4u*)(HB + (size_t)(b * SEQ + 16 * j + i) * HBP + col + d0); const float* pp = pos + i * 64 + d0;
#pragma unroll
            for (int q = 0; q < 4; ++q) a.w[q] = pk2(bflo(x[q]) + pp[2 * q], bfhi(x[q]) + pp[2 * q + 1]); }
#pragma unroll
        for (int nt = 0; nt < 2; ++nt) { Frag bw; bw.u = *(const v4u*)(wt + (size_t)((nh + nt) * 16 + fr) * 2048 + ks * 32 + fq * 8); acc[nt] = mfma16(a.v, bw.v, acc[nt]); }
    }
    if (kind == 0) { bf16* Ko = (bf16*)(ws + WS_NSA_KCMP) + (size_t)b * 512 * 64;
#pragma unroll
        for (int nt = 0; nt < 2; ++nt)
#pragma unroll
            for (int i = 0; i < 4; ++i) Ko[(jt * 16 + fq * 4 + i) * 64 + (nh + nt) * 16 + fr] = (bf16)f2bf(acc[nt][i]);
    } else { bf16* Vo = (bf16*)(ws + WS_NSA_VCMPT) + (size_t)b * 64 * 512;
#pragma unroll
        for (int nt = 0; nt < 2; ++nt) { v2u o; o.x = pk2(acc[nt][0], acc[nt][1]); o.y = pk2(acc[nt][2], acc[nt][3]); *(v2u*)(Vo + ((nh + nt) * 16 + fr) * 512 + jt * 16 + fq * 4) = o; } }
}
__device__ __forceinline__ void nsa_vt_item(int it, int l, const Args& args, LAS unsigned char* wlds, int lane) {
    unsigned char* ws = args.ws; const bf16* HB = (const bf16*)(ws + WS_HB);
    const int b = it >> 8, which = (it >> 7) & 1, n = it & 127;
    LAS bf16* buf = (LAS bf16*)wlds;
    stage64(HB, b * SEQ + n * 64, which ? HB_NSA_VW : HB_NSA_VS, buf, lane);
    if (which) {
        const int fr = lane & 15, fq = lane >> 4;
        bf16* vdst = (bf16*)(ws + WS_NSA_VWT) + ((size_t)(b * 256 + n * 2) * 4) * 512 + lane * 8;
        bf16* kdst = (bf16*)(ws + WS_WIN + l * WIN_L) + ((size_t)(b * 256 + n * 2) * 4) * 512 + lane * 8;
#pragma unroll
        for (int hb = 0; hb < 2; ++hb)
#pragma unroll
            for (int dt = 0; dt < 4; ++dt) { v4u o;
#pragma unroll
                for (int q = 0; q < 2; ++q) {
                    o[q] = (unsigned)buf[(hb * 32 + fq * 4 + 2 * q) * 72 + dt * 16 + fr] | ((unsigned)buf[(hb * 32 + fq * 4 + 2 * q + 1) * 72 + dt * 16 + fr] << 16);
                    o[2 + q] = (unsigned)buf[(hb * 32 + 16 + fq * 4 + 2 * q) * 72 + dt * 16 + fr] | ((unsigned)buf[(hb * 32 + 16 + fq * 4 + 2 * q + 1) * 72 + dt * 16 + fr] << 16); }
                *(v4u*)(vdst + (hb * 4 + dt) * 512) = o; }
#pragma unroll
        for (int hb = 0; hb < 2; ++hb)
#pragma unroll
            for (int tt = 0; tt < 2; ++tt)
#pragma unroll
                for (int ks = 0; ks < 2; ++ks) { const v4u x = *(const v4u*)(HB + (size_t)(b * SEQ + n * 64 + hb * 32 + tt * 16 + fr) * HBP + HB_NSA_KW + ks * 32 + fq * 8); *(v4u*)(kdst + (hb * 4 + tt * 2 + ks) * 512) = x; }
    } else {
        const int fr = lane & 15, fq = lane >> 4;
        bf16* vdst = (bf16*)(ws + WS_NSA_VST) + ((size_t)(b * 128 + n) * 8) * 512 + lane * 8;
        bf16* kdst = (bf16*)(ws + WS_NSA_KSW) + ((size_t)(b * 128 + n) * 8) * 512 + lane * 8;
#pragma unroll
        for (int dt = 0; dt < 4; ++dt)
#pragma unroll
            for (int k2 = 0; k2 < 2; ++k2) { v4u o;
#pragma unroll
                for (int q = 0; q < 2; ++q) {
                    o[q] = (unsigned)buf[(k2 * 32 + fq * 4 + 2 * q) * 72 + dt * 16 + fr] | ((unsigned)buf[(k2 * 32 + fq * 4 + 2 * q + 1) * 72 + dt * 16 + fr] << 16);
                    o[2 + q] = (unsigned)buf[(k2 * 32 + 16 + fq * 4 + 2 * q) * 72 + dt * 16 + fr] | ((unsigned)buf[(k2 * 32 + 16 + fq * 4 + 2 * q + 1) * 72 + dt * 16 + fr] << 16); }
                *(v4u*)(vdst + (dt * 2 + k2) * 512) = o; }
#pragma unroll
        for (int kt = 0; kt < 4; ++kt)
#pragma unroll
            for (int ks = 0; ks < 2; ++ks) { const v4u x = *(const v4u*)(HB + (size_t)(b * SEQ + n * 64 + kt * 16 + fr) * HBP + HB_NSA_KS + ks * 32 + fq * 8); *(v4u*)(kdst + (kt * 2 + ks) * 512) = x; }
    }
    LDS_WAIT();
}
__device__ __forceinline__ void nsa_lut_init(const float* t5, LAS float* lut, int lane) {
#pragma unroll
    for (int r = 0; r < 2; ++r) { const int k = r * 64 + lane, d = (k > 0) ? k - 1 : 0; int bk = d;
        if (d >= 16) { bk = 16 + (int)(logf((float)d / 16.0f) / 2.0794415f * 16.0f); bk = bk < 31 ? bk : 31; }
#pragma unroll
        for (int h = 0; h < 4; ++h) lut[h * 128 + k] = (k > 0) ? t5[bk * 4 + h] : -1e30f; }
    LDS_WAIT();
}
#define NSA_BIAS(dist, h, b31v) (lut[(h) * 128 + (((dist) < -1) ? 0 : (((dist) > 126) ? 127 : (dist) + 1))])
__device__ __forceinline__ void nsa_item(int b, int qt, int l, const Args& args, LAS unsigned char* wlds, int lane) {
    unsigned char* ws = args.ws; const bf16* HB = (const bf16*)(ws + WS_HB); bf16* XN = (bf16*)(ws + WS_XN);
    const int t0 = qt * 16, tok0 = b * SEQ + t0, cur = t0 >> 6, fr = lane & 15, fq = lane >> 4;
    LAS bf16* outb = (LAS bf16*)(wlds + 8192); LAS float* imp = (LAS float*)wlds; const LAS float* lut = (const LAS float*)(wlds + 16384);
    const float* t5 = opaque(args.in[I_T5]);
    const float L2E = 1.4426950408889634f;
    Frag qa[4][2];
#pragma unroll
    for (int h = 0; h < 4; ++h)
#pragma unroll
        for (int ks = 0; ks < 2; ++ks) qa[h][ks].u = *(const v4u*)(HB + (size_t)(tok0 + fr) * HBP + HB_NSA_Q + h * 64 + ks * 32 + fq * 8);
    const int tq = t0 + fr;
#pragma unroll
    for (int i = 0; i < 32; ++i) imp[i * 64 + lane] = 0.f;
    const bf16* KC = (const bf16*)(ws + WS_NSA_KCMP) + (size_t)b * 512 * 64; const bf16* VCT = (const bf16*)(ws + WS_NSA_VCMPT) + (size_t)b * 64 * 512;
    const int nblk = t0 >> 4, npair = (nblk + 31) >> 5;
    float mc[4], lc[4];
#pragma unroll
    for (int h = 0; h < 4; ++h) { mc[h] = -1e30f; lc[h] = 0.f; }
    Frag kc1[2];
#pragma unroll
    for (int ks = 0; ks < 2; ++ks) kc1[ks].u = *(const v4u*)(KC + (size_t)fr * 64 + ks * 32 + fq * 8);
    for (int kt = 0; kt < 2 * npair; ++kt) {
        Frag kf[2], kn1[2];
        { const int ktn = (kt + 1 < 2 * npair) ? kt + 1 : kt;
#pragma unroll
          for (int ks = 0; ks < 2; ++ks) kn1[ks].u = *(const v4u*)(KC + (size_t)(ktn * 16 + fr) * 64 + ks * 32 + fq * 8); }
        kf[0].u = kc1[0].u; kf[1].u = kc1[1].u;
#pragma unroll
        for (int h = 0; h < 4; ++h) { f32x4 acc = {0.f, 0.f, 0.f, 0.f}; acc = mfma16(kf[0].v, qa[h][0].v, acc); acc = mfma16(kf[1].v, qa[h][1].v, acc);
            float s[4]; float mx = -1e30f;
#pragma unroll
            for (int i = 0; i < 4; ++i) { const int dist = tq - (16 * (kt * 16 + fq * 4 + i) + 31); const float bb = NSA_BIAS(dist, h, 0); s[i] = acc[i] * 0.125f + bb; mx = fmaxf(mx, s[i]); }
            mx = red4_max(mx);
            const float mn = fmaxf(mc[h], mx); float ps = 0.f;
#pragma unroll
            for (int i = 0; i < 4; ++i) ps += __builtin_amdgcn_exp2f((s[i] - fmaxf(mn, -1e20f)) * L2E);
            lc[h] = lc[h] * __builtin_amdgcn_exp2f((mc[h] - mn) * L2E) + ps; mc[h] = mn; }
        kc1[0].u = kn1[0].u; kc1[1].u = kn1[1].u;
    }
#pragma unroll
    for (int h = 0; h < 4; ++h) { float t = lc[h]; t = red4_sum(t); lc[h] = (t > 0.f) ? 1.0f / t : 0.f; }
    f32x4 oc[4][4];
#pragma unroll
    for (int dt = 0; dt < 4; ++dt)
#pragma unroll
        for (int h = 0; h < 4; ++h) oc[dt][h] = (f32x4){0.f, 0.f, 0.f, 0.f};
    for (int kp = 0; kp < npair; ++kp) {
        unsigned pw[4][4];
#pragma unroll
        for (int tt = 0; tt < 2; ++tt) { const int kt = kp * 2 + tt; Frag kf[2];
#pragma unroll
            for (int ks = 0; ks < 2; ++ks) kf[ks].u = *(const v4u*)(KC + (size_t)(kt * 16 + fr) * 64 + ks * 32 + fq * 8);
            float impv = 0.f;
#pragma unroll
            for (int h = 0; h < 4; ++h) { f32x4 acc = {0.f, 0.f, 0.f, 0.f}; acc = mfma16(kf[0].v, qa[h][0].v, acc); acc = mfma16(kf[1].v, qa[h][1].v, acc);
                float p[4];
#pragma unroll
                for (int i = 0; i < 4; ++i) { const int dist = tq - (16 * (kt * 16 + fq * 4 + i) + 31);
                    const float bb = NSA_BIAS(dist, h, 0); p[i] = __builtin_amdgcn_exp2f(((acc[i] * 0.125f + bb) - fmaxf(mc[h], -1e20f)) * L2E) * lc[h]; }
                impv += p[0] + p[1] + p[2];
                pw[h][2 * tt] = pk2(p[0], p[1]); pw[h][2 * tt + 1] = pk2(p[2], p[3]); }
            imp[fr * 128 + kt * 4 + fq] = impv; __builtin_amdgcn_sched_barrier(0); }
#pragma unroll
        for (int dt = 0; dt < 4; ++dt) { const bf16* vp = VCT + (size_t)(dt * 16 + fr) * 512 + kp * 32 + fq * 4; const v2u lo2 = *(const v2u*)vp, hi2 = *(const v2u*)(vp + 16);
            Frag vf; vf.w[0] = lo2.x; vf.w[1] = lo2.y; vf.w[2] = hi2.x; vf.w[3] = hi2.y;
#pragma unroll
            for (int h = 0; h < 4; ++h) { Frag pf; pf.w[0] = pw[h][0]; pf.w[1] = pw[h][1]; pf.w[2] = pw[h][2]; pf.w[3] = pw[h][3]; oc[dt][h] = mfma16(vf.v, pf.v, oc[dt][h]); } }
    }
#pragma unroll
    for (int h = 0; h < 4; ++h) { const float gc_ = 1.0f / (1.0f + expf(-bf2f(HB[(size_t)(tok0 + fr) * HBP + HB_NSA_G + 0 + h])));
#pragma unroll
        for (int dt = 0; dt < 4; ++dt) { v2u w; w.x = pk2(oc[dt][h][0] * gc_, oc[dt][h][1] * gc_); w.y = pk2(oc[dt][h][2] * gc_, oc[dt][h][3] * gc_); *(LAS v2u*)(outb + fr * 256 + h * 64 + dt * 16 + fq * 4) = w; } }
    LDS_WAIT();
    unsigned taken = 0u;
    if (cur >= 16) {
        float cand[32];
#pragma unroll
        for (int k = 0; k < 32; ++k) { const int s = fq * 32 + k; cand[k] = (s >= 1 && s <= cur - 2) ? imp[fr * 128 + s] : -1.0f; }
        for (int r = 0; r < 13; ++r) {
            float bv = -1.0f; int bk = 0;
#pragma unroll
            for (int k = 0; k < 32; ++k) { const bool free_ = ((taken >> k) & 1u) == 0u; if (free_ && cand[k] > bv) { bv = cand[k]; bk = k; } }
            int bs = fq * 32 + bk;
#pragma unroll
            for (int o = 16; o <= 32; o <<= 1) { const float ov = __shfl_xor(bv, o); const int os = __shfl_xor(bs, o); if (ov > bv || (ov == bv && os < bs)) { bv = ov; bs = os; } }
            taken |= ((bs >> 5) == fq && bv >= 0.f) ? (1u << (bs & 31)) : 0u;
        }
        taken |= (fq == 0) ? 1u : 0u;
        taken |= ((cur >> 5) == fq) ? (1u << (cur & 31)) : 0u;
        taken |= (((cur - 1) >> 5) == fq) ? (1u << ((cur - 1) & 31)) : 0u;
    } else {
        taken = (fq == 0) ? ((2u << cur) - 1u) : 0u;
    }
    LDS_WAIT();
    const bf16* VST = (const bf16*)(ws + WS_NSA_VST) + (size_t)b * 128 * 4096; const bf16* KSW = (const bf16*)(ws + WS_NSA_KSW) + (size_t)b * 128 * 4096;
    { const int qi = fr >> 2, hh = fr & 3;
      LAS unsigned char* blist = (LAS unsigned char*)wlds;
#define NSA_SEL_LOADK(KF, sblk_) do { const bf16* kp_ = KSW + (size_t)(sblk_) * 4096 + lane * 8; \
        _Pragma("unroll") for (int kt = 0; kt < 4; ++kt) _Pragma("unroll") for (int ks = 0; ks < 2; ++ks) KF[kt][ks].u = *(const v4u*)(kp_ + (kt * 2 + ks) * 512); } while (0)
#define NSA_SEL_LOADV(VF, sblk_) do { const bf16* vp_ = VST + (size_t)(sblk_) * 4096 + lane * 8; \
        _Pragma("unroll") for (int dt = 0; dt < 4; ++dt) _Pragma("unroll") for (int k2 = 0; k2 < 2; ++k2) VF[dt][k2].u = *(const v4u*)(vp_ + (dt * 2 + k2) * 512); } while (0)
#define NSA_SEL_STEP_(KF, VF, sblk_, FAR) do { const int key0 = (sblk_) * 64; const unsigned mwd_ = ((sblk_) >> 5) == 0 ? mw0 : ((sblk_) >> 5) == 1 ? mw1 : ((sblk_) >> 5) == 2 ? mw2 : mw3; const float selm_ = (((mwd_ >> ((sblk_) & 31)) & 1u) != 0u) ? 0.f : -1e30f; \
        f32x4 sc[4]; float mx = -1e30f; const float c0_ = bfar_ + selm_;     \
        _Pragma("unroll") for (int kt = 0; kt < 4; ++kt) { f32x4 acc = {0.f, 0.f, 0.f, 0.f}; acc = mfma16(KF[kt][0].v, qs[0].v, acc); acc = mfma16(KF[kt][1].v, qs[1].v, acc); \
            _Pragma("unroll") for (int i = 0; i < 4; ++i) { if (FAR) sc[kt][i] = acc[i] * 0.125f + c0_; else { const int dist = tqs - (key0 + kt * 16 + fq * 4 + i); const float bb = NSA_BIAS(dist, hh, 0); sc[kt][i] = (acc[i] * 0.125f + bb) + selm_; } mx = fmaxf(mx, sc[kt][i]); } } \
        mx = red4_max(mx); \
        const float mn = fmaxf(ms, mx), alpha = __builtin_amdgcn_exp2f((ms - mn) * L2E), nml_ = -fmaxf(mn, -1e20f) * L2E; ms = mn; \
        float ps = 0.f; unsigned pw[4][2]; \
        _Pragma("unroll") for (int kt = 0; kt < 4; ++kt) { float p[4]; \
            _Pragma("unroll") for (int i = 0; i < 4; ++i) { p[i] = __builtin_amdgcn_exp2f(__builtin_fmaf(sc[kt][i], L2E, nml_)); ps += p[i]; } \
            pw[kt][0] = pk2(p[0], p[1]); pw[kt][1] = pk2(p[2], p[3]); } \
        if (__builtin_amdgcn_ballot_w64(alpha != 1.0f) != 0ull) { ls = ls * alpha; _Pragma("unroll") for (int dt = 0; dt < 4; ++dt) os_[dt] = os_[dt] * alpha; }     \
        ls += ps; \
        _Pragma("unroll") for (int dt = 0; dt < 4; ++dt) { \
            _Pragma("unroll") for (int k2 = 0; k2 < 2; ++k2) { Frag pf; pf.w[0] = pw[2 * k2][0]; pf.w[1] = pw[2 * k2][1]; pf.w[2] = pw[2 * k2 + 1][0]; pf.w[3] = pw[2 * k2 + 1][1]; os_[dt] = mfma16(VF[dt][k2].v, pf.v, os_[dt]); } } } while (0)
#define NSA_SEL_STEP(KF, VF, sblk_) do { if ((sblk_) * 64 + 189 <= t0 + g * 4) NSA_SEL_STEP_(KF, VF, sblk_, 1); else NSA_SEL_STEP_(KF, VF, sblk_, 0); } while (0)
    const float bfar_ = lut[hh * 128 + 127];
    for (int g = 0; g < 4; ++g) {
        const int tqs = t0 + g * 4 + qi;
        Frag qs[2];
#pragma unroll
        for (int ks = 0; ks < 2; ++ks) qs[ks].u = *(const v4u*)(HB + (size_t)(tok0 + g * 4 + qi) * HBP + HB_NSA_Q + hh * 64 + ks * 32 + fq * 8);
        f32x4 os_[4];
#pragma unroll
        for (int dt = 0; dt < 4; ++dt) os_[dt] = (f32x4){0.f, 0.f, 0.f, 0.f};
        float ms = -1e30f, ls = 0.f;
        const unsigned mw0 = (unsigned)__shfl((int)taken, (g * 4 + qi)), mw1 = (unsigned)__shfl((int)taken, (g * 4 + qi) + 16), mw2 = (unsigned)__shfl((int)taken, (g * 4 + qi) + 32), mw3 = (unsigned)__shfl((int)taken, (g * 4 + qi) + 48);
        int nb = 0;
        for (int wd = 0; wd < 4; ++wd) { unsigned uni = 0u;
#pragma unroll
            for (int q2 = 0; q2 < 4; ++q2) uni |= (unsigned)__shfl((int)taken, (g * 4 + q2) + 16 * wd);
            uni = (unsigned)__builtin_amdgcn_readfirstlane((int)uni);
            while (uni) { const int bit = __builtin_ctz(uni); uni &= uni - 1u; blist[nb] = (unsigned char)(wd * 32 + bit); ++nb; } }
        LDS_WAIT();
        Frag kA[4][2], kB[4][2], vv[4][2];
        { const int s0b = __builtin_amdgcn_readfirstlane((int)blist[0]); NSA_SEL_LOADK(kA, s0b); }
        for (int i = 0; i < nb; i += 2) {
            const int sa = __builtin_amdgcn_readfirstlane((int)blist[i]); const int sb = __builtin_amdgcn_readfirstlane((int)blist[(i + 1 < nb) ? i + 1 : i]);
            NSA_SEL_LOADV(vv, sa); NSA_SEL_LOADK(kB, sb);
            NSA_SEL_STEP(kA, vv, sa);
            if (i + 1 < nb) { const int sc2 = __builtin_amdgcn_readfirstlane((int)blist[(i + 2 < nb) ? i + 2 : i]); NSA_SEL_LOADV(vv, sb); NSA_SEL_LOADK(kA, sc2); NSA_SEL_STEP(kB, vv, sb); }
        }
        ls = red4_sum(ls);
        const float gsel = (1.0f / (1.0f + expf(-bf2f(HB[(size_t)(tok0 + g * 4 + qi) * HBP + HB_NSA_G + 4 + hh])))) / ls;
#pragma unroll
        for (int dt = 0; dt < 4; ++dt) { LAS v2u* op = (LAS v2u*)(outb + (g * 4 + qi) * 256 + hh * 64 + dt * 16 + fq * 4); const v2u a = *op; v2u w; w.x = pk2(bflo(a.x) + os_[dt][0] * gsel, bfhi(a.x) + os_[dt][1] * gsel); w.y = pk2(bflo(a.y) + os_[dt][2] * gsel, bfhi(a.y) + os_[dt][3] * gsel); *op = w; }
    } }
    LDS_WAIT();
#pragma unroll
    for (int h = 0; h < 4; ++h)
#pragma unroll
        for (int ks = 0; ks < 2; ++ks) qa[h][ks].u = *(const v4u*)(opaque(HB) + (size_t)(tok0 + fr) * HBP + HB_NSA_Q + h * 64 + ks * 32 + fq * 8);
    const bf16* VWT = (const bf16*)(ws + WS_NSA_VWT) + (size_t)b * 256 * 2048; const bf16* KWW = (const bf16*)(ws + WS_WIN + l * WIN_L) + (size_t)b * 256 * 2048;
    f32x4 ow[4][4];
#pragma unroll
    for (int dt = 0; dt < 4; ++dt)
#pragma unroll
        for (int h = 0; h < 4; ++h) ow[dt][h] = (f32x4){0.f, 0.f, 0.f, 0.f};
    float mw_[4], lw[4];
#pragma unroll
    for (int h = 0; h < 4; ++h) { mw_[h] = -1e30f; lw[h] = 0.f; }
    const int kstart = (t0 >= 512) ? ((t0 - 511) & ~31) : 0;
#define NSA_WIN_LOAD(KF, VF, k0_) do { _Pragma("unroll") for (int tt = 0; tt < 2; ++tt) _Pragma("unroll") for (int ks = 0; ks < 2; ++ks) KF[tt][ks].u = *(const v4u*)(KWW + (size_t)((k0_) >> 5) * 2048 + (tt * 2 + ks) * 512 + lane * 8); \
        _Pragma("unroll") for (int dt = 0; dt < 4; ++dt) VF[dt].u = *(const v4u*)(VWT + (size_t)((k0_) >> 5) * 2048 + dt * 512 + lane * 8); } while (0)
    Frag kf[2][2], vf[4];
    NSA_WIN_LOAD(kf, vf, kstart);
    for (int k0 = kstart; k0 < t0 + 16; k0 += 32) {
        Frag kn[2][2], vn[4];
        { const int k1 = (k0 + 32 < t0 + 16) ? k0 + 32 : k0; NSA_WIN_LOAD(kn, vn, k1); }
#pragma unroll
        for (int h = 0; h < 4; ++h) {
            float s[8]; float mx = -1e30f;
#pragma unroll
            for (int tt = 0; tt < 2; ++tt) { f32x4 acc = {0.f, 0.f, 0.f, 0.f}; acc = mfma16(kf[tt][0].v, qa[h][0].v, acc); acc = mfma16(kf[tt][1].v, qa[h][1].v, acc);
#pragma unroll
                for (int i = 0; i < 4; ++i) { const int dist = tq - (k0 + tt * 16 + fq * 4 + i); const float bb = NSA_BIAS(dist, h, 0); s[tt * 4 + i] = (acc[i] * 0.125f + bb) + ((dist < 512) ? 0.f : -1e30f); mx = fmaxf(mx, s[tt * 4 + i]); } }
            mx = red4_max(mx);
            const float mn = fmaxf(mw_[h], mx), alpha = __builtin_amdgcn_exp2f((mw_[h] - mn) * L2E); mw_[h] = mn;
            float p[8]; float ps = 0.f;
#pragma unroll
            for (int i = 0; i < 8; ++i) { p[i] = __builtin_amdgcn_exp2f((s[i] - fmaxf(mn, -1e20f)) * L2E); ps += p[i]; }
            lw[h] = lw[h] * alpha + ps;
            Frag pf; pf.w[0] = pk2(p[0], p[1]); pf.w[1] = pk2(p[2], p[3]); pf.w[2] = pk2(p[4], p[5]); pf.w[3] = pk2(p[6], p[7]);
#pragma unroll
            for (int dt = 0; dt < 4; ++dt) { ow[dt][h] = ow[dt][h] * alpha; ow[dt][h] = mfma16(vf[dt].v, pf.v, ow[dt][h]); }
            __builtin_amdgcn_sched_barrier(0);
        }
#pragma unroll
        for (int tt = 0; tt < 2; ++tt)
#pragma unroll
            for (int ks = 0; ks < 2; ++ks) kf[tt][ks].u = kn[tt][ks].u;
#pragma unroll
        for (int dt = 0; dt < 4; ++dt) vf[dt].u = vn[dt].u;
    }
#pragma unroll
    for (int h = 0; h < 4; ++h) { float t = lw[h]; t = red4_sum(t);
        const float gw_ = (1.0f / (1.0f + expf(-bf2f(HB[(size_t)(tok0 + fr) * HBP + HB_NSA_G + 8 + h])))) / t;
#pragma unroll
        for (int dt = 0; dt < 4; ++dt) { const v2u a = *(const LAS v2u*)(outb + fr * 256 + h * 64 + dt * 16 + fq * 4);
            v2u w; w.x = pk2(bflo(a.x) + ow[dt][h][0] * gw_, bfhi(a.x) + ow[dt][h][1] * gw_); w.y = pk2(bflo(a.y) + ow[dt][h][2] * gw_, bfhi(a.y) + ow[dt][h][3] * gw_); *(v2u*)(XN + (size_t)(tok0 + fr) * DM + h * 64 + dt * 16 + fq * 4) = w; } }
    LDS_WAIT();
}

#define PEER_SU 64.0f
#define PEER_SV 8.0f
#define PEER_SX 16.0f
typedef float f32x2v __attribute__((ext_vector_type(2)));
__device__ __forceinline__ float gelu_erf(float x) { return 0.5f * x * (1.0f + erff(x * 0.70710678118654752f)); }
template<int MODE> __device__ __forceinline__ void peer_item(int it, int l, const Args& args, LAS unsigned char* wlds, int lane) {
    unsigned char* ws = args.ws; const bf16* QP = (const bf16*)(ws + WS_PEER_QP);
    const int tok0 = it * 16, fr = lane & 15, fq = lane >> 4;
    LAS unsigned short* eidx = (LAS unsigned short*)wlds; LAS float* egate = (LAS float*)(wlds + 4096); LAS float* tkv = (LAS float*)(wlds + 12288);
    LAS float* cbuf = (LAS float*)(wlds + 16384); LAS unsigned char* ctab = (LAS unsigned char*)(wlds + 16384 + 512);
    const bf16* keys = opaque((const bf16*)(ws + WS_PKEYS) + (size_t)l * 8 * 2 * 128 * 128);
    if (MODE & 1) {
    { int c = 0, ij = 0xFF;
#pragma unroll
      for (int i = 0; i < 16; ++i)
#pragma unroll
          for (int j = 0; j < 16; ++j) if ((i + 1) * (j + 1) <= 16) { ij = (c == lane) ? ((i << 4) | j) : ij; ++c; }
      ctab[lane] = (unsigned char)ij; }
    LDS_WAIT();
    Frag qb[4], ka[8][4];
#define PA_LOAD(pc_) do { const bf16* kb_ = keys + (size_t)(pc_) * 128 * 128 + lane * 8;     \
        _Pragma("unroll") for (int ks = 0; ks < 4; ++ks) qb[ks].u = *(const v4u*)(QP + (size_t)(tok0 + fr) * 2048 + (pc_) * 128 + ks * 32 + fq * 8); \
        _Pragma("unroll") for (int mt = 0; mt < 8; ++mt) _Pragma("unroll") for (int ks = 0; ks < 4; ++ks) ka[mt][ks].u = *(const v4u*)(kb_ + (mt * 4 + ks) * 512); } while (0)
    PA_LOAD(0);
    for (int pc = 0; pc < 16; ++pc) {
        const int p = pc >> 1, c = pc & 1;
        {
            float sc[32];
#pragma unroll
            for (int mt = 0; mt < 8; ++mt) { f32x4 acc = {0.f, 0.f, 0.f, 0.f};
#pragma unroll
                for (int ks = 0; ks < 4; ++ks) acc = mfma16(ka[mt][ks].v, qb[ks].v, acc);
#pragma unroll
                for (int i = 0; i < 4; ++i) sc[mt * 4 + i] = __uint_as_float((__float_as_uint(acc[i]) & 0xFFFFFF80u) | (unsigned)(mt * 16 + fq * 4 + i)); }
            { const int pn = (pc < 15) ? pc + 1 : 15; PA_LOAD(pn); }
            __builtin_amdgcn_sched_barrier(0);
#pragma unroll
            for (int k = 2; k <= 32; k <<= 1)
#pragma unroll
                for (int j = k >> 1; j > 0; j >>= 1)
#pragma unroll
                    for (int i = 0; i < 32; ++i) { const int l2 = i ^ j; if (l2 > i) { const float a = sc[i], b2 = sc[l2]; const bool desc = (i & k) == 0; sc[i] = desc ? fmaxf(a, b2) : fminf(a, b2); sc[l2] = desc ? fminf(a, b2) : fmaxf(a, b2); } }
            for (int r = 0; r < 16; ++r) { const float w = red4_max(sc[0]); const bool own = (sc[0] == w);
#pragma unroll
                for (int k = 0; k < 15; ++k) sc[k] = own ? sc[k + 1] : sc[k];
                sc[15] = own ? -3.0e38f : sc[15];
                tkv[c * 256 + fr * 16 + r] = w; }
        }
        if (c == 0) continue;
        LDS_WAIT();
        float cs[16];
#pragma unroll
        for (int r = 0; r < 13; ++r) { const int cid = 4 * r + fq; const int ij = ctab[cid];
            const float v1 = tkv[fr * 16 + (ij >> 4)], v2 = tkv[256 + fr * 16 + (ij & 15)];
            cs[r] = (ij == 0xFF) ? -3.0e38f : __uint_as_float((__float_as_uint(v1 + v2) & 0xFFFFFFC0u) | (unsigned)cid); }
        cs[13] = -3.0e38f; cs[14] = -3.0e38f; cs[15] = -3.0e38f;
#pragma unroll
        for (int k = 2; k <= 16; k <<= 1)
#pragma unroll
            for (int j = k >> 1; j > 0; j >>= 1)
#pragma unroll
                for (int i = 0; i < 16; ++i) { const int l2 = i ^ j; if (l2 > i) { const float a = cs[i], b2 = cs[l2]; const bool desc = (i & k) == 0; cs[i] = desc ? fmaxf(a, b2) : fminf(a, b2); cs[l2] = desc ? fminf(a, b2) : fmaxf(a, b2); } }
        float top0 = 0.f, den = 0.f;
        for (int rr = 0; rr < 16; ++rr) { const float w = red4_max(cs[0]); const bool own = (cs[0] == w);
#pragma unroll
            for (int k = 0; k < 15; ++k) cs[k] = own ? cs[k + 1] : cs[k];
            cs[15] = own ? -3.0e38f : cs[15];
            const int ij = ctab[__float_as_uint(w) & 63u];
            const int i1 = (int)(__float_as_uint(tkv[fr * 16 + (ij >> 4)]) & 127u), i2 = (int)(__float_as_uint(tkv[256 + fr * 16 + (ij & 15)]) & 127u);
            if (rr == 0) top0 = w;
            const float ex = __builtin_amdgcn_exp2f((w - top0) * 1.4426950408889634f); den += ex;
            eidx[fr * 128 + p * 16 + rr] = (unsigned short)(i1 * 128 + i2); egate[fr * 128 + p * 16 + rr] = ex; }
        LDS_WAIT();
        { const float rden = 1.0f / den;
#pragma unroll
          for (int rr = 0; rr < 16; ++rr) egate[fr * 128 + p * 16 + rr] *= rden; }
        LDS_WAIT();
    }
    }
    LDS_WAIT();
    if (!(MODE & 2)) return;
    const float* ngain = opaque((l + 1 < DEPTH) ? (args.in[I_N1G] + (l + 1) * DM) : args.in[I_FNG]);
    const unsigned char* U8 = (const unsigned char*)(ws + WS_PEER_U); const unsigned char* V8 = (const unsigned char*)(ws + WS_PEER_V); const unsigned char* X8 = (const unsigned char*)(ws + WS_PEER_X8);
#define PU_LOAD(S, ks_) do { XA[S] = *(const v4u*)(X8 + tok * DM + (ks_) * 64 + fq * 16); \
        _Pragma("unroll") for (int et = 0; et < 8; ++et) UB[S][et] = *(const v4u*)(U8 + (size_t)el[et] * DM + (ks_) * 64 + fq * 16); } while (0)
#define PU_MMA(S) do { const long xa0 = (long)(((unsigned long long)XA[S][1] << 32) | XA[S][0]), xa1 = (long)(((unsigned long long)XA[S][3] << 32) | XA[S][2]); \
        _Pragma("unroll") for (int et = 0; et < 8; ++et) { const long ub0 = (long)(((unsigned long long)UB[S][et][1] << 32) | UB[S][et][0]), ub1 = (long)(((unsigned long long)UB[S][et][3] << 32) | UB[S][et][2]); \
            acc[et] = __builtin_amdgcn_mfma_f32_16x16x32_fp8_fp8(xa0, ub0, acc[et], 0, 0, 0); acc[et] = __builtin_amdgcn_mfma_f32_16x16x32_fp8_fp8(xa1, ub1, acc[et], 0, 0, 0); } } while (0)
#define PV_LOAD(S, e_) do { _Pragma("unroll") for (int e2 = 0; e2 < 8; ++e2) { const int ex = eidx[t * 128 + (e_) + e2]; VV[S][e2] = *(const v4u*)(V8 + (size_t)ex * DM + lane * 16); } } while (0)
#define PV_FMA(S, e_) do { _Pragma("unroll") for (int e2 = 0; e2 < 8; ++e2) { const float ce = cbuf[(e_) + e2]; \
        _Pragma("unroll") for (int k = 0; k < 4; ++k) { const f32x2v lo2 = __builtin_amdgcn_cvt_pk_f32_fp8((int)VV[S][e2][k], false), hi2 = __builtin_amdgcn_cvt_pk_f32_fp8((int)VV[S][e2][k], true); \
            o[4 * k] += ce * lo2.x; o[4 * k + 1] += ce * lo2.y; o[4 * k + 2] += ce * hi2.x; o[4 * k + 3] += ce * hi2.y; } if (e2 & 1) __builtin_amdgcn_sched_barrier(0); } } while (0)
    for (int t = 0; t < 16; ++t) {
        const size_t tok = (size_t)(tok0 + t);
        const int lane_t = lane_id_v();
        const int lane = lane_t, fr = lane_t & 15, fq = lane_t >> 4;
        const int fr7 = fr & 7, hf = fr >> 3;
        v4u VV[2][8];
#pragma unroll
        for (int tp = 0; tp < 2; ++tp) {
            int el[8];
#pragma unroll
            for (int et = 0; et < 8; ++et) el[et] = eidx[t * 128 + (tp * 8 + et) * 8 + fr7];
            f32x4 acc[8];
#pragma unroll
            for (int et = 0; et < 8; ++et) acc[et] = (f32x4){0.f, 0.f, 0.f, 0.f};
#pragma unroll 2
            for (int ks = 0; ks < 8; ++ks) {
                v4u UB[8];
                const v4u XA = *(const v4u*)(X8 + tok * DM + ks * 128 + (fr & 1) * 64 + fq * 16);
#pragma unroll
                for (int et = 0; et < 8; ++et) UB[et] = *(const v4u*)(U8 + (size_t)el[et] * DM + ks * 128 + hf * 64 + fq * 16);
                const long xa0 = (long)(((unsigned long long)XA[1] << 32) | XA[0]), xa1 = (long)(((unsigned long long)XA[3] << 32) | XA[2]);
#pragma unroll
                for (int et = 0; et < 8; ++et) { const long ub0 = (long)(((unsigned long long)UB[et][1] << 32) | UB[et][0]), ub1 = (long)(((unsigned long long)UB[et][3] << 32) | UB[et][2]);
                    acc[et] = __builtin_amdgcn_mfma_f32_16x16x32_fp8_fp8(xa0, ub0, acc[et], 0, 0, 0); acc[et] = __builtin_amdgcn_mfma_f32_16x16x32_fp8_fp8(xa1, ub1, acc[et], 0, 0, 0); }
            }
            if (tp == 1) { PV_LOAD(0, 0); PV_LOAD(1, 8); }
#pragma unroll
            for (int et = 0; et < 8; ++et) { const float v = hf ? acc[et][1] : acc[et][0]; const float tv = v + dpp_mov<0x128>(v);     const int e = (tp * 8 + et) * 8 + fr7;
                const float c = egate[t * 128 + e] * gelu_erf(tv * (1.0f / (PEER_SX * PEER_SU))) * (1.0f / PEER_SV);
                cbuf[(fq == 0 && hf == 0) ? e : 192 + lane] = c; }
        }
        LDS_WAIT();
        float o[16];
#pragma unroll
        for (int k = 0; k < 16; ++k) o[k] = 0.f;
        for (int e = 0; e < 112; e += 16) {
            PV_FMA(0, e); PV_LOAD(0, e + 16);
            PV_FMA(1, e + 8); PV_LOAD(1, e + 24);
        }
        PV_FMA(0, 112); PV_FMA(1, 120);
        const int lane_e = lane_id_v();
        float* hrow = args.out + tok * DM + lane_e * 16; float ss = 0.f;
#pragma unroll
        for (int k4 = 0; k4 < 4; ++k4) { const f32x4 hv = *(const f32x4*)(hrow + 4 * k4);
#pragma unroll
            for (int k = 0; k < 4; ++k) { o[4 * k4 + k] += hv[k]; ss += o[4 * k4 + k] * o[4 * k4 + k]; } }
        const float rn = 1.0f / sqrtf(wave_sum(ss) * (1.f / DM) + NORM_EPS);
        const float* gp = ngain + lane_e * 16;
        if (l + 1 < DEPTH) {
#pragma unroll
            for (int k4 = 0; k4 < 4; ++k4) { f32x4 hv = {o[4 * k4], o[4 * k4 + 1], o[4 * k4 + 2], o[4 * k4 + 3]}; *(f32x4*)(hrow + 4 * k4) = hv; }
            bf16* xrow = (bf16*)(ws + WS_XN) + tok * DM + lane_e * 16; v4u w0, w1;
#pragma unroll
            for (int k = 0; k < 4; ++k) { w0[k] = pk2(o[2 * k] * rn * gp[2 * k], o[2 * k + 1] * rn * gp[2 * k + 1]); w1[k] = pk2(o[8 + 2 * k] * rn * gp[8 + 2 * k], o[8 + 2 * k + 1] * rn * gp[8 + 2 * k + 1]); }
            *(v4u*)xrow = w0; *(v4u*)(xrow + 8) = w1;
        } else {
#pragma unroll
            for (int k4 = 0; k4 < 4; ++k4) { f32x4 hv = {o[4 * k4] * rn * gp[4 * k4], o[4 * k4 + 1] * rn * gp[4 * k4 + 1], o[4 * k4 + 2] * rn * gp[4 * k4 + 2], o[4 * k4 + 3] * rn * gp[4 * k4 + 3]}; *(f32x4*)(hrow + 4 * k4) = hv; }
        }
        LDS_WAIT();
    }
}

#ifndef MK_SPLIT
#define MK_SPLIT 0
#endif

#define IN(k) (lo <= (k) && (k) < hi)
#define SEAM(k) do { if (IN(k) && IN((k) + 1)) xcd_barrier(bar, wave == 0 && lane_id_v() == 0); } while (0)
template <int l>
__device__ __forceinline__ void layer_phases(const Args& args, LAS unsigned char* lds, const XcdBarrier& bar, const int lo, const int hi, const int wave) {
    constexpr int G = GRID_WG; const int bx = blockIdx.x;
    const int gw = bx * NWAVES + wave, NGW = G * NWAVES, vw = wave * G + bx;
    unsigned char* ws = args.ws;
    unsigned* ctl = (unsigned*)(ws + WS_CTL);
    LAS unsigned char* wlds = lds + wave * WAVE_LDS;
    bf16* XN = (bf16*)(ws + WS_XN); bf16* HB = (bf16*)(ws + WS_HB);
    (void)gw; (void)NGW; (void)ctl; (void)wlds; (void)HB; (void)vw;
        const int pb = 1 + 8 * l;
        if (IN(pb + 0)) {
            const int lane = lane_id_v(); (void)lane;
            pg8::Gemm g{XN, (const bf16*)(ws + WS_WIN + l * WIN_L), M_TOK, N_IN_PAD, DM}; pg8::StaticOrder S; S.init(M_TOK, N_IN_PAD, G, bx);
            pg8::EpiHb E{HB, HBP, HBP};
            pg8::gemm_phase<pg8::EpiHb, pg8::StaticOrder, true, true>(lds, g, S, E, wave);
        }
        SEAM(pb + 0);
        if (IN(pb + 1)) {
            const int lane = lane_id_v(); (void)lane;
            { const int it = vw - 256; if (it >= 0 && it < 512) nsa_cmp_item(it, l, args, lane_id_v()); }
            for (int it = vw; it < 2048; it += NGW) { gdn_prep_item(it, l, args, wlds, lane_id_v()); }
            for (int it = vw; it < M_TOK / 16; it += NGW) { mla_prep_item(it, l, args, lane_id_v()); }
            for (int it = vw; it < 2048; it += NGW) { mlstm_prep_item(it, l, args, wlds, lane_id_v()); }
            { const int it = vw - 1024; if (it >= 0) nsa_vt_item(it, l, args, wlds, lane_id_v()); }
        }
        SEAM(pb + 1);
        if (IN(pb + 2)) {
            const int lane = lane_id_v(); (void)lane;
            nsa_lut_init(args.in[I_T5], (LAS float*)(wlds + 16384), lane);
            { const int it = vw - 256; if (it >= 0 && it < 64) gdn_scan_item(it, args, lane_id_v()); }
            { const int it = vw; if (it < 256) mlstm_scan_item(it, args, lane_id_v()); }
            for (int it = vw; it < 2048; it += NGW) { mla_attn_item(it & 15, 127 - (it >> 4), args, wlds, lane_id_v()); }
            { unsigned* qh = ctl + CW_Q + 64 * (l * 8 + (bx & 7));
              for (;;) { const int m = wave_pop(qh, lane_id_v()); if (m >= 256) break; const int j = 8 * m + (7 - (bx & 7)); nsa_item(j & 3, 511 - (j >> 2), l, args, wlds, lane_id_v()); } }
        }
        SEAM(pb + 2);
        if (IN(pb + 3)) {
            const int lane = lane_id_v(); (void)lane;
            for (int it = vw; it < 2048; it += NGW) { gdn_out_item(it, l, args, lane_id_v()); }
            for (int it = vw; it < 2048; it += NGW) { mlstm_out_item(it, l, args, wlds, lane_id_v()); }
            {
                const f32x4* su = (const f32x4*)(args.in[I_PEER_U] + (size_t)l * 16384 * DM); const f32x4* sv = (const f32x4*)(args.in[I_PEER_V] + (size_t)l * 16384 * DM);
                v4u* du = (v4u*)(ws + WS_PEER_U); v4u* dv = (v4u*)(ws + WS_PEER_V);
                unsigned* du32 = (unsigned*)du; unsigned* dv32 = (unsigned*)dv;
                for (size_t c = (size_t)gw; c < (size_t)16384 * DM / 1024; c += (size_t)NGW) {
                    f32x4 a[4], b2[4];
#pragma unroll
                    for (int q = 0; q < 4; ++q) { a[q] = su[c * 256 + q * 64 + lane]; b2[q] = sv[c * 256 + q * 64 + lane]; }
#pragma unroll
                    for (int q = 0; q < 4; ++q) {
                        int pa = __builtin_amdgcn_cvt_pk_fp8_f32(a[q][0] * PEER_SU, a[q][1] * PEER_SU, 0, false); pa = __builtin_amdgcn_cvt_pk_fp8_f32(a[q][2] * PEER_SU, a[q][3] * PEER_SU, pa, true);
                        int pb2 = __builtin_amdgcn_cvt_pk_fp8_f32(b2[q][0] * PEER_SV, b2[q][1] * PEER_SV, 0, false); pb2 = __builtin_amdgcn_cvt_pk_fp8_f32(b2[q][2] * PEER_SV, b2[q][3] * PEER_SV, pb2, true);
                        du32[c * 256 + q * 64 + lane] = (unsigned)pa; dv32[c * 256 + q * 64 + lane] = (unsigned)pb2; }
                }
            }
        }
        SEAM(pb + 3);
        if (IN(pb + 4)) {
            const int lane = lane_id_v(); (void)lane;
            pg8::Gemm g{XN, (const bf16*)(ws + WS_WOUT + l * WOUT_L), M_TOK, DM, DM}; pg8::StaticOrder S; S.init(M_TOK, DM, G, bx);
            pg8::EpiRes E{args.out, l == 0 ? args.in[I_X] : (const float*)args.out, DM};
            pg8::gemm_phase<pg8::EpiRes, pg8::StaticOrder, true, true>(lds, g, S, E, wave);
        }
        SEAM(pb + 4);
        if (IN(pb + 5)) {
            const int lane = lane_id_v(); (void)lane;
            {
                const float* g2 = args.in[I_N2G] + l * DM; unsigned char* X8 = ws + WS_PEER_X8;
                f32x4 gg[4];
#pragma unroll
                for (int j = 0; j < 4; ++j) gg[j] = ((const f32x4*)g2)[lane + 64 * j];
                for (int m0 = gw; m0 < M_TOK; m0 += 4 * NGW) {
                    f32x4 v[4][4]; float s[4];
#pragma unroll
                    for (int q = 0; q < 4; ++q) { const f32x4* xr = (const f32x4*)(args.out + (size_t)(m0 + q * NGW) * DM) + lane; s[q] = 0.f;
#pragma unroll
                        for (int j = 0; j < 4; ++j) { v[q][j] = xr[64 * j]; s[q] += (v[q][j].x * v[q][j].x + v[q][j].y * v[q][j].y) + (v[q][j].z * v[q][j].z + v[q][j].w * v[q][j].w); } }
#pragma unroll
                    for (int q = 0; q < 4; ++q) { const size_t m = (size_t)(m0 + q * NGW); const float r = 1.0f / sqrtf(wave_sum(s[q]) * (1.f / DM) + NORM_EPS);
#pragma unroll
                        for (int j = 0; j < 4; ++j) { const float y0 = v[q][j].x * r * gg[j].x, y1 = v[q][j].y * r * gg[j].y, y2 = v[q][j].z * r * gg[j].z, y3 = v[q][j].w * r * gg[j].w;
                            v2u o; o.x = pk2(y0, y1); o.y = pk2(y2, y3); ((v2u*)(XN + m * DM))[lane + 64 * j] = o;
                            int p8 = __builtin_amdgcn_cvt_pk_fp8_f32(y0 * PEER_SX, y1 * PEER_SX, 0, false); p8 = __builtin_amdgcn_cvt_pk_fp8_f32(y2 * PEER_SX, y3 * PEER_SX, p8, true);
                            ((int*)(X8 + m * DM))[lane + 64 * j] = p8; } }
                }
            }
        }
        SEAM(pb + 5);
        if (IN(pb + 6)) {
            const int lane = lane_id_v(); (void)lane;
            pg8::Gemm g{XN, (const bf16*)(ws + WS_WQ + l * WQ_L), M_TOK, 2048, DM}; pg8::StaticOrder S; S.init(M_TOK, 2048, G, bx);
            pg8::EpiBf16<0> E{(bf16*)(ws + WS_PEER_QP), 2048, nullptr, 0, 0, 1.f};
            pg8::gemm_phase<pg8::EpiBf16<0>, pg8::StaticOrder, true, true>(lds, g, S, E, wave);
        }
        SEAM(pb + 6);
        if (IN(pb + 7)) {
            const int lane = lane_id_v(); (void)lane;
            static_assert(G * NWAVES == M_TOK / 16, "one PEER item per wave");
            for (int it = vw; it < M_TOK / 16; it += NGW) { peer_item<1>(it, l, args, wlds, lane_id_v()); }
            for (int it = vw; it < M_TOK / 16; it += NGW) { peer_item<2>(it, l, args, wlds, lane_id_v()); }
        }
        SEAM(pb + 7);
}

__global__ void __launch_bounds__(NWAVES * 64, 2) fwd_kernel(Args args) {
    extern __shared__ __attribute__((aligned(16))) unsigned char lds_raw[];
    LAS unsigned char* lds = (LAS unsigned char*)lds_raw;
    volatile LAS unsigned* MISC = (volatile LAS unsigned*)(lds + MISC_OFF);
    const int wave = __builtin_amdgcn_readfirstlane((int)(threadIdx.x >> 6)); const int tid = wave * 64 + lane_id_v();
    constexpr int G = GRID_WG; const int bx = blockIdx.x;
    const int gw = bx * NWAVES + wave, NGW = G * NWAVES;
    unsigned char* ws = args.ws;
    unsigned* ctl = (unsigned*)(ws + WS_CTL);
    for (int u = tid; u < (LDS_BYTES - MISC_OFF) / 4; u += NWAVES * 64) MISC[u] = 0u;
    __syncthreads();
    XcdBarrier bar; bar.bar = ctl + CW_BAR; bar.x = 0; bar.st = nullptr;
    if (!MK_SPLIT) bar = xcd_barrier_post(ctl + CW_BAR, MISC + 8, tid == 0);
    const int lo = args.ph_lo, hi = args.ph_hi;
    LAS unsigned char* wlds = lds + wave * WAVE_LDS;
    bf16* XN = (bf16*)(ws + WS_XN); bf16* HB = (bf16*)(ws + WS_HB);

    if (IN(0)) {
        const int lane = lane_id_v();
        LAS float* scr = (LAS float*)wlds;
        constexpr int I_IN = (DM / 64) * (N_IN_PAD / 32), I_OUT = (DM / 64) * (DM / 32), I_Q = (DM / 64) * (2048 / 32);
        constexpr int I_UQ = (256 / 64) * (384 / 32), I_UKV = (128 / 64) * (512 / 32), I_CMP = (2048 / 64) * (64 / 32);
        constexpr int PER_L = I_IN + I_OUT + I_Q + I_UQ + I_UKV + 2 * I_CMP;
        for (int it = gw; it < DEPTH * PER_L; it += NGW) {
            const int l = it / PER_L; int r = it % PER_L;
            unsigned char* wsm = ws + WS_WSM + l * WSM_L;
            if (r < I_IN) { tr_item(args.in[I_WIN] + (size_t)l * DM * D_IN, D_IN, D_IN, MapHb(), (bf16*)(ws + WS_WIN + l * WIN_L), DM, scr, r / (N_IN_PAD / 32), r % (N_IN_PAD / 32), lane); continue; } r -= I_IN;
            if (r < I_OUT) { tr_item(args.in[I_WOUT] + (size_t)l * DM * DM, DM, DM, MapId(), (bf16*)(ws + WS_WOUT + l * WOUT_L), DM, scr, r / (DM / 32), r % (DM / 32), lane); continue; } r -= I_OUT;
            if (r < I_Q) { tr_item(args.in[I_PEER_WQ] + (size_t)l * DM * 2048, 2048, 2048, MapId(), (bf16*)(ws + WS_WQ + l * WQ_L), DM, scr, r / (2048 / 32), r % (2048 / 32), lane); continue; } r -= I_Q;
            if (r < I_UQ) { tr_item(args.in[I_MLA_WUQ] + (size_t)l * 256 * 384, 384, 384, MapId(), (bf16*)(wsm + WSM_UQ), 256, scr, r / (384 / 32), r % (384 / 32), lane); continue; } r -= I_UQ;
            if (r < I_UKV) { tr_item(args.in[I_MLA_WUKV] + (size_t)l * 128 * 512, 512, 512, MapId(), (bf16*)(wsm + WSM_UKV), 128, scr, r / (512 / 32), r % (512 / 32), lane); continue; } r -= I_UKV;
            if (r < I_CMP) { tr_item(args.in[I_CMPK] + (size_t)l * 2048 * 64, 64, 64, MapId(), (bf16*)(wsm + WSM_CK), 2048, scr, r / 2, r % 2, lane); continue; } r -= I_CMP;
            tr_item(args.in[I_CMPV] + (size_t)l * 2048 * 64, 64, 64, MapId(), (bf16*)(wsm + WSM_CV), 2048, scr, r / 2, r % 2, lane);
        }
        { const f32x4* ksrc = (const f32x4*)args.in[I_PEER_KEYS]; v2u* kdst = (v2u*)(ws + WS_PKEYS);
          for (int i = gw * 64 + lane; i < DEPTH * 16 * 128 * 128 / 4; i += NGW * 64) { const f32x4 a = ksrc[i]; v2u o; o.x = pk2(a[0], a[1]); o.y = pk2(a[2], a[3]);
              const int mat = i >> 12, m = (i >> 5) & 127, k4 = (i & 31) * 4;
              kdst[(size_t)mat * 4096 + ((((m >> 4) * 4 + (k4 >> 5)) * 64 + ((k4 >> 3) & 3) * 16 + (m & 15)) * 8 + (k4 & 7)) / 4] = o; } }
        for (int m0 = gw; m0 < M_TOK; m0 += 4 * NGW) {
            f32x4 v[4][4]; float s[4];
#pragma unroll
            for (int q = 0; q < 4; ++q) { const f32x4* xr = (const f32x4*)(args.in[I_X] + (size_t)(m0 + q * NGW) * DM) + lane; s[q] = 0.f;
#pragma unroll
                for (int j = 0; j < 4; ++j) { v[q][j] = xr[64 * j]; s[q] += (v[q][j].x * v[q][j].x + v[q][j].y * v[q][j].y) + (v[q][j].z * v[q][j].z + v[q][j].w * v[q][j].w); } }
#pragma unroll
            for (int q = 0; q < 4; ++q) { const float r = 1.0f / sqrtf(wave_sum(s[q]) * (1.f / DM) + NORM_EPS); v2u* o8 = (v2u*)(XN + (size_t)(m0 + q * NGW) * DM) + lane;
#pragma unroll
                for (int j = 0; j < 4; ++j) { const f32x4 gg = ((const f32x4*)args.in[I_N1G])[lane + 64 * j]; v2u o; o.x = pk2(v[q][j].x * r * gg.x, v[q][j].y * r * gg.y); o.y = pk2(v[q][j].z * r * gg.z, v[q][j].w * r * gg.w); o8[64 * j] = o; } }
        }
    }
    SEAM(0);

    layer_phases<0>(args, lds, bar, lo, hi, wave);
    layer_phases<1>(args, lds, bar, lo, hi, wave);
#undef IN
#undef SEAM
}

extern "C" void kernel_launch(void* const* d_in, const int* in_sizes, int n_in, void* d_out, int out_size, void* d_ws, size_t ws_size, hipStream_t stream) {
    static int grid = 0;
    if (grid == 0) {
        if (n_in != 26 || in_sizes[0] != M_TOK * DM || out_size != M_TOK * DM || ws_size < WS_END) { fprintf(stderr, "kernel_launch: unexpected shapes/workspace (n_in %d, ws %zu < %zu)\n", n_in, ws_size, (size_t)WS_END); grid = -1; return; }
        int dev = 0, cus = 0, per_cu = 0;
        if (hipGetDevice(&dev) != hipSuccess || hipDeviceGetAttribute(&cus, hipDeviceAttributeMultiprocessorCount, dev) != hipSuccess) { grid = -1; return; }
        if (hipFuncSetAttribute((const void*)fwd_kernel, hipFuncAttributeMaxDynamicSharedMemorySize, LDS_BYTES) != hipSuccess) { fprintf(stderr, "kernel_launch: hipFuncSetAttribute failed\n"); grid = -1; return; }
        if (hipOccupancyMaxActiveBlocksPerMultiprocessor(&per_cu, (const void*)fwd_kernel, NWAVES * 64, LDS_BYTES) != hipSuccess || per_cu < 1) { fprintf(stderr, "kernel_launch: occupancy query says %d blocks per CU\n", per_cu); }
        (void)hipGetLastError();
        if (cus < GRID_WG) { fprintf(stderr, "kernel_launch: %d CUs < %d workgroups: the grid would not be resident\n", cus, GRID_WG); grid = -1; return; }
        grid = GRID_WG;
    }
    if (grid < 0) return;
    if (hipMemsetAsync((char*)d_ws + WS_CTL, 0, CTL_ZERO_BYTES, stream) != hipSuccess) return;
    Args a{};
    for (int i = 0; i < 26; ++i) a.in[i] = (const float*)d_in[i];
    a.out = (float*)d_out; a.ws = (unsigned char*)d_ws;
#if MK_SPLIT
    for (int p = 0; p < N_PHASES; ++p) { a.ph_lo = p; a.ph_hi = p + 1; hipLaunchKernelGGL(fwd_kernel, dim3(grid), dim3(NWAVES * 64), LDS_BYTES, stream, a); }
#else
    a.ph_lo = 0; a.ph_hi = N_PHASES;
    hipLaunchKernelGGL(fwd_kernel, dim3(grid), dim3(NWAVES * 64), LDS_BYTES, stream, a);
#endif
    const hipError_t le = hipPeekAtLastError();
    if (le != hipSuccess) fprintf(stderr, "kernel_launch: launch failed: %s\n", hipGetErrorName(le));
}
```

```cpp
#include <hip/hip_runtime.h>
#include <cstdio>
#include <cstdint>

namespace pg8 {
#define PG8_LAS __attribute__((address_space(3)))
typedef unsigned short bf16_t;
typedef short bf16x8 __attribute__((ext_vector_type(8)));
typedef float f32x4 __attribute__((ext_vector_type(4)));
typedef unsigned u32x4 __attribute__((ext_vector_type(4)));
constexpr int BM = 256, BK = 64, HALF = 128, HTB = HALF * BK * 2  , STAGE_BYTES = 8 * HTB, NXCD = 8, WGM = 8;

__host__ __device__ __forceinline__ int lds_byte(int r, int c) { const int st = (r >> 4) * 2 + (c >> 5), rr = r & 15, cc = c & 31, ob = rr * 64 + cc * 2; return st * 1024 + (ob ^ (((ob >> 9) & 1) << 5)); }
__host__ __device__ __forceinline__ void stage_rc(int b, int& R, int& C) { const int st = b / 1024, sb = b % 1024, swz = sb ^ (((sb >> 9) & 1) << 5); R = (st >> 1) * 16 + swz / 64; C = (st & 1) * 32 + (swz % 64) / 2; }
__host__ __device__ __forceinline__ int perm32(int rho) { const int n = rho >> 4, i = rho & 15; return 8 * (i >> 2) + 4 * n + (i & 3); }

struct Unit { int pm, pn; };
struct Gemm { const bf16_t* A; const bf16_t* Bt; int M, N, K; };

struct StaticOrder {
    int nM, nN, nwg, G, c;
    __host__ __device__ void init(int M, int N, int G_, int c_) { nM = M / BM; nN = N / BM; nwg = nM * nN; G = G_; c = c_; }
    __host__ __device__ bool next(int i, Unit& u) const {
        const long L = (long)i * G + c; if (L >= nwg) return false;
        int wgid = (int)L; { const int q = nwg / NXCD, r = nwg % NXCD, xcd = wgid % NXCD, off = wgid / NXCD; wgid = (xcd < r ? xcd * (q + 1) : r * (q + 1) + (xcd - r) * q) + off; }
        const int nig = WGM * nN, gid = wgid / nig, fm = gid * WGM, gsz = (nM - fm) < WGM ? (nM - fm) : WGM;
        u.pm = fm + ((wgid % nig) % gsz); u.pn = (wgid % nig) / gsz; return true;
    }
    __device__ __forceinline__ void a_ready(const Unit&) const {}
    __device__ __forceinline__ void done(const Unit&) const {}
};

typedef __bf16 pg8_bf16x2 __attribute__((ext_vector_type(2)));
typedef float pg8_f32x2 __attribute__((ext_vector_type(2)));
__device__ __forceinline__ unsigned cvt_pk_bf16(float lo, float hi) { const pg8_f32x2 v = {lo, hi}; const pg8_bf16x2 b = __builtin_convertvector(v, pg8_bf16x2); return __builtin_bit_cast(unsigned, b); }
typedef float f32x2 __attribute__((ext_vector_type(2)));
__device__ __forceinline__ f32x2 gelu_pk(f32x2 v) {
    const f32x2 av = __builtin_elementwise_abs(v), d = av * 0.2316418882f + 1.0f;
    f32x2 t; t.x = __builtin_amdgcn_rcpf(d.x); t.y = __builtin_amdgcn_rcpf(d.y);
    f32x2 q = t * 0.5307027145f + (-0.7265760135f); q = q * t + 0.7107068705f; q = q * t + (-0.142248368f); q = q * t + 0.127414796f; q = q * t;
    const f32x2 s = (v * v) * (-0.72134752044f);
    f32x2 e; e.x = __builtin_amdgcn_exp2f(s.x); e.y = __builtin_amdgcn_exp2f(s.y);
    const f32x2 m = v * (q * e), r = v - m;
    f32x2 o; o.x = v.x < 0.f ? m.x : r.x; o.y = v.y < 0.f ? m.y : r.y; return o;
}


template <int ACT  > struct EpiBf16 {
    static constexpr bool PERM = true, AFTER_DRAIN = false; static_assert(ACT == 0 || ACT == 1, "EpiBf16: ACT is 0 (none) or 1 (gelu_pk)");
    bf16_t* O; int ldc; const float* bias; int split_cols; size_t split_stride; float scale0;
    __device__ __forceinline__ void operator()(const f32x4 (&acc)[2][2][4][2], const Unit& u, int wr, int wc, int fr, int fq) const {
        const int row0 = u.pm * BM + wr * 64 + fr; int colt = u.pn * BM; bf16_t* base = O;
        float sc = 1.f; if (split_cols) { const int t = colt / split_cols; base += (size_t)t * split_stride; colt -= t * split_cols; if (t == 0) sc = scale0; }
        const int col0 = colt + wc * 32 + 8 * fq, bcol0 = u.pn * BM + wc * 32 + 8 * fq;
        f32x4 bv[2][2];
#pragma unroll
        for (int bj = 0; bj < 2; ++bj)
#pragma unroll
            for (int n = 0; n < 2; ++n) bv[bj][n] = bias ? *(const f32x4*)(bias + bcol0 + bj * HALF + 4 * n) : (f32x4){0.f, 0.f, 0.f, 0.f};
#pragma unroll
        for (int ai = 0; ai < 2; ++ai)
#pragma unroll
            for (int m = 0; m < 4; ++m) { bf16_t* rowp = base + (size_t)(row0 + ai * HALF + m * 16) * ldc + col0;
#pragma unroll
                for (int bj = 0; bj < 2; ++bj) { f32x4 v0 = acc[ai][bj][m][0] + bv[bj][0], v1 = acc[ai][bj][m][1] + bv[bj][1];
                    if (ACT == 1) { f32x2 a = gelu_pk((f32x2){v0[0], v0[1]}), b = gelu_pk((f32x2){v0[2], v0[3]}), c = gelu_pk((f32x2){v1[0], v1[1]}), d = gelu_pk((f32x2){v1[2], v1[3]});
                        v0 = (f32x4){a.x, a.y, b.x, b.y}; v1 = (f32x4){c.x, c.y, d.x, d.y}; }
                    v0 = v0 * sc; v1 = v1 * sc; u32x4 w; w.x = cvt_pk_bf16(v0[0], v0[1]); w.y = cvt_pk_bf16(v0[2], v0[3]); w.z = cvt_pk_bf16(v1[0], v1[1]); w.w = cvt_pk_bf16(v1[2], v1[3]);
                    *(u32x4*)(rowp + bj * HALF) = w; } }
    }
};

struct EpiHb {
    static constexpr bool PERM = true, AFTER_DRAIN = false;
    bf16_t* O; int ldc; int ncols;
    __device__ __forceinline__ void operator()(const f32x4 (&acc)[2][2][4][2], const Unit& u, int wr, int wc, int fr, int fq) const {
        const int row0 = u.pm * BM + wr * 64 + fr; const int col0 = u.pn * BM + wc * 32 + 8 * fq;
#pragma unroll
        for (int ai = 0; ai < 2; ++ai)
#pragma unroll
            for (int m = 0; m < 4; ++m) { bf16_t* rowp = O + (size_t)(row0 + ai * HALF + m * 16) * ldc + col0;
#pragma unroll
                for (int bj = 0; bj < 2; ++bj) { const f32x4 v0 = acc[ai][bj][m][0], v1 = acc[ai][bj][m][1];
                    u32x4 w; w.x = cvt_pk_bf16(v0[0], v0[1]); w.y = cvt_pk_bf16(v0[2], v0[3]); w.z = cvt_pk_bf16(v1[0], v1[1]); w.w = cvt_pk_bf16(v1[2], v1[3]);
                    if (col0 + bj * HALF < ncols) *(u32x4*)(rowp + bj * HALF) = w; } }
    }
};
struct EpiRes {
    static constexpr bool PERM = false, AFTER_DRAIN = false;
    float* C; const float* R; int ldc;
    __device__ __forceinline__ void operator()(const f32x4 (&acc)[2][2][4][2], const Unit& u, int wr, int wc, int fr, int fq) const {
        const int row0 = u.pm * BM + wr * 64 + fr, col0 = u.pn * BM + wc * 32 + 4 * fq;
#pragma unroll
        for (int ai = 0; ai < 2; ++ai)
#pragma unroll
            for (int m = 0; m < 4; ++m) { const size_t ro = (size_t)(row0 + ai * HALF + m * 16) * ldc + col0;
#pragma unroll
                for (int bj = 0; bj < 2; ++bj)
#pragma unroll
                    for (int n = 0; n < 2; ++n) { const f32x4 r = *(const f32x4*)(R + ro + bj * HALF + n * 16); *(f32x4*)(C + ro + bj * HALF + n * 16) = acc[ai][bj][m][n] + r; } }
    }
};


template <class Epi, class Sched, bool ALIGN_EPI = false, bool SP2 = false>
__device__ __forceinline__ void gemm_phase(PG8_LAS unsigned char* lds, const Gemm g, const Sched& S, const Epi& E, const int wave_in) {
    const int wid = wave_in, lane = (int)__builtin_amdgcn_mbcnt_hi(~0u, __builtin_amdgcn_mbcnt_lo(~0u, 0u)), tid = wid * 64 + lane, wr = wid >> 2, wc = wid & 3, fr = lane & 15, fq = lane >> 4;
    const int K = g.K, nt = K / BK;
    unsigned voffA[2], voffB[2];
#pragma unroll
    for (int i = 0; i < 2; ++i) { int R, C; stage_rc(tid * 16 + i * 8192, R, C); const int Rb = Epi::PERM ? ((R & ~31) + perm32(R & 31)) : R;
        voffA[i] = (unsigned)(R * K + C) * 2u; voffB[i] = (unsigned)(Rb * K + C) * 2u; }
    const size_t kstep = (size_t)(BK * 2);
    const size_t hstep = (size_t)HALF * K * 2;
    const size_t tstep = 2 * hstep;
    const unsigned ldsw = (unsigned)wid * 1024u;
    const int aoff = lds_byte(wr * 64 + fr, fq * 8), boff = lds_byte(wc * 32 + fr, fq * 8);
#define PG8_SA(b, h) (((b) * 2 + (h)) * HTB)
#define PG8_SB(b, h) ((4 + (b) * 2 + (h)) * HTB)
#define PG8_STAGE(bufoff, gbase, voff) do { _Pragma("unroll") for (int _i = 0; _i < 2; ++_i) \
        __builtin_amdgcn_global_load_lds((const unsigned*)((const char*)(gbase) + (voff)[_i]), (PG8_LAS unsigned*)(lds + (bufoff) + ldsw + _i * 8192), 16, 0, 0); } while (0)
#define PG8_LDA(dst, b, h) do { _Pragma("unroll") for (int m = 0; m < 4; ++m) _Pragma("unroll") for (int k = 0; k < 2; ++k) dst[m][k] = *(const PG8_LAS bf16x8*)(lds + PG8_SA(b, h) + aoff + m * 2048 + k * 1024); } while (0)
#define PG8_LDB(dst, b, h) do { _Pragma("unroll") for (int n = 0; n < 2; ++n) _Pragma("unroll") for (int k = 0; k < 2; ++k) dst[n][k] = *(const PG8_LAS bf16x8*)(lds + PG8_SB(b, h) + boff + n * 2048 + k * 1024); } while (0)
#define PG8_MMA(ai, bj, At, Bt) do { __builtin_amdgcn_s_setprio(1); _Pragma("unroll") for (int m = 0; m < 4; ++m) _Pragma("unroll") for (int n = 0; n < 2; ++n) _Pragma("unroll") for (int k = 0; k < 2; ++k) \
        acc[ai][bj][m][n] = __builtin_amdgcn_mfma_f32_16x16x32_bf16(Bt[n][k], At[m][k], acc[ai][bj][m][n], 0, 0, 0); __builtin_amdgcn_s_setprio(0); } while (0)
#define PG8_WAIT_V(n) asm volatile("s_waitcnt vmcnt(" #n ")" ::: "memory")
#define PG8_WAIT_L(n) asm volatile("s_waitcnt lgkmcnt(" #n ")" ::: "memory")
#define PG8_BAR __builtin_amdgcn_s_barrier()
#define PG8_SCHED __builtin_amdgcn_sched_barrier(0)
    Unit cur, nxt; int ui = 0;
    if (!S.next(0, cur)) return;
    f32x4 acc[2][2][4][2];
#pragma unroll
    for (int a = 0; a < 2; ++a)
#pragma unroll
        for (int b = 0; b < 2; ++b)
#pragma unroll
            for (int m = 0; m < 4; ++m)
#pragma unroll
                for (int n = 0; n < 2; ++n) acc[a][b][m][n] = (f32x4){0.f, 0.f, 0.f, 0.f};
    bf16x8 At[4][2], B0[2][2], B1[2][2];
    const char* cA = (const char*)g.A + (size_t)cur.pm * tstep; const char* cB = (const char*)g.Bt + (size_t)cur.pn * tstep;
    S.a_ready(cur);
    if constexpr (SP2) {
        PG8_STAGE(PG8_SB(0, 0), cB, voffB); PG8_STAGE(PG8_SB(0, 1), cB + hstep, voffB); PG8_STAGE(PG8_SA(0, 0), cA, voffA); PG8_STAGE(PG8_SA(0, 1), cA + hstep, voffA);
        if (wr == 1) PG8_BAR;
        PG8_WAIT_V(2); PG8_BAR;
        PG8_STAGE(PG8_SB(1, 0), cB + kstep, voffB); PG8_STAGE(PG8_SA(1, 0), cA + kstep, voffA); PG8_STAGE(PG8_SB(1, 1), cB + hstep + kstep, voffB);
        PG8_WAIT_V(6); PG8_BAR;
    } else {
        PG8_STAGE(PG8_SB(0, 0), cB, voffB); PG8_STAGE(PG8_SA(0, 0), cA, voffA); PG8_STAGE(PG8_SB(0, 1), cB + hstep, voffB); PG8_STAGE(PG8_SA(0, 1), cA + hstep, voffA);
        if (wr == 1) PG8_BAR;
        PG8_WAIT_V(4); PG8_BAR;
        PG8_STAGE(PG8_SB(1, 0), cB + kstep, voffB); PG8_STAGE(PG8_SA(1, 0), cA + kstep, voffA); PG8_STAGE(PG8_SB(1, 1), cB + hstep + kstep, voffB);
        PG8_WAIT_V(6); PG8_BAR;
    }
    for (;;) {
        const bool has_next = S.next(ui + 1, nxt);
        const char* nA = has_next ? (const char*)g.A + (size_t)nxt.pm * tstep : cA; const char* nB = has_next ? (const char*)g.Bt + (size_t)nxt.pn * tstep : cB;
        for (int t = 0; t < nt; t += 2) {
            const bool last = (t == nt - 2);
            const char* a1 = cA + (size_t)(t + 1) * kstep;
            const char* a2 = last ? nA : cA + (size_t)(t + 2) * kstep; const char* b2 = last ? nB : cB + (size_t)(t + 2) * kstep;
            const char* a3 = a2 + kstep; const char* b3 = b2 + kstep;
            if (last && has_next) S.a_ready(nxt);
            if constexpr (SP2) {
            PG8_LDB(B0, 0, 0); PG8_LDB(B1, 0, 1); PG8_SCHED; PG8_LDA(At, 0, 0); PG8_STAGE(PG8_SA(1, 1), a1 + hstep, voffA);
            PG8_WAIT_V(8); PG8_WAIT_L(0); PG8_BAR; PG8_MMA(0, 0, At, B0); PG8_MMA(0, 1, At, B1); PG8_BAR; PG8_SCHED;
            PG8_LDA(At, 0, 1); PG8_STAGE(PG8_SB(0, 0), b2, voffB); PG8_STAGE(PG8_SB(0, 1), b2 + hstep, voffB); PG8_STAGE(PG8_SA(0, 0), a2, voffA);
            PG8_WAIT_V(8); PG8_WAIT_L(0); PG8_BAR; PG8_MMA(1, 0, At, B0); PG8_MMA(1, 1, At, B1); PG8_BAR; PG8_SCHED;
            PG8_LDB(B0, 1, 0); PG8_LDB(B1, 1, 1); PG8_SCHED; PG8_LDA(At, 1, 0); PG8_STAGE(PG8_SA(0, 1), a2 + hstep, voffA);
            PG8_WAIT_V(8); PG8_WAIT_L(0); PG8_BAR; PG8_MMA(0, 0, At, B0); PG8_MMA(0, 1, At, B1); PG8_BAR; PG8_SCHED;
            PG8_LDA(At, 1, 1); PG8_STAGE(PG8_SB(1, 0), b3, voffB); PG8_STAGE(PG8_SB(1, 1), b3 + hstep, voffB); PG8_STAGE(PG8_SA(1, 0), a3, voffA);
            PG8_WAIT_V(8); PG8_WAIT_L(0); PG8_BAR; PG8_MMA(1, 0, At, B0); PG8_MMA(1, 1, At, B1); PG8_BAR; PG8_SCHED;
            } else {
            PG8_LDB(B0, 0, 0); PG8_SCHED; PG8_LDA(At, 0, 0); PG8_STAGE(PG8_SA(1, 1), a1 + hstep, voffA);
            PG8_WAIT_L(8); PG8_BAR; PG8_WAIT_L(0); PG8_MMA(0, 0, At, B0); PG8_BAR; PG8_SCHED;
            PG8_LDB(B1, 0, 1); PG8_STAGE(PG8_SB(0, 0), b2, voffB);
            PG8_BAR; PG8_WAIT_L(0); PG8_MMA(0, 1, At, B1); PG8_BAR;
            PG8_LDA(At, 0, 1); PG8_STAGE(PG8_SA(0, 0), a2, voffA);
            PG8_BAR; PG8_WAIT_L(0); PG8_MMA(1, 0, At, B0); PG8_BAR; PG8_SCHED;
            PG8_STAGE(PG8_SB(0, 1), b2 + hstep, voffB);
            PG8_WAIT_V(6); PG8_BAR; PG8_MMA(1, 1, At, B1); PG8_BAR;
            PG8_LDB(B0, 1, 0); PG8_SCHED; PG8_LDA(At, 1, 0); PG8_STAGE(PG8_SA(0, 1), a2 + hstep, voffA);
            PG8_WAIT_L(8); PG8_BAR; PG8_WAIT_L(0); PG8_MMA(0, 0, At, B0); PG8_BAR; PG8_SCHED;
            PG8_LDB(B1, 1, 1); PG8_STAGE(PG8_SB(1, 0), b3, voffB);
            PG8_BAR; PG8_WAIT_L(0); PG8_MMA(0, 1, At, B1); PG8_BAR;
            PG8_LDA(At, 1, 1); PG8_STAGE(PG8_SA(1, 0), a3, voffA);
            PG8_BAR; PG8_WAIT_L(0); PG8_MMA(1, 0, At, B0); PG8_BAR; PG8_SCHED;
            PG8_STAGE(PG8_SB(1, 1), b3 + hstep, voffB);
            PG8_WAIT_V(6); PG8_BAR; PG8_MMA(1, 1, At, B1); PG8_BAR;
            }
        }
        if constexpr (ALIGN_EPI) { if (wr == 0) PG8_BAR; }
        if constexpr (!Epi::AFTER_DRAIN) { E(acc, cur, wr, wc, fr, fq); S.done(cur); }
        if (!has_next) break;
#pragma unroll
        for (int a = 0; a < 2; ++a)
#pragma unroll
            for (int b = 0; b < 2; ++b)
#pragma unroll
                for (int m = 0; m < 4; ++m)
#pragma unroll
                    for (int n = 0; n < 2; ++n) acc[a][b][m][n] = (f32x4){0.f, 0.f, 0.f, 0.f};
        cur = nxt; cA = nA; cB = nB; ++ui;
        if constexpr (ALIGN_EPI) { if (wr == 1) PG8_BAR; }
    }
    PG8_WAIT_V(0);
    if constexpr (!ALIGN_EPI) { if (wr == 0) PG8_BAR; }
    PG8_BAR;
    if constexpr (Epi::AFTER_DRAIN) { E.fused(acc, cur, wr, wc, fr, fq, lds, wid, lane); S.done(cur); }
#undef PG8_SA
#undef PG8_SB
#undef PG8_STAGE
#undef PG8_LDA
#undef PG8_LDB
#undef PG8_MMA
#undef PG8_WAIT_V
#undef PG8_WAIT_L
#undef PG8_BAR
#undef PG8_SCHED
}
}

constexpr int NB = 4, SEQ = 8192, M_TOK = NB * SEQ, DM = 1024, DEPTH = 2;
constexpr int D_IN = 3132, HBP = 3136, N_IN_PAD = 3328;
constexpr float NORM_EPS = 1e-6f;
constexpr int HB_NSA_Q = 0, HB_NSA_KC = 256, HB_NSA_VC = 320, HB_NSA_KS = 384, HB_NSA_VS = 448, HB_NSA_KW = 512, HB_NSA_VW = 576;
constexpr int HB_ML_Q = 640, HB_ML_K = 896, HB_ML_V = 1152, HB_ML_OG = 1408;
constexpr int HB_GD_Q = 1664, HB_GD_K = 1920, HB_GD_V = 2176, HB_GD_Z = 2432;
constexpr int HB_MLA_CQ = 2688, HB_MLA_CKV = 2944, HB_MLA_KR = 3072;
constexpr int HB_NSA_G = 3104, HB_ML_IG = 3116, HB_ML_FG = 3120, HB_GD_BETA = 3124, HB_GD_A = 3128;
__host__ __device__ __forceinline__ int hb_src_col(int c) {
    if (c < 640) return c;
    if (c < 1408) return 652 + (c - 640);
    if (c < 1664) return 1428 + (c - 1408);
    if (c < 2432) return 1684 + (c - 1664);
    if (c < 2688) return 2460 + (c - 2432);
    if (c < 3104) return 2716 + (c - 2688);
    if (c < 3116) return 640 + (c - 3104);
    if (c < 3124) return 1420 + (c - 3116);
    return 2452 + (c - 3124);
}
constexpr int GRID_WG = 256;
constexpr size_t MiB = 1u << 20;
constexpr size_t WS_CTL = 0, CTL_ZERO_BYTES = 1 * MiB;
constexpr size_t WS_WIN = 1 * MiB, WIN_L = (size_t)N_IN_PAD * DM * 2;
constexpr size_t WS_WOUT = 14 * MiB, WOUT_L = (size_t)DM * DM * 2;
constexpr size_t WS_WQ = 18 * MiB, WQ_L = (size_t)2048 * DM * 2;
constexpr size_t WS_WSM = 26 * MiB, WSM_L = 1 * MiB;
constexpr size_t WSM_UQ = 0, WSM_UKV = 196608, WSM_CK = 327680, WSM_CV = 589824;
constexpr size_t WS_XN = 28 * MiB;
constexpr size_t WS_HB = 92 * MiB;
constexpr size_t WS_MLA_Q = 288 * MiB, WS_MLA_K = 312 * MiB, WS_MLA_VT = 336 * MiB;
constexpr size_t WS_NSA_VST = 352 * MiB, WS_NSA_VWT = 356 * MiB, WS_NSA_KCMP = 360 * MiB, WS_NSA_VCMPT = 360 * MiB + 512 * 1024;
constexpr size_t WS_ML_C = 361 * MiB, WS_ML_N = 393 * MiB, WS_ML_SC = 393 * MiB + 512 * 1024;
constexpr size_t WS_GD_W = 394 * MiB, WS_GD_UT = 410 * MiB, WS_GD_KDT = 426 * MiB, WS_GD_QD = 442 * MiB, WS_GD_AQK = 458 * MiB, WS_GD_ST = 474 * MiB, WS_GD_VNT = 490 * MiB, WS_GD_GE = 506 * MiB;
constexpr size_t WS_PKEYS = 507 * MiB;
constexpr size_t WS_NSA_KSW = 508 * MiB;
constexpr size_t WS_END = 512 * MiB;
constexpr size_t WS_PEER_QP = 92 * MiB, WS_PEER_U = 394 * MiB, WS_PEER_V = 410 * MiB;
constexpr size_t WS_PEER_X8 = 288 * MiB;
constexpr int CW_TMO = 0, CW_BAR = 4096, CW_Q = 16384, CW_TS = 65536;
constexpr int NWAVES = 8, WAVE_LDS = 18432, MISC_OFF = NWAVES * WAVE_LDS, LDS_BYTES = MISC_OFF + 1024;
static_assert(LDS_BYTES <= 163840 && MISC_OFF >= 131072, "LDS map");

#define GAS __attribute__((address_space(1)))
#define LAS __attribute__((address_space(3)))
typedef unsigned short bf16;
typedef unsigned v4u __attribute__((ext_vector_type(4)));
typedef unsigned v2u __attribute__((ext_vector_type(2)));
typedef float f32x4 __attribute__((ext_vector_type(4)));
typedef short bf16x8 __attribute__((ext_vector_type(8)));
#define RLX_AGENT __ATOMIC_RELAXED, __HIP_MEMORY_SCOPE_AGENT
#define LDS_WAIT() asm volatile("s_waitcnt lgkmcnt(0)" ::: "memory")
#define VM_WAIT() asm volatile("s_waitcnt vmcnt(0)" ::: "memory")
__device__ __forceinline__ unsigned f2bf(float f) { unsigned u = __builtin_bit_cast(unsigned, f); return (u + 0x7fffu + ((u >> 16) & 1u)) >> 16; }
typedef __bf16 bf16x2_hw __attribute__((ext_vector_type(2)));
typedef float f32x2_hw __attribute__((ext_vector_type(2)));
__device__ __forceinline__ unsigned pk2(float lo, float hi) { const f32x2_hw v = {lo, hi}; const bf16x2_hw b = __builtin_convertvector(v, bf16x2_hw); return __builtin_bit_cast(unsigned, b); }
__device__ __forceinline__ float bf2f(unsigned b) { return __builtin_bit_cast(float, b << 16); }
__device__ __forceinline__ float bflo(unsigned w) { return __builtin_bit_cast(float, w << 16); }
__device__ __forceinline__ float bfhi(unsigned w) { return __builtin_bit_cast(float, w & 0xffff0000u); }
typedef unsigned u32x2_t __attribute__((ext_vector_type(2)));
__device__ __forceinline__ float red4_max(float x) {
    auto s = __builtin_amdgcn_permlane16_swap(__float_as_uint(x), __float_as_uint(x), false, false);
    x = fmaxf(__uint_as_float(s[0]), __uint_as_float(s[1]));
    auto t = __builtin_amdgcn_permlane32_swap(__float_as_uint(x), __float_as_uint(x), false, false);
    return fmaxf(__uint_as_float(t[0]), __uint_as_float(t[1]));
}
__device__ __forceinline__ float red4_sum(float x) {
    auto s = __builtin_amdgcn_permlane16_swap(__float_as_uint(x), __float_as_uint(x), false, false);
    x = __uint_as_float(s[0]) + __uint_as_float(s[1]);
    auto t = __builtin_amdgcn_permlane32_swap(__float_as_uint(x), __float_as_uint(x), false, false);
    return __uint_as_float(t[0]) + __uint_as_float(t[1]);
}
template <int CTRL> __device__ __forceinline__ float dpp_mov(float x) { return __int_as_float(__builtin_amdgcn_mov_dpp(__float_as_int(x), CTRL, 0xf, 0xf, true)); }
__device__ __forceinline__ float wave_sum(float v) {
    v += dpp_mov<0xB1>(v); v += dpp_mov<0x4E>(v); v += dpp_mov<0x141>(v); v += dpp_mov<0x140>(v);
    return red4_sum(v);
}
__device__ __forceinline__ float wave_max(float v) {
    v = fmaxf(v, dpp_mov<0xB1>(v)); v = fmaxf(v, dpp_mov<0x4E>(v)); v = fmaxf(v, dpp_mov<0x141>(v)); v = fmaxf(v, dpp_mov<0x140>(v));
    return red4_max(v);
}
__device__ __forceinline__ int wave_pop(unsigned* ctr, int lane) {
    __builtin_amdgcn_wave_barrier();
    const unsigned v = __hip_atomic_fetch_add(ctr, (lane == 0) ? 1u : 0u, RLX_AGENT);
    const int r = (int)__builtin_amdgcn_readfirstlane(v);
    __builtin_amdgcn_wave_barrier();
    return r;
}
__device__ __forceinline__ float fexp(float x) { return __builtin_amdgcn_exp2f(x * 1.4426950408889634f); }
__device__ __forceinline__ f32x4 mfma16(bf16x8 a, bf16x8 b, f32x4 c) { return __builtin_amdgcn_mfma_f32_16x16x32_bf16(a, b, c, 0, 0, 0); }
__device__ __forceinline__ int lane_id() { return (int)__builtin_amdgcn_mbcnt_hi(~0u, __builtin_amdgcn_mbcnt_lo(~0u, 0u)); }
__device__ __forceinline__ int lane_id_v() { int l; asm volatile("v_mbcnt_lo_u32_b32 %0, -1, 0\n\tv_mbcnt_hi_u32_b32 %0, -1, %0" : "=v"(l)); return l; }
template <class T> __device__ __forceinline__ T* opaque(T* p) { asm volatile("" : "+s"(p)); return p; }
union Frag { bf16x8 v; v4u u; unsigned w[4]; };

constexpr int N_PHASES = 1 + 8 * DEPTH;
struct Args { const float* in[26]; float* out; unsigned char* ws; int ph_lo, ph_hi; };
enum { I_X = 0, I_POS, I_T5, I_N1G, I_N2G, I_FNG, I_WIN, I_WOUT, I_CMPK, I_CMPV, I_CMPPOS, I_ML_IB, I_ML_FB, I_ML_NG, I_GD_CONV, I_GD_ALOG, I_GD_DT, I_GD_NG,
       I_MLA_QNG, I_MLA_KVNG, I_MLA_WUQ, I_MLA_WUKV, I_PEER_WQ, I_PEER_KEYS, I_PEER_U, I_PEER_V };

#define XB_TMO      128
#define XB_XCNT(j)  (256  + 64 * (j))
#define XB_XSUB(j)  (1280 + 64 * (j))
#define XB_XGEN(j)  (2304 + 64 * (j))
#define XB_TOP      3328
#define XB_TOPGEN   3392
#define XCD_BAR_WORDS 3456
#define XB_SPIN_CAP (1u << 21)

__device__ __forceinline__ unsigned xb_ld(unsigned* p)              { return __hip_atomic_load(p, __ATOMIC_RELAXED, __HIP_MEMORY_SCOPE_AGENT); }
__device__ __forceinline__ unsigned xb_add(unsigned* p, unsigned v) { return __hip_atomic_fetch_add(p, v, __ATOMIC_RELAXED, __HIP_MEMORY_SCOPE_AGENT); }
__device__ __forceinline__ unsigned xb_xcc_id() { return (unsigned)__builtin_amdgcn_s_getreg((3 << 11) | 20) & 0xFu; }
#define XB_SPIN(cond, bar) do { unsigned _sp = 0; while (cond) { __builtin_amdgcn_s_sleep(1); \
    if ((++_sp & 255u) == 0u) { if (xb_ld(&(bar)[XB_TMO])) break; if (_sp > XB_SPIN_CAP) { atomicAdd(&(bar)[XB_TMO], 1u); break; } } } } while (0)

struct XcdBarrier {
    unsigned* bar; unsigned x;
    volatile LAS unsigned* st;
};

__device__ __forceinline__ XcdBarrier xcd_barrier_post(unsigned* bar, volatile LAS unsigned* st, const bool is_t0) {
    XcdBarrier b; b.bar = bar; b.x = xb_xcc_id(); b.st = st;
    if (is_t0) (void)xb_add(&bar[XB_XCNT(b.x)], 1u);
    return b;
}
__device__ __forceinline__ void xcd_barrier_complete(unsigned* bar, unsigned x, unsigned& nloc, unsigned& nx) {
    const unsigned G = gridDim.x * gridDim.y * gridDim.z;
    unsigned sum, cnt, mine, sp = 0u;
    for (;;) {
        sum = 0u; cnt = 0u; mine = 0u;
#pragma unroll
        for (unsigned j = 0; j < 16; ++j) { const unsigned c = xb_ld(&bar[XB_XCNT(j)]); sum += c; cnt += (c > 0u) ? 1u : 0u; mine = (j == x) ? c : mine; }
        if (sum == G) break;
        __builtin_amdgcn_s_sleep(1);
        if ((++sp & 255u) == 0u) { if (xb_ld(&bar[XB_TMO])) break; if (sp > XB_SPIN_CAP) { atomicAdd(&bar[XB_TMO], 1u); break; } }
    }
    nloc = mine > 0u ? mine : 1u; nx = cnt > 0u ? cnt : 1u;
}

__device__ __forceinline__ void xcd_barrier(const XcdBarrier& b, const bool is_t0) {
    asm volatile("s_waitcnt vmcnt(0)" ::: "memory");
    __syncthreads();
    if (is_t0) {
        unsigned* bar = b.bar;
        __builtin_amdgcn_s_waitcnt(0);
        unsigned nloc = b.st[0], nx = b.st[1];
        if (nloc == 0u) { xcd_barrier_complete(bar, b.x, nloc, nx); b.st[0] = nloc; b.st[1] = nx; }
        const unsigned old = xb_add(&bar[XB_XSUB(b.x)], 1u);
        const unsigned gen = old / nloc;
        if (old + 1u == (gen + 1u) * nloc) {
            __builtin_amdgcn_fence(__ATOMIC_RELEASE, "agent");
            asm volatile("s_waitcnt vmcnt(0)" ::: "memory");
            const unsigned og = xb_add(&bar[XB_TOP], 1u);
            const unsigned tg = og / nx;
            if (og + 1u == (tg + 1u) * nx) xb_add(&bar[XB_TOPGEN], 1u);
            else XB_SPIN(xb_ld(&bar[XB_TOPGEN]) == tg, bar);
            __builtin_amdgcn_fence(__ATOMIC_ACQUIRE, "agent");
            xb_add(&bar[XB_XGEN(b.x)], 1u);
            asm volatile("s_waitcnt vmcnt(0)" ::: "memory");
        } else {
            XB_SPIN(xb_ld(&bar[XB_XGEN(b.x)]) == gen, bar);
            __builtin_amdgcn_fence(__ATOMIC_ACQUIRE, "agent");
            asm volatile("s_waitcnt vmcnt(0)" ::: "memory");
        }
    }
    __syncthreads();
}

template <class Map>
__device__ __forceinline__ void tr_item(const float* src, int ldsrc, int nreal, Map map, bf16* dst, int K, LAS float* scr, int kb, int nb, int lane) {
    const int k0 = 64 * kb, n0 = 32 * nb;
    const int n = n0 + (lane & 31);
    const int sc = (n < nreal) ? map(n) : -1;
#pragma unroll 8
    for (int i = 0; i < 32; ++i) { const int kk = 2 * i + (lane >> 5); scr[kk * 33 + (lane & 31)] = (sc >= 0) ? src[(size_t)(k0 + kk) * ldsrc + sc] : 0.f; }
    LDS_WAIT();
    const int c = lane & 7;
#pragma unroll
    for (int j = 0; j < 4; ++j) { const int nn = (lane >> 3) + 8 * j; const LAS float* s = scr + (8 * c) * 33 + nn;
        v4u o; o.x = pk2(s[0 * 33], s[1 * 33]); o.y = pk2(s[2 * 33], s[3 * 33]); o.z = pk2(s[4 * 33], s[5 * 33]); o.w = pk2(s[6 * 33], s[7 * 33]);
        *(v4u*)(dst + (size_t)(n0 + nn) * K + k0 + 8 * c) = o; }
    LDS_WAIT();
}
struct MapId { __device__ __forceinline__ int operator()(int n) const { return n; } };
struct MapHb { __device__ __forceinline__ int operator()(int n) const { return hb_src_col(n); } };
__device__ __forceinline__ void rms_row_bf16(const float* xrow, const float* g, bf16* orow, int lane) {
    const f32x4* xr = (const f32x4*)xrow + lane; const f32x4* gr = (const f32x4*)g + lane;
    f32x4 v[4]; float s = 0.f;
#pragma unroll
    for (int j = 0; j < 4; ++j) { v[j] = xr[64 * j]; s += (v[j].x * v[j].x + v[j].y * v[j].y) + (v[j].z * v[j].z + v[j].w * v[j].w); }
    const float r = 1.0f / sqrtf(wave_sum(s) * (1.f / DM) + NORM_EPS);
    v2u* o8 = (v2u*)orow + lane;
#pragma unroll
    for (int j = 0; j < 4; ++j) { const f32x4 gg = gr[64 * j]; v2u o; o.x = pk2(v[j].x * r * gg.x, v[j].y * r * gg.y); o.y = pk2(v[j].z * r * gg.z, v[j].w * r * gg.w); o8[64 * j] = o; }
}
__device__ __forceinline__ void rms_row_f32(const float* xrow, const float* g, float* orow, int lane) {
    const f32x4* xr = (const f32x4*)xrow + lane; const f32x4* gr = (const f32x4*)g + lane;
    f32x4 v[4]; float s = 0.f;
#pragma unroll
    for (int j = 0; j < 4; ++j) { v[j] = xr[64 * j]; s += (v[j].x * v[j].x + v[j].y * v[j].y) + (v[j].z * v[j].z + v[j].w * v[j].w); }
    const float r = 1.0f / sqrtf(wave_sum(s) * (1.f / DM) + NORM_EPS);
    f32x4* o = (f32x4*)orow + lane;
#pragma unroll
    for (int j = 0; j < 4; ++j) { const f32x4 gg = gr[64 * j]; o[64 * j] = v[j] * r * gg; }
}

__device__ __forceinline__ void mla_prep_item(int it, int l, const Args& args, int lane) {
    unsigned char* ws = args.ws;
    const bf16* HB = (const bf16*)(ws + WS_HB);
    bf16* Qo = (bf16*)(ws + WS_MLA_Q); bf16* Ko = (bf16*)(ws + WS_MLA_K); bf16* VT = (bf16*)(ws + WS_MLA_VT);
    const bf16* uq_t = opaque((const bf16*)(ws + WS_WSM + l * WSM_L + WSM_UQ)); const bf16* ukv_t = opaque((const bf16*)(ws + WS_WSM + l * WSM_L + WSM_UKV));
    const int fr = lane & 15, fq = lane >> 4;
    const int tok0 = it * 16, b = tok0 / SEQ, s0 = tok0 % SEQ;
    const float* gq = opaque(args.in[I_MLA_QNG] + l * 256); const float* gkv = opaque(args.in[I_MLA_KVNG] + l * 128);
    const int* pos = (const int*)args.in[I_POS];
    float cs[4], sn[4];
    { const float pf_ = (float)pos[tok0 + fr];
#pragma unroll
      for (int i = 0; i < 4; ++i) { const float inv_freq = exp2f(-(float)(fq * 4 + i) * (13.287712379549449f / 16.0f));
          const float ang = pf_ * inv_freq; sincosf(ang, &sn[i], &cs[i]); } }
    const int blk32 = s0 >> 5, half = (s0 >> 4) & 1;
    const float qscale = 0.10206207261596577f * 1.4426950408889634f;
    {
        Frag a[8]; float ss = 0.f;
#pragma unroll
        for (int ks = 0; ks < 8; ++ks) { a[ks].u = *(const v4u*)(HB + (size_t)(tok0 + fr) * HBP + HB_MLA_CQ + ks * 32 + fq * 8);
#pragma unroll
            for (int j = 0; j < 4; ++j) { const float x0 = bflo(a[ks].w[j]), x1 = bfhi(a[ks].w[j]); ss += x0 * x0 + x1 * x1; } }
        ss = red4_sum(ss);
        const float r = 1.0f / sqrtf(ss * (1.f / 256.f) + NORM_EPS);
#pragma unroll
        for (int ks = 0; ks < 8; ++ks) { const float* gp = gq + ks * 32 + fq * 8;
#pragma unroll
            for (int j = 0; j < 4; ++j) a[ks].w[j] = pk2(bflo(a[ks].w[j]) * r * gp[2 * j], bfhi(a[ks].w[j]) * r * gp[2 * j + 1]); }
        for (int h = 0; h < 4; ++h) {
            f32x4 acc[6];
#pragma unroll
            for (int j = 0; j < 6; ++j) { acc[j] = (f32x4){0.f, 0.f, 0.f, 0.f};
#pragma unroll
                for (int ks = 0; ks < 8; ++ks) { Frag bq; bq.u = *(const v4u*)(uq_t + (size_t)(h * 96 + j * 16 + fr) * 256 + ks * 32 + fq * 8); acc[j] = mfma16(bq.v, a[ks].v, acc[j]); } }
            bf16* qrow = Qo + ((size_t)(b * 4 + h) * SEQ + s0 + fr) * 96 + fq * 4;
#pragma unroll
            for (int j = 0; j < 4; ++j) { v2u o; o.x = pk2(acc[j][0] * qscale, acc[j][1] * qscale); o.y = pk2(acc[j][2] * qscale, acc[j][3] * qscale); *(v2u*)(qrow + j * 16) = o; }
            { float r1[4], r2[4];
#pragma unroll
              for (int i = 0; i < 4; ++i) { const float t1 = acc[4][i], t2 = acc[5][i]; r1[i] = (t1 * cs[i] - t2 * sn[i]) * qscale; r2[i] = (t2 * cs[i] + t1 * sn[i]) * qscale; }
              v2u o1, o2; o1.x = pk2(r1[0], r1[1]); o1.y = pk2(r1[2], r1[3]); o2.x = pk2(r2[0], r2[1]); o2.y = pk2(r2[2], r2[3]); *(v2u*)(qrow + 64) = o1; *(v2u*)(qrow + 80) = o2; }
        }
    }
    {
        Frag a[4]; float ss = 0.f;
#pragma unroll
        for (int ks = 0; ks < 4; ++ks) { a[ks].u = *(const v4u*)(HB + (size_t)(tok0 + fr) * HBP + HB_MLA_CKV + ks * 32 + fq * 8);
#pragma unroll
            for (int j = 0; j < 4; ++j) { const float x0 = bflo(a[ks].w[j]), x1 = bfhi(a[ks].w[j]); ss += x0 * x0 + x1 * x1; } }
        ss = red4_sum(ss);
        const float r = 1.0f / sqrtf(ss * (1.f / 128.f) + NORM_EPS);
#pragma unroll
        for (int ks = 0; ks < 4; ++ks) { const float* gp = gkv + ks * 32 + fq * 8;
#pragma unroll
            for (int j = 0; j < 4; ++j) a[ks].w[j] = pk2(bflo(a[ks].w[j]) * r * gp[2 * j], bfhi(a[ks].w[j]) * r * gp[2 * j + 1]); }
        for (int h = 0; h < 4; ++h) {
            f32x4 acc[8];
#pragma unroll
            for (int j = 0; j < 8; ++j) { acc[j] = (f32x4){0.f, 0.f, 0.f, 0.f};
#pragma unroll
                for (int ks = 0; ks < 4; ++ks) { Frag bq; bq.u = *(const v4u*)(ukv_t + (size_t)(h * 128 + j * 16 + fr) * 128 + ks * 32 + fq * 8); acc[j] = (j < 4) ? mfma16(bq.v, a[ks].v, acc[j]) : mfma16(a[ks].v, bq.v, acc[j]); } }
            bf16* kblk = Ko + (size_t)(b * 4 + h) * SEQ * 96 + (size_t)blk32 * 3072;
#pragma unroll
            for (int j = 0; j < 4; ++j) { v2u o; o.x = pk2(acc[j][0], acc[j][1]); o.y = pk2(acc[j][2], acc[j][3]);
                *(v2u*)(kblk + ((half * 3 + (j >> 1)) * 64 + ((j & 1) * 2 + (fq >> 1)) * 16 + fr) * 8 + (fq & 1) * 4) = o; }
            bf16* vblk = VT + (size_t)(b * 4 + h) * 64 * SEQ + (size_t)blk32 * 2048;
#pragma unroll
            for (int j = 0; j < 4; ++j) { v2u o; o.x = pk2(acc[4 + j][0], acc[4 + j][1]); o.y = pk2(acc[4 + j][2], acc[4 + j][3]);
                *(v2u*)(vblk + (j * 64 + lane) * 8 + half * 4) = o; }
        }
        { const bf16* kr = HB + (size_t)(tok0 + fr) * HBP + HB_MLA_KR + fq * 4;
          const v2u a1 = *(const v2u*)kr, a2 = *(const v2u*)(kr + 16);
          const float t1[4] = {bflo(a1.x), bfhi(a1.x), bflo(a1.y), bfhi(a1.y)}, t2[4] = {bflo(a2.x), bfhi(a2.x), bflo(a2.y), bfhi(a2.y)};
          float r1[4], r2[4];
#pragma unroll
          for (int i = 0; i < 4; ++i) { r1[i] = t1[i] * cs[i] - t2[i] * sn[i]; r2[i] = t2[i] * cs[i] + t1[i] * sn[i]; }
          v2u o1, o2; o1.x = pk2(r1[0], r1[1]); o1.y = pk2(r1[2], r1[3]); o2.x = pk2(r2[0], r2[1]); o2.y = pk2(r2[2], r2[3]);
#pragma unroll
          for (int h = 0; h < 4; ++h) { bf16* kblk = Ko + (size_t)(b * 4 + h) * SEQ * 96 + (size_t)blk32 * 3072 + ((half * 3 + 2) * 64 + fr) * 8 + (fq & 1) * 4;
              *(v2u*)(kblk + (fq >> 1) * 128) = o1; *(v2u*)(kblk + (2 + (fq >> 1)) * 128) = o2; } }
    }
}
#define MLA_LOADK(KF, k0_) do { const bf16* kp_ = K + (size_t)((k0_) >> 5) * 3072 + lane * 8; _Pragma("unroll") for (int t = 0; t < 2; ++t) { _Pragma("unroll") for (int ks = 0; ks < 3; ++ks) KF[t][ks].u = *(const v4u*)(kp_ + (t * 3 + ks) * 512); } } while (0)
#define MLA_LOADV(VF, k0_) do { const bf16* vp_ = VT + (size_t)((k0_) >> 5) * 2048 + lane * 8; _Pragma("unroll") for (int dt = 0; dt < 4; ++dt) VF[dt].u = *(const v4u*)(vp_ + dt * 512); } while (0)
#define MLA_STEP_(KF, VF, k0_, DIAG) do { \
    Frag pf[4]; f32x4 sA_[4], sB_[4]; \
    _Pragma("unroll") for (int nt = 0; nt < 4; ++nt) { Frag q0, q1, q2; q0.u = *(const LAS v4u*)(ql + (nt * 16 + fr) * 104 + fq * 8); q1.u = *(const LAS v4u*)(ql + (nt * 16 + fr) * 104 + 32 + fq * 8); q2.u = *(const LAS v4u*)(ql + (nt * 16 + fr) * 104 + 64 + fq * 8); \
        f32x4 s0_ = {0.f, 0.f, 0.f, 0.f}, s1_ = {0.f, 0.f, 0.f, 0.f}; \
        s0_ = mfma16(KF[0][0].v, q0.v, s0_); s1_ = mfma16(KF[1][0].v, q0.v, s1_); s0_ = mfma16(KF[0][1].v, q1.v, s0_); s1_ = mfma16(KF[1][1].v, q1.v, s1_); s0_ = mfma16(KF[0][2].v, q2.v, s0_); s1_ = mfma16(KF[1][2].v, q2.v, s1_); \
        sA_[nt] = s0_; sB_[nt] = s1_; } \
      \
    _Pragma("unroll") for (int nt = 0; nt < 4; ++nt) { f32x4 s0_ = sA_[nt], s1_ = sB_[nt]; \
        if (DIAG) { _Pragma("unroll") for (int i = 0; i < 4; ++i) { if ((k0_) + fq * 4 + i > s0 + nt * 16 + fr) s0_[i] = -1e30f; if ((k0_) + 16 + fq * 4 + i > s0 + nt * 16 + fr) s1_[i] = -1e30f; } } \
        float mx = fmaxf(fmaxf(fmaxf(s0_[0], s0_[1]), fmaxf(s0_[2], s0_[3])), fmaxf(fmaxf(s1_[0], s1_[1]), fmaxf(s1_[2], s1_[3]))); \
        mx = red4_max(mx); \
        const float mn = fmaxf(mrun[nt], mx); \
        float p[8]; float ps = 0.f; \
        _Pragma("unroll") for (int i = 0; i < 4; ++i) { p[i] = __builtin_amdgcn_exp2f(s0_[i] - mn); p[4 + i] = __builtin_amdgcn_exp2f(s1_[i] - mn); ps += p[i] + p[4 + i]; } \
        if (__builtin_amdgcn_ballot_w64(mn > mrun[nt]) != 0ull) {         \
            const float alpha = __builtin_amdgcn_exp2f(mrun[nt] - mn); mrun[nt] = mn; lrun[nt] = lrun[nt] * alpha; \
            _Pragma("unroll") for (int dt = 0; dt < 4; ++dt) o[dt][nt] = o[dt][nt] * alpha; } \
        lrun[nt] += ps; \
        pf[nt].w[0] = pk2(p[0], p[1]); pf[nt].w[1] = pk2(p[2], p[3]); pf[nt].w[2] = pk2(p[4], p[5]); pf[nt].w[3] = pk2(p[6], p[7]); } \
    _Pragma("unroll") for (int dt = 0; dt < 4; ++dt) _Pragma("unroll") for (int nt = 0; nt < 4; ++nt) o[dt][nt] = mfma16(VF[dt].v, pf[nt].v, o[dt][nt]); __builtin_amdgcn_sched_barrier(0); } while (0)
__device__ __forceinline__ void mla_attn_item(int bh, int qt, const Args& args, LAS unsigned char* wlds, int lane) {
    unsigned char* ws = args.ws;
    const bf16* Q = (const bf16*)(ws + WS_MLA_Q) + (size_t)bh * SEQ * 96; const bf16* K = (const bf16*)(ws + WS_MLA_K) + (size_t)bh * SEQ * 96;
    const bf16* VT = (const bf16*)(ws + WS_MLA_VT) + (size_t)bh * 64 * SEQ; bf16* XN = (bf16*)(ws + WS_XN);
    const int fr = lane & 15, fq = lane >> 4, s0 = qt * 64, b = bh >> 2, h = bh & 3;
    LAS bf16* ql = (LAS bf16*)wlds;
#pragma unroll
    for (int i = 0; i < 12; ++i) { const int idx = i * 64 + lane, r = idx / 12, c = idx % 12; *(LAS v4u*)(ql + r * 104 + c * 8) = *(const v4u*)(Q + (size_t)(s0 + r) * 96 + c * 8); }
    LDS_WAIT();
    f32x4 o[4][4];
#pragma unroll
    for (int dt = 0; dt < 4; ++dt)
#pragma unroll
        for (int nt = 0; nt < 4; ++nt) o[dt][nt] = (f32x4){0.f, 0.f, 0.f, 0.f};
    float mrun[4], lrun[4];
#pragma unroll
    for (int nt = 0; nt < 4; ++nt) { mrun[nt] = -1e30f; lrun[nt] = 0.f; }
    const int nkb = (s0 + 64) / 32;
    Frag kA[2][3], kB[2][3], vv[4];
    MLA_LOADK(kA, 0);
    for (int kb = 0; kb < nkb - 2; kb += 2) {
        MLA_LOADV(vv, kb * 32); MLA_LOADK(kB, (kb + 1) * 32);
        MLA_STEP_(kA, vv, kb * 32, 0);
        MLA_LOADV(vv, (kb + 1) * 32); MLA_LOADK(kA, (kb + 2) * 32);
        MLA_STEP_(kB, vv, (kb + 1) * 32, 0);
    }
    { const int kb = nkb - 2;
        MLA_LOADV(vv, kb * 32); MLA_LOADK(kB, (kb + 1) * 32);
        MLA_STEP_(kA, vv, kb * 32, 1);
        MLA_LOADV(vv, (kb + 1) * 32);
        MLA_STEP_(kB, vv, (kb + 1) * 32, 1);
    }
#pragma unroll
    for (int nt = 0; nt < 4; ++nt) {
        float lt = lrun[nt]; lt = red4_sum(lt);
        const float inv = 1.0f / lt;
        bf16* orow = XN + (size_t)(b * SEQ + s0 + nt * 16 + fr) * DM + 768 + h * 64 + fq * 4;
#pragma unroll
        for (int dt = 0; dt < 4; ++dt) { v2u w; w.x = pk2(o[dt][nt][0] * inv, o[dt][nt][1] * inv); w.y = pk2(o[dt][nt][2] * inv, o[dt][nt][3] * inv); *(v2u*)(orow + dt * 16) = w; }
    }
    LDS_WAIT();
}

__device__ __forceinline__ void stage64(const bf16* HB, int tok0, int col0, LAS bf16* buf, int lane) {
#pragma unroll
    for (int i = 0; i < 8; ++i) { const int idx = i * 64 + lane, r = idx >> 3, c8 = idx & 7;
        const v4u v = *(const v4u*)(HB + (size_t)(tok0 + r) * HBP + col0 + c8 * 8); *(LAS v4u*)(buf + r * 72 + c8 * 8) = v; }
    LDS_WAIT();
}
__device__ __forceinline__ float log_sigmoid(float x) { return fminf(x, 0.f) - log1pf(expf(-fabsf(x))); }
__device__ __forceinline__ float wave_incl_sum(float v, int lane) {
#pragma unroll
    for (int o = 1; o < 64; o <<= 1) { const float t = __shfl_up(v, o); if (lane >= o) v += t; }
    return v;
}
__device__ __forceinline__ float wave_incl_max(float v, int lane) {
#pragma unroll
    for (int o = 1; o < 64; o <<= 1) { const float t = __shfl_up(v, o); if (lane >= o) v = fmaxf(v, t); }
    return v;
}
__device__ __forceinline__ void mlstm_prep_item(int it, int l, const Args& args, LAS unsigned char* wlds, int lane) {
    unsigned char* ws = args.ws; const bf16* HB = (const bf16*)(ws + WS_HB);
    const int bh = it >> 7, n = it & 127, b = bh >> 2, h = bh & 3, tok0 = b * SEQ + n * 64, fr = lane & 15, fq = lane >> 4;
    LAS bf16* buf = (LAS bf16*)wlds;
    const float ib = opaque(args.in[I_ML_IB] + l * 4)[h], fb = opaque(args.in[I_ML_FB] + l * 4)[h];
    const float ig = bf2f(HB[(size_t)(tok0 + lane) * HBP + HB_ML_IG + h]) + ib;
    const float lf = log_sigmoid(bf2f(HB[(size_t)(tok0 + lane) * HBP + HB_ML_FG + h]) + fb);
    const float bcum = wave_incl_sum(lf, lane), a = ig - bcum, amax = wave_max(a), bend = __shfl(bcum, 63);
    const float w = fexp(a - amax);
    float wv[2][8];
#pragma unroll
    for (int ks = 0; ks < 2; ++ks)
#pragma unroll
        for (int j = 0; j < 8; ++j) wv[ks][j] = __shfl(w, ks * 32 + fq * 8 + j);
    stage64(HB, tok0, HB_ML_V + h * 64, buf, lane);
    Frag af[4][2];
#pragma unroll
    for (int mt = 0; mt < 4; ++mt)
#pragma unroll
        for (int ks = 0; ks < 2; ++ks)
#pragma unroll
            for (int j = 0; j < 4; ++j) { const int s = ks * 32 + fq * 8 + 2 * j, e = mt * 16 + fr;
                af[mt][ks].w[j] = pk2(bf2f(buf[s * 72 + e]) * wv[ks][2 * j], bf2f(buf[(s + 1) * 72 + e]) * wv[ks][2 * j + 1]); }
    LDS_WAIT();
    stage64(HB, tok0, HB_ML_K + h * 64, buf, lane);
    Frag bfm[4][2];
#pragma unroll
    for (int nt = 0; nt < 4; ++nt)
#pragma unroll
        for (int ks = 0; ks < 2; ++ks)
#pragma unroll
            for (int j = 0; j < 4; ++j) { const int s = ks * 32 + fq * 8 + 2 * j, kd = nt * 16 + fr;
                bfm[nt][ks].w[j] = pk2(bf2f(buf[s * 72 + kd]) * 0.125f, bf2f(buf[(s + 1) * 72 + kd]) * 0.125f); }
    LDS_WAIT();
    float* Cc = (float*)(ws + WS_ML_C) + (size_t)it * 4096;
#pragma unroll
    for (int mt = 0; mt < 4; ++mt)
#pragma unroll
        for (int nt = 0; nt < 4; ++nt) { f32x4 acc = {0.f, 0.f, 0.f, 0.f};
#pragma unroll
            for (int ks = 0; ks < 2; ++ks) acc = mfma16(af[mt][ks].v, bfm[nt][ks].v, acc);
#pragma unroll
            for (int i = 0; i < 4; ++i) Cc[(mt * 16 + fq * 4 + i) * 64 + nt * 16 + fr] = acc[i]; }
    {
        Frag an[2];
#pragma unroll
        for (int ks = 0; ks < 2; ++ks)
#pragma unroll
            for (int j = 0; j < 4; ++j) an[ks].w[j] = (fr == 0) ? pk2(wv[ks][2 * j], wv[ks][2 * j + 1]) : 0u;
        float* Nn = (float*)(ws + WS_ML_N) + (size_t)it * 64; float* dummy = (float*)(ws + WS_ML_SC) + (size_t)it * 4 + 3;
#pragma unroll
        for (int nt = 0; nt < 4; ++nt) { f32x4 acc = {0.f, 0.f, 0.f, 0.f}; acc = mfma16(an[0].v, bfm[nt][0].v, acc); acc = mfma16(an[1].v, bfm[nt][1].v, acc);
            float* dst = (fq == 0) ? (Nn + nt * 16 + fr) : dummy; *dst = acc[0]; } }
    { float* sc = (float*)(ws + WS_ML_SC) + (size_t)it * 4; sc[lane & 1] = (lane & 1) ? bend : bend + amax; }
}
__device__ __forceinline__ void mlstm_scan_item(int it, const Args& args, int lane) {
    unsigned char* ws = args.ws; const int bh = it >> 4, part = it & 15;
    float* Cb = (float*)(ws + WS_ML_C) + (size_t)bh * 128 * 4096 + part * 256 + lane;
    float* Nb = (float*)(ws + WS_ML_N) + (size_t)bh * 128 * 64 + lane;
    float* sc = (float*)(ws + WS_ML_SC) + (size_t)bh * 128 * 4;
    float c0 = 0.f, c1 = 0.f, c2 = 0.f, c3 = 0.f, nn = 0.f, m = 0.f;
    for (int n0 = 0; n0 < 128; n0 += 4) {
        float d[4][4], ml_[4], be_[4], dn_[4];
#pragma unroll
        for (int q = 0; q < 4; ++q) { const float* cp = Cb + (size_t)(n0 + q) * 4096; d[q][0] = cp[0]; d[q][1] = cp[64]; d[q][2] = cp[128]; d[q][3] = cp[192];
            ml_[q] = sc[(n0 + q) * 4 + 0]; be_[q] = sc[(n0 + q) * 4 + 1]; dn_[q] = (part == 0) ? Nb[(n0 + q) * 64] : 0.f; }
#pragma unroll
        for (int q = 0; q < 4; ++q) { float* cp = Cb + (size_t)(n0 + q) * 4096;
            const float mnew = fmaxf(be_[q] + m, ml_[q]), fc = fexp(be_[q] + m - mnew), fd = fexp(ml_[q] - mnew);
            cp[0] = c0; cp[64] = c1; cp[128] = c2; cp[192] = c3;
            c0 = fc * c0 + fd * d[q][0]; c1 = fc * c1 + fd * d[q][1]; c2 = fc * c2 + fd * d[q][2]; c3 = fc * c3 + fd * d[q][3];
            if (part == 0) { Nb[(n0 + q) * 64] = nn; nn = fc * nn + fd * dn_[q]; sc[(n0 + q) * 4 + 2] = m; }
            m = mnew; }
    }
}
__device__ __forceinline__ void mlstm_out_item(int it, int l, const Args& args, LAS unsigned char* wlds, int lane) {
    unsigned char* ws = args.ws; const bf16* HB = (const bf16*)(ws + WS_HB); bf16* XN = (bf16*)(ws + WS_XN);
    const int bh = it >> 7, n = it & 127, b = bh >> 2, h = bh & 3, tok0 = b * SEQ + n * 64, fr = lane & 15, fq = lane >> 4;
    LAS bf16* buf = (LAS bf16*)wlds;
    const float ib = opaque(args.in[I_ML_IB] + l * 4)[h], fb = opaque(args.in[I_ML_FB] + l * 4)[h];
    const float ig = bf2f(HB[(size_t)(tok0 + lane) * HBP + HB_ML_IG + h]) + ib;
    const float lf = log_sigmoid(bf2f(HB[(size_t)(tok0 + lane) * HBP + HB_ML_FG + h]) + fb);
    const float bcum = wave_incl_sum(lf, lane), a = ig - bcum, pmax = wave_incl_max(a, lane);
    const float* sc = (const float*)(ws + WS_ML_SC) + (size_t)it * 4;
    const float mst = sc[2];
    const float mt_ = bcum + fmaxf(pmax, mst);
    const float inter_l = fexp(bcum + mst - mt_), emm_l = fexp(-mt_), bm_l = bcum - mt_;
    stage64(HB, tok0, HB_ML_V + h * 64, buf, lane);
    Frag kf[4][2];
#pragma unroll
    for (int t = 0; t < 4; ++t)
#pragma unroll
        for (int ks = 0; ks < 2; ++ks) kf[t][ks].u = *(const v4u*)(HB + (size_t)(tok0 + t * 16 + fr) * HBP + HB_ML_K + h * 64 + ks * 32 + fq * 8);
    float as_[4][4];
#pragma unroll
    for (int mt = 0; mt < 4; ++mt)
#pragma unroll
        for (int i = 0; i < 4; ++i) as_[mt][i] = __shfl(a, mt * 16 + fq * 4 + i);
    const float* Cst = (const float*)(ws + WS_ML_C) + (size_t)it * 4096; const float* Nst = (const float*)(ws + WS_ML_N) + (size_t)it * 64;
    const float* ng = opaque(args.in[I_ML_NG] + l * 256) + h * 64;
    for (int nt = 0; nt < 4; ++nt) {
        const int tl = nt * 16 + fr;
        const float bm = __shfl(bm_l, tl), inter = __shfl(inter_l, tl), emm = __shfl(emm_l, tl);
        Frag q0, q1;
        q0.u = *(const v4u*)(HB + (size_t)(tok0 + tl) * HBP + HB_ML_Q + h * 64 + fq * 8); q1.u = *(const v4u*)(HB + (size_t)(tok0 + tl) * HBP + HB_ML_Q + h * 64 + 32 + fq * 8);
        f32x4 st[4]; float den = 0.f;
#pragma unroll
        for (int mt = 0; mt < 4; ++mt) { st[mt] = (f32x4){0.f, 0.f, 0.f, 0.f}; st[mt] = mfma16(kf[mt][0].v, q0.v, st[mt]); st[mt] = mfma16(kf[mt][1].v, q1.v, st[mt]);
#pragma unroll
            for (int i = 0; i < 4; ++i) { const int s = mt * 16 + fq * 4 + i; const float d = (s <= tl) ? fexp(bm + as_[mt][i]) : 0.f; st[mt][i] = st[mt][i] * 0.125f * d; den += st[mt][i]; } }
        den = red4_sum(den);
        Frag pf[2];
#pragma unroll
        for (int k2 = 0; k2 < 2; ++k2) { pf[k2].w[0] = pk2(st[2 * k2][0], st[2 * k2][1]); pf[k2].w[1] = pk2(st[2 * k2][2], st[2 * k2][3]); pf[k2].w[2] = pk2(st[2 * k2 + 1][0], st[2 * k2 + 1][1]); pf[k2].w[3] = pk2(st[2 * k2 + 1][2], st[2 * k2 + 1][3]); }
        float nq = 0.f;
#pragma unroll
        for (int j = 0; j < 4; ++j) { nq += Nst[fq * 8 + 2 * j] * bflo(q0.w[j]) + Nst[fq * 8 + 2 * j + 1] * bfhi(q0.w[j]); nq += Nst[32 + fq * 8 + 2 * j] * bflo(q1.w[j]) + Nst[32 + fq * 8 + 2 * j + 1] * bfhi(q1.w[j]); }
        nq = red4_sum(nq);
        const float dent = den + inter * nq; const float rden = 1.0f / fmaxf(fabsf(dent), emm);
        f32x4 hv[4]; float ss = 0.f;
#pragma unroll
        for (int et = 0; et < 4; ++et) {
            f32x4 num = {0.f, 0.f, 0.f, 0.f}, cq = {0.f, 0.f, 0.f, 0.f};
#pragma unroll
            for (int k2 = 0; k2 < 2; ++k2) { Frag va; const int e = et * 16 + fr;
#pragma unroll
                for (int j = 0; j < 4; ++j) { const int sa = (2 * k2 + (j >> 1)) * 16 + fq * 4 + 2 * (j & 1); va.w[j] = (unsigned)buf[sa * 72 + e] | ((unsigned)buf[(sa + 1) * 72 + e] << 16); }
                num = mfma16(va.v, pf[k2].v, num); }
#pragma unroll
            for (int ks = 0; ks < 2; ++ks) { const float* cp = Cst + (size_t)(et * 16 + fr) * 64 + ks * 32 + fq * 8; const f32x4 c0 = *(const f32x4*)cp, c1 = *(const f32x4*)(cp + 4);
                Frag ca; ca.w[0] = pk2(c0[0], c0[1]); ca.w[1] = pk2(c0[2], c0[3]); ca.w[2] = pk2(c1[0], c1[1]); ca.w[3] = pk2(c1[2], c1[3]);
                cq = mfma16(ca.v, ks == 0 ? q0.v : q1.v, cq); }
            const v2u ogw = *(const v2u*)(HB + (size_t)(tok0 + tl) * HBP + HB_ML_OG + h * 64 + et * 16 + fq * 4);
            const float og[4] = {bflo(ogw.x), bfhi(ogw.x), bflo(ogw.y), bfhi(ogw.y)};
#pragma unroll
            for (int i = 0; i < 4; ++i) { const float hval = (num[i] + inter * cq[i]) * rden; const float o = hval / (1.0f + fexp(-og[i])); hv[et][i] = o; ss += o * o; }
        }
        ss = red4_sum(ss);
        const float rn = 1.0f / sqrtf(ss * (1.f / 64.f) + NORM_EPS);
        bf16* orow = XN + (size_t)(tok0 + tl) * DM + 256 + h * 64 + fq * 4;
#pragma unroll
        for (int et = 0; et < 4; ++et) { const float* gp = ng + et * 16 + fq * 4; v2u w; w.x = pk2(hv[et][0] * rn * gp[0], hv[et][1] * rn * gp[1]); w.y = pk2(hv[et][2] * rn * gp[2], hv[et][3] * rn * gp[3]); *(v2u*)(orow + et * 16) = w; }
    }
    LDS_WAIT();
}

__device__ __forceinline__ float silu_f(float x) { return x * __builtin_amdgcn_rcpf(1.0f + __builtin_amdgcn_exp2f(-1.4426950408889634f * x)); }
template <int NORM>
__device__ __forceinline__ void gdn_conv_chunk(const bf16* HB, int tok0, bool first, int col0, const float* cw, int ch0, float nscale, LAS bf16* buf, int lane) {
#pragma unroll
    for (int i = 0; i < 9; ++i) { const int idx = i * 64 + lane, r = idx >> 3, c8 = idx & 7;
        if (idx < 67 * 8) { v4u v = {0u, 0u, 0u, 0u}; if (!(first && r < 3)) v = *(const v4u*)(HB + (size_t)(tok0 - 3 + r) * HBP + col0 + c8 * 8); *(LAS v4u*)(buf + r * 72 + c8 * 8) = v; } }
    LDS_WAIT();
    const float w0 = cw[ch0 + lane], w1 = cw[768 + ch0 + lane], w2 = cw[1536 + ch0 + lane], w3 = cw[2304 + ch0 + lane];
    float xm3 = bf2f(buf[0 * 72 + lane]), xm2 = bf2f(buf[1 * 72 + lane]), xm1 = bf2f(buf[2 * 72 + lane]);
#pragma unroll 4
    for (int t = 0; t < 64; ++t) {
        const float x0 = bf2f(buf[(t + 3) * 72 + lane]);
        float o = silu_f(w0 * xm3 + w1 * xm2 + w2 * xm1 + w3 * x0);
        xm3 = xm2; xm2 = xm1; xm1 = x0;
        if (NORM) { const float ss = wave_sum(o * o); o *= nscale / sqrtf(ss + NORM_EPS); }
        buf[t * 72 + lane] = (bf16)f2bf(o);
    }
    LDS_WAIT();
}
__device__ __forceinline__ void gdn_prep_item(int it, int l, const Args& args, LAS unsigned char* wlds, int lane) {
    unsigned char* ws = args.ws; const bf16* HB = (const bf16*)(ws + WS_HB);
    const int bh = it >> 7, n = it & 127, b = bh >> 2, h = bh & 3, tok0 = b * SEQ + n * 64, fr = lane & 15, fq = lane >> 4;
    LAS bf16* buf = (LAS bf16*)wlds; LAS float* sg = (LAS float*)(wlds + 16384);
    const float* cw = opaque(args.in[I_GD_CONV] + (size_t)l * 4 * 768);
    const float alog = opaque(args.in[I_GD_ALOG] + l * 4)[h], dtb = opaque(args.in[I_GD_DT] + l * 4)[h];
    const float beta_l = 1.0f / (1.0f + fexp(-bf2f(HB[(size_t)(tok0 + lane) * HBP + HB_GD_BETA + h])));
    const float apre = bf2f(HB[(size_t)(tok0 + lane) * HBP + HB_GD_A + h]) + dtb;
    const float sp = fmaxf(apre, 0.f) + log1pf(expf(-fabsf(apre)));
    const float gc_l = wave_incl_sum(-fexp(alog) * sp, lane);
    const float gend = __shfl(gc_l, 63);
    sg[lane] = gc_l; sg[64 + lane] = beta_l; sg[128 + lane] = fexp(gc_l);
    LDS_WAIT();
    const size_t cb = (size_t)it * 4096;
    bf16* Wo = (bf16*)(ws + WS_GD_W) + cb; bf16* UTo = (bf16*)(ws + WS_GD_UT) + cb; bf16* KDTo = (bf16*)(ws + WS_GD_KDT) + cb; bf16* QDo = (bf16*)(ws + WS_GD_QD) + cb; bf16* AQKo = (bf16*)(ws + WS_GD_AQK) + cb;
    gdn_conv_chunk<1>(HB, tok0, n == 0, HB_GD_K + h * 64, cw, 256 + h * 64, 1.0f, buf, lane);
#pragma unroll
    for (int t8 = 0; t8 < 8; ++t8) { v4u o;
#pragma unroll
        for (int j = 0; j < 4; ++j) { const int t = t8 * 8 + 2 * j; o[j] = pk2(bf2f(buf[t * 72 + lane]) * fexp(gend - sg[t]), bf2f(buf[(t + 1) * 72 + lane]) * fexp(gend - sg[t + 1])); }
        *(v4u*)(KDTo + lane * 64 + t8 * 8) = o; }
    Frag kf[4][2];
#pragma unroll
    for (int t = 0; t < 4; ++t)
#pragma unroll
        for (int ks = 0; ks < 2; ++ks) kf[t][ks].u = *(const LAS v4u*)(buf + (t * 16 + fr) * 72 + ks * 32 + fq * 8);
    LDS_WAIT();
    gdn_conv_chunk<1>(HB, tok0, n == 0, HB_GD_Q + h * 64, cw, h * 64, 0.125f, buf, lane);
#pragma unroll 8
    for (int t = 0; t < 64; ++t) QDo[t * 64 + lane] = (bf16)f2bf(bf2f(buf[t * 72 + lane]) * sg[128 + t]);
    float gci[4][4], gcj[4];
#pragma unroll
    for (int mt = 0; mt < 4; ++mt)
#pragma unroll
        for (int ii = 0; ii < 4; ++ii) gci[mt][ii] = sg[mt * 16 + fq * 4 + ii];
#pragma unroll
    for (int nt = 0; nt < 4; ++nt) gcj[nt] = sg[nt * 16 + fr];
#pragma unroll
    for (int mt = 0; mt < 4; ++mt) {
        Frag q0, q1; q0.u = *(const LAS v4u*)(buf + (mt * 16 + fr) * 72 + fq * 8); q1.u = *(const LAS v4u*)(buf + (mt * 16 + fr) * 72 + 32 + fq * 8);
#pragma unroll
        for (int nt = 0; nt < 4; ++nt) { f32x4 acc = {0.f, 0.f, 0.f, 0.f};
            if (nt <= mt) { acc = mfma16(q0.v, kf[nt][0].v, acc); acc = mfma16(q1.v, kf[nt][1].v, acc); }
#pragma unroll
            for (int ii = 0; ii < 4; ++ii) { const int i = mt * 16 + fq * 4 + ii, j = nt * 16 + fr; const float vv = (nt <= mt && i >= j) ? acc[ii] * fexp(gci[mt][ii] - gcj[nt]) : 0.f; AQKo[i * 64 + j] = (bf16)f2bf(vv); } } }
    LDS_WAIT();
    gdn_conv_chunk<0>(HB, tok0, n == 0, HB_GD_V + h * 64, cw, 512 + h * 64, 1.0f, buf, lane);
    LAS float* Xl = (LAS float*)wlds;
    { float xx[64];
#pragma unroll
      for (int t = 0; t < 64; ++t) xx[t] = bf2f(buf[t * 72 + lane]) * sg[64 + t];
      LDS_WAIT();
#pragma unroll
      for (int t = 0; t < 64; ++t) Xl[t * 64 + lane] = xx[t]; }
    float am[4][4][4];
#define GDN_SOLVE() do { _Pragma("unroll") for (int mt = 0; mt < 4; ++mt) { \
        _Pragma("unroll") for (int nt = 0; nt < mt; ++nt) { float xo[16]; \
            _Pragma("unroll") for (int jj = 0; jj < 16; ++jj) xo[jj] = Xl[(nt * 16 + jj) * 64 + lane]; \
            for (int fqp = 0; fqp < 4; ++fqp) { _Pragma("unroll") for (int ii = 0; ii < 4; ++ii) { const int i = mt * 16 + fqp * 4 + ii; float xi = Xl[i * 64 + lane]; \
                const float af = am[mt][nt][ii]; const int av = __builtin_bit_cast(int, af); \
                _Pragma("unroll") for (int jj = 0; jj < 16; ++jj) xi -= __builtin_bit_cast(float, __builtin_amdgcn_readlane(av, fqp * 16 + jj)) * xo[jj]; \
                Xl[i * 64 + lane] = xi; } } } \
        { float xd[16]; \
          _Pragma("unroll") for (int r = 0; r < 16; ++r) xd[r] = Xl[(mt * 16 + r) * 64 + lane]; \
          _Pragma("unroll") for (int r = 1; r < 16; ++r) { const float af = am[mt][mt][r & 3]; const int av = __builtin_bit_cast(int, af); \
              _Pragma("unroll") for (int jj = 0; jj < r; ++jj) xd[r] -= __builtin_bit_cast(float, __builtin_amdgcn_readlane(av, (r >> 2) * 16 + jj)) * xd[jj]; } \
          _Pragma("unroll") for (int r = 1; r < 16; ++r) Xl[(mt * 16 + r) * 64 + lane] = xd[r]; } } } while (0)
#pragma unroll
    for (int mt = 0; mt < 4; ++mt)
#pragma unroll
        for (int nt = 0; nt < 4; ++nt) { f32x4 acc = {0.f, 0.f, 0.f, 0.f};
            if (nt <= mt) { acc = mfma16(kf[mt][0].v, kf[nt][0].v, acc); acc = mfma16(kf[mt][1].v, kf[nt][1].v, acc); }
#pragma unroll
            for (int ii = 0; ii < 4; ++ii) { const int i = mt * 16 + fq * 4 + ii, j = nt * 16 + fr; am[mt][nt][ii] = (nt <= mt && i > j) ? acc[ii] * sg[64 + i] * fexp(gci[mt][ii] - gcj[nt]) : 0.f; } }
    asm volatile("" ::: "memory");
    GDN_SOLVE();
#pragma unroll
    for (int t8 = 0; t8 < 8; ++t8) { v4u o;
#pragma unroll
        for (int j = 0; j < 4; ++j) o[j] = pk2(Xl[(t8 * 8 + 2 * j) * 64 + lane], Xl[(t8 * 8 + 2 * j + 1) * 64 + lane]);
        *(v4u*)(UTo + lane * 64 + t8 * 8) = o; }
    LDS_WAIT();
    gdn_conv_chunk<1>(HB, tok0, n == 0, HB_GD_K + h * 64, cw, 256 + h * 64, 1.0f, buf, lane);
    { float xx[64];
#pragma unroll
      for (int t = 0; t < 64; ++t) xx[t] = bf2f(buf[t * 72 + lane]) * sg[64 + t] * sg[128 + t];
      LDS_WAIT();
#pragma unroll
      for (int t = 0; t < 64; ++t) Xl[t * 64 + lane] = xx[t]; }
#pragma unroll
    for (int mt = 0; mt < 4; ++mt)
#pragma unroll
        for (int nt = 0; nt < 4; ++nt) { f32x4 acc = {0.f, 0.f, 0.f, 0.f};
            if (nt <= mt) { acc = mfma16(kf[mt][0].v, kf[nt][0].v, acc); acc = mfma16(kf[mt][1].v, kf[nt][1].v, acc); }
#pragma unroll
            for (int ii = 0; ii < 4; ++ii) { const int i = mt * 16 + fq * 4 + ii, j = nt * 16 + fr; am[mt][nt][ii] = (nt <= mt && i > j) ? acc[ii] * sg[64 + i] * fexp(gci[mt][ii] - gcj[nt]) : 0.f; } }
    asm volatile("" ::: "memory");
    GDN_SOLVE();
#pragma unroll 8
    for (int t = 0; t < 64; ++t) Wo[t * 64 + lane] = (bf16)f2bf(Xl[t * 64 + lane]);
    ((float*)(ws + WS_GD_GE))[it] = fexp(gend);
    LDS_WAIT();
}
__device__ __forceinline__ void gdn_scan_item(int it, const Args& args, int lane) {
    unsigned char* ws = args.ws; const int bh = it >> 2, vg = it & 3, fr = lane & 15, fq = lane >> 4;
    const bf16* Wb = (const bf16*)(ws + WS_GD_W); const bf16* UTb = (const bf16*)(ws + WS_GD_UT); const bf16* KDTb = (const bf16*)(ws + WS_GD_KDT);
    bf16* STb = (bf16*)(ws + WS_GD_ST); bf16* VNTb = (bf16*)(ws + WS_GD_VNT); const float* GE = (const float*)(ws + WS_GD_GE);
    f32x4 S[4];
#pragma unroll
    for (int mt = 0; mt < 4; ++mt) S[mt] = (f32x4){0.f, 0.f, 0.f, 0.f};
#define GDN_SCAN_LOAD(AW, AKD, UTV, GEV, nn) do { const size_t cb_ = (size_t)(bh * 128 + (nn)) * 4096; _Pragma("unroll") for (int mt = 0; mt < 4; ++mt) { _Pragma("unroll") for (int s = 0; s < 2; ++s) { \
        const bf16* wp = Wb + cb_ + (mt * 16 + fr) * 64 + (2 * s) * 16 + fq * 4; const v2u a0 = *(const v2u*)wp, a1 = *(const v2u*)(wp + 16); AW[mt][s].w[0] = a0.x; AW[mt][s].w[1] = a0.y; AW[mt][s].w[2] = a1.x; AW[mt][s].w[3] = a1.y; \
        const bf16* kp = KDTb + cb_ + (mt * 16 + fr) * 64 + (2 * s) * 16 + fq * 4; const v2u k0 = *(const v2u*)kp, k1 = *(const v2u*)(kp + 16); AKD[mt][s].w[0] = k0.x; AKD[mt][s].w[1] = k0.y; AKD[mt][s].w[2] = k1.x; AKD[mt][s].w[3] = k1.y; } \
        UTV[mt] = *(const v2u*)(UTb + cb_ + (vg * 16 + fr) * 64 + mt * 16 + fq * 4); } GEV = GE[bh * 128 + (nn)]; } while (0)
    Frag aw[4][2], akd[4][2], awn[4][2], akdn[4][2]; v2u ut[4], utn[4]; float ge, gen;
    GDN_SCAN_LOAD(aw, akd, ut, ge, 0);
    for (int n = 0; n < 128; ++n) {
        const size_t cb = (size_t)(bh * 128 + n) * 4096;
        { const int nn = (n + 1 < 128) ? n + 1 : n; GDN_SCAN_LOAD(awn, akdn, utn, gen, nn); }
        Frag bS[2];
#pragma unroll
        for (int s = 0; s < 2; ++s) { bS[s].w[0] = pk2(S[2 * s][0], S[2 * s][1]); bS[s].w[1] = pk2(S[2 * s][2], S[2 * s][3]); bS[s].w[2] = pk2(S[2 * s + 1][0], S[2 * s + 1][1]); bS[s].w[3] = pk2(S[2 * s + 1][2], S[2 * s + 1][3]); }
#pragma unroll
        for (int mt = 0; mt < 4; ++mt) { v2u o; o.x = pk2(S[mt][0], S[mt][1]); o.y = pk2(S[mt][2], S[mt][3]); *(v2u*)(STb + cb + (vg * 16 + fr) * 64 + mt * 16 + fq * 4) = o; }
        Frag bV[2]; unsigned vnw[4][2];
#pragma unroll
        for (int mt = 0; mt < 4; ++mt) { f32x4 acc = {0.f, 0.f, 0.f, 0.f}; acc = mfma16(aw[mt][0].v, bS[0].v, acc); acc = mfma16(aw[mt][1].v, bS[1].v, acc);
            const float v0 = bflo(ut[mt].x) - acc[0], v1 = bfhi(ut[mt].x) - acc[1], v2 = bflo(ut[mt].y) - acc[2], v3 = bfhi(ut[mt].y) - acc[3];
            vnw[mt][0] = pk2(v0, v1); vnw[mt][1] = pk2(v2, v3);
            v2u o; o.x = vnw[mt][0]; o.y = vnw[mt][1]; *(v2u*)(VNTb + cb + (vg * 16 + fr) * 64 + mt * 16 + fq * 4) = o; }
#pragma unroll
        for (int s = 0; s < 2; ++s) { bV[s].w[0] = vnw[2 * s][0]; bV[s].w[1] = vnw[2 * s][1]; bV[s].w[2] = vnw[2 * s + 1][0]; bV[s].w[3] = vnw[2 * s + 1][1]; }
#pragma unroll
        for (int mt = 0; mt < 4; ++mt) { f32x4 acc = S[mt] * ge; acc = mfma16(akd[mt][0].v, bV[0].v, acc); acc = mfma16(akd[mt][1].v, bV[1].v, acc); S[mt] = acc; }
#pragma unroll
        for (int mt = 0; mt < 4; ++mt) { aw[mt][0] = awn[mt][0]; aw[mt][1] = awn[mt][1]; akd[mt][0] = akdn[mt][0]; akd[mt][1] = akdn[mt][1]; ut[mt] = utn[mt]; }
        ge = gen;
    }
}
__device__ __forceinline__ void gdn_out_item(int it, int l, const Args& args, int lane) {
    unsigned char* ws = args.ws; const bf16* HB = (const bf16*)(ws + WS_HB); bf16* XN = (bf16*)(ws + WS_XN);
    const int bh = it >> 7, n = it & 127, b = bh >> 2, h = bh & 3, tok0 = b * SEQ + n * 64, fr = lane & 15, fq = lane >> 4;
    const size_t cb = (size_t)it * 4096;
    const bf16* ST = (const bf16*)(ws + WS_GD_ST) + cb; const bf16* VNT = (const bf16*)(ws + WS_GD_VNT) + cb; const bf16* QD = (const bf16*)(ws + WS_GD_QD) + cb; const bf16* AQK = (const bf16*)(ws + WS_GD_AQK) + cb;
    const float* ng = opaque(args.in[I_GD_NG] + l * 64);
    Frag sa[4][2], va[4][2];
#pragma unroll
    for (int vt = 0; vt < 4; ++vt)
#pragma unroll
        for (int ks = 0; ks < 2; ++ks) { sa[vt][ks].u = *(const v4u*)(ST + (vt * 16 + fr) * 64 + ks * 32 + fq * 8); va[vt][ks].u = *(const v4u*)(VNT + (vt * 16 + fr) * 64 + ks * 32 + fq * 8); }
    for (int lt = 0; lt < 4; ++lt) {
        const int tl = lt * 16 + fr;
        Frag qb[2], ab[2];
#pragma unroll
        for (int ks = 0; ks < 2; ++ks) { qb[ks].u = *(const v4u*)(QD + tl * 64 + ks * 32 + fq * 8); ab[ks].u = *(const v4u*)(AQK + tl * 64 + ks * 32 + fq * 8); }
        f32x4 o[4]; float ss = 0.f;
#pragma unroll
        for (int vt = 0; vt < 4; ++vt) { f32x4 acc = {0.f, 0.f, 0.f, 0.f};
#pragma unroll
            for (int ks = 0; ks < 2; ++ks) { acc = mfma16(sa[vt][ks].v, qb[ks].v, acc); acc = mfma16(va[vt][ks].v, ab[ks].v, acc); }
            o[vt] = acc; ss += acc[0] * acc[0] + acc[1] * acc[1] + acc[2] * acc[2] + acc[3] * acc[3]; }
        ss = red4_sum(ss);
        const float rn = 1.0f / sqrtf(ss * (1.f / 64.f) + NORM_EPS);
        bf16* orow = XN + (size_t)(tok0 + tl) * DM + 512 + h * 64 + fq * 4;
#pragma unroll
        for (int vt = 0; vt < 4; ++vt) { const v2u zw = *(const v2u*)(HB + (size_t)(tok0 + tl) * HBP + HB_GD_Z + h * 64 + vt * 16 + fq * 4);
            const float* gp = ng + vt * 16 + fq * 4;
            v2u w; w.x = pk2(o[vt][0] * rn * gp[0] * silu_f(bflo(zw.x)), o[vt][1] * rn * gp[1] * silu_f(bfhi(zw.x))); w.y = pk2(o[vt][2] * rn * gp[2] * silu_f(bflo(zw.y)), o[vt][3] * rn * gp[3] * silu_f(bfhi(zw.y)));
            *(v2u*)(orow + vt * 16) = w; }
    }
}

__device__ __forceinline__ void nsa_cmp_item(int it2, int l, const Args& args, int lane) {
    unsigned char* ws = args.ws; const bf16* HB = (const bf16*)(ws + WS_HB);
    const int it = it2 >> 1, nh = (it2 & 1) * 2;
    const int b = it >> 6, kind = (it >> 5) & 1, jt = it & 31, fr = lane & 15, fq = lane >> 4;
    const bf16* wt = opaque((const bf16*)(ws + WS_WSM + l * WSM_L + (kind ? WSM_CV : WSM_CK)));
    const float* pos = opaque(args.in[I_CMPPOS] + l * 2048);
    const int j = jt * 16 + fr, col = kind ? HB_NSA_VC : HB_NSA_KC;
    f32x4 acc[2];
#pragma unroll
    for (int nt = 0; nt < 2; ++nt) acc[nt] = (f32x4){0.f, 0.f, 0.f, 0.f};
#pragma unroll 4
    for (int ks = 0; ks < 64; ++ks) {
        const int i = ks >> 1, d0 = (ks & 1) * 32 + fq * 8;
        Frag a; a.u = (v4u){0u, 0u, 0u, 0u};
        if (j < 511) { const v4u x = *(const v4u*)(HB + (size_t)(b * SEQ + 16 * j + i) * HBP + col + d0); const float* pp = pos + i * 64 + d0;
#pragma unroll
            for (int q = 0; q < 4; ++q) a.w[q] = pk2(bflo(x[q]) + pp[2 * q], bfhi(x[q]) + pp[2 * q + 1]); }
#pragma unroll
        for (int nt = 0; nt < 2; ++nt) { Frag bw; bw.u = *(const v4u*)(wt + (size_t)((nh + nt) * 16 + fr) * 2048 + ks * 32 + fq * 8); acc[nt] = mfma16(a.v, bw.v, acc[nt]); }
    }
    if (kind == 0) { bf16* Ko = (bf16*)(ws + WS_NSA_KCMP) + (size_t)b * 512 * 64;
#pragma unroll
        for (int nt = 0; nt < 2; ++nt)
#pragma unroll
            for (int i = 0; i < 4; ++i) Ko[(jt * 16 + fq * 4 + i) * 64 + (nh + nt) * 16 + fr] = (bf16)f2bf(acc[nt][i]);
    } else { bf16* Vo = (bf16*)(ws + WS_NSA_VCMPT) + (size_t)b * 64 * 512;
#pragma unroll
        for (int nt = 0; nt < 2; ++nt) { v2u o; o.x = pk2(acc[nt][0], acc[nt][1]); o.y = pk2(acc[nt][2], acc[nt][3]); *(v2u*)(Vo + ((nh + nt) * 16 + fr) * 512 + jt * 16 + fq * 4) = o; } }
}
__device__ __forceinline__ void nsa_vt_item(int it, int l, const Args& args, LAS unsigned char* wlds, int lane) {
    unsigned char* ws = args.ws; const bf16* HB = (const bf16*)(ws + WS_HB);
    const int b = it >> 8, which = (it >> 7) & 1, n = it & 127;
    LAS bf16* buf = (LAS bf16*)wlds;
    stage64(HB, b * SEQ + n * 64, which ? HB_NSA_VW : HB_NSA_VS, buf, lane);
    if (which) {
        const int fr = lane & 15, fq = lane >> 4;
        bf16* vdst = (bf16*)(ws + WS_NSA_VWT) + ((size_t)(b * 256 + n * 2) * 4) * 512 + lane * 8;
        bf16* kdst = (bf16*)(ws + WS_WIN + l * WIN_L) + ((size_t)(b * 256 + n * 2) * 4) * 512 + lane * 8;
#pragma unroll
        for (int hb = 0; hb < 2; ++hb)
#pragma unroll
            for (int dt = 0; dt < 4; ++dt) { v4u o;
#pragma unroll
                for (int q = 0; q < 2; ++q) {
                    o[q] = (unsigned)buf[(hb * 32 + fq * 4 + 2 * q) * 72 + dt * 16 + fr] | ((unsigned)buf[(hb * 32 + fq * 4 + 2 * q + 1) * 72 + dt * 16 + fr] << 16);
                    o[2 + q] = (unsigned)buf[(hb * 32 + 16 + fq * 4 + 2 * q) * 72 + dt * 16 + fr] | ((unsigned)buf[(hb * 32 + 16 + fq * 4 + 2 * q + 1) * 72 + dt * 16 + fr] << 16); }
                *(v4u*)(vdst + (hb * 4 + dt) * 512) = o; }
#pragma unroll
        for (int hb = 0; hb < 2; ++hb)
#pragma unroll
            for (int tt = 0; tt < 2; ++tt)
#pragma unroll
                for (int ks = 0; ks < 2; ++ks) { const v4u x = *(const v4u*)(HB + (size_t)(b * SEQ + n * 64 + hb * 32 + tt * 16 + fr) * HBP + HB_NSA_KW + ks * 32 + fq * 8); *(v4u*)(kdst + (hb * 4 + tt * 2 + ks) * 512) = x; }
    } else {
        const int fr = lane & 15, fq = lane >> 4;
        bf16* vdst = (bf16*)(ws + WS_NSA_VST) + ((size_t)(b * 128 + n) * 8) * 512 + lane * 8;
        bf16* kdst = (bf16*)(ws + WS_NSA_KSW) + ((size_t)(b * 128 + n) * 8) * 512 + lane * 8;
#pragma unroll
        for (int dt = 0; dt < 4; ++dt)
#pragma unroll
            for (int k2 = 0; k2 < 2; ++k2) { v4u o;
#pragma unroll
                for (int q = 0; q < 2; ++q) {
                    o[q] = (unsigned)buf[(k2 * 32 + fq * 4 + 2 * q) * 72 + dt * 16 + fr] | ((unsigned)buf[(k2 * 32 + fq * 4 + 2 * q + 1) * 72 + dt * 16 + fr] << 16);
                    o[2 + q] = (unsigned)buf[(k2 * 32 + 16 + fq * 4 + 2 * q) * 72 + dt * 16 + fr] | ((unsigned)buf[(k2 * 32 + 16 + fq * 4 + 2 * q + 1) * 72 + dt * 16 + fr] << 16); }
                *(v4u*)(vdst + (dt * 2 + k2) * 512) = o; }
#pragma unroll
        for (int kt = 0; kt < 4; ++kt)
#pragma unroll
            for (int ks = 0; ks < 2; ++ks) { const v4u x = *(const v4u*)(HB + (size_t)(b * SEQ + n * 64 + kt * 16 + fr) * HBP + HB_NSA_KS + ks * 32 + fq * 8); *(v4u*)(kdst + (kt * 2 + ks) * 512) = x; }
    }
    LDS_WAIT();
}
__device__ __forceinline__ void nsa_lut_init(const float* t5, LAS float* lut, int lane) {
#pragma unroll
    for (int r = 0; r < 2; ++r) { const int k = r * 64 + lane, d = (k > 0) ? k - 1 : 0; int bk = d;
        if (d >= 16) { bk = 16 + (int)(logf((float)d / 16.0f) / 2.0794415f * 16.0f); bk = bk < 31 ? bk : 31; }
#pragma unroll
        for (int h = 0; h < 4; ++h) lut[h * 128 + k] = (k > 0) ? t5[bk * 4 + h] : -1e30f; }
    LDS_WAIT();
}
#define NSA_BIAS(dist, h, b31v) (lut[(h) * 128 + (((dist) < -1) ? 0 : (((dist) > 126) ? 127 : (dist) + 1))])
__device__ __forceinline__ void nsa_item(int b, int qt, int l, const Args& args, LAS unsigned char* wlds, int lane) {
    unsigned char* ws = args.ws; const bf16* HB = (const bf16*)(ws + WS_HB); bf16* XN = (bf16*)(ws + WS_XN);
    const int t0 = qt * 16, tok0 = b * SEQ + t0, cur = t0 >> 6, fr = lane & 15, fq = lane >> 4;
    LAS bf16* outb = (LAS bf16*)(wlds + 8192); LAS float* imp = (LAS float*)wlds; const LAS float* lut = (const LAS float*)(wlds + 16384);
    const float* t5 = opaque(args.in[I_T5]);
    const float L2E = 1.4426950408889634f;
    Frag qa[4][2];
#pragma unroll
    for (int h = 0; h < 4; ++h)
#pragma unroll
        for (int ks = 0; ks < 2; ++ks) qa[h][ks].u = *(const v4u*)(HB + (size_t)(tok0 + fr) * HBP + HB_NSA_Q + h * 64 + ks * 32 + fq * 8);
    const int tq = t0 + fr;
#pragma unroll
    for (int i = 0; i < 32; ++i) imp[i * 64 + lane] = 0.f;
    const bf16* KC = (const bf16*)(ws + WS_NSA_KCMP) + (size_t)b * 512 * 64; const bf16* VCT = (const bf16*)(ws + WS_NSA_VCMPT) + (size_t)b * 64 * 512;
    const int nblk = t0 >> 4, npair = (nblk + 31) >> 5;
    float mc[4], lc[4];
#pragma unroll
    for (int h = 0; h < 4; ++h) { mc[h] = -1e30f; lc[h] = 0.f; }
    Frag kc1[2];
#pragma unroll
    for (int ks = 0; ks < 2; ++ks) kc1[ks].u = *(const v4u*)(KC + (size_t)fr * 64 + ks * 32 + fq * 8);
    for (int kt = 0; kt < 2 * npair; ++kt) {
        Frag kf[2], kn1[2];
        { const int ktn = (kt + 1 < 2 * npair) ? kt + 1 : kt;
#pragma unroll
          for (int ks = 0; ks < 2; ++ks) kn1[ks].u = *(const v4u*)(KC + (size_t)(ktn * 16 + fr) * 64 + ks * 32 + fq * 8); }
        kf[0].u = kc1[0].u; kf[1].u = kc1[1].u;
#pragma unroll
        for (int h = 0; h < 4; ++h) { f32x4 acc = {0.f, 0.f, 0.f, 0.f}; acc = mfma16(kf[0].v, qa[h][0].v, acc); acc = mfma16(kf[1].v, qa[h][1].v, acc);
            float s[4]; float mx = -1e30f;
#pragma unroll
            for (int i = 0; i < 4; ++i) { const int dist = tq - (16 * (kt * 16 + fq * 4 + i) + 31); const float bb = NSA_BIAS(dist, h, 0); s[i] = acc[i] * 0.125f + bb; mx = fmaxf(mx, s[i]); }
            mx = red4_max(mx);
            const float mn = fmaxf(mc[h], mx); float ps = 0.f;
#pragma unroll
            for (int i = 0; i < 4; ++i) ps += __builtin_amdgcn_exp2f((s[i] - fmaxf(mn, -1e20f)) * L2E);
            lc[h] = lc[h] * __builtin_amdgcn_exp2f((mc[h] - mn) * L2E) + ps; mc[h] = mn; }
        kc1[0].u = kn1[0].u; kc1[1].u = kn1[1].u;
    }
#pragma unroll
    for (int h = 0; h < 4; ++h) { float t = lc[h]; t = red4_sum(t); lc[h] = (t > 0.f) ? 1.0f / t : 0.f; }
    f32x4 oc[4][4];
#pragma unroll
    for (int dt = 0; dt < 4; ++dt)
#pragma unroll
        for (int h = 0; h < 4; ++h) oc[dt][h] = (f32x4){0.f, 0.f, 0.f, 0.f};
    for (int kp = 0; kp < npair; ++kp) {
        unsigned pw[4][4];
#pragma unroll
        for (int tt = 0; tt < 2; ++tt) { const int kt = kp * 2 + tt; Frag kf[2];
#pragma unroll
            for (int ks = 0; ks < 2; ++ks) kf[ks].u = *(const v4u*)(KC + (size_t)(kt * 16 + fr) * 64 + ks * 32 + fq * 8);
            float impv = 0.f;
#pragma unroll
            for (int h = 0; h < 4; ++h) { f32x4 acc = {0.f, 0.f, 0.f, 0.f}; acc = mfma16(kf[0].v, qa[h][0].v, acc); acc = mfma16(kf[1].v, qa[h][1].v, acc);
                float p[4];
#pragma unroll
                for (int i = 0; i < 4; ++i) { const int dist = tq - (16 * (kt * 16 + fq * 4 + i) + 31);
                    const float bb = NSA_BIAS(dist, h, 0); p[i] = __builtin_amdgcn_exp2f(((acc[i] * 0.125f + bb) - fmaxf(mc[h], -1e20f)) * L2E) * lc[h]; }
                impv += p[0] + p[1] + p[2];
                pw[h][2 * tt] = pk2(p[0], p[1]); pw[h][2 * tt + 1] = pk2(p[2], p[3]); }
            imp[fr * 128 + kt * 4 + fq] = impv; __builtin_amdgcn_sched_barrier(0); }
#pragma unroll
        for (int dt = 0; dt < 4; ++dt) { const bf16* vp = VCT + (size_t)(dt * 16 + fr) * 512 + kp * 32 + fq * 4; const v2u lo2 = *(const v2u*)vp, hi2 = *(const v2u*)(vp + 16);
            Frag vf; vf.w[0] = lo2.x; vf.w[1] = lo2.y; vf.w[2] = hi2.x; vf.w[3] = hi2.y;
#pragma unroll
            for (int h = 0; h < 4; ++h) { Frag pf; pf.w[0] = pw[h][0]; pf.w[1] = pw[h][1]; pf.w[2] = pw[h][2]; pf.w[3] = pw[h][3]; oc[dt][h] = mfma16(vf.v, pf.v, oc[dt][h]); } }
    }
#pragma unroll
    for (int h = 0; h < 4; ++h) { const float gc_ = 1.0f / (1.0f + expf(-bf2f(HB[(size_t)(tok0 + fr) * HBP + HB_NSA_G + 0 + h])));
#pragma unroll
        for (int dt = 0; dt < 4; ++dt) { v2u w; w.x = pk2(oc[dt][h][0] * gc_, oc[dt][h][1] * gc_); w.y = pk2(oc[dt][h][2] * gc_, oc[dt][h][3] * gc_); *(LAS v2u*)(outb + fr * 256 + h * 64 + dt * 16 + fq * 4) = w; } }
    LDS_WAIT();
    unsigned taken = 0u;
    if (cur >= 16) {
        float cand[32];
#pragma unroll
        for (int k = 0; k < 32; ++k) { const int s = fq * 32 + k; cand[k] = (s >= 1 && s <= cur - 2) ? imp[fr * 128 + s] : -1.0f; }
        for (int r = 0; r < 13; ++r) {
            float bv = -1.0f; int bk = 0;
#pragma unroll
            for (int k = 0; k < 32; ++k) { const bool free_ = ((taken >> k) & 1u) == 0u; if (free_ && cand[k] > bv) { bv = cand[k]; bk = k; } }
            int bs = fq * 32 + bk;
#pragma unroll
            for (int o = 16; o <= 32; o <<= 1) { const float ov = __shfl_xor(bv, o); const int os = __shfl_xor(bs, o); if (ov > bv || (ov == bv && os < bs)) { bv = ov; bs = os; } }
            taken |= ((bs >> 5) == fq && bv >= 0.f) ? (1u << (bs & 31)) : 0u;
        }
        taken |= (fq == 0) ? 1u : 0u;
        taken |= ((cur >> 5) == fq) ? (1u << (cur & 31)) : 0u;
        taken |= (((cur - 1) >> 5) == fq) ? (1u << ((cur - 1) & 31)) : 0u;
    } else {
        taken = (fq == 0) ? ((2u << cur) - 1u) : 0u;
    }
    LDS_WAIT();
    const bf16* VST = (const bf16*)(ws + WS_NSA_VST) + (size_t)b * 128 * 4096; const bf16* KSW = (const bf16*)(ws + WS_NSA_KSW) + (size_t)b * 128 * 4096;
    { const int qi = fr >> 2, hh = fr & 3;
      LAS unsigned char* blist = (LAS unsigned char*)wlds;
#define NSA_SEL_LOADK(KF, sblk_) do { const bf16* kp_ = KSW + (size_t)(sblk_) * 4096 + lane * 8; \
        _Pragma("unroll") for (int kt = 0; kt < 4; ++kt) _Pragma("unroll") for (int ks = 0; ks < 2; ++ks) KF[kt][ks].u = *(const v4u*)(kp_ + (kt * 2 + ks) * 512); } while (0)
#define NSA_SEL_LOADV(VF, sblk_) do { const bf16* vp_ = VST + (size_t)(sblk_) * 4096 + lane * 8; \
        _Pragma("unroll") for (int dt = 0; dt < 4; ++dt) _Pragma("unroll") for (int k2 = 0; k2 < 2; ++k2) VF[dt][k2].u = *(const v4u*)(vp_ + (dt * 2 + k2) * 512); } while (0)
#define NSA_SEL_STEP_(KF, VF, sblk_, FAR) do { const int key0 = (sblk_) * 64; const unsigned mwd_ = ((sblk_) >> 5) == 0 ? mw0 : ((sblk_) >> 5) == 1 ? mw1 : ((sblk_) >> 5) == 2 ? mw2 : mw3; const float selm_ = (((mwd_ >> ((sblk_) & 31)) & 1u) != 0u) ? 0.f : -1e30f; \
        f32x4 sc[4]; float mx = -1e30f; const float c0_ = bfar_ + selm_;     \
        _Pragma("unroll") for (int kt = 0; kt < 4; ++kt) { f32x4 acc = {0.f, 0.f, 0.f, 0.f}; acc = mfma16(KF[kt][0].v, qs[0].v, acc); acc = mfma16(KF[kt][1].v, qs[1].v, acc); \
            _Pragma("unroll") for (int i = 0; i < 4; ++i) { if (FAR) sc[kt][i] = acc[i] * 0.125f + c0_; else { const int dist = tqs - (key0 + kt * 16 + fq * 4 + i); const float bb = NSA_BIAS(dist, hh, 0); sc[kt][i] = (acc[i] * 0.125f + bb) + selm_; } mx = fmaxf(mx, sc[kt][i]); } } \
        mx = red4_max(mx); \
        const float mn = fmaxf(ms, mx), alpha = __builtin_amdgcn_exp2f((ms - mn) * L2E), nml_ = -fmaxf(mn, -1e20f) * L2E; ms = mn; \
        float ps = 0.f; unsigned pw[4][2]; \
        _Pragma("unroll") for (int kt = 0; kt < 4; ++kt) { float p[4]; \
            _Pragma("unroll") for (int i = 0; i < 4; ++i) { p[i] = __builtin_amdgcn_exp2f(__builtin_fmaf(sc[kt][i], L2E, nml_)); ps += p[i]; } \
            pw[kt][0] = pk2(p[0], p[1]); pw[kt][1] = pk2(p[2], p[3]); } \
        if (__builtin_amdgcn_ballot_w64(alpha != 1.0f) != 0ull) { ls = ls * alpha; _Pragma("unroll") for (int dt = 0; dt < 4; ++dt) os_[dt] = os_[dt] * alpha; }     \
        ls += ps; \
        _Pragma("unroll") for (int dt = 0; dt < 4; ++dt) { \
            _Pragma("unroll") for (int k2 = 0; k2 < 2; ++k2) { Frag pf; pf.w[0] = pw[2 * k2][0]; pf.w[1] = pw[2 * k2][1]; pf.w[2] = pw[2 * k2 + 1][0]; pf.w[3] = pw[2 * k2 + 1][1]; os_[dt] = mfma16(VF[dt][k2].v, pf.v, os_[dt]); } } } while (0)
#define NSA_SEL_STEP(KF, VF, sblk_) do { if ((sblk_) * 64 + 189 <= t0 + g * 4) NSA_SEL_STEP_(KF, VF, sblk_, 1); else NSA_SEL_STEP_(KF, VF, sblk_, 0); } while (0)
    const float bfar_ = lut[hh * 128 + 127];
    for (int g = 0; g < 4; ++g) {
        const int tqs = t0 + g * 4 + qi;
        Frag qs[2];
#pragma unroll
        for (int ks = 0; ks < 2; ++ks) qs[ks].u = *(const v4u*)(HB + (size_t)(tok0 + g * 4 + qi) * HBP + HB_NSA_Q + hh * 64 + ks * 32 + fq * 8);
        f32x4 os_[4];
#pragma unroll
        for (int dt = 0; dt < 4; ++dt) os_[dt] = (f32x4){0.f, 0.f, 0.f, 0.f};
        float ms = -1e30f, ls = 0.f;
        const unsigned mw0 = (unsigned)__shfl((int)taken, (g * 4 + qi)), mw1 = (unsigned)__shfl((int)taken, (g * 4 + qi) + 16), mw2 = (unsigned)__shfl((int)taken, (g * 4 + qi) + 32), mw3 = (unsigned)__shfl((int)taken, (g * 4 + qi) + 48);
        int nb = 0;
        for (int wd = 0; wd < 4; ++wd) { unsigned uni = 0u;
#pragma unroll
            for (int q2 = 0; q2 < 4; ++q2) uni |= (unsigned)__shfl((int)taken, (g * 4 + q2) + 16 * wd);
            uni = (unsigned)__builtin_amdgcn_readfirstlane((int)uni);
            while (uni) { const int bit = __builtin_ctz(uni); uni &= uni - 1u; blist[nb] = (unsigned char)(wd * 32 + bit); ++nb; } }
        LDS_WAIT();
        Frag kA[4][2], kB[4][2], vv[4][2];
        { const int s0b = __builtin_amdgcn_readfirstlane((int)blist[0]); NSA_SEL_LOADK(kA, s0b); }
        for (int i = 0; i < nb; i += 2) {
            const int sa = __builtin_amdgcn_readfirstlane((int)blist[i]); const int sb = __builtin_amdgcn_readfirstlane((int)blist[(i + 1 < nb) ? i + 1 : i]);
            NSA_SEL_LOADV(vv, sa); NSA_SEL_LOADK(kB, sb);
            NSA_SEL_STEP(kA, vv, sa);
            if (i + 1 < nb) { const int sc2 = __builtin_amdgcn_readfirstlane((int)blist[(i + 2 < nb) ? i + 2 : i]); NSA_SEL_LOADV(vv, sb); NSA_SEL_LOADK(kA, sc2); NSA_SEL_STEP(kB, vv, sb); }
        }
        ls = red4_sum(ls);
        const float gsel = (1.0f / (1.0f + expf(-bf2f(HB[(size_t)(tok0 + g * 4 + qi) * HBP + HB_NSA_G + 4 + hh])))) / ls;
#pragma unroll
        for (int dt = 0; dt < 4; ++dt) { LAS v2u* op = (LAS v2u*)(outb + (g * 4 + qi) * 256 + hh * 64 + dt * 16 + fq * 4); const v2u a = *op; v2u w; w.x = pk2(bflo(a.x) + os_[dt][0] * gsel, bfhi(a.x) + os_[dt][1] * gsel); w.y = pk2(bflo(a.y) + os_[dt][2] * gsel, bfhi(a.y) + os_[dt][3] * gsel); *op = w; }
    } }
    LDS_WAIT();
#pragma unroll
    for (int h = 0; h < 4; ++h)
#pragma unroll
        for (int ks = 0; ks < 2; ++ks) qa[h][ks].u = *(const v4u*)(opaque(HB) + (size_t)(tok0 + fr) * HBP + HB_NSA_Q + h * 64 + ks * 32 + fq * 8);
    const bf16* VWT = (const bf16*)(ws + WS_NSA_VWT) + (size_t)b * 256 * 2048; const bf16* KWW = (const bf16*)(ws + WS_WIN + l * WIN_L) + (size_t)b * 256 * 2048;
    f32x4 ow[4][4];
#pragma unroll
    for (int dt = 0; dt < 4; ++dt)
#pragma unroll
        for (int h = 0; h < 4; ++h) ow[dt][h] = (f32x4){0.f, 0.f, 0.f, 0.f};
    float mw_[4], lw[4];
#pragma unroll
    for (int h = 0; h < 4; ++h) { mw_[h] = -1e30f; lw[h] = 0.f; }
    const int kstart = (t0 >= 512) ? ((t0 - 511) & ~31) : 0;
#define NSA_WIN_LOAD(KF, VF, k0_) do { _Pragma("unroll") for (int tt = 0; tt < 2; ++tt) _Pragma("unroll") for (int ks = 0; ks < 2; ++ks) KF[tt][ks].u = *(const v4u*)(KWW + (size_t)((k0_) >> 5) * 2048 + (tt * 2 + ks) * 512 + lane * 8); \
        _Pragma("unroll") for (int dt = 0; dt < 4; ++dt) VF[dt].u = *(const v4u*)(VWT + (size_t)((k0_) >> 5) * 2048 + dt * 512 + lane * 8); } while (0)
    Frag kf[2][2], vf[4];
    NSA_WIN_LOAD(kf, vf, kstart);
    for (int k0 = kstart; k0 < t0 + 16; k0 += 32) {
        Frag kn[2][2], vn[4];
        { const int k1 = (k0 + 32 < t0 + 16) ? k0 + 32 : k0; NSA_WIN_LOAD(kn, vn, k1); }
#pragma unroll
        for (int h = 0; h < 4; ++h) {
            float s[8]; float mx = -1e30f;
#pragma unroll
            for (int tt = 0; tt < 2; ++tt) { f32x4 acc = {0.f, 0.f, 0.f, 0.f}; acc = mfma16(kf[tt][0].v, qa[h][0].v, acc); acc = mfma16(kf[tt][1].v, qa[h][1].v, acc);
#pragma unroll
                for (int i = 0; i < 4; ++i) { const int dist = tq - (k0 + tt * 16 + fq * 4 + i); const float bb = NSA_BIAS(dist, h, 0); s[tt * 4 + i] = (acc[i] * 0.125f + bb) + ((dist < 512) ? 0.f : -1e30f); mx = fmaxf(mx, s[tt * 4 + i]); } }
            mx = red4_max(mx);
            const float mn = fmaxf(mw_[h], mx), alpha = __builtin_amdgcn_exp2f((mw_[h] - mn) * L2E); mw_[h] = mn;
            float p[8]; float ps = 0.f;
#pragma unroll
            for (int i = 0; i < 8; ++i) { p[i] = __builtin_amdgcn_exp2f((s[i] - fmaxf(mn, -1e20f)) * L2E); ps += p[i]; }
            lw[h] = lw[h] * alpha + ps;
            Frag pf; pf.w[0] = pk2(p[0], p[1]); pf.w[1] = pk2(p[2], p[3]); pf.w[2] = pk2(p[4], p[5]); pf.w[3] = pk2(p[6], p[7]);
#pragma unroll
            for (int dt = 0; dt < 4; ++dt) { ow[dt][h] = ow[dt][h] * alpha; ow[dt][h] = mfma16(vf[dt].v, pf.v, ow[dt][h]); }
            __builtin_amdgcn_sched_barrier(0);
        }
#pragma unroll
        for (int tt = 0; tt < 2; ++tt)
#pragma unroll
            for (int ks = 0; ks < 2; ++ks) kf[tt][ks].u = kn[tt][ks].u;
#pragma unroll
        for (int dt = 0; dt < 4; ++dt) vf[dt].u = vn[dt].u;
    }
#pragma unroll
    for (int h = 0; h < 4; ++h) { float t = lw[h]; t = red4_sum(t);
        const float gw_ = (1.0f / (1.0f + expf(-bf2f(HB[(size_t)(tok0 + fr) * HBP + HB_NSA_G + 8 + h])))) / t;
#pragma unroll
        for (int dt = 0; dt < 4; ++dt) { const v2u a = *(const LAS v2u*)(outb + fr * 256 + h * 64 + dt * 16 + fq * 4);
            v2u w; w.x = pk2(bflo(a.x) + ow[dt][h][0] * gw_, bfhi(a.x) + ow[dt][h][1] * gw_); w.y = pk2(bflo(a.y) + ow[dt][h][2] * gw_, bfhi(a.y) + ow[dt][h][3] * gw_); *(v2u*)(XN + (size_t)(tok0 + fr) * DM + h * 64 + dt * 16 + fq * 4) = w; } }
    LDS_WAIT();
}

#define PEER_SU 64.0f
#define PEER_SV 8.0f
#define PEER_SX 16.0f
typedef float f32x2v __attribute__((ext_vector_type(2)));
__device__ __forceinline__ float gelu_erf(float x) { return 0.5f * x * (1.0f + erff(x * 0.70710678118654752f)); }
template<int MODE> __device__ __forceinline__ void peer_item(int it, int l, const Args& args, LAS unsigned char* wlds, int lane) {
    unsigned char* ws = args.ws; const bf16* QP = (const bf16*)(ws + WS_PEER_QP);
    const int tok0 = it * 16, fr = lane & 15, fq = lane >> 4;
    LAS unsigned short* eidx = (LAS unsigned short*)wlds; LAS float* egate = (LAS float*)(wlds + 4096); LAS float* tkv = (LAS float*)(wlds + 12288);
    LAS float* cbuf = (LAS float*)(wlds + 16384); LAS unsigned char* ctab = (LAS unsigned char*)(wlds + 16384 + 512);
    const bf16* keys = opaque((const bf16*)(ws + WS_PKEYS) + (size_t)l * 8 * 2 * 128 * 128);
    if (MODE & 1) {
    { int c = 0, ij = 0xFF;
#pragma unroll
      for (int i = 0; i < 16; ++i)
#pragma unroll
          for (int j = 0; j < 16; ++j) if ((i + 1) * (j + 1) <= 16) { ij = (c == lane) ? ((i << 4) | j) : ij; ++c; }
      ctab[lane] = (unsigned char)ij; }
    LDS_WAIT();
    Frag qb[4], ka[8][4];
#define PA_LOAD(pc_) do { const bf16* kb_ = keys + (size_t)(pc_) * 128 * 128 + lane * 8;     \
        _Pragma("unroll") for (int ks = 0; ks < 4; ++ks) qb[ks].u = *(const v4u*)(QP + (size_t)(tok0 + fr) * 2048 + (pc_) * 128 + ks * 32 + fq * 8); \
        _Pragma("unroll") for (int mt = 0; mt < 8; ++mt) _Pragma("unroll") for (int ks = 0; ks < 4; ++ks) ka[mt][ks].u = *(const v4u*)(kb_ + (mt * 4 + ks) * 512); } while (0)
    PA_LOAD(0);
    for (int pc = 0; pc < 16; ++pc) {
        const int p = pc >> 1, c = pc & 1;
        {
            float sc[32];
#pragma unroll
            for (int mt = 0; mt < 8; ++mt) { f32x4 acc = {0.f, 0.f, 0.f, 0.f};
#pragma unroll
                for (int ks = 0; ks < 4; ++ks) acc = mfma16(ka[mt][ks].v, qb[ks].v, acc);
#pragma unroll
                for (int i = 0; i < 4; ++i) sc[mt * 4 + i] = __uint_as_float((__float_as_uint(acc[i]) & 0xFFFFFF80u) | (unsigned)(mt * 16 + fq * 4 + i)); }
            { const int pn = (pc < 15) ? pc + 1 : 15; PA_LOAD(pn); }
            __builtin_amdgcn_sched_barrier(0);
#pragma unroll
            for (int k = 2; k <= 32; k <<= 1)
#pragma unroll
                for (int j = k >> 1; j > 0; j >>= 1)
#pragma unroll
                    for (int i = 0; i < 32; ++i) { const int l2 = i ^ j; if (l2 > i) { const float a = sc[i], b2 = sc[l2]; const bool desc = (i & k) == 0; sc[i] = desc ? fmaxf(a, b2) : fminf(a, b2); sc[l2] = desc ? fminf(a, b2) : fmaxf(a, b2); } }
            for (int r = 0; r < 16; ++r) { const float w = red4_max(sc[0]); const bool own = (sc[0] == w);
#pragma unroll
                for (int k = 0; k < 15; ++k) sc[k] = own ? sc[k + 1] : sc[k];
                sc[15] = own ? -3.0e38f : sc[15];
                tkv[c * 256 + fr * 16 + r] = w; }
        }
        if (c == 0) continue;
        LDS_WAIT();
        float cs[16];
#pragma unroll
        for (int r = 0; r < 13; ++r) { const int cid = 4 * r + fq; const int ij = ctab[cid];
            const float v1 = tkv[fr * 16 + (ij >> 4)], v2 = tkv[256 + fr * 16 + (ij & 15)];
            cs[r] = (ij == 0xFF) ? -3.0e38f : __uint_as_float((__float_as_uint(v1 + v2) & 0xFFFFFFC0u) | (unsigned)cid); }
        cs[13] = -3.0e38f; cs[14] = -3.0e38f; cs[15] = -3.0e38f;
#pragma unroll
        for (int k = 2; k <= 16; k <<= 1)
#pragma unroll
            for (int j = k >> 1; j > 0; j >>= 1)
#pragma unroll
                for (int i = 0; i < 16; ++i) { const int l2 = i ^ j; if (l2 > i) { const float a = cs[i], b2 = cs[l2]; const bool desc = (i & k) == 0; cs[i] = desc ? fmaxf(a, b2) : fminf(a, b2); cs[l2] = desc ? fminf(a, b2) : fmaxf(a, b2); } }
        float top0 = 0.f, den = 0.f;
        for (int rr = 0; rr < 16; ++rr) { const float w = red4_max(cs[0]); const bool own = (cs[0] == w);
#pragma unroll
            for (int k = 0; k < 15; ++k) cs[k] = own ? cs[k + 1] : cs[k];
            cs[15] = own ? -3.0e38f : cs[15];
            const int ij = ctab[__float_as_uint(w) & 63u];
            const int i1 = (int)(__float_as_uint(tkv[fr * 16 + (ij >> 4)]) & 127u), i2 = (int)(__float_as_uint(tkv[256 + fr * 16 + (ij & 15)]) & 127u);
            if (rr == 0) top0 = w;
            const float ex = __builtin_amdgcn_exp2f((w - top0) * 1.4426950408889634f); den += ex;
            eidx[fr * 128 + p * 16 + rr] = (unsigned short)(i1 * 128 + i2); egate[fr * 128 + p * 16 + rr] = ex; }
        LDS_WAIT();
        { const float rden = 1.0f / den;
#pragma unroll
          for (int rr = 0; rr < 16; ++rr) egate[fr * 128 + p * 16 + rr] *= rden; }
        LDS_WAIT();
    }
    }
    LDS_WAIT();
    if (!(MODE & 2)) return;
    const float* ngain = opaque((l + 1 < DEPTH) ? (args.in[I_N1G] + (l + 1) * DM) : args.in[I_FNG]);
    const unsigned char* U8 = (const unsigned char*)(ws + WS_PEER_U); const unsigned char* V8 = (const unsigned char*)(ws + WS_PEER_V); const unsigned char* X8 = (const unsigned char*)(ws + WS_PEER_X8);
#define PU_LOAD(S, ks_) do { XA[S] = *(const v4u*)(X8 + tok * DM + (ks_) * 64 + fq * 16); \
        _Pragma("unroll") for (int et = 0; et < 8; ++et) UB[S][et] = *(const v4u*)(U8 + (size_t)el[et] * DM + (ks_) * 64 + fq * 16); } while (0)
#define PU_MMA(S) do { const long xa0 = (long)(((unsigned long long)XA[S][1] << 32) | XA[S][0]), xa1 = (long)(((unsigned long long)XA[S][3] << 32) | XA[S][2]); \
        _Pragma("unroll") for (int et = 0; et < 8; ++et) { const long ub0 = (long)(((unsigned long long)UB[S][et][1] << 32) | UB[S][et][0]), ub1 = (long)(((unsigned long long)UB[S][et][3] << 32) | UB[S][et][2]); \
            acc[et] = __builtin_amdgcn_mfma_f32_16x16x32_fp8_fp8(xa0, ub0, acc[et], 0, 0, 0); acc[et] = __builtin_amdgcn_mfma_f32_16x16x32_fp8_fp8(xa1, ub1, acc[et], 0, 0, 0); } } while (0)
#define PV_LOAD(S, e_) do { _Pragma("unroll") for (int e2 = 0; e2 < 8; ++e2) { const int ex = eidx[t * 128 + (e_) + e2]; VV[S][e2] = *(const v4u*)(V8 + (size_t)ex * DM + lane * 16); } } while (0)
#define PV_FMA(S, e_) do { _Pragma("unroll") for (int e2 = 0; e2 < 8; ++e2) { const float ce = cbuf[(e_) + e2]; \
        _Pragma("unroll") for (int k = 0; k < 4; ++k) { const f32x2v lo2 = __builtin_amdgcn_cvt_pk_f32_fp8((int)VV[S][e2][k], false), hi2 = __builtin_amdgcn_cvt_pk_f32_fp8((int)VV[S][e2][k], true); \
            o[4 * k] += ce * lo2.x; o[4 * k + 1] += ce * lo2.y; o[4 * k + 2] += ce * hi2.x; o[4 * k + 3] += ce * hi2.y; } if (e2 & 1) __builtin_amdgcn_sched_barrier(0); } } while (0)
    for (int t = 0; t < 16; ++t) {
        const size_t tok = (size_t)(tok0 + t);
        const int lane_t = lane_id_v();
        const int lane = lane_t, fr = lane_t & 15, fq = lane_t >> 4;
        const int fr7 = fr & 7, hf = fr >> 3;
        v4u VV[2][8];
#pragma unroll
        for (int tp = 0; tp < 2; ++tp) {
            int el[8];
#pragma unroll
            for (int et = 0; et < 8; ++et) el[et] = eidx[t * 128 + (tp * 8 + et) * 8 + fr7];
            f32x4 acc[8];
#pragma unroll
            for (int et = 0; et < 8; ++et) acc[et] = (f32x4){0.f, 0.f, 0.f, 0.f};
#pragma unroll 2
            for (int ks = 0; ks < 8; ++ks) {
                v4u UB[8];
                const v4u XA = *(const v4u*)(X8 + tok * DM + ks * 128 + (fr & 1) * 64 + fq * 16);
#pragma unroll
                for (int et = 0; et < 8; ++et) UB[et] = *(const v4u*)(U8 + (size_t)el[et] * DM + ks * 128 + hf * 64 + fq * 16);
                const long xa0 = (long)(((unsigned long long)XA[1] << 32) | XA[0]), xa1 = (long)(((unsigned long long)XA[3] << 32) | XA[2]);
#pragma unroll
                for (int et = 0; et < 8; ++et) { const long ub0 = (long)(((unsigned long long)UB[et][1] << 32) | UB[et][0]), ub1 = (long)(((unsigned long long)UB[et][3] << 32) | UB[et][2]);
                    acc[et] = __builtin_amdgcn_mfma_f32_16x16x32_fp8_fp8(xa0, ub0, acc[et], 0, 0, 0); acc[et] = __builtin_amdgcn_mfma_f32_16x16x32_fp8_fp8(xa1, ub1, acc[et], 0, 0, 0); }
            }
            if (tp == 1) { PV_LOAD(0, 0); PV_LOAD(1, 8); }
#pragma unroll
            for (int et = 0; et < 8; ++et) { const float v = hf ? acc[et][1] : acc[et][0]; const float tv = v + dpp_mov<0x128>(v);     const int e = (tp * 8 + et) * 8 + fr7;
                const pg8::f32x2 gv_ = pg8::gelu_pk((pg8::f32x2){tv * (1.0f / (PEER_SX * PEER_SU)), 0.f});
                const float c = egate[t * 128 + e] * gv_.x * (1.0f / PEER_SV);
                cbuf[(fq == 0 && hf == 0) ? e : 192 + lane] = c; }
        }
        LDS_WAIT();
        float o[16];
#pragma unroll
        for (int k = 0; k < 16; ++k) o[k] = 0.f;
        for (int e = 0; e < 112; e += 16) {
            PV_FMA(0, e); PV_LOAD(0, e + 16);
            PV_FMA(1, e + 8); PV_LOAD(1, e + 24);
        }
        PV_FMA(0, 112); PV_FMA(1, 120);
        const int lane_e = lane_id_v();
        float* hrow = args.out + tok * DM + lane_e * 16; float ss = 0.f;
#pragma unroll
        for (int k4 = 0; k4 < 4; ++k4) { const f32x4 hv = *(const f32x4*)(hrow + 4 * k4);
#pragma unroll
            for (int k = 0; k < 4; ++k) { o[4 * k4 + k] += hv[k]; ss += o[4 * k4 + k] * o[4 * k4 + k]; } }
        const float rn = 1.0f / sqrtf(wave_sum(ss) * (1.f / DM) + NORM_EPS);
        const float* gp = ngain + lane_e * 16;
        if (l + 1 < DEPTH) {
#pragma unroll
            for (int k4 = 0; k4 < 4; ++k4) { f32x4 hv = {o[4 * k4], o[4 * k4 + 1], o[4 * k4 + 2], o[4 * k4 + 3]}; *(f32x4*)(hrow + 4 * k4) = hv; }
            bf16* xrow = (bf16*)(ws + WS_XN) + tok * DM + lane_e * 16; v4u w0, w1;
#pragma unroll
            for (int k = 0; k < 4; ++k) { w0[k] = pk2(o[2 * k] * rn * gp[2 * k], o[2 * k + 1] * rn * gp[2 * k + 1]); w1[k] = pk2(o[8 + 2 * k] * rn * gp[8 + 2 * k], o[8 + 2 * k + 1] * rn * gp[8 + 2 * k + 1]); }
            *(v4u*)xrow = w0; *(v4u*)(xrow + 8) = w1;
        } else {
#pragma unroll
            for (int k4 = 0; k4 < 4; ++k4) { f32x4 hv = {o[4 * k4] * rn * gp[4 * k4], o[4 * k4 + 1] * rn * gp[4 * k4 + 1], o[4 * k4 + 2] * rn * gp[4 * k4 + 2], o[4 * k4 + 3] * rn * gp[4 * k4 + 3]}; *(f32x4*)(hrow + 4 * k4) = hv; }
        }
        LDS_WAIT();
    }
}

#ifndef MK_SPLIT
#define MK_SPLIT 0
#endif

#define IN(k) (lo <= (k) && (k) < hi)
#define SEAM(k) do { if (IN(k) && IN((k) + 1)) xcd_barrier(bar, wave == 0 && lane_id_v() == 0); } while (0)
template <int l>
__device__ __forceinline__ void layer_phases(const Args& args, LAS unsigned char* lds, const XcdBarrier& bar, const int lo, const int hi, const int wave) {
    constexpr int G = GRID_WG; const int bx = blockIdx.x;
    const int gw = bx * NWAVES + wave, NGW = G * NWAVES, vw = wave * G + bx;
    unsigned char* ws = args.ws;
    unsigned* ctl = (unsigned*)(ws + WS_CTL);
    LAS unsigned char* wlds = lds + wave * WAVE_LDS;
    bf16* XN = (bf16*)(ws + WS_XN); bf16* HB = (bf16*)(ws + WS_HB);
    (void)gw; (void)NGW; (void)ctl; (void)wlds; (void)HB; (void)vw;
        const int pb = 1 + 8 * l;
        if (IN(pb + 0)) {
            const int lane = lane_id_v(); (void)lane;
            pg8::Gemm g{XN, (const bf16*)(ws + WS_WIN + l * WIN_L), M_TOK, N_IN_PAD, DM}; pg8::StaticOrder S; S.init(M_TOK, N_IN_PAD, G, bx);
            pg8::EpiHb E{HB, HBP, HBP};
            pg8::gemm_phase<pg8::EpiHb, pg8::StaticOrder, true, true>(lds, g, S, E, wave);
        }
        SEAM(pb + 0);
        if (IN(pb + 1)) {
            const int lane = lane_id_v(); (void)lane;
            { const int it = vw - 256; if (it >= 0 && it < 512) nsa_cmp_item(it, l, args, lane_id_v()); }
            for (int it = vw; it < 2048; it += NGW) { gdn_prep_item(it, l, args, wlds, lane_id_v()); }
            for (int it = vw; it < M_TOK / 16; it += NGW) { mla_prep_item(it, l, args, lane_id_v()); }
            for (int it = vw; it < 2048; it += NGW) { mlstm_prep_item(it, l, args, wlds, lane_id_v()); }
            { const int it = vw - 1024; if (it >= 0) nsa_vt_item(it, l, args, wlds, lane_id_v()); }
        }
        SEAM(pb + 1);
        if (IN(pb + 2)) {
            const int lane = lane_id_v(); (void)lane;
            nsa_lut_init(args.in[I_T5], (LAS float*)(wlds + 16384), lane);
            { const int it = vw - 256; if (it >= 0 && it < 64) gdn_scan_item(it, args, lane_id_v()); }
            { const int it = vw; if (it < 256) mlstm_scan_item(it, args, lane_id_v()); }
            for (int it = vw; it < 2048; it += NGW) { mla_attn_item(it & 15, 127 - (it >> 4), args, wlds, lane_id_v()); }
            { unsigned* qh = ctl + CW_Q + 64 * (l * 8 + (bx & 7));
              for (;;) { const int m = wave_pop(qh, lane_id_v()); if (m >= 256) break; const int j = 8 * m + (7 - (bx & 7)); nsa_item(j & 3, 511 - (j >> 2), l, args, wlds, lane_id_v()); } }
        }
        SEAM(pb + 2);
        if (IN(pb + 3)) {
            const int lane = lane_id_v(); (void)lane;
            for (int it = vw; it < 2048; it += NGW) { gdn_out_item(it, l, args, lane_id_v()); }
            for (int it = vw; it < 2048; it += NGW) { mlstm_out_item(it, l, args, wlds, lane_id_v()); }
            {
                const f32x4* su = (const f32x4*)(args.in[I_PEER_U] + (size_t)l * 16384 * DM); const f32x4* sv = (const f32x4*)(args.in[I_PEER_V] + (size_t)l * 16384 * DM);
                v4u* du = (v4u*)(ws + WS_PEER_U); v4u* dv = (v4u*)(ws + WS_PEER_V);
                unsigned* du32 = (unsigned*)du; unsigned* dv32 = (unsigned*)dv;
                for (size_t c = (size_t)gw; c < (size_t)16384 * DM / 1024; c += (size_t)NGW) {
                    f32x4 a[4], b2[4];
#pragma unroll
                    for (int q = 0; q < 4; ++q) { a[q] = su[c * 256 + q * 64 + lane]; b2[q] = sv[c * 256 + q * 64 + lane]; }
#pragma unroll
                    for (int q = 0; q < 4; ++q) {
                        int pa = __builtin_amdgcn_cvt_pk_fp8_f32(a[q][0] * PEER_SU, a[q][1] * PEER_SU, 0, false); pa = __builtin_amdgcn_cvt_pk_fp8_f32(a[q][2] * PEER_SU, a[q][3] * PEER_SU, pa, true);
                        int pb2 = __builtin_amdgcn_cvt_pk_fp8_f32(b2[q][0] * PEER_SV, b2[q][1] * PEER_SV, 0, false); pb2 = __builtin_amdgcn_cvt_pk_fp8_f32(b2[q][2] * PEER_SV, b2[q][3] * PEER_SV, pb2, true);
                        du32[c * 256 + q * 64 + lane] = (unsigned)pa; dv32[c * 256 + q * 64 + lane] = (unsigned)pb2; }
                }
            }
        }
        SEAM(pb + 3);
        if (IN(pb + 4)) {
            const int lane = lane_id_v(); (void)lane;
            pg8::Gemm g{XN, (const bf16*)(ws + WS_WOUT + l * WOUT_L), M_TOK, DM, DM}; pg8::StaticOrder S; S.init(M_TOK, DM, G, bx);
            pg8::EpiRes E{args.out, l == 0 ? args.in[I_X] : (const float*)args.out, DM};
            pg8::gemm_phase<pg8::EpiRes, pg8::StaticOrder, true, true>(lds, g, S, E, wave);
        }
        SEAM(pb + 4);
        if (IN(pb + 5)) {
            const int lane = lane_id_v(); (void)lane;
            {
                const float* g2 = args.in[I_N2G] + l * DM; unsigned char* X8 = ws + WS_PEER_X8;
                f32x4 gg[4];
#pragma unroll
                for (int j = 0; j < 4; ++j) gg[j] = ((const f32x4*)g2)[lane + 64 * j];
                for (int m0 = gw; m0 < M_TOK; m0 += 4 * NGW) {
                    f32x4 v[4][4]; float s[4];
#pragma unroll
                    for (int q = 0; q < 4; ++q) { const f32x4* xr = (const f32x4*)(args.out + (size_t)(m0 + q * NGW) * DM) + lane; s[q] = 0.f;
#pragma unroll
                        for (int j = 0; j < 4; ++j) { v[q][j] = xr[64 * j]; s[q] += (v[q][j].x * v[q][j].x + v[q][j].y * v[q][j].y) + (v[q][j].z * v[q][j].z + v[q][j].w * v[q][j].w); } }
#pragma unroll
                    for (int q = 0; q < 4; ++q) { const size_t m = (size_t)(m0 + q * NGW); const float r = 1.0f / sqrtf(wave_sum(s[q]) * (1.f / DM) + NORM_EPS);
#pragma unroll
                        for (int j = 0; j < 4; ++j) { const float y0 = v[q][j].x * r * gg[j].x, y1 = v[q][j].y * r * gg[j].y, y2 = v[q][j].z * r * gg[j].z, y3 = v[q][j].w * r * gg[j].w;
                            v2u o; o.x = pk2(y0, y1); o.y = pk2(y2, y3); ((v2u*)(XN + m * DM))[lane + 64 * j] = o;
                            int p8 = __builtin_amdgcn_cvt_pk_fp8_f32(y0 * PEER_SX, y1 * PEER_SX, 0, false); p8 = __builtin_amdgcn_cvt_pk_fp8_f32(y2 * PEER_SX, y3 * PEER_SX, p8, true);
                            ((int*)(X8 + m * DM))[lane + 64 * j] = p8; } }
                }
            }
        }
        SEAM(pb + 5);
        if (IN(pb + 6)) {
            const int lane = lane_id_v(); (void)lane;
            pg8::Gemm g{XN, (const bf16*)(ws + WS_WQ + l * WQ_L), M_TOK, 2048, DM}; pg8::StaticOrder S; S.init(M_TOK, 2048, G, bx);
            pg8::EpiBf16<0> E{(bf16*)(ws + WS_PEER_QP), 2048, nullptr, 0, 0, 1.f};
            pg8::gemm_phase<pg8::EpiBf16<0>, pg8::StaticOrder, true, true>(lds, g, S, E, wave);
        }
        SEAM(pb + 6);
        if (IN(pb + 7)) {
            const int lane = lane_id_v(); (void)lane;
            static_assert(G * NWAVES == M_TOK / 16, "one PEER item per wave");
            for (int it = vw; it < M_TOK / 16; it += NGW) { peer_item<1>(it, l, args, wlds, lane_id_v()); }
            for (int it = vw; it < M_TOK / 16; it += NGW) { peer_item<2>(it, l, args, wlds, lane_id_v()); }
        }
        SEAM(pb + 7);
}

__global__ void __launch_bounds__(NWAVES * 64, 2) fwd_kernel(Args args) {
    extern __shared__ __attribute__((aligned(16))) unsigned char lds_raw[];
    LAS unsigned char* lds = (LAS unsigned char*)lds_raw;
    volatile LAS unsigned* MISC = (volatile LAS unsigned*)(lds + MISC_OFF);
    const int wave = __builtin_amdgcn_readfirstlane((int)(threadIdx.x >> 6)); const int tid = wave * 64 + lane_id_v();
    constexpr int G = GRID_WG; const int bx = blockIdx.x;
    const int gw = bx * NWAVES + wave, NGW = G * NWAVES;
    unsigned char* ws = args.ws;
    unsigned* ctl = (unsigned*)(ws + WS_CTL);
    for (int u = tid; u < (LDS_BYTES - MISC_OFF) / 4; u += NWAVES * 64) MISC[u] = 0u;
    __syncthreads();
    XcdBarrier bar; bar.bar = ctl + CW_BAR; bar.x = 0; bar.st = nullptr;
    if (!MK_SPLIT) bar = xcd_barrier_post(ctl + CW_BAR, MISC + 8, tid == 0);
    const int lo = args.ph_lo, hi = args.ph_hi;
    LAS unsigned char* wlds = lds + wave * WAVE_LDS;
    bf16* XN = (bf16*)(ws + WS_XN); bf16* HB = (bf16*)(ws + WS_HB);

    if (IN(0)) {
        const int lane = lane_id_v();
        LAS float* scr = (LAS float*)wlds;
        constexpr int I_IN = (DM / 64) * (N_IN_PAD / 32), I_OUT = (DM / 64) * (DM / 32), I_Q = (DM / 64) * (2048 / 32);
        constexpr int I_UQ = (256 / 64) * (384 / 32), I_UKV = (128 / 64) * (512 / 32), I_CMP = (2048 / 64) * (64 / 32);
        constexpr int PER_L = I_IN + I_OUT + I_Q + I_UQ + I_UKV + 2 * I_CMP;
        for (int it = gw; it < DEPTH * PER_L; it += NGW) {
            const int l = it / PER_L; int r = it % PER_L;
            unsigned char* wsm = ws + WS_WSM + l * WSM_L;
            if (r < I_IN) { tr_item(args.in[I_WIN] + (size_t)l * DM * D_IN, D_IN, D_IN, MapHb(), (bf16*)(ws + WS_WIN + l * WIN_L), DM, scr, r / (N_IN_PAD / 32), r % (N_IN_PAD / 32), lane); continue; } r -= I_IN;
            if (r < I_OUT) { tr_item(args.in[I_WOUT] + (size_t)l * DM * DM, DM, DM, MapId(), (bf16*)(ws + WS_WOUT + l * WOUT_L), DM, scr, r / (DM / 32), r % (DM / 32), lane); continue; } r -= I_OUT;
            if (r < I_Q) { tr_item(args.in[I_PEER_WQ] + (size_t)l * DM * 2048, 2048, 2048, MapId(), (bf16*)(ws + WS_WQ + l * WQ_L), DM, scr, r / (2048 / 32), r % (2048 / 32), lane); continue; } r -= I_Q;
            if (r < I_UQ) { tr_item(args.in[I_MLA_WUQ] + (size_t)l * 256 * 384, 384, 384, MapId(), (bf16*)(wsm + WSM_UQ), 256, scr, r / (384 / 32), r % (384 / 32), lane); continue; } r -= I_UQ;
            if (r < I_UKV) { tr_item(args.in[I_MLA_WUKV] + (size_t)l * 128 * 512, 512, 512, MapId(), (bf16*)(wsm + WSM_UKV), 128, scr, r / (512 / 32), r % (512 / 32), lane); continue; } r -= I_UKV;
            if (r < I_CMP) { tr_item(args.in[I_CMPK] + (size_t)l * 2048 * 64, 64, 64, MapId(), (bf16*)(wsm + WSM_CK), 2048, scr, r / 2, r % 2, lane); continue; } r -= I_CMP;
            tr_item(args.in[I_CMPV] + (size_t)l * 2048 * 64, 64, 64, MapId(), (bf16*)(wsm + WSM_CV), 2048, scr, r / 2, r % 2, lane);
        }
        { const f32x4* ksrc = (const f32x4*)args.in[I_PEER_KEYS]; v2u* kdst = (v2u*)(ws + WS_PKEYS);
          for (int i = gw * 64 + lane; i < DEPTH * 16 * 128 * 128 / 4; i += NGW * 64) { const f32x4 a = ksrc[i]; v2u o; o.x = pk2(a[0], a[1]); o.y = pk2(a[2], a[3]);
              const int mat = i >> 12, m = (i >> 5) & 127, k4 = (i & 31) * 4;
              kdst[(size_t)mat * 4096 + ((((m >> 4) * 4 + (k4 >> 5)) * 64 + ((k4 >> 3) & 3) * 16 + (m & 15)) * 8 + (k4 & 7)) / 4] = o; } }
        for (int m0 = gw; m0 < M_TOK; m0 += 4 * NGW) {
            f32x4 v[4][4]; float s[4];
#pragma unroll
            for (int q = 0; q < 4; ++q) { const f32x4* xr = (const f32x4*)(args.in[I_X] + (size_t)(m0 + q * NGW) * DM) + lane; s[q] = 0.f;
#pragma unroll
                for (int j = 0; j < 4; ++j) { v[q][j] = xr[64 * j]; s[q] += (v[q][j].x * v[q][j].x + v[q][j].y * v[q][j].y) + (v[q][j].z * v[q][j].z + v[q][j].w * v[q][j].w); } }
#pragma unroll
            for (int q = 0; q < 4; ++q) { const float r = 1.0f / sqrtf(wave_sum(s[q]) * (1.f / DM) + NORM_EPS); v2u* o8 = (v2u*)(XN + (size_t)(m0 + q * NGW) * DM) + lane;
#pragma unroll
                for (int j = 0; j < 4; ++j) { const f32x4 gg = ((const f32x4*)args.in[I_N1G])[lane + 64 * j]; v2u o; o.x = pk2(v[q][j].x * r * gg.x, v[q][j].y * r * gg.y); o.y = pk2(v[q][j].z * r * gg.z, v[q][j].w * r * gg.w); o8[64 * j] = o; } }
        }
    }
    SEAM(0);

    layer_phases<0>(args, lds, bar, lo, hi, wave);
    layer_phases<1>(args, lds, bar, lo, hi, wave);
#undef IN
#undef SEAM
}

extern "C" void kernel_launch(void* const* d_in, const int* in_sizes, int n_in, void* d_out, int out_size, void* d_ws, size_t ws_size, hipStream_t stream) {
    static int grid = 0;
    if (grid == 0) {
        if (n_in != 26 || in_sizes[0] != M_TOK * DM || out_size != M_TOK * DM || ws_size < WS_END) { fprintf(stderr, "kernel_launch: unexpected shapes/workspace (n_in %d, ws %zu < %zu)\n", n_in, ws_size, (size_t)WS_END); grid = -1; return; }
        int dev = 0, cus = 0, per_cu = 0;
        if (hipGetDevice(&dev) != hipSuccess || hipDeviceGetAttribute(&cus, hipDeviceAttributeMultiprocessorCount, dev) != hipSuccess) { grid = -1; return; }
        if (hipFuncSetAttribute((const void*)fwd_kernel, hipFuncAttributeMaxDynamicSharedMemorySize, LDS_BYTES) != hipSuccess) { fprintf(stderr, "kernel_launch: hipFuncSetAttribute failed\n"); grid = -1; return; }
        if (hipOccupancyMaxActiveBlocksPerMultiprocessor(&per_cu, (const void*)fwd_kernel, NWAVES * 64, LDS_BYTES) != hipSuccess || per_cu < 1) { fprintf(stderr, "kernel_launch: occupancy query says %d blocks per CU\n", per_cu); }
        (void)hipGetLastError();
        if (cus < GRID_WG) { fprintf(stderr, "kernel_launch: %d CUs < %d workgroups: the grid would not be resident\n", cus, GRID_WG); grid = -1; return; }
        grid = GRID_WG;
    }
    if (grid < 0) return;
    if (hipMemsetAsync((char*)d_ws + WS_CTL, 0, CTL_ZERO_BYTES, stream) != hipSuccess) return;
    Args a{};
    for (int i = 0; i < 26; ++i) a.in[i] = (const float*)d_in[i];
    a.out = (float*)d_out; a.ws = (unsigned char*)d_ws;
#if MK_SPLIT
    for (int p = 0; p < N_PHASES; ++p) { a.ph_lo = p; a.ph_hi = p + 1; hipLaunchKernelGGL(fwd_kernel, dim3(grid), dim3(NWAVES * 64), LDS_BYTES, stream, a); }
#else
    a.ph_lo = 0; a.ph_hi = N_PHASES;
    hipLaunchKernelGGL(fwd_kernel, dim3(grid), dim3(NWAVES * 64), LDS_BYTES, stream, a);
#endif
    const hipError_t le = hipPeekAtLastError();
    if (le != hipSuccess) fprintf(stderr, "kernel_launch: launch failed: %s\n", hipGetErrorName(le));
}
```

```cpp
#include <hip/hip_runtime.h>
#include <cstdio>
#include <cstdint>

namespace pg8 {
#define PG8_LAS __attribute__((address_space(3)))
typedef unsigned short bf16_t;
typedef short bf16x8 __attribute__((ext_vector_type(8)));
typedef float f32x4 __attribute__((ext_vector_type(4)));
typedef unsigned u32x4 __attribute__((ext_vector_type(4)));
constexpr int BM = 256, BK = 64, HALF = 128, HTB = HALF * BK * 2  , STAGE_BYTES = 8 * HTB, NXCD = 8, WGM = 8;

__host__ __device__ __forceinline__ int lds_byte(int r, int c) { const int st = (r >> 4) * 2 + (c >> 5), rr = r & 15, cc = c & 31, ob = rr * 64 + cc * 2; return st * 1024 + (ob ^ (((ob >> 9) & 1) << 5)); }
__host__ __device__ __forceinline__ void stage_rc(int b, int& R, int& C) { const int st = b / 1024, sb = b % 1024, swz = sb ^ (((sb >> 9) & 1) << 5); R = (st >> 1) * 16 + swz / 64; C = (st & 1) * 32 + (swz % 64) / 2; }
__host__ __device__ __forceinline__ int perm32(int rho) { const int n = rho >> 4, i = rho & 15; return 8 * (i >> 2) + 4 * n + (i & 3); }

struct Unit { int pm, pn; };
struct Gemm { const bf16_t* A; const bf16_t* Bt; int M, N, K; };

struct StaticOrder {
    int nM, nN, nwg, G, c;
    __host__ __device__ void init(int M, int N, int G_, int c_) { nM = M / BM; nN = N / BM; nwg = nM * nN; G = G_; c = c_; }
    __host__ __device__ bool next(int i, Unit& u) const {
        const long L = (long)i * G + c; if (L >= nwg) return false;
        int wgid = (int)L; { const int q = nwg / NXCD, r = nwg % NXCD, xcd = wgid % NXCD, off = wgid / NXCD; wgid = (xcd < r ? xcd * (q + 1) : r * (q + 1) + (xcd - r) * q) + off; }
        const int nig = WGM * nN, gid = wgid / nig, fm = gid * WGM, gsz = (nM - fm) < WGM ? (nM - fm) : WGM;
        u.pm = fm + ((wgid % nig) % gsz); u.pn = (wgid % nig) / gsz; return true;
    }
    __device__ __forceinline__ void a_ready(const Unit&) const {}
    __device__ __forceinline__ void done(const Unit&) const {}
};

typedef __bf16 pg8_bf16x2 __attribute__((ext_vector_type(2)));
typedef float pg8_f32x2 __attribute__((ext_vector_type(2)));
__device__ __forceinline__ unsigned cvt_pk_bf16(float lo, float hi) { const pg8_f32x2 v = {lo, hi}; const pg8_bf16x2 b = __builtin_convertvector(v, pg8_bf16x2); return __builtin_bit_cast(unsigned, b); }
typedef float f32x2 __attribute__((ext_vector_type(2)));
__device__ __forceinline__ f32x2 gelu_pk(f32x2 v) {
    const f32x2 av = __builtin_elementwise_abs(v), d = av * 0.2316418882f + 1.0f;
    f32x2 t; t.x = __builtin_amdgcn_rcpf(d.x); t.y = __builtin_amdgcn_rcpf(d.y);
    f32x2 q = t * 0.5307027145f + (-0.7265760135f); q = q * t + 0.7107068705f; q = q * t + (-0.142248368f); q = q * t + 0.127414796f; q = q * t;
    const f32x2 s = (v * v) * (-0.72134752044f);
    f32x2 e; e.x = __builtin_amdgcn_exp2f(s.x); e.y = __builtin_amdgcn_exp2f(s.y);
    const f32x2 m = v * (q * e), r = v - m;
    f32x2 o; o.x = v.x < 0.f ? m.x : r.x; o.y = v.y < 0.f ? m.y : r.y; return o;
}


template <int ACT  > struct EpiBf16 {
    static constexpr bool PERM = true, AFTER_DRAIN = false; static_assert(ACT == 0 || ACT == 1, "EpiBf16: ACT is 0 (none) or 1 (gelu_pk)");
    bf16_t* O; int ldc; const float* bias; int split_cols; size_t split_stride; float scale0;
    __device__ __forceinline__ void operator()(const f32x4 (&acc)[2][2][4][2], const Unit& u, int wr, int wc, int fr, int fq) const {
        const int row0 = u.pm * BM + wr * 64 + fr; int colt = u.pn * BM; bf16_t* base = O;
        float sc = 1.f; if (split_cols) { const int t = colt / split_cols; base += (size_t)t * split_stride; colt -= t * split_cols; if (t == 0) sc = scale0; }
        const int col0 = colt + wc * 32 + 8 * fq, bcol0 = u.pn * BM + wc * 32 + 8 * fq;
        f32x4 bv[2][2];
#pragma unroll
        for (int bj = 0; bj < 2; ++bj)
#pragma unroll
            for (int n = 0; n < 2; ++n) bv[bj][n] = bias ? *(const f32x4*)(bias + bcol0 + bj * HALF + 4 * n) : (f32x4){0.f, 0.f, 0.f, 0.f};
#pragma unroll
        for (int ai = 0; ai < 2; ++ai)
#pragma unroll
            for (int m = 0; m < 4; ++m) { bf16_t* rowp = base + (size_t)(row0 + ai * HALF + m * 16) * ldc + col0;
#pragma unroll
                for (int bj = 0; bj < 2; ++bj) { f32x4 v0 = acc[ai][bj][m][0] + bv[bj][0], v1 = acc[ai][bj][m][1] + bv[bj][1];
                    if (ACT == 1) { f32x2 a = gelu_pk((f32x2){v0[0], v0[1]}), b = gelu_pk((f32x2){v0[2], v0[3]}), c = gelu_pk((f32x2){v1[0], v1[1]}), d = gelu_pk((f32x2){v1[2], v1[3]});
                        v0 = (f32x4){a.x, a.y, b.x, b.y}; v1 = (f32x4){c.x, c.y, d.x, d.y}; }
                    v0 = v0 * sc; v1 = v1 * sc; u32x4 w; w.x = cvt_pk_bf16(v0[0], v0[1]); w.y = cvt_pk_bf16(v0[2], v0[3]); w.z = cvt_pk_bf16(v1[0], v1[1]); w.w = cvt_pk_bf16(v1[2], v1[3]);
                    *(u32x4*)(rowp + bj * HALF) = w; } }
    }
};

struct EpiHb {
    static constexpr bool PERM = true, AFTER_DRAIN = false;
    bf16_t* O; int ldc; int ncols;
    __device__ __forceinline__ void operator()(const f32x4 (&acc)[2][2][4][2], const Unit& u, int wr, int wc, int fr, int fq) const {
        const int row0 = u.pm * BM + wr * 64 + fr; const int col0 = u.pn * BM + wc * 32 + 8 * fq;
#pragma unroll
        for (int ai = 0; ai < 2; ++ai)
#pragma unroll
            for (int m = 0; m < 4; ++m) { bf16_t* rowp = O + (size_t)(row0 + ai * HALF + m * 16) * ldc + col0;
#pragma unroll
                for (int bj = 0; bj < 2; ++bj) { const f32x4 v0 = acc[ai][bj][m][0], v1 = acc[ai][bj][m][1];
                    u32x4 w; w.x = cvt_pk_bf16(v0[0], v0[1]); w.y = cvt_pk_bf16(v0[2], v0[3]); w.z = cvt_pk_bf16(v1[0], v1[1]); w.w = cvt_pk_bf16(v1[2], v1[3]);
                    if (col0 + bj * HALF < ncols) *(u32x4*)(rowp + bj * HALF) = w; } }
    }
};
struct EpiRes {
    static constexpr bool PERM = false, AFTER_DRAIN = false;
    float* C; const float* R; int ldc;
    __device__ __forceinline__ void operator()(const f32x4 (&acc)[2][2][4][2], const Unit& u, int wr, int wc, int fr, int fq) const {
        const int row0 = u.pm * BM + wr * 64 + fr, col0 = u.pn * BM + wc * 32 + 4 * fq;
#pragma unroll
        for (int ai = 0; ai < 2; ++ai)
#pragma unroll
            for (int m = 0; m < 4; ++m) { const size_t ro = (size_t)(row0 + ai * HALF + m * 16) * ldc + col0;
#pragma unroll
                for (int bj = 0; bj < 2; ++bj)
#pragma unroll
                    for (int n = 0; n < 2; ++n) { const f32x4 r = *(const f32x4*)(R + ro + bj * HALF + n * 16); *(f32x4*)(C + ro + bj * HALF + n * 16) = acc[ai][bj][m][n] + r; } }
    }
};


template <class Epi, class Sched, bool ALIGN_EPI = false, bool SP2 = false>
__device__ __forceinline__ void gemm_phase(PG8_LAS unsigned char* lds, const Gemm g, const Sched& S, const Epi& E, const int wave_in) {
    const int wid = wave_in, lane = (int)__builtin_amdgcn_mbcnt_hi(~0u, __builtin_amdgcn_mbcnt_lo(~0u, 0u)), tid = wid * 64 + lane, wr = wid >> 2, wc = wid & 3, fr = lane & 15, fq = lane >> 4;
    const int K = g.K, nt = K / BK;
    unsigned voffA[2], voffB[2];
#pragma unroll
    for (int i = 0; i < 2; ++i) { int R, C; stage_rc(tid * 16 + i * 8192, R, C); const int Rb = Epi::PERM ? ((R & ~31) + perm32(R & 31)) : R;
        voffA[i] = (unsigned)(R * K + C) * 2u; voffB[i] = (unsigned)(Rb * K + C) * 2u; }
    const size_t kstep = (size_t)(BK * 2);
    const size_t hstep = (size_t)HALF * K * 2;
    const size_t tstep = 2 * hstep;
    const unsigned ldsw = (unsigned)wid * 1024u;
    const int aoff = lds_byte(wr * 64 + fr, fq * 8), boff = lds_byte(wc * 32 + fr, fq * 8);
#define PG8_SA(b, h) (((b) * 2 + (h)) * HTB)
#define PG8_SB(b, h) ((4 + (b) * 2 + (h)) * HTB)
#define PG8_STAGE(bufoff, gbase, voff) do { _Pragma("unroll") for (int _i = 0; _i < 2; ++_i) \
        __builtin_amdgcn_global_load_lds((const unsigned*)((const char*)(gbase) + (voff)[_i]), (PG8_LAS unsigned*)(lds + (bufoff) + ldsw + _i * 8192), 16, 0, 0); } while (0)
#define PG8_LDA(dst, b, h) do { _Pragma("unroll") for (int m = 0; m < 4; ++m) _Pragma("unroll") for (int k = 0; k < 2; ++k) dst[m][k] = *(const PG8_LAS bf16x8*)(lds + PG8_SA(b, h) + aoff + m * 2048 + k * 1024); } while (0)
#define PG8_LDB(dst, b, h) do { _Pragma("unroll") for (int n = 0; n < 2; ++n) _Pragma("unroll") for (int k = 0; k < 2; ++k) dst[n][k] = *(const PG8_LAS bf16x8*)(lds + PG8_SB(b, h) + boff + n * 2048 + k * 1024); } while (0)
#define PG8_MMA(ai, bj, At, Bt) do { __builtin_amdgcn_s_setprio(1); _Pragma("unroll") for (int m = 0; m < 4; ++m) _Pragma("unroll") for (int n = 0; n < 2; ++n) _Pragma("unroll") for (int k = 0; k < 2; ++k) \
        acc[ai][bj][m][n] = __builtin_amdgcn_mfma_f32_16x16x32_bf16(Bt[n][k], At[m][k], acc[ai][bj][m][n], 0, 0, 0); __builtin_amdgcn_s_setprio(0); } while (0)
#define PG8_WAIT_V(n) asm volatile("s_waitcnt vmcnt(" #n ")" ::: "memory")
#define PG8_WAIT_L(n) asm volatile("s_waitcnt lgkmcnt(" #n ")" ::: "memory")
#define PG8_BAR __builtin_amdgcn_s_barrier()
#define PG8_SCHED __builtin_amdgcn_sched_barrier(0)
    Unit cur, nxt; int ui = 0;
    if (!S.next(0, cur)) return;
    f32x4 acc[2][2][4][2];
#pragma unroll
    for (int a = 0; a < 2; ++a)
#pragma unroll
        for (int b = 0; b < 2; ++b)
#pragma unroll
            for (int m = 0; m < 4; ++m)
#pragma unroll
                for (int n = 0; n < 2; ++n) acc[a][b][m][n] = (f32x4){0.f, 0.f, 0.f, 0.f};
    bf16x8 At[4][2], B0[2][2], B1[2][2];
    const char* cA = (const char*)g.A + (size_t)cur.pm * tstep; const char* cB = (const char*)g.Bt + (size_t)cur.pn * tstep;
    S.a_ready(cur);
    if constexpr (SP2) {
        PG8_STAGE(PG8_SB(0, 0), cB, voffB); PG8_STAGE(PG8_SB(0, 1), cB + hstep, voffB); PG8_STAGE(PG8_SA(0, 0), cA, voffA); PG8_STAGE(PG8_SA(0, 1), cA + hstep, voffA);
        if (wr == 1) PG8_BAR;
        PG8_WAIT_V(2); PG8_BAR;
        PG8_STAGE(PG8_SB(1, 0), cB + kstep, voffB); PG8_STAGE(PG8_SA(1, 0), cA + kstep, voffA); PG8_STAGE(PG8_SB(1, 1), cB + hstep + kstep, voffB);
        PG8_WAIT_V(6); PG8_BAR;
    } else {
        PG8_STAGE(PG8_SB(0, 0), cB, voffB); PG8_STAGE(PG8_SA(0, 0), cA, voffA); PG8_STAGE(PG8_SB(0, 1), cB + hstep, voffB); PG8_STAGE(PG8_SA(0, 1), cA + hstep, voffA);
        if (wr == 1) PG8_BAR;
        PG8_WAIT_V(4); PG8_BAR;
        PG8_STAGE(PG8_SB(1, 0), cB + kstep, voffB); PG8_STAGE(PG8_SA(1, 0), cA + kstep, voffA); PG8_STAGE(PG8_SB(1, 1), cB + hstep + kstep, voffB);
        PG8_WAIT_V(6); PG8_BAR;
    }
    for (;;) {
        const bool has_next = S.next(ui + 1, nxt);
        const char* nA = has_next ? (const char*)g.A + (size_t)nxt.pm * tstep : cA; const char* nB = has_next ? (const char*)g.Bt + (size_t)nxt.pn * tstep : cB;
        for (int t = 0; t < nt; t += 2) {
            const bool last = (t == nt - 2);
            const char* a1 = cA + (size_t)(t + 1) * kstep;
            const char* a2 = last ? nA : cA + (size_t)(t + 2) * kstep; const char* b2 = last ? nB : cB + (size_t)(t + 2) * kstep;
            const char* a3 = a2 + kstep; const char* b3 = b2 + kstep;
            if (last && has_next) S.a_ready(nxt);
            if constexpr (SP2) {
            PG8_LDB(B0, 0, 0); PG8_LDB(B1, 0, 1); PG8_SCHED; PG8_LDA(At, 0, 0); PG8_STAGE(PG8_SA(1, 1), a1 + hstep, voffA);
            PG8_WAIT_V(8); PG8_WAIT_L(0); PG8_BAR; PG8_MMA(0, 0, At, B0); PG8_MMA(0, 1, At, B1); PG8_BAR; PG8_SCHED;
            PG8_LDA(At, 0, 1); PG8_STAGE(PG8_SB(0, 0), b2, voffB); PG8_STAGE(PG8_SB(0, 1), b2 + hstep, voffB); PG8_STAGE(PG8_SA(0, 0), a2, voffA);
            PG8_WAIT_V(8); PG8_WAIT_L(0); PG8_BAR; PG8_MMA(1, 0, At, B0); PG8_MMA(1, 1, At, B1); PG8_BAR; PG8_SCHED;
            PG8_LDB(B0, 1, 0); PG8_LDB(B1, 1, 1); PG8_SCHED; PG8_LDA(At, 1, 0); PG8_STAGE(PG8_SA(0, 1), a2 + hstep, voffA);
            PG8_WAIT_V(8); PG8_WAIT_L(0); PG8_BAR; PG8_MMA(0, 0, At, B0); PG8_MMA(0, 1, At, B1); PG8_BAR; PG8_SCHED;
            PG8_LDA(At, 1, 1); PG8_STAGE(PG8_SB(1, 0), b3, voffB); PG8_STAGE(PG8_SB(1, 1), b3 + hstep, voffB); PG8_STAGE(PG8_SA(1, 0), a3, voffA);
            PG8_WAIT_V(8); PG8_WAIT_L(0); PG8_BAR; PG8_MMA(1, 0, At, B0); PG8_MMA(1, 1, At, B1); PG8_BAR; PG8_SCHED;
            } else {
            PG8_LDB(B0, 0, 0); PG8_SCHED; PG8_LDA(At, 0, 0); PG8_STAGE(PG8_SA(1, 1), a1 + hstep, voffA);
            PG8_WAIT_L(8); PG8_BAR; PG8_WAIT_L(0); PG8_MMA(0, 0, At, B0); PG8_BAR; PG8_SCHED;
            PG8_LDB(B1, 0, 1); PG8_STAGE(PG8_SB(0, 0), b2, voffB);
            PG8_BAR; PG8_WAIT_L(0); PG8_MMA(0, 1, At, B1); PG8_BAR;
            PG8_LDA(At, 0, 1); PG8_STAGE(PG8_SA(0, 0), a2, voffA);
            PG8_BAR; PG8_WAIT_L(0); PG8_MMA(1, 0, At, B0); PG8_BAR; PG8_SCHED;
            PG8_STAGE(PG8_SB(0, 1), b2 + hstep, voffB);
            PG8_WAIT_V(6); PG8_BAR; PG8_MMA(1, 1, At, B1); PG8_BAR;
            PG8_LDB(B0, 1, 0); PG8_SCHED; PG8_LDA(At, 1, 0); PG8_STAGE(PG8_SA(0, 1), a2 + hstep, voffA);
            PG8_WAIT_L(8); PG8_BAR; PG8_WAIT_L(0); PG8_MMA(0, 0, At, B0); PG8_BAR; PG8_SCHED;
            PG8_LDB(B1, 1, 1); PG8_STAGE(PG8_SB(1, 0), b3, voffB);
            PG8_BAR; PG8_WAIT_L(0); PG8_MMA(0, 1, At, B1); PG8_BAR;
            PG8_LDA(At, 1, 1); PG8_STAGE(PG8_SA(1, 0), a3, voffA);
            PG8_BAR; PG8_WAIT_L(0); PG8_MMA(1, 0, At, B0); PG8_BAR; PG8_SCHED;
            PG8_STAGE(PG8_SB(1, 1), b3 + hstep, voffB);
            PG8_WAIT_V(6); PG8_BAR; PG8_MMA(1, 1, At, B1); PG8_BAR;
            }
        }
        if constexpr (ALIGN_EPI) { if (wr == 0) PG8_BAR; }
        if constexpr (!Epi::AFTER_DRAIN) { E(acc, cur, wr, wc, fr, fq); S.done(cur); }
        if (!has_next) break;
#pragma unroll
        for (int a = 0; a < 2; ++a)
#pragma unroll
            for (int b = 0; b < 2; ++b)
#pragma unroll
                for (int m = 0; m < 4; ++m)
#pragma unroll
                    for (int n = 0; n < 2; ++n) acc[a][b][m][n] = (f32x4){0.f, 0.f, 0.f, 0.f};
        cur = nxt; cA = nA; cB = nB; ++ui;
        if constexpr (ALIGN_EPI) { if (wr == 1) PG8_BAR; }
    }
    PG8_WAIT_V(0);
    if constexpr (!ALIGN_EPI) { if (wr == 0) PG8_BAR; }
    PG8_BAR;
    if constexpr (Epi::AFTER_DRAIN) { E.fused(acc, cur, wr, wc, fr, fq, lds, wid, lane); S.done(cur); }
#undef PG8_SA
#undef PG8_SB
#undef PG8_STAGE
#undef PG8_LDA
#undef PG8_LDB
#undef PG8_MMA
#undef PG8_WAIT_V
#undef PG8_WAIT_L
#undef PG8_BAR
#undef PG8_SCHED
}
}

constexpr int NB = 4, SEQ = 8192, M_TOK = NB * SEQ, DM = 1024, DEPTH = 2;
constexpr int D_IN = 3132, HBP = 3136, N_IN_PAD = 3328;
constexpr float NORM_EPS = 1e-6f;
constexpr int HB_NSA_Q = 0, HB_NSA_KC = 256, HB_NSA_VC = 320, HB_NSA_KS = 384, HB_NSA_VS = 448, HB_NSA_KW = 512, HB_NSA_VW = 576;
constexpr int HB_ML_Q = 640, HB_ML_K = 896, HB_ML_V = 1152, HB_ML_OG = 1408;
constexpr int HB_GD_Q = 1664, HB_GD_K = 1920, HB_GD_V = 2176, HB_GD_Z = 2432;
constexpr int HB_MLA_CQ = 2688, HB_MLA_CKV = 2944, HB_MLA_KR = 3072;
constexpr int HB_NSA_G = 3104, HB_ML_IG = 3116, HB_ML_FG = 3120, HB_GD_BETA = 3124, HB_GD_A = 3128;
__host__ __device__ __forceinline__ int hb_src_col(int c) {
    if (c < 640) return c;
    if (c < 1408) return 652 + (c - 640);
    if (c < 1664) return 1428 + (c - 1408);
    if (c < 2432) return 1684 + (c - 1664);
    if (c < 2688) return 2460 + (c - 2432);
    if (c < 3104) return 2716 + (c - 2688);
    if (c < 3116) return 640 + (c - 3104);
    if (c < 3124) return 1420 + (c - 3116);
    return 2452 + (c - 3124);
}
constexpr int GRID_WG = 256;
constexpr size_t MiB = 1u << 20;
constexpr size_t WS_CTL = 0, CTL_ZERO_BYTES = 1 * MiB;
constexpr size_t WS_WIN = 1 * MiB, WIN_L = (size_t)N_IN_PAD * DM * 2;
constexpr size_t WS_WOUT = 14 * MiB, WOUT_L = (size_t)DM * DM * 2;
constexpr size_t WS_WQ = 18 * MiB, WQ_L = (size_t)2048 * DM * 2;
constexpr size_t WS_WSM = 26 * MiB, WSM_L = 1 * MiB;
constexpr size_t WSM_UQ = 0, WSM_UKV = 196608, WSM_CK = 327680, WSM_CV = 589824;
constexpr size_t WS_XN = 28 * MiB;
constexpr size_t WS_HB = 92 * MiB;
constexpr size_t WS_MLA_Q = 288 * MiB, WS_MLA_K = 312 * MiB, WS_MLA_VT = 336 * MiB;
constexpr size_t WS_NSA_VST = 352 * MiB, WS_NSA_VWT = 356 * MiB, WS_NSA_KCMP = 360 * MiB, WS_NSA_VCMPT = 360 * MiB + 512 * 1024;
constexpr size_t WS_ML_C = 361 * MiB, WS_ML_N = 393 * MiB, WS_ML_SC = 393 * MiB + 512 * 1024;
constexpr size_t WS_GD_W = 394 * MiB, WS_GD_UT = 410 * MiB, WS_GD_KDT = 426 * MiB, WS_GD_QD = 442 * MiB, WS_GD_AQK = 458 * MiB, WS_GD_ST = 474 * MiB, WS_GD_VNT = 490 * MiB, WS_GD_GE = 506 * MiB;
constexpr size_t WS_PKEYS = 507 * MiB;
constexpr size_t WS_NSA_KSW = 508 * MiB;
constexpr size_t WS_END = 512 * MiB;
constexpr size_t WS_PEER_QP = 92 * MiB, WS_PEER_U = 394 * MiB, WS_PEER_V = 410 * MiB;
constexpr size_t WS_PEER_X8 = 288 * MiB;
constexpr int CW_TMO = 0, CW_BAR = 4096, CW_Q = 16384, CW_TS = 65536;
constexpr int NWAVES = 8, WAVE_LDS = 18432, MISC_OFF = NWAVES * WAVE_LDS, LDS_BYTES = MISC_OFF + 1024;
static_assert(LDS_BYTES <= 163840 && MISC_OFF >= 131072, "LDS map");

#define GAS __attribute__((address_space(1)))
#define LAS __attribute__((address_space(3)))
typedef unsigned short bf16;
typedef unsigned v4u __attribute__((ext_vector_type(4)));
typedef unsigned v2u __attribute__((ext_vector_type(2)));
typedef float f32x4 __attribute__((ext_vector_type(4)));
typedef short bf16x8 __attribute__((ext_vector_type(8)));
#define RLX_AGENT __ATOMIC_RELAXED, __HIP_MEMORY_SCOPE_AGENT
#define LDS_WAIT() asm volatile("s_waitcnt lgkmcnt(0)" ::: "memory")
#define VM_WAIT() asm volatile("s_waitcnt vmcnt(0)" ::: "memory")
__device__ __forceinline__ unsigned f2bf(float f) { unsigned u = __builtin_bit_cast(unsigned, f); return (u + 0x7fffu + ((u >> 16) & 1u)) >> 16; }
typedef __bf16 bf16x2_hw __attribute__((ext_vector_type(2)));
typedef float f32x2_hw __attribute__((ext_vector_type(2)));
__device__ __forceinline__ unsigned pk2(float lo, float hi) { const f32x2_hw v = {lo, hi}; const bf16x2_hw b = __builtin_convertvector(v, bf16x2_hw); return __builtin_bit_cast(unsigned, b); }
__device__ __forceinline__ float bf2f(unsigned b) { return __builtin_bit_cast(float, b << 16); }
__device__ __forceinline__ float bflo(unsigned w) { return __builtin_bit_cast(float, w << 16); }
__device__ __forceinline__ float bfhi(unsigned w) { return __builtin_bit_cast(float, w & 0xffff0000u); }
typedef unsigned u32x2_t __attribute__((ext_vector_type(2)));
__device__ __forceinline__ float red4_max(float x) {
    auto s = __builtin_amdgcn_permlane16_swap(__float_as_uint(x), __float_as_uint(x), false, false);
    x = fmaxf(__uint_as_float(s[0]), __uint_as_float(s[1]));
    auto t = __builtin_amdgcn_permlane32_swap(__float_as_uint(x), __float_as_uint(x), false, false);
    return fmaxf(__uint_as_float(t[0]), __uint_as_float(t[1]));
}
__device__ __forceinline__ float red4_sum(float x) {
    auto s = __builtin_amdgcn_permlane16_swap(__float_as_uint(x), __float_as_uint(x), false, false);
    x = __uint_as_float(s[0]) + __uint_as_float(s[1]);
    auto t = __builtin_amdgcn_permlane32_swap(__float_as_uint(x), __float_as_uint(x), false, false);
    return __uint_as_float(t[0]) + __uint_as_float(t[1]);
}
template <int CTRL> __device__ __forceinline__ float dpp_mov(float x) { return __int_as_float(__builtin_amdgcn_mov_dpp(__float_as_int(x), CTRL, 0xf, 0xf, true)); }
__device__ __forceinline__ float wave_sum(float v) {
    v += dpp_mov<0xB1>(v); v += dpp_mov<0x4E>(v); v += dpp_mov<0x141>(v); v += dpp_mov<0x140>(v);
    return red4_sum(v);
}
__device__ __forceinline__ float wave_max(float v) {
    v = fmaxf(v, dpp_mov<0xB1>(v)); v = fmaxf(v, dpp_mov<0x4E>(v)); v = fmaxf(v, dpp_mov<0x141>(v)); v = fmaxf(v, dpp_mov<0x140>(v));
    return red4_max(v);
}
__device__ __forceinline__ int wave_pop(unsigned* ctr, int lane) {
    __builtin_amdgcn_wave_barrier();
    const unsigned v = __hip_atomic_fetch_add(ctr, (lane == 0) ? 1u : 0u, RLX_AGENT);
    const int r = (int)__builtin_amdgcn_readfirstlane(v);
    __builtin_amdgcn_wave_barrier();
    return r;
}
__device__ __forceinline__ float fexp(float x) { return __builtin_amdgcn_exp2f(x * 1.4426950408889634f); }
__device__ __forceinline__ f32x4 mfma16(bf16x8 a, bf16x8 b, f32x4 c) { return __builtin_amdgcn_mfma_f32_16x16x32_bf16(a, b, c, 0, 0, 0); }
__device__ __forceinline__ int lane_id() { return (int)__builtin_amdgcn_mbcnt_hi(~0u, __builtin_amdgcn_mbcnt_lo(~0u, 0u)); }
__device__ __forceinline__ int lane_id_v() { int l; asm volatile("v_mbcnt_lo_u32_b32 %0, -1, 0\n\tv_mbcnt_hi_u32_b32 %0, -1, %0" : "=v"(l)); return l; }
template <class T> __device__ __forceinline__ T* opaque(T* p) { asm volatile("" : "+s"(p)); return p; }
union Frag { bf16x8 v; v4u u; unsigned w[4]; };

constexpr int N_PHASES = 1 + 8 * DEPTH;
struct Args { const float* in[26]; float* out; unsigned char* ws; int ph_lo, ph_hi; };
enum { I_X = 0, I_POS, I_T5, I_N1G, I_N2G, I_FNG, I_WIN, I_WOUT, I_CMPK, I_CMPV, I_CMPPOS, I_ML_IB, I_ML_FB, I_ML_NG, I_GD_CONV, I_GD_ALOG, I_GD_DT, I_GD_NG,
       I_MLA_QNG, I_MLA_KVNG, I_MLA_WUQ, I_MLA_WUKV, I_PEER_WQ, I_PEER_KEYS, I_PEER_U, I_PEER_V };

#define XB_TMO      128
#define XB_XCNT(j)  (256  + 64 * (j))
#define XB_XSUB(j)  (1280 + 64 * (j))
#define XB_XGEN(j)  (2304 + 64 * (j))
#define XB_TOP      3328
#define XB_TOPGEN   3392
#define XCD_BAR_WORDS 3456
#define XB_SPIN_CAP (1u << 21)

__device__ __forceinline__ unsigned xb_ld(unsigned* p)              { return __hip_atomic_load(p, __ATOMIC_RELAXED, __HIP_MEMORY_SCOPE_AGENT); }
__device__ __forceinline__ unsigned xb_add(unsigned* p, unsigned v) { return __hip_atomic_fetch_add(p, v, __ATOMIC_RELAXED, __HIP_MEMORY_SCOPE_AGENT); }
__device__ __forceinline__ unsigned xb_xcc_id() { return (unsigned)__builtin_amdgcn_s_getreg((3 << 11) | 20) & 0xFu; }
#define XB_SPIN(cond, bar) do { unsigned _sp = 0; while (cond) { __builtin_amdgcn_s_sleep(1); \
    if ((++_sp & 255u) == 0u) { if (xb_ld(&(bar)[XB_TMO])) break; if (_sp > XB_SPIN_CAP) { atomicAdd(&(bar)[XB_TMO], 1u); break; } } } } while (0)

struct XcdBarrier {
    unsigned* bar; unsigned x;
    volatile LAS unsigned* st;
};

__device__ __forceinline__ XcdBarrier xcd_barrier_post(unsigned* bar, volatile LAS unsigned* st, const bool is_t0) {
    XcdBarrier b; b.bar = bar; b.x = xb_xcc_id(); b.st = st;
    if (is_t0) (void)xb_add(&bar[XB_XCNT(b.x)], 1u);
    return b;
}
__device__ __forceinline__ void xcd_barrier_complete(unsigned* bar, unsigned x, unsigned& nloc, unsigned& nx) {
    const unsigned G = gridDim.x * gridDim.y * gridDim.z;
    unsigned sum, cnt, mine, sp = 0u;
    for (;;) {
        sum = 0u; cnt = 0u; mine = 0u;
#pragma unroll
        for (unsigned j = 0; j < 16; ++j) { const unsigned c = xb_ld(&bar[XB_XCNT(j)]); sum += c; cnt += (c > 0u) ? 1u : 0u; mine = (j == x) ? c : mine; }
        if (sum == G) break;
        __builtin_amdgcn_s_sleep(1);
        if ((++sp & 255u) == 0u) { if (xb_ld(&bar[XB_TMO])) break; if (sp > XB_SPIN_CAP) { atomicAdd(&bar[XB_TMO], 1u); break; } }
    }
    nloc = mine > 0u ? mine : 1u; nx = cnt > 0u ? cnt : 1u;
}

__device__ __forceinline__ void xcd_barrier(const XcdBarrier& b, const bool is_t0) {
    asm volatile("s_waitcnt vmcnt(0)" ::: "memory");
    __syncthreads();
    if (is_t0) {
        unsigned* bar = b.bar;
        __builtin_amdgcn_s_waitcnt(0);
        unsigned nloc = b.st[0], nx = b.st[1];
        if (nloc == 0u) { xcd_barrier_complete(bar, b.x, nloc, nx); b.st[0] = nloc; b.st[1] = nx; }
        const unsigned old = xb_add(&bar[XB_XSUB(b.x)], 1u);
        const unsigned gen = old / nloc;
        if (old + 1u == (gen + 1u) * nloc) {
            __builtin_amdgcn_fence(__ATOMIC_RELEASE, "agent");
            asm volatile("s_waitcnt vmcnt(0)" ::: "memory");
            const unsigned og = xb_add(&bar[XB_TOP], 1u);
            const unsigned tg = og / nx;
            if (og + 1u == (tg + 1u) * nx) xb_add(&bar[XB_TOPGEN], 1u);
            else XB_SPIN(xb_ld(&bar[XB_TOPGEN]) == tg, bar);
            __builtin_amdgcn_fence(__ATOMIC_ACQUIRE, "agent");
            xb_add(&bar[XB_XGEN(b.x)], 1u);
            asm volatile("s_waitcnt vmcnt(0)" ::: "memory");
        } else {
            XB_SPIN(xb_ld(&bar[XB_XGEN(b.x)]) == gen, bar);
            __builtin_amdgcn_fence(__ATOMIC_ACQUIRE, "agent");
            asm volatile("s_waitcnt vmcnt(0)" ::: "memory");
        }
    }
    __syncthreads();
}

template <class Map>
__device__ __forceinline__ void tr_item(const float* src, int ldsrc, int nreal, Map map, bf16* dst, int K, LAS float* scr, int kb, int nb, int lane) {
    const int k0 = 64 * kb, n0 = 32 * nb;
    const int n = n0 + (lane & 31);
    const int sc = (n < nreal) ? map(n) : -1;
#pragma unroll 8
    for (int i = 0; i < 32; ++i) { const int kk = 2 * i + (lane >> 5); scr[kk * 33 + (lane & 31)] = (sc >= 0) ? src[(size_t)(k0 + kk) * ldsrc + sc] : 0.f; }
    LDS_WAIT();
    const int c = lane & 7;
#pragma unroll
    for (int j = 0; j < 4; ++j) { const int nn = (lane >> 3) + 8 * j; const LAS float* s = scr + (8 * c) * 33 + nn;
        v4u o; o.x = pk2(s[0 * 33], s[1 * 33]); o.y = pk2(s[2 * 33], s[3 * 33]); o.z = pk2(s[4 * 33], s[5 * 33]); o.w = pk2(s[6 * 33], s[7 * 33]);
        *(v4u*)(dst + (size_t)(n0 + nn) * K + k0 + 8 * c) = o; }
    LDS_WAIT();
}
struct MapId { __device__ __forceinline__ int operator()(int n) const { return n; } };
struct MapHb { __device__ __forceinline__ int operator()(int n) const { return hb_src_col(n); } };
__device__ __forceinline__ void rms_row_bf16(const float* xrow, const float* g, bf16* orow, int lane) {
    const f32x4* xr = (const f32x4*)xrow + lane; const f32x4* gr = (const f32x4*)g + lane;
    f32x4 v[4]; float s = 0.f;
#pragma unroll
    for (int j = 0; j < 4; ++j) { v[j] = xr[64 * j]; s += (v[j].x * v[j].x + v[j].y * v[j].y) + (v[j].z * v[j].z + v[j].w * v[j].w); }
    const float r = 1.0f / sqrtf(wave_sum(s) * (1.f / DM) + NORM_EPS);
    v2u* o8 = (v2u*)orow + lane;
#pragma unroll
    for (int j = 0; j < 4; ++j) { const f32x4 gg = gr[64 * j]; v2u o; o.x = pk2(v[j].x * r * gg.x, v[j].y * r * gg.y); o.y = pk2(v[j].z * r * gg.z, v[j].w * r * gg.w); o8[64 * j] = o; }
}
__device__ __forceinline__ void rms_row_f32(const float* xrow, const float* g, float* orow, int lane) {
    const f32x4* xr = (const f32x4*)xrow + lane; const f32x4* gr = (const f32x4*)g + lane;
    f32x4 v[4]; float s = 0.f;
#pragma unroll
    for (int j = 0; j < 4; ++j) { v[j] = xr[64 * j]; s += (v[j].x * v[j].x + v[j].y * v[j].y) + (v[j].z * v[j].z + v[j].w * v[j].w); }
    const float r = 1.0f / sqrtf(wave_sum(s) * (1.f / DM) + NORM_EPS);
    f32x4* o = (f32x4*)orow + lane;
#pragma unroll
    for (int j = 0; j < 4; ++j) { const f32x4 gg = gr[64 * j]; o[64 * j] = v[j] * r * gg; }
}

__device__ __forceinline__ void mla_prep_item(int it, int l, const Args& args, int lane) {
    unsigned char* ws = args.ws;
    const bf16* HB = (const bf16*)(ws + WS_HB);
    bf16* Qo = (bf16*)(ws + WS_MLA_Q); bf16* Ko = (bf16*)(ws + WS_MLA_K); bf16* VT = (bf16*)(ws + WS_MLA_VT);
    const bf16* uq_t = opaque((const bf16*)(ws + WS_WSM + l * WSM_L + WSM_UQ)); const bf16* ukv_t = opaque((const bf16*)(ws + WS_WSM + l * WSM_L + WSM_UKV));
    const int fr = lane & 15, fq = lane >> 4;
    const int tok0 = it * 16, b = tok0 / SEQ, s0 = tok0 % SEQ;
    const float* gq = opaque(args.in[I_MLA_QNG] + l * 256); const float* gkv = opaque(args.in[I_MLA_KVNG] + l * 128);
    const int* pos = (const int*)args.in[I_POS];
    float cs[4], sn[4];
    { const float pf_ = (float)pos[tok0 + fr];
#pragma unroll
      for (int i = 0; i < 4; ++i) { const float inv_freq = exp2f(-(float)(fq * 4 + i) * (13.287712379549449f / 16.0f));
          const float ang = pf_ * inv_freq; sincosf(ang, &sn[i], &cs[i]); } }
    const int blk32 = s0 >> 5, half = (s0 >> 4) & 1;
    const float qscale = 0.10206207261596577f * 1.4426950408889634f;
    {
        Frag a[8]; float ss = 0.f;
#pragma unroll
        for (int ks = 0; ks < 8; ++ks) { a[ks].u = *(const v4u*)(HB + (size_t)(tok0 + fr) * HBP + HB_MLA_CQ + ks * 32 + fq * 8);
#pragma unroll
            for (int j = 0; j < 4; ++j) { const float x0 = bflo(a[ks].w[j]), x1 = bfhi(a[ks].w[j]); ss += x0 * x0 + x1 * x1; } }
        ss = red4_sum(ss);
        const float r = 1.0f / sqrtf(ss * (1.f / 256.f) + NORM_EPS);
#pragma unroll
        for (int ks = 0; ks < 8; ++ks) { const float* gp = gq + ks * 32 + fq * 8;
#pragma unroll
            for (int j = 0; j < 4; ++j) a[ks].w[j] = pk2(bflo(a[ks].w[j]) * r * gp[2 * j], bfhi(a[ks].w[j]) * r * gp[2 * j + 1]); }
        for (int h = 0; h < 4; ++h) {
            f32x4 acc[6];
#pragma unroll
            for (int j = 0; j < 6; ++j) { acc[j] = (f32x4){0.f, 0.f, 0.f, 0.f};
#pragma unroll
                for (int ks = 0; ks < 8; ++ks) { Frag bq; bq.u = *(const v4u*)(uq_t + (size_t)(h * 96 + j * 16 + fr) * 256 + ks * 32 + fq * 8); acc[j] = mfma16(bq.v, a[ks].v, acc[j]); } }
            bf16* qrow = Qo + ((size_t)(b * 4 + h) * SEQ + s0 + fr) * 96 + fq * 4;
#pragma unroll
            for (int j = 0; j < 4; ++j) { v2u o; o.x = pk2(acc[j][0] * qscale, acc[j][1] * qscale); o.y = pk2(acc[j][2] * qscale, acc[j][3] * qscale); *(v2u*)(qrow + j * 16) = o; }
            { float r1[4], r2[4];
#pragma unroll
              for (int i = 0; i < 4; ++i) { const float t1 = acc[4][i], t2 = acc[5][i]; r1[i] = (t1 * cs[i] - t2 * sn[i]) * qscale; r2[i] = (t2 * cs[i] + t1 * sn[i]) * qscale; }
              v2u o1, o2; o1.x = pk2(r1[0], r1[1]); o1.y = pk2(r1[2], r1[3]); o2.x = pk2(r2[0], r2[1]); o2.y = pk2(r2[2], r2[3]); *(v2u*)(qrow + 64) = o1; *(v2u*)(qrow + 80) = o2; }
        }
    }
    {
        Frag a[4]; float ss = 0.f;
#pragma unroll
        for (int ks = 0; ks < 4; ++ks) { a[ks].u = *(const v4u*)(HB + (size_t)(tok0 + fr) * HBP + HB_MLA_CKV + ks * 32 + fq * 8);
#pragma unroll
            for (int j = 0; j < 4; ++j) { const float x0 = bflo(a[ks].w[j]), x1 = bfhi(a[ks].w[j]); ss += x0 * x0 + x1 * x1; } }
        ss = red4_sum(ss);
        const float r = 1.0f / sqrtf(ss * (1.f / 128.f) + NORM_EPS);
#pragma unroll
        for (int ks = 0; ks < 4; ++ks) { const float* gp = gkv + ks * 32 + fq * 8;
#pragma unroll
            for (int j = 0; j < 4; ++j) a[ks].w[j] = pk2(bflo(a[ks].w[j]) * r * gp[2 * j], bfhi(a[ks].w[j]) * r * gp[2 * j + 1]); }
        for (int h = 0; h < 4; ++h) {
            f32x4 acc[8];
#pragma unroll
            for (int j = 0; j < 8; ++j) { acc[j] = (f32x4){0.f, 0.f, 0.f, 0.f};
#pragma unroll
                for (int ks = 0; ks < 4; ++ks) { Frag bq; bq.u = *(const v4u*)(ukv_t + (size_t)(h * 128 + j * 16 + fr) * 128 + ks * 32 + fq * 8); acc[j] = (j < 4) ? mfma16(bq.v, a[ks].v, acc[j]) : mfma16(a[ks].v, bq.v, acc[j]); } }
            bf16* kblk = Ko + (size_t)(b * 4 + h) * SEQ * 96 + (size_t)blk32 * 3072;
#pragma unroll
            for (int j = 0; j < 4; ++j) { v2u o; o.x = pk2(acc[j][0], acc[j][1]); o.y = pk2(acc[j][2], acc[j][3]);
                *(v2u*)(kblk + ((half * 3 + (j >> 1)) * 64 + ((j & 1) * 2 + (fq >> 1)) * 16 + fr) * 8 + (fq & 1) * 4) = o; }
            bf16* vblk = VT + (size_t)(b * 4 + h) * 64 * SEQ + (size_t)blk32 * 2048;
#pragma unroll
            for (int j = 0; j < 4; ++j) { v2u o; o.x = pk2(acc[4 + j][0], acc[4 + j][1]); o.y = pk2(acc[4 + j][2], acc[4 + j][3]);
                *(v2u*)(vblk + (j * 64 + lane) * 8 + half * 4) = o; }
        }
        { const bf16* kr = HB + (size_t)(tok0 + fr) * HBP + HB_MLA_KR + fq * 4;
          const v2u a1 = *(const v2u*)kr, a2 = *(const v2u*)(kr + 16);
          const float t1[4] = {bflo(a1.x), bfhi(a1.x), bflo(a1.y), bfhi(a1.y)}, t2[4] = {bflo(a2.x), bfhi(a2.x), bflo(a2.y), bfhi(a2.y)};
          float r1[4], r2[4];
#pragma unroll
          for (int i = 0; i < 4; ++i) { r1[i] = t1[i] * cs[i] - t2[i] * sn[i]; r2[i] = t2[i] * cs[i] + t1[i] * sn[i]; }
          v2u o1, o2; o1.x = pk2(r1[0], r1[1]); o1.y = pk2(r1[2], r1[3]); o2.x = pk2(r2[0], r2[1]); o2.y = pk2(r2[2], r2[3]);
#pragma unroll
          for (int h = 0; h < 4; ++h) { bf16* kblk = Ko + (size_t)(b * 4 + h) * SEQ * 96 + (size_t)blk32 * 3072 + ((half * 3 + 2) * 64 + fr) * 8 + (fq & 1) * 4;
              *(v2u*)(kblk + (fq >> 1) * 128) = o1; *(v2u*)(kblk + (2 + (fq >> 1)) * 128) = o2; } }
    }
}
#define MLA_LOADK(KF, k0_) do { const bf16* kp_ = K + (size_t)((k0_) >> 5) * 3072 + lane * 8; _Pragma("unroll") for (int t = 0; t < 2; ++t) { _Pragma("unroll") for (int ks = 0; ks < 3; ++ks) KF[t][ks].u = *(const v4u*)(kp_ + (t * 3 + ks) * 512); } } while (0)
#define MLA_LOADV(VF, k0_) do { const bf16* vp_ = VT + (size_t)((k0_) >> 5) * 2048 + lane * 8; _Pragma("unroll") for (int dt = 0; dt < 4; ++dt) VF[dt].u = *(const v4u*)(vp_ + dt * 512); } while (0)
#define MLA_STEP_(KF, VF, k0_, DIAG) do { \
    Frag pf[4]; f32x4 sA_[4], sB_[4]; \
    _Pragma("unroll") for (int nt = 0; nt < 4; ++nt) { Frag q0, q1, q2; q0.u = *(const LAS v4u*)(ql + (nt * 16 + fr) * 104 + fq * 8); q1.u = *(const LAS v4u*)(ql + (nt * 16 + fr) * 104 + 32 + fq * 8); q2.u = *(const LAS v4u*)(ql + (nt * 16 + fr) * 104 + 64 + fq * 8); \
        f32x4 s0_ = {0.f, 0.f, 0.f, 0.f}, s1_ = {0.f, 0.f, 0.f, 0.f}; \
        s0_ = mfma16(KF[0][0].v, q0.v, s0_); s1_ = mfma16(KF[1][0].v, q0.v, s1_); s0_ = mfma16(KF[0][1].v, q1.v, s0_); s1_ = mfma16(KF[1][1].v, q1.v, s1_); s0_ = mfma16(KF[0][2].v, q2.v, s0_); s1_ = mfma16(KF[1][2].v, q2.v, s1_); \
        sA_[nt] = s0_; sB_[nt] = s1_; } \
      \
    _Pragma("unroll") for (int nt = 0; nt < 4; ++nt) { f32x4 s0_ = sA_[nt], s1_ = sB_[nt]; \
        if (DIAG) { _Pragma("unroll") for (int i = 0; i < 4; ++i) { if ((k0_) + fq * 4 + i > s0 + nt * 16 + fr) s0_[i] = -1e30f; if ((k0_) + 16 + fq * 4 + i > s0 + nt * 16 + fr) s1_[i] = -1e30f; } } \
        float mx = fmaxf(fmaxf(fmaxf(s0_[0], s0_[1]), fmaxf(s0_[2], s0_[3])), fmaxf(fmaxf(s1_[0], s1_[1]), fmaxf(s1_[2], s1_[3]))); \
        mx = red4_max(mx); \
        const float mn = fmaxf(mrun[nt], mx); \
        float p[8]; float ps = 0.f; \
        _Pragma("unroll") for (int i = 0; i < 4; ++i) { p[i] = __builtin_amdgcn_exp2f(s0_[i] - mn); p[4 + i] = __builtin_amdgcn_exp2f(s1_[i] - mn); ps += p[i] + p[4 + i]; } \
        if (__builtin_amdgcn_ballot_w64(mn > mrun[nt]) != 0ull) {         \
            const float alpha = __builtin_amdgcn_exp2f(mrun[nt] - mn); mrun[nt] = mn; lrun[nt] = lrun[nt] * alpha; \
            _Pragma("unroll") for (int dt = 0; dt < 4; ++dt) o[dt][nt] = o[dt][nt] * alpha; } \
        lrun[nt] += ps; \
        pf[nt].w[0] = pk2(p[0], p[1]); pf[nt].w[1] = pk2(p[2], p[3]); pf[nt].w[2] = pk2(p[4], p[5]); pf[nt].w[3] = pk2(p[6], p[7]); } \
    _Pragma("unroll") for (int dt = 0; dt < 4; ++dt) _Pragma("unroll") for (int nt = 0; nt < 4; ++nt) o[dt][nt] = mfma16(VF[dt].v, pf[nt].v, o[dt][nt]); __builtin_amdgcn_sched_barrier(0); } while (0)
__device__ __forceinline__ void mla_attn_item(int bh, int qt, const Args& args, LAS unsigned char* wlds, int lane) {
    unsigned char* ws = args.ws;
    const bf16* Q = (const bf16*)(ws + WS_MLA_Q) + (size_t)bh * SEQ * 96; const bf16* K = (const bf16*)(ws + WS_MLA_K) + (size_t)bh * SEQ * 96;
    const bf16* VT = (const bf16*)(ws + WS_MLA_VT) + (size_t)bh * 64 * SEQ; bf16* XN = (bf16*)(ws + WS_XN);
    const int fr = lane & 15, fq = lane >> 4, s0 = qt * 64, b = bh >> 2, h = bh & 3;
    LAS bf16* ql = (LAS bf16*)wlds;
#pragma unroll
    for (int i = 0; i < 12; ++i) { const int idx = i * 64 + lane, r = idx / 12, c = idx % 12; *(LAS v4u*)(ql + r * 104 + c * 8) = *(const v4u*)(Q + (size_t)(s0 + r) * 96 + c * 8); }
    LDS_WAIT();
    f32x4 o[4][4];
#pragma unroll
    for (int dt = 0; dt < 4; ++dt)
#pragma unroll
        for (int nt = 0; nt < 4; ++nt) o[dt][nt] = (f32x4){0.f, 0.f, 0.f, 0.f};
    float mrun[4], lrun[4];
#pragma unroll
    for (int nt = 0; nt < 4; ++nt) { mrun[nt] = -1e30f; lrun[nt] = 0.f; }
    const int nkb = (s0 + 64) / 32;
    Frag kA[2][3], kB[2][3], vv[4];
    MLA_LOADK(kA, 0);
    for (int kb = 0; kb < nkb - 2; kb += 2) {
        MLA_LOADV(vv, kb * 32); MLA_LOADK(kB, (kb + 1) * 32);
        MLA_STEP_(kA, vv, kb * 32, 0);
        MLA_LOADV(vv, (kb + 1) * 32); MLA_LOADK(kA, (kb + 2) * 32);
        MLA_STEP_(kB, vv, (kb + 1) * 32, 0);
    }
    { const int kb = nkb - 2;
        MLA_LOADV(vv, kb * 32); MLA_LOADK(kB, (kb + 1) * 32);
        MLA_STEP_(kA, vv, kb * 32, 1);
        MLA_LOADV(vv, (kb + 1) * 32);
        MLA_STEP_(kB, vv, (kb + 1) * 32, 1);
    }
#pragma unroll
    for (int nt = 0; nt < 4; ++nt) {
        float lt = lrun[nt]; lt = red4_sum(lt);
        const float inv = 1.0f / lt;
        bf16* orow = XN + (size_t)(b * SEQ + s0 + nt * 16 + fr) * DM + 768 + h * 64 + fq * 4;
#pragma unroll
        for (int dt = 0; dt < 4; ++dt) { v2u w; w.x = pk2(o[dt][nt][0] * inv, o[dt][nt][1] * inv); w.y = pk2(o[dt][nt][2] * inv, o[dt][nt][3] * inv); *(v2u*)(orow + dt * 16) = w; }
    }
    LDS_WAIT();
}

__device__ __forceinline__ void stage64(const bf16* HB, int tok0, int col0, LAS bf16* buf, int lane) {
#pragma unroll
    for (int i = 0; i < 8; ++i) { const int idx = i * 64 + lane, r = idx >> 3, c8 = idx & 7;
        const v4u v = *(const v4u*)(HB + (size_t)(tok0 + r) * HBP + col0 + c8 * 8); *(LAS v4u*)(buf + r * 72 + c8 * 8) = v; }
    LDS_WAIT();
}
__device__ __forceinline__ float log_sigmoid(float x) { return fminf(x, 0.f) - log1pf(expf(-fabsf(x))); }
__device__ __forceinline__ float wave_incl_sum(float v, int lane) {
#pragma unroll
    for (int o = 1; o < 64; o <<= 1) { const float t = __shfl_up(v, o); if (lane >= o) v += t; }
    return v;
}
__device__ __forceinline__ float wave_incl_max(float v, int lane) {
#pragma unroll
    for (int o = 1; o < 64; o <<= 1) { const float t = __shfl_up(v, o); if (lane >= o) v = fmaxf(v, t); }
    return v;
}
__device__ __forceinline__ void mlstm_prep_item(int it, int l, const Args& args, LAS unsigned char* wlds, int lane) {
    unsigned char* ws = args.ws; const bf16* HB = (const bf16*)(ws + WS_HB);
    const int bh = it >> 7, n = it & 127, b = bh >> 2, h = bh & 3, tok0 = b * SEQ + n * 64, fr = lane & 15, fq = lane >> 4;
    LAS bf16* buf = (LAS bf16*)wlds;
    const float ib = opaque(args.in[I_ML_IB] + l * 4)[h], fb = opaque(args.in[I_ML_FB] + l * 4)[h];
    const float ig = bf2f(HB[(size_t)(tok0 + lane) * HBP + HB_ML_IG + h]) + ib;
    const float lf = log_sigmoid(bf2f(HB[(size_t)(tok0 + lane) * HBP + HB_ML_FG + h]) + fb);
    const float bcum = wave_incl_sum(lf, lane), a = ig - bcum, amax = wave_max(a), bend = __shfl(bcum, 63);
    const float w = fexp(a - amax);
    float wv[2][8];
#pragma unroll
    for (int ks = 0; ks < 2; ++ks)
#pragma unroll
        for (int j = 0; j < 8; ++j) wv[ks][j] = __shfl(w, ks * 32 + fq * 8 + j);
    stage64(HB, tok0, HB_ML_V + h * 64, buf, lane);
    Frag af[4][2];
#pragma unroll
    for (int mt = 0; mt < 4; ++mt)
#pragma unroll
        for (int ks = 0; ks < 2; ++ks)
#pragma unroll
            for (int j = 0; j < 4; ++j) { const int s = ks * 32 + fq * 8 + 2 * j, e = mt * 16 + fr;
                af[mt][ks].w[j] = pk2(bf2f(buf[s * 72 + e]) * wv[ks][2 * j], bf2f(buf[(s + 1) * 72 + e]) * wv[ks][2 * j + 1]); }
    LDS_WAIT();
    stage64(HB, tok0, HB_ML_K + h * 64, buf, lane);
    Frag bfm[4][2];
#pragma unroll
    for (int nt = 0; nt < 4; ++nt)
#pragma unroll
        for (int ks = 0; ks < 2; ++ks)
#pragma unroll
            for (int j = 0; j < 4; ++j) { const int s = ks * 32 + fq * 8 + 2 * j, kd = nt * 16 + fr;
                bfm[nt][ks].w[j] = pk2(bf2f(buf[s * 72 + kd]) * 0.125f, bf2f(buf[(s + 1) * 72 + kd]) * 0.125f); }
    LDS_WAIT();
    float* Cc = (float*)(ws + WS_ML_C) + (size_t)it * 4096;
#pragma unroll
    for (int mt = 0; mt < 4; ++mt)
#pragma unroll
        for (int nt = 0; nt < 4; ++nt) { f32x4 acc = {0.f, 0.f, 0.f, 0.f};
#pragma unroll
            for (int ks = 0; ks < 2; ++ks) acc = mfma16(af[mt][ks].v, bfm[nt][ks].v, acc);
#pragma unroll
            for (int i = 0; i < 4; ++i) Cc[(mt * 16 + fq * 4 + i) * 64 + nt * 16 + fr] = acc[i]; }
    {
        Frag an[2];
#pragma unroll
        for (int ks = 0; ks < 2; ++ks)
#pragma unroll
            for (int j = 0; j < 4; ++j) an[ks].w[j] = (fr == 0) ? pk2(wv[ks][2 * j], wv[ks][2 * j + 1]) : 0u;
        float* Nn = (float*)(ws + WS_ML_N) + (size_t)it * 64; float* dummy = (float*)(ws + WS_ML_SC) + (size_t)it * 4 + 3;
#pragma unroll
        for (int nt = 0; nt < 4; ++nt) { f32x4 acc = {0.f, 0.f, 0.f, 0.f}; acc = mfma16(an[0].v, bfm[nt][0].v, acc); acc = mfma16(an[1].v, bfm[nt][1].v, acc);
            float* dst = (fq == 0) ? (Nn + nt * 16 + fr) : dummy; *dst = acc[0]; } }
    { float* sc = (float*)(ws + WS_ML_SC) + (size_t)it * 4; sc[lane & 1] = (lane & 1) ? bend : bend + amax; }
}
__device__ __forceinline__ void mlstm_scan_item(int it, const Args& args, int lane) {
    unsigned char* ws = args.ws; const int bh = it >> 4, part = it & 15;
    float* Cb = (float*)(ws + WS_ML_C) + (size_t)bh * 128 * 4096 + part * 256 + lane;
    float* Nb = (float*)(ws + WS_ML_N) + (size_t)bh * 128 * 64 + lane;
    float* sc = (float*)(ws + WS_ML_SC) + (size_t)bh * 128 * 4;
    float c0 = 0.f, c1 = 0.f, c2 = 0.f, c3 = 0.f, nn = 0.f, m = 0.f;
    for (int n0 = 0; n0 < 128; n0 += 4) {
        float d[4][4], ml_[4], be_[4], dn_[4];
#pragma unroll
        for (int q = 0; q < 4; ++q) { const float* cp = Cb + (size_t)(n0 + q) * 4096; d[q][0] = cp[0]; d[q][1] = cp[64]; d[q][2] = cp[128]; d[q][3] = cp[192];
            ml_[q] = sc[(n0 + q) * 4 + 0]; be_[q] = sc[(n0 + q) * 4 + 1]; dn_[q] = (part == 0) ? Nb[(n0 + q) * 64] : 0.f; }
#pragma unroll
        for (int q = 0; q < 4; ++q) { float* cp = Cb + (size_t)(n0 + q) * 4096;
            const float mnew = fmaxf(be_[q] + m, ml_[q]), fc = fexp(be_[q] + m - mnew), fd = fexp(ml_[q] - mnew);
            cp[0] = c0; cp[64] = c1; cp[128] = c2; cp[192] = c3;
            c0 = fc * c0 + fd * d[q][0]; c1 = fc * c1 + fd * d[q][1]; c2 = fc * c2 + fd * d[q][2]; c3 = fc * c3 + fd * d[q][3];
            if (part == 0) { Nb[(n0 + q) * 64] = nn; nn = fc * nn + fd * dn_[q]; sc[(n0 + q) * 4 + 2] = m; }
            m = mnew; }
    }
}
__device__ __forceinline__ void mlstm_out_item(int it, int l, const Args& args, LAS unsigned char* wlds, int lane) {
    unsigned char* ws = args.ws; const bf16* HB = (const bf16*)(ws + WS_HB); bf16* XN = (bf16*)(ws + WS_XN);
    const int bh = it >> 7, n = it & 127, b = bh >> 2, h = bh & 3, tok0 = b * SEQ + n * 64, fr = lane & 15, fq = lane >> 4;
    LAS bf16* buf = (LAS bf16*)wlds;
    const float ib = opaque(args.in[I_ML_IB] + l * 4)[h], fb = opaque(args.in[I_ML_FB] + l * 4)[h];
    const float ig = bf2f(HB[(size_t)(tok0 + lane) * HBP + HB_ML_IG + h]) + ib;
    const float lf = log_sigmoid(bf2f(HB[(size_t)(tok0 + lane) * HBP + HB_ML_FG + h]) + fb);
    const float bcum = wave_incl_sum(lf, lane), a = ig - bcum, pmax = wave_incl_max(a, lane);
    const float* sc = (const float*)(ws + WS_ML_SC) + (size_t)it * 4;
    const float mst = sc[2];
    const float mt_ = bcum + fmaxf(pmax, mst);
    const float inter_l = fexp(bcum + mst - mt_), emm_l = fexp(-mt_), bm_l = bcum - mt_;
    stage64(HB, tok0, HB_ML_V + h * 64, buf, lane);
    Frag kf[4][2];
#pragma unroll
    for (int t = 0; t < 4; ++t)
#pragma unroll
        for (int ks = 0; ks < 2; ++ks) kf[t][ks].u = *(const v4u*)(HB + (size_t)(tok0 + t * 16 + fr) * HBP + HB_ML_K + h * 64 + ks * 32 + fq * 8);
    float as_[4][4];
#pragma unroll
    for (int mt = 0; mt < 4; ++mt)
#pragma unroll
        for (int i = 0; i < 4; ++i) as_[mt][i] = __shfl(a, mt * 16 + fq * 4 + i);
    const float* Cst = (const float*)(ws + WS_ML_C) + (size_t)it * 4096; const float* Nst = (const float*)(ws + WS_ML_N) + (size_t)it * 64;
    const float* ng = opaque(args.in[I_ML_NG] + l * 256) + h * 64;
    for (int nt = 0; nt < 4; ++nt) {
        const int tl = nt * 16 + fr;
        const float bm = __shfl(bm_l, tl), inter = __shfl(inter_l, tl), emm = __shfl(emm_l, tl);
        Frag q0, q1;
        q0.u = *(const v4u*)(HB + (size_t)(tok0 + tl) * HBP + HB_ML_Q + h * 64 + fq * 8); q1.u = *(const v4u*)(HB + (size_t)(tok0 + tl) * HBP + HB_ML_Q + h * 64 + 32 + fq * 8);
        f32x4 st[4]; float den = 0.f;
#pragma unroll
        for (int mt = 0; mt < 4; ++mt) { st[mt] = (f32x4){0.f, 0.f, 0.f, 0.f}; st[mt] = mfma16(kf[mt][0].v, q0.v, st[mt]); st[mt] = mfma16(kf[mt][1].v, q1.v, st[mt]);
#pragma unroll
            for (int i = 0; i < 4; ++i) { const int s = mt * 16 + fq * 4 + i; const float d = (s <= tl) ? fexp(bm + as_[mt][i]) : 0.f; st[mt][i] = st[mt][i] * 0.125f * d; den += st[mt][i]; } }
        den = red4_sum(den);
        Frag pf[2];
#pragma unroll
        for (int k2 = 0; k2 < 2; ++k2) { pf[k2].w[0] = pk2(st[2 * k2][0], st[2 * k2][1]); pf[k2].w[1] = pk2(st[2 * k2][2], st[2 * k2][3]); pf[k2].w[2] = pk2(st[2 * k2 + 1][0], st[2 * k2 + 1][1]); pf[k2].w[3] = pk2(st[2 * k2 + 1][2], st[2 * k2 + 1][3]); }
        float nq = 0.f;
#pragma unroll
        for (int j = 0; j < 4; ++j) { nq += Nst[fq * 8 + 2 * j] * bflo(q0.w[j]) + Nst[fq * 8 + 2 * j + 1] * bfhi(q0.w[j]); nq += Nst[32 + fq * 8 + 2 * j] * bflo(q1.w[j]) + Nst[32 + fq * 8 + 2 * j + 1] * bfhi(q1.w[j]); }
        nq = red4_sum(nq);
        const float dent = den + inter * nq; const float rden = 1.0f / fmaxf(fabsf(dent), emm);
        f32x4 hv[4]; float ss = 0.f;
#pragma unroll
        for (int et = 0; et < 4; ++et) {
            f32x4 num = {0.f, 0.f, 0.f, 0.f}, cq = {0.f, 0.f, 0.f, 0.f};
#pragma unroll
            for (int k2 = 0; k2 < 2; ++k2) { Frag va; const int e = et * 16 + fr;
#pragma unroll
                for (int j = 0; j < 4; ++j) { const int sa = (2 * k2 + (j >> 1)) * 16 + fq * 4 + 2 * (j & 1); va.w[j] = (unsigned)buf[sa * 72 + e] | ((unsigned)buf[(sa + 1) * 72 + e] << 16); }
                num = mfma16(va.v, pf[k2].v, num); }
#pragma unroll
            for (int ks = 0; ks < 2; ++ks) { const float* cp = Cst + (size_t)(et * 16 + fr) * 64 + ks * 32 + fq * 8; const f32x4 c0 = *(const f32x4*)cp, c1 = *(const f32x4*)(cp + 4);
                Frag ca; ca.w[0] = pk2(c0[0], c0[1]); ca.w[1] = pk2(c0[2], c0[3]); ca.w[2] = pk2(c1[0], c1[1]); ca.w[3] = pk2(c1[2], c1[3]);
                cq = mfma16(ca.v, ks == 0 ? q0.v : q1.v, cq); }
            const v2u ogw = *(const v2u*)(HB + (size_t)(tok0 + tl) * HBP + HB_ML_OG + h * 64 + et * 16 + fq * 4);
            const float og[4] = {bflo(ogw.x), bfhi(ogw.x), bflo(ogw.y), bfhi(ogw.y)};
#pragma unroll
            for (int i = 0; i < 4; ++i) { const float hval = (num[i] + inter * cq[i]) * rden; const float o = hval / (1.0f + fexp(-og[i])); hv[et][i] = o; ss += o * o; }
        }
        ss = red4_sum(ss);
        const float rn = 1.0f / sqrtf(ss * (1.f / 64.f) + NORM_EPS);
        bf16* orow = XN + (size_t)(tok0 + tl) * DM + 256 + h * 64 + fq * 4;
#pragma unroll
        for (int et = 0; et < 4; ++et) { const float* gp = ng + et * 16 + fq * 4; v2u w; w.x = pk2(hv[et][0] * rn * gp[0], hv[et][1] * rn * gp[1]); w.y = pk2(hv[et][2] * rn * gp[2], hv[et][3] * rn * gp[3]); *(v2u*)(orow + et * 16) = w; }
    }
    LDS_WAIT();
}

__device__ __forceinline__ float silu_f(float x) { return x * __builtin_amdgcn_rcpf(1.0f + __builtin_amdgcn_exp2f(-1.4426950408889634f * x)); }
template <int NORM>
__device__ __forceinline__ void gdn_conv_chunk(const bf16* HB, int tok0, bool first, int col0, const float* cw, int ch0, float nscale, LAS bf16* buf, int lane) {
#pragma unroll
    for (int i = 0; i < 9; ++i) { const int idx = i * 64 + lane, r = idx >> 3, c8 = idx & 7;
        if (idx < 67 * 8) { v4u v = {0u, 0u, 0u, 0u}; if (!(first && r < 3)) v = *(const v4u*)(HB + (size_t)(tok0 - 3 + r) * HBP + col0 + c8 * 8); *(LAS v4u*)(buf + r * 72 + c8 * 8) = v; } }
    LDS_WAIT();
    const float w0 = cw[ch0 + lane], w1 = cw[768 + ch0 + lane], w2 = cw[1536 + ch0 + lane], w3 = cw[2304 + ch0 + lane];
    float xm3 = bf2f(buf[0 * 72 + lane]), xm2 = bf2f(buf[1 * 72 + lane]), xm1 = bf2f(buf[2 * 72 + lane]);
#pragma unroll 4
    for (int t = 0; t < 64; ++t) {
        const float x0 = bf2f(buf[(t + 3) * 72 + lane]);
        float o = silu_f(w0 * xm3 + w1 * xm2 + w2 * xm1 + w3 * x0);
        xm3 = xm2; xm2 = xm1; xm1 = x0;
        if (NORM) { const float ss = wave_sum(o * o); o *= nscale * __builtin_amdgcn_rsqf(ss + NORM_EPS); }
        buf[t * 72 + lane] = (bf16)f2bf(o);
    }
    LDS_WAIT();
}
__device__ __forceinline__ void gdn_prep_item(int it, int l, const Args& args, LAS unsigned char* wlds, int lane) {
    unsigned char* ws = args.ws; const bf16* HB = (const bf16*)(ws + WS_HB);
    const int bh = it >> 7, n = it & 127, b = bh >> 2, h = bh & 3, tok0 = b * SEQ + n * 64, fr = lane & 15, fq = lane >> 4;
    LAS bf16* buf = (LAS bf16*)wlds; LAS float* sg = (LAS float*)(wlds + 16384);
    const float* cw = opaque(args.in[I_GD_CONV] + (size_t)l * 4 * 768);
    const float alog = opaque(args.in[I_GD_ALOG] + l * 4)[h], dtb = opaque(args.in[I_GD_DT] + l * 4)[h];
    const float beta_l = 1.0f / (1.0f + fexp(-bf2f(HB[(size_t)(tok0 + lane) * HBP + HB_GD_BETA + h])));
    const float apre = bf2f(HB[(size_t)(tok0 + lane) * HBP + HB_GD_A + h]) + dtb;
    const float sp = fmaxf(apre, 0.f) + log1pf(expf(-fabsf(apre)));
    const float gc_l = wave_incl_sum(-fexp(alog) * sp, lane);
    const float gend = __shfl(gc_l, 63);
    sg[lane] = gc_l; sg[64 + lane] = beta_l; sg[128 + lane] = fexp(gc_l);
    LDS_WAIT();
    const size_t cb = (size_t)it * 4096;
    bf16* Wo = (bf16*)(ws + WS_GD_W) + cb; bf16* UTo = (bf16*)(ws + WS_GD_UT) + cb; bf16* KDTo = (bf16*)(ws + WS_GD_KDT) + cb; bf16* QDo = (bf16*)(ws + WS_GD_QD) + cb; bf16* AQKo = (bf16*)(ws + WS_GD_AQK) + cb;
    gdn_conv_chunk<1>(HB, tok0, n == 0, HB_GD_K + h * 64, cw, 256 + h * 64, 1.0f, buf, lane);
#pragma unroll
    for (int t8 = 0; t8 < 8; ++t8) { v4u o;
#pragma unroll
        for (int j = 0; j < 4; ++j) { const int t = t8 * 8 + 2 * j; o[j] = pk2(bf2f(buf[t * 72 + lane]) * fexp(gend - sg[t]), bf2f(buf[(t + 1) * 72 + lane]) * fexp(gend - sg[t + 1])); }
        *(v4u*)(KDTo + lane * 64 + t8 * 8) = o; }
    Frag kf[4][2];
#pragma unroll
    for (int t = 0; t < 4; ++t)
#pragma unroll
        for (int ks = 0; ks < 2; ++ks) kf[t][ks].u = *(const LAS v4u*)(buf + (t * 16 + fr) * 72 + ks * 32 + fq * 8);
    LDS_WAIT();
    gdn_conv_chunk<1>(HB, tok0, n == 0, HB_GD_Q + h * 64, cw, h * 64, 0.125f, buf, lane);
#pragma unroll 8
    for (int t = 0; t < 64; ++t) QDo[t * 64 + lane] = (bf16)f2bf(bf2f(buf[t * 72 + lane]) * sg[128 + t]);
    float gci[4][4], gcj[4];
#pragma unroll
    for (int mt = 0; mt < 4; ++mt)
#pragma unroll
        for (int ii = 0; ii < 4; ++ii) gci[mt][ii] = sg[mt * 16 + fq * 4 + ii];
#pragma unroll
    for (int nt = 0; nt < 4; ++nt) gcj[nt] = sg[nt * 16 + fr];
#pragma unroll
    for (int mt = 0; mt < 4; ++mt) {
        Frag q0, q1; q0.u = *(const LAS v4u*)(buf + (mt * 16 + fr) * 72 + fq * 8); q1.u = *(const LAS v4u*)(buf + (mt * 16 + fr) * 72 + 32 + fq * 8);
#pragma unroll
        for (int nt = 0; nt < 4; ++nt) { f32x4 acc = {0.f, 0.f, 0.f, 0.f};
            if (nt <= mt) { acc = mfma16(q0.v, kf[nt][0].v, acc); acc = mfma16(q1.v, kf[nt][1].v, acc); }
#pragma unroll
            for (int ii = 0; ii < 4; ++ii) { const int i = mt * 16 + fq * 4 + ii, j = nt * 16 + fr; const float vv = (nt <= mt && i >= j) ? acc[ii] * fexp(gci[mt][ii] - gcj[nt]) : 0.f; AQKo[i * 64 + j] = (bf16)f2bf(vv); } } }
    LDS_WAIT();
    gdn_conv_chunk<0>(HB, tok0, n == 0, HB_GD_V + h * 64, cw, 512 + h * 64, 1.0f, buf, lane);
    LAS float* Xl = (LAS float*)wlds;
    { float xx[64];
#pragma unroll
      for (int t = 0; t < 64; ++t) xx[t] = bf2f(buf[t * 72 + lane]) * sg[64 + t];
      LDS_WAIT();
#pragma unroll
      for (int t = 0; t < 64; ++t) Xl[t * 64 + lane] = xx[t]; }
    float am[4][4][4];
#define GDN_SOLVE() do { _Pragma("unroll") for (int mt = 0; mt < 4; ++mt) { \
        _Pragma("unroll") for (int nt = 0; nt < mt; ++nt) { float xo[16]; \
            _Pragma("unroll") for (int jj = 0; jj < 16; ++jj) xo[jj] = Xl[(nt * 16 + jj) * 64 + lane]; \
            for (int fqp = 0; fqp < 4; ++fqp) { _Pragma("unroll") for (int ii = 0; ii < 4; ++ii) { const int i = mt * 16 + fqp * 4 + ii; float xi = Xl[i * 64 + lane]; \
                const float af = am[mt][nt][ii]; const int av = __builtin_bit_cast(int, af); \
                _Pragma("unroll") for (int jj = 0; jj < 16; ++jj) xi -= __builtin_bit_cast(float, __builtin_amdgcn_readlane(av, fqp * 16 + jj)) * xo[jj]; \
                Xl[i * 64 + lane] = xi; } } } \
        { float xd[16]; \
          _Pragma("unroll") for (int r = 0; r < 16; ++r) xd[r] = Xl[(mt * 16 + r) * 64 + lane]; \
          _Pragma("unroll") for (int r = 1; r < 16; ++r) { const float af = am[mt][mt][r & 3]; const int av = __builtin_bit_cast(int, af); \
              _Pragma("unroll") for (int jj = 0; jj < r; ++jj) xd[r] -= __builtin_bit_cast(float, __builtin_amdgcn_readlane(av, (r >> 2) * 16 + jj)) * xd[jj]; } \
          _Pragma("unroll") for (int r = 1; r < 16; ++r) Xl[(mt * 16 + r) * 64 + lane] = xd[r]; } } } while (0)
#pragma unroll
    for (int mt = 0; mt < 4; ++mt)
#pragma unroll
        for (int nt = 0; nt < 4; ++nt) { f32x4 acc = {0.f, 0.f, 0.f, 0.f};
            if (nt <= mt) { acc = mfma16(kf[mt][0].v, kf[nt][0].v, acc); acc = mfma16(kf[mt][1].v, kf[nt][1].v, acc); }
#pragma unroll
            for (int ii = 0; ii < 4; ++ii) { const int i = mt * 16 + fq * 4 + ii, j = nt * 16 + fr; am[mt][nt][ii] = (nt <= mt && i > j) ? acc[ii] * sg[64 + i] * fexp(gci[mt][ii] - gcj[nt]) : 0.f; } }
    asm volatile("" ::: "memory");
    GDN_SOLVE();
#pragma unroll
    for (int t8 = 0; t8 < 8; ++t8) { v4u o;
#pragma unroll
        for (int j = 0; j < 4; ++j) o[j] = pk2(Xl[(t8 * 8 + 2 * j) * 64 + lane], Xl[(t8 * 8 + 2 * j + 1) * 64 + lane]);
        *(v4u*)(UTo + lane * 64 + t8 * 8) = o; }
    LDS_WAIT();
    gdn_conv_chunk<1>(HB, tok0, n == 0, HB_GD_K + h * 64, cw, 256 + h * 64, 1.0f, buf, lane);
    { float xx[64];
#pragma unroll
      for (int t = 0; t < 64; ++t) xx[t] = bf2f(buf[t * 72 + lane]) * sg[64 + t] * sg[128 + t];
      LDS_WAIT();
#pragma unroll
      for (int t = 0; t < 64; ++t) Xl[t * 64 + lane] = xx[t]; }
#pragma unroll
    for (int mt = 0; mt < 4; ++mt)
#pragma unroll
        for (int nt = 0; nt < 4; ++nt) { f32x4 acc = {0.f, 0.f, 0.f, 0.f};
            if (nt <= mt) { acc = mfma16(kf[mt][0].v, kf[nt][0].v, acc); acc = mfma16(kf[mt][1].v, kf[nt][1].v, acc); }
#pragma unroll
            for (int ii = 0; ii < 4; ++ii) { const int i = mt * 16 + fq * 4 + ii, j = nt * 16 + fr; am[mt][nt][ii] = (nt <= mt && i > j) ? acc[ii] * sg[64 + i] * fexp(gci[mt][ii] - gcj[nt]) : 0.f; } }
    asm volatile("" ::: "memory");
    GDN_SOLVE();
#pragma unroll 8
    for (int t = 0; t < 64; ++t) Wo[t * 64 + lane] = (bf16)f2bf(Xl[t * 64 + lane]);
    ((float*)(ws + WS_GD_GE))[it] = fexp(gend);
    LDS_WAIT();
}
__device__ __forceinline__ void gdn_scan_item(int it, const Args& args, int lane) {
    unsigned char* ws = args.ws; const int bh = it >> 2, vg = it & 3, fr = lane & 15, fq = lane >> 4;
    const bf16* Wb = (const bf16*)(ws + WS_GD_W); const bf16* UTb = (const bf16*)(ws + WS_GD_UT); const bf16* KDTb = (const bf16*)(ws + WS_GD_KDT);
    bf16* STb = (bf16*)(ws + WS_GD_ST); bf16* VNTb = (bf16*)(ws + WS_GD_VNT); const float* GE = (const float*)(ws + WS_GD_GE);
    f32x4 S[4];
#pragma unroll
    for (int mt = 0; mt < 4; ++mt) S[mt] = (f32x4){0.f, 0.f, 0.f, 0.f};
#define GDN_SCAN_LOAD(AW, AKD, UTV, GEV, nn) do { const size_t cb_ = (size_t)(bh * 128 + (nn)) * 4096; _Pragma("unroll") for (int mt = 0; mt < 4; ++mt) { _Pragma("unroll") for (int s = 0; s < 2; ++s) { \
        const bf16* wp = Wb + cb_ + (mt * 16 + fr) * 64 + (2 * s) * 16 + fq * 4; const v2u a0 = *(const v2u*)wp, a1 = *(const v2u*)(wp + 16); AW[mt][s].w[0] = a0.x; AW[mt][s].w[1] = a0.y; AW[mt][s].w[2] = a1.x; AW[mt][s].w[3] = a1.y; \
        const bf16* kp = KDTb + cb_ + (mt * 16 + fr) * 64 + (2 * s) * 16 + fq * 4; const v2u k0 = *(const v2u*)kp, k1 = *(const v2u*)(kp + 16); AKD[mt][s].w[0] = k0.x; AKD[mt][s].w[1] = k0.y; AKD[mt][s].w[2] = k1.x; AKD[mt][s].w[3] = k1.y; } \
        UTV[mt] = *(const v2u*)(UTb + cb_ + (vg * 16 + fr) * 64 + mt * 16 + fq * 4); } GEV = GE[bh * 128 + (nn)]; } while (0)
    Frag aw[4][2], akd[4][2], awn[4][2], akdn[4][2]; v2u ut[4], utn[4]; float ge, gen;
    GDN_SCAN_LOAD(aw, akd, ut, ge, 0);
    for (int n = 0; n < 128; ++n) {
        const size_t cb = (size_t)(bh * 128 + n) * 4096;
        { const int nn = (n + 1 < 128) ? n + 1 : n; GDN_SCAN_LOAD(awn, akdn, utn, gen, nn); }
        Frag bS[2];
#pragma unroll
        for (int s = 0; s < 2; ++s) { bS[s].w[0] = pk2(S[2 * s][0], S[2 * s][1]); bS[s].w[1] = pk2(S[2 * s][2], S[2 * s][3]); bS[s].w[2] = pk2(S[2 * s + 1][0], S[2 * s + 1][1]); bS[s].w[3] = pk2(S[2 * s + 1][2], S[2 * s + 1][3]); }
#pragma unroll
        for (int mt = 0; mt < 4; ++mt) { v2u o; o.x = pk2(S[mt][0], S[mt][1]); o.y = pk2(S[mt][2], S[mt][3]); *(v2u*)(STb + cb + (vg * 16 + fr) * 64 + mt * 16 + fq * 4) = o; }
        Frag bV[2]; unsigned vnw[4][2];
#pragma unroll
        for (int mt = 0; mt < 4; ++mt) { f32x4 acc = {0.f, 0.f, 0.f, 0.f}; acc = mfma16(aw[mt][0].v, bS[0].v, acc); acc = mfma16(aw[mt][1].v, bS[1].v, acc);
            const float v0 = bflo(ut[mt].x) - acc[0], v1 = bfhi(ut[mt].x) - acc[1], v2 = bflo(ut[mt].y) - acc[2], v3 = bfhi(ut[mt].y) - acc[3];
            vnw[mt][0] = pk2(v0, v1); vnw[mt][1] = pk2(v2, v3);
            v2u o; o.x = vnw[mt][0]; o.y = vnw[mt][1]; *(v2u*)(VNTb + cb + (vg * 16 + fr) * 64 + mt * 16 + fq * 4) = o; }
#pragma unroll
        for (int s = 0; s < 2; ++s) { bV[s].w[0] = vnw[2 * s][0]; bV[s].w[1] = vnw[2 * s][1]; bV[s].w[2] = vnw[2 * s + 1][0]; bV[s].w[3] = vnw[2 * s + 1][1]; }
#pragma unroll
        for (int mt = 0; mt < 4; ++mt) { f32x4 acc = S[mt] * ge; acc = mfma16(akd[mt][0].v, bV[0].v, acc); acc = mfma16(akd[mt][1].v, bV[1].v, acc); S[mt] = acc; }
#pragma unroll
        for (int mt = 0; mt < 4; ++mt) { aw[mt][0] = awn[mt][0]; aw[mt][1] = awn[mt][1]; akd[mt][0] = akdn[mt][0]; akd[mt][1] = akdn[mt][1]; ut[mt] = utn[mt]; }
        ge = gen;
    }
}
__device__ __forceinline__ void gdn_out_item(int it, int l, const Args& args, int lane) {
    unsigned char* ws = args.ws; const bf16* HB = (const bf16*)(ws + WS_HB); bf16* XN = (bf16*)(ws + WS_XN);
    const int bh = it >> 7, n = it & 127, b = bh >> 2, h = bh & 3, tok0 = b * SEQ + n * 64, fr = lane & 15, fq = lane >> 4;
    const size_t cb = (size_t)it * 4096;
    const bf16* ST = (const bf16*)(ws + WS_GD_ST) + cb; const bf16* VNT = (const bf16*)(ws + WS_GD_VNT) + cb; const bf16* QD = (const bf16*)(ws + WS_GD_QD) + cb; const bf16* AQK = (const bf16*)(ws + WS_GD_AQK) + cb;
    const float* ng = opaque(args.in[I_GD_NG] + l * 64);
    Frag sa[4][2], va[4][2];
#pragma unroll
    for (int vt = 0; vt < 4; ++vt)
#pragma unroll
        for (int ks = 0; ks < 2; ++ks) { sa[vt][ks].u = *(const v4u*)(ST + (vt * 16 + fr) * 64 + ks * 32 + fq * 8); va[vt][ks].u = *(const v4u*)(VNT + (vt * 16 + fr) * 64 + ks * 32 + fq * 8); }
    for (int lt = 0; lt < 4; ++lt) {
        const int tl = lt * 16 + fr;
        Frag qb[2], ab[2];
#pragma unroll
        for (int ks = 0; ks < 2; ++ks) { qb[ks].u = *(const v4u*)(QD + tl * 64 + ks * 32 + fq * 8); ab[ks].u = *(const v4u*)(AQK + tl * 64 + ks * 32 + fq * 8); }
        f32x4 o[4]; float ss = 0.f;
#pragma unroll
        for (int vt = 0; vt < 4; ++vt) { f32x4 acc = {0.f, 0.f, 0.f, 0.f};
#pragma unroll
            for (int ks = 0; ks < 2; ++ks) { acc = mfma16(sa[vt][ks].v, qb[ks].v, acc); acc = mfma16(va[vt][ks].v, ab[ks].v, acc); }
            o[vt] = acc; ss += acc[0] * acc[0] + acc[1] * acc[1] + acc[2] * acc[2] + acc[3] * acc[3]; }
        ss = red4_sum(ss);
        const float rn = 1.0f / sqrtf(ss * (1.f / 64.f) + NORM_EPS);
        bf16* orow = XN + (size_t)(tok0 + tl) * DM + 512 + h * 64 + fq * 4;
#pragma unroll
        for (int vt = 0; vt < 4; ++vt) { const v2u zw = *(const v2u*)(HB + (size_t)(tok0 + tl) * HBP + HB_GD_Z + h * 64 + vt * 16 + fq * 4);
            const float* gp = ng + vt * 16 + fq * 4;
            v2u w; w.x = pk2(o[vt][0] * rn * gp[0] * silu_f(bflo(zw.x)), o[vt][1] * rn * gp[1] * silu_f(bfhi(zw.x))); w.y = pk2(o[vt][2] * rn * gp[2] * silu_f(bflo(zw.y)), o[vt][3] * rn * gp[3] * silu_f(bfhi(zw.y)));
            *(v2u*)(orow + vt * 16) = w; }
    }
}

__device__ __forceinline__ void nsa_cmp_item(int it2, int l, const Args& args, int lane) {
    unsigned char* ws = args.ws; const bf16* HB = (const bf16*)(ws + WS_HB);
    const int it = it2 >> 1, nh = (it2 & 1) * 2;
    const int b = it >> 6, kind = (it >> 5) & 1, jt = it & 31, fr = lane & 15, fq = lane >> 4;
    const bf16* wt = opaque((const bf16*)(ws + WS_WSM + l * WSM_L + (kind ? WSM_CV : WSM_CK)));
    const float* pos = opaque(args.in[I_CMPPOS] + l * 2048);
    const int j = jt * 16 + fr, col = kind ? HB_NSA_VC : HB_NSA_KC;
    f32x4 acc[2];
#pragma unroll
    for (int nt = 0; nt < 2; ++nt) acc[nt] = (f32x4){0.f, 0.f, 0.f, 0.f};
#pragma unroll 4
    for (int ks = 0; ks < 64; ++ks) {
        const int i = ks >> 1, d0 = (ks & 1) * 32 + fq * 8;
        Frag a; a.u = (v4u){0u, 0u, 0u, 0u};
        if (j < 511) { const v4u x = *(const v4u*)(HB + (size_t)(b * SEQ + 16 * j + i) * HBP + col + d0); const float* pp = pos + i * 64 + d0;
#pragma unroll
            for (int q = 0; q < 4; ++q) a.w[q] = pk2(bflo(x[q]) + pp[2 * q], bfhi(x[q]) + pp[2 * q + 1]); }
#pragma unroll
        for (int nt = 0; nt < 2; ++nt) { Frag bw; bw.u = *(const v4u*)(wt + (size_t)((nh + nt) * 16 + fr) * 2048 + ks * 32 + fq * 8); acc[nt] = mfma16(a.v, bw.v, acc[nt]); }
    }
    if (kind == 0) { bf16* Ko = (bf16*)(ws + WS_NSA_KCMP) + (size_t)b * 512 * 64;
#pragma unroll
        for (int nt = 0; nt < 2; ++nt)
#pragma unroll
            for (int i = 0; i < 4; ++i) Ko[(jt * 16 + fq * 4 + i) * 64 + (nh + nt) * 16 + fr] = (bf16)f2bf(acc[nt][i]);
    } else { bf16* Vo = (bf16*)(ws + WS_NSA_VCMPT) + (size_t)b * 64 * 512;
#pragma unroll
        for (int nt = 0; nt < 2; ++nt) { v2u o; o.x = pk2(acc[nt][0], acc[nt][1]); o.y = pk2(acc[nt][2], acc[nt][3]); *(v2u*)(Vo + ((nh + nt) * 16 + fr) * 512 + jt * 16 + fq * 4) = o; } }
}
__device__ __forceinline__ void nsa_vt_item(int it, int l, const Args& args, LAS unsigned char* wlds, int lane) {
    unsigned char* ws = args.ws; const bf16* HB = (const bf16*)(ws + WS_HB);
    const int b = it >> 8, which = (it >> 7) & 1, n = it & 127;
    LAS bf16* buf = (LAS bf16*)wlds;
    stage64(HB, b * SEQ + n * 64, which ? HB_NSA_VW : HB_NSA_VS, buf, lane);
    if (which) {
        const int fr = lane & 15, fq = lane >> 4;
        bf16* vdst = (bf16*)(ws + WS_NSA_VWT) + ((size_t)(b * 256 + n * 2) * 4) * 512 + lane * 8;
        bf16* kdst = (bf16*)(ws + WS_WIN + l * WIN_L) + ((size_t)(b * 256 + n * 2) * 4) * 512 + lane * 8;
#pragma unroll
        for (int hb = 0; hb < 2; ++hb)
#pragma unroll
            for (int dt = 0; dt < 4; ++dt) { v4u o;
#pragma unroll
                for (int q = 0; q < 2; ++q) {
                    o[q] = (unsigned)buf[(hb * 32 + fq * 4 + 2 * q) * 72 + dt * 16 + fr] | ((unsigned)buf[(hb * 32 + fq * 4 + 2 * q + 1) * 72 + dt * 16 + fr] << 16);
                    o[2 + q] = (unsigned)buf[(hb * 32 + 16 + fq * 4 + 2 * q) * 72 + dt * 16 + fr] | ((unsigned)buf[(hb * 32 + 16 + fq * 4 + 2 * q + 1) * 72 + dt * 16 + fr] << 16); }
                *(v4u*)(vdst + (hb * 4 + dt) * 512) = o; }
#pragma unroll
        for (int hb = 0; hb < 2; ++hb)
#pragma unroll
            for (int tt = 0; tt < 2; ++tt)
#pragma unroll
                for (int ks = 0; ks < 2; ++ks) { const v4u x = *(const v4u*)(HB + (size_t)(b * SEQ + n * 64 + hb * 32 + tt * 16 + fr) * HBP + HB_NSA_KW + ks * 32 + fq * 8); *(v4u*)(kdst + (hb * 4 + tt * 2 + ks) * 512) = x; }
    } else {
        const int fr = lane & 15, fq = lane >> 4;
        bf16* vdst = (bf16*)(ws + WS_NSA_VST) + ((size_t)(b * 128 + n) * 8) * 512 + lane * 8;
        bf16* kdst = (bf16*)(ws + WS_NSA_KSW) + ((size_t)(b * 128 + n) * 8) * 512 + lane * 8;
#pragma unroll
        for (int dt = 0; dt < 4; ++dt)
#pragma unroll
            for (int k2 = 0; k2 < 2; ++k2) { v4u o;
#pragma unroll
                for (int q = 0; q < 2; ++q) {
                    o[q] = (unsigned)buf[(k2 * 32 + fq * 4 + 2 * q) * 72 + dt * 16 + fr] | ((unsigned)buf[(k2 * 32 + fq * 4 + 2 * q + 1) * 72 + dt * 16 + fr] << 16);
                    o[2 + q] = (unsigned)buf[(k2 * 32 + 16 + fq * 4 + 2 * q) * 72 + dt * 16 + fr] | ((unsigned)buf[(k2 * 32 + 16 + fq * 4 + 2 * q + 1) * 72 + dt * 16 + fr] << 16); }
                *(v4u*)(vdst + (dt * 2 + k2) * 512) = o; }
#pragma unroll
        for (int kt = 0; kt < 4; ++kt)
#pragma unroll
            for (int ks = 0; ks < 2; ++ks) { const v4u x = *(const v4u*)(HB + (size_t)(b * SEQ + n * 64 + kt * 16 + fr) * HBP + HB_NSA_KS + ks * 32 + fq * 8); *(v4u*)(kdst + (kt * 2 + ks) * 512) = x; }
    }
    LDS_WAIT();
}
__device__ __forceinline__ void nsa_lut_init(const float* t5, LAS float* lut, int lane) {
#pragma unroll
    for (int r = 0; r < 2; ++r) { const int k = r * 64 + lane, d = (k > 0) ? k - 1 : 0; int bk = d;
        if (d >= 16) { bk = 16 + (int)(logf((float)d / 16.0f) / 2.0794415f * 16.0f); bk = bk < 31 ? bk : 31; }
#pragma unroll
        for (int h = 0; h < 4; ++h) lut[h * 128 + k] = (k > 0) ? t5[bk * 4 + h] : -1e30f; }
    LDS_WAIT();
}
#define NSA_BIAS(dist, h, b31v) (lut[(h) * 128 + (((dist) < -1) ? 0 : (((dist) > 126) ? 127 : (dist) + 1))])
__device__ __forceinline__ void nsa_item(int b, int qt, int l, const Args& args, LAS unsigned char* wlds, int lane) {
    unsigned char* ws = args.ws; const bf16* HB = (const bf16*)(ws + WS_HB); bf16* XN = (bf16*)(ws + WS_XN);
    const int t0 = qt * 16, tok0 = b * SEQ + t0, cur = t0 >> 6, fr = lane & 15, fq = lane >> 4;
    LAS bf16* outb = (LAS bf16*)(wlds + 8192); LAS float* imp = (LAS float*)wlds; const LAS float* lut = (const LAS float*)(wlds + 16384);
    const float* t5 = opaque(args.in[I_T5]);
    const float L2E = 1.4426950408889634f;
    Frag qa[4][2];
#pragma unroll
    for (int h = 0; h < 4; ++h)
#pragma unroll
        for (int ks = 0; ks < 2; ++ks) qa[h][ks].u = *(const v4u*)(HB + (size_t)(tok0 + fr) * HBP + HB_NSA_Q + h * 64 + ks * 32 + fq * 8);
    const int tq = t0 + fr;
#pragma unroll
    for (int i = 0; i < 32; ++i) imp[i * 64 + lane] = 0.f;
    const bf16* KC = (const bf16*)(ws + WS_NSA_KCMP) + (size_t)b * 512 * 64; const bf16* VCT = (const bf16*)(ws + WS_NSA_VCMPT) + (size_t)b * 64 * 512;
    const int nblk = t0 >> 4, npair = (nblk + 31) >> 5;
    float mc[4], lc[4];
#pragma unroll
    for (int h = 0; h < 4; ++h) { mc[h] = -1e30f; lc[h] = 0.f; }
    Frag kc1[2];
#pragma unroll
    for (int ks = 0; ks < 2; ++ks) kc1[ks].u = *(const v4u*)(KC + (size_t)fr * 64 + ks * 32 + fq * 8);
    for (int kt = 0; kt < 2 * npair; ++kt) {
        Frag kf[2], kn1[2];
        { const int ktn = (kt + 1 < 2 * npair) ? kt + 1 : kt;
#pragma unroll
          for (int ks = 0; ks < 2; ++ks) kn1[ks].u = *(const v4u*)(KC + (size_t)(ktn * 16 + fr) * 64 + ks * 32 + fq * 8); }
        kf[0].u = kc1[0].u; kf[1].u = kc1[1].u;
#pragma unroll
        for (int h = 0; h < 4; ++h) { f32x4 acc = {0.f, 0.f, 0.f, 0.f}; acc = mfma16(kf[0].v, qa[h][0].v, acc); acc = mfma16(kf[1].v, qa[h][1].v, acc);
            float s[4]; float mx = -1e30f;
#pragma unroll
            for (int i = 0; i < 4; ++i) { const int dist = tq - (16 * (kt * 16 + fq * 4 + i) + 31); const float bb = NSA_BIAS(dist, h, 0); s[i] = acc[i] * 0.125f + bb; mx = fmaxf(mx, s[i]); }
            mx = red4_max(mx);
            const float mn = fmaxf(mc[h], mx); float ps = 0.f;
#pragma unroll
            for (int i = 0; i < 4; ++i) ps += __builtin_amdgcn_exp2f((s[i] - fmaxf(mn, -1e20f)) * L2E);
            lc[h] = lc[h] * __builtin_amdgcn_exp2f((mc[h] - mn) * L2E) + ps; mc[h] = mn; }
        kc1[0].u = kn1[0].u; kc1[1].u = kn1[1].u;
    }
#pragma unroll
    for (int h = 0; h < 4; ++h) { float t = lc[h]; t = red4_sum(t); lc[h] = (t > 0.f) ? 1.0f / t : 0.f; }
    f32x4 oc[4][4];
#pragma unroll
    for (int dt = 0; dt < 4; ++dt)
#pragma unroll
        for (int h = 0; h < 4; ++h) oc[dt][h] = (f32x4){0.f, 0.f, 0.f, 0.f};
    for (int kp = 0; kp < npair; ++kp) {
        unsigned pw[4][4];
#pragma unroll
        for (int tt = 0; tt < 2; ++tt) { const int kt = kp * 2 + tt; Frag kf[2];
#pragma unroll
            for (int ks = 0; ks < 2; ++ks) kf[ks].u = *(const v4u*)(KC + (size_t)(kt * 16 + fr) * 64 + ks * 32 + fq * 8);
            float impv = 0.f;
#pragma unroll
            for (int h = 0; h < 4; ++h) { f32x4 acc = {0.f, 0.f, 0.f, 0.f}; acc = mfma16(kf[0].v, qa[h][0].v, acc); acc = mfma16(kf[1].v, qa[h][1].v, acc);
                float p[4];
#pragma unroll
                for (int i = 0; i < 4; ++i) { const int dist = tq - (16 * (kt * 16 + fq * 4 + i) + 31);
                    const float bb = NSA_BIAS(dist, h, 0); p[i] = __builtin_amdgcn_exp2f(((acc[i] * 0.125f + bb) - fmaxf(mc[h], -1e20f)) * L2E) * lc[h]; }
                impv += p[0] + p[1] + p[2];
                pw[h][2 * tt] = pk2(p[0], p[1]); pw[h][2 * tt + 1] = pk2(p[2], p[3]); }
            imp[fr * 128 + kt * 4 + fq] = impv; __builtin_amdgcn_sched_barrier(0); }
#pragma unroll
        for (int dt = 0; dt < 4; ++dt) { const bf16* vp = VCT + (size_t)(dt * 16 + fr) * 512 + kp * 32 + fq * 4; const v2u lo2 = *(const v2u*)vp, hi2 = *(const v2u*)(vp + 16);
            Frag vf; vf.w[0] = lo2.x; vf.w[1] = lo2.y; vf.w[2] = hi2.x; vf.w[3] = hi2.y;
#pragma unroll
            for (int h = 0; h < 4; ++h) { Frag pf; pf.w[0] = pw[h][0]; pf.w[1] = pw[h][1]; pf.w[2] = pw[h][2]; pf.w[3] = pw[h][3]; oc[dt][h] = mfma16(vf.v, pf.v, oc[dt][h]); } }
    }
#pragma unroll
    for (int h = 0; h < 4; ++h) { const float gc_ = 1.0f / (1.0f + fexp(-bf2f(HB[(size_t)(tok0 + fr) * HBP + HB_NSA_G + 0 + h])));
#pragma unroll
        for (int dt = 0; dt < 4; ++dt) { v2u w; w.x = pk2(oc[dt][h][0] * gc_, oc[dt][h][1] * gc_); w.y = pk2(oc[dt][h][2] * gc_, oc[dt][h][3] * gc_); *(LAS v2u*)(outb + fr * 256 + h * 64 + dt * 16 + fq * 4) = w; } }
    LDS_WAIT();
    unsigned taken = 0u;
    if (cur >= 16) {
        float cand[32];
#pragma unroll
        for (int k = 0; k < 32; ++k) { const int s = fq * 32 + k; cand[k] = (s >= 1 && s <= cur - 2) ? imp[fr * 128 + s] : -1.0f; }
        for (int r = 0; r < 13; ++r) {
            float bv = -1.0f; int bk = 0;
#pragma unroll
            for (int k = 0; k < 32; ++k) { const bool free_ = ((taken >> k) & 1u) == 0u; if (free_ && cand[k] > bv) { bv = cand[k]; bk = k; } }
            int bs = fq * 32 + bk;
#pragma unroll
            for (int o = 16; o <= 32; o <<= 1) { const float ov = __shfl_xor(bv, o); const int os = __shfl_xor(bs, o); if (ov > bv || (ov == bv && os < bs)) { bv = ov; bs = os; } }
            taken |= ((bs >> 5) == fq && bv >= 0.f) ? (1u << (bs & 31)) : 0u;
        }
        taken |= (fq == 0) ? 1u : 0u;
        taken |= ((cur >> 5) == fq) ? (1u << (cur & 31)) : 0u;
        taken |= (((cur - 1) >> 5) == fq) ? (1u << ((cur - 1) & 31)) : 0u;
    } else {
        taken = (fq == 0) ? ((2u << cur) - 1u) : 0u;
    }
    LDS_WAIT();
    const bf16* VST = (const bf16*)(ws + WS_NSA_VST) + (size_t)b * 128 * 4096; const bf16* KSW = (const bf16*)(ws + WS_NSA_KSW) + (size_t)b * 128 * 4096;
    { const int qi = fr >> 2, hh = fr & 3;
      LAS unsigned char* blist = (LAS unsigned char*)wlds;
#define NSA_SEL_LOADK(KF, sblk_) do { const bf16* kp_ = KSW + (size_t)(sblk_) * 4096 + lane * 8; \
        _Pragma("unroll") for (int kt = 0; kt < 4; ++kt) _Pragma("unroll") for (int ks = 0; ks < 2; ++ks) KF[kt][ks].u = *(const v4u*)(kp_ + (kt * 2 + ks) * 512); } while (0)
#define NSA_SEL_LOADV(VF, sblk_) do { const bf16* vp_ = VST + (size_t)(sblk_) * 4096 + lane * 8; \
        _Pragma("unroll") for (int dt = 0; dt < 4; ++dt) _Pragma("unroll") for (int k2 = 0; k2 < 2; ++k2) VF[dt][k2].u = *(const v4u*)(vp_ + (dt * 2 + k2) * 512); } while (0)
#define NSA_SEL_STEP_(KF, VF, sblk_, FAR) do { const int key0 = (sblk_) * 64; const unsigned mwd_ = ((sblk_) >> 5) == 0 ? mw0 : ((sblk_) >> 5) == 1 ? mw1 : ((sblk_) >> 5) == 2 ? mw2 : mw3; const float selm_ = (((mwd_ >> ((sblk_) & 31)) & 1u) != 0u) ? 0.f : -1e30f; \
        f32x4 sc[4]; float mx = -1e30f; const float c0_ = bfar_ + selm_;     \
        _Pragma("unroll") for (int kt = 0; kt < 4; ++kt) { f32x4 acc = {0.f, 0.f, 0.f, 0.f}; acc = mfma16(KF[kt][0].v, qs[0].v, acc); acc = mfma16(KF[kt][1].v, qs[1].v, acc); \
            _Pragma("unroll") for (int i = 0; i < 4; ++i) { if (FAR) sc[kt][i] = acc[i] * 0.125f + c0_; else { const int dist = tqs - (key0 + kt * 16 + fq * 4 + i); const float bb = NSA_BIAS(dist, hh, 0); sc[kt][i] = (acc[i] * 0.125f + bb) + selm_; } mx = fmaxf(mx, sc[kt][i]); } } \
        mx = red4_max(mx); \
        const float mn = fmaxf(ms, mx), alpha = __builtin_amdgcn_exp2f((ms - mn) * L2E), nml_ = -fmaxf(mn, -1e20f) * L2E; ms = mn; \
        float ps = 0.f; unsigned pw[4][2]; \
        _Pragma("unroll") for (int kt = 0; kt < 4; ++kt) { float p[4]; \
            _Pragma("unroll") for (int i = 0; i < 4; ++i) { p[i] = __builtin_amdgcn_exp2f(__builtin_fmaf(sc[kt][i], L2E, nml_)); ps += p[i]; } \
            pw[kt][0] = pk2(p[0], p[1]); pw[kt][1] = pk2(p[2], p[3]); } \
        if (__builtin_amdgcn_ballot_w64(alpha != 1.0f) != 0ull) { ls = ls * alpha; _Pragma("unroll") for (int dt = 0; dt < 4; ++dt) os_[dt] = os_[dt] * alpha; }     \
        ls += ps; \
        _Pragma("unroll") for (int dt = 0; dt < 4; ++dt) { \
            _Pragma("unroll") for (int k2 = 0; k2 < 2; ++k2) { Frag pf; pf.w[0] = pw[2 * k2][0]; pf.w[1] = pw[2 * k2][1]; pf.w[2] = pw[2 * k2 + 1][0]; pf.w[3] = pw[2 * k2 + 1][1]; os_[dt] = mfma16(VF[dt][k2].v, pf.v, os_[dt]); } } } while (0)
#define NSA_SEL_STEP(KF, VF, sblk_) do { if ((sblk_) * 64 + 189 <= t0 + g * 4) NSA_SEL_STEP_(KF, VF, sblk_, 1); else NSA_SEL_STEP_(KF, VF, sblk_, 0); } while (0)
    const float bfar_ = lut[hh * 128 + 127];
    for (int g = 0; g < 4; ++g) {
        const int tqs = t0 + g * 4 + qi;
        Frag qs[2];
#pragma unroll
        for (int ks = 0; ks < 2; ++ks) qs[ks].u = *(const v4u*)(HB + (size_t)(tok0 + g * 4 + qi) * HBP + HB_NSA_Q + hh * 64 + ks * 32 + fq * 8);
        f32x4 os_[4];
#pragma unroll
        for (int dt = 0; dt < 4; ++dt) os_[dt] = (f32x4){0.f, 0.f, 0.f, 0.f};
        float ms = -1e30f, ls = 0.f;
        const unsigned mw0 = (unsigned)__shfl((int)taken, (g * 4 + qi)), mw1 = (unsigned)__shfl((int)taken, (g * 4 + qi) + 16), mw2 = (unsigned)__shfl((int)taken, (g * 4 + qi) + 32), mw3 = (unsigned)__shfl((int)taken, (g * 4 + qi) + 48);
        int nb = 0;
        for (int wd = 0; wd < 4; ++wd) { unsigned uni = 0u;
#pragma unroll
            for (int q2 = 0; q2 < 4; ++q2) uni |= (unsigned)__shfl((int)taken, (g * 4 + q2) + 16 * wd);
            uni = (unsigned)__builtin_amdgcn_readfirstlane((int)uni);
            while (uni) { const int bit = __builtin_ctz(uni); uni &= uni - 1u; blist[nb] = (unsigned char)(wd * 32 + bit); ++nb; } }
        LDS_WAIT();
        Frag kA[4][2], kB[4][2], vv[4][2];
        { const int s0b = __builtin_amdgcn_readfirstlane((int)blist[0]); NSA_SEL_LOADK(kA, s0b); }
        for (int i = 0; i < nb; i += 2) {
            const int sa = __builtin_amdgcn_readfirstlane((int)blist[i]); const int sb = __builtin_amdgcn_readfirstlane((int)blist[(i + 1 < nb) ? i + 1 : i]);
            NSA_SEL_LOADV(vv, sa); NSA_SEL_LOADK(kB, sb);
            NSA_SEL_STEP(kA, vv, sa);
            if (i + 1 < nb) { const int sc2 = __builtin_amdgcn_readfirstlane((int)blist[(i + 2 < nb) ? i + 2 : i]); NSA_SEL_LOADV(vv, sb); NSA_SEL_LOADK(kA, sc2); NSA_SEL_STEP(kB, vv, sb); }
        }
        ls = red4_sum(ls);
        const float gsel = (1.0f / (1.0f + fexp(-bf2f(HB[(size_t)(tok0 + g * 4 + qi) * HBP + HB_NSA_G + 4 + hh])))) / ls;
#pragma unroll
        for (int dt = 0; dt < 4; ++dt) { LAS v2u* op = (LAS v2u*)(outb + (g * 4 + qi) * 256 + hh * 64 + dt * 16 + fq * 4); const v2u a = *op; v2u w; w.x = pk2(bflo(a.x) + os_[dt][0] * gsel, bfhi(a.x) + os_[dt][1] * gsel); w.y = pk2(bflo(a.y) + os_[dt][2] * gsel, bfhi(a.y) + os_[dt][3] * gsel); *op = w; }
    } }
    LDS_WAIT();
#pragma unroll
    for (int h = 0; h < 4; ++h)
#pragma unroll
        for (int ks = 0; ks < 2; ++ks) qa[h][ks].u = *(const v4u*)(opaque(HB) + (size_t)(tok0 + fr) * HBP + HB_NSA_Q + h * 64 + ks * 32 + fq * 8);
    const bf16* VWT = (const bf16*)(ws + WS_NSA_VWT) + (size_t)b * 256 * 2048; const bf16* KWW = (const bf16*)(ws + WS_WIN + l * WIN_L) + (size_t)b * 256 * 2048;
    f32x4 ow[4][4];
#pragma unroll
    for (int dt = 0; dt < 4; ++dt)
#pragma unroll
        for (int h = 0; h < 4; ++h) ow[dt][h] = (f32x4){0.f, 0.f, 0.f, 0.f};
    float mw_[4], lw[4];
#pragma unroll
    for (int h = 0; h < 4; ++h) { mw_[h] = -1e30f; lw[h] = 0.f; }
    const int kstart = (t0 >= 512) ? ((t0 - 511) & ~31) : 0;
#define NSA_WIN_LOAD(KF, VF, k0_) do { _Pragma("unroll") for (int tt = 0; tt < 2; ++tt) _Pragma("unroll") for (int ks = 0; ks < 2; ++ks) KF[tt][ks].u = *(const v4u*)(KWW + (size_t)((k0_) >> 5) * 2048 + (tt * 2 + ks) * 512 + lane * 8); \
        _Pragma("unroll") for (int dt = 0; dt < 4; ++dt) VF[dt].u = *(const v4u*)(VWT + (size_t)((k0_) >> 5) * 2048 + dt * 512 + lane * 8); } while (0)
    Frag kf[2][2], vf[4];
    NSA_WIN_LOAD(kf, vf, kstart);
    for (int k0 = kstart; k0 < t0 + 16; k0 += 32) {
        Frag kn[2][2], vn[4];
        { const int k1 = (k0 + 32 < t0 + 16) ? k0 + 32 : k0; NSA_WIN_LOAD(kn, vn, k1); }
#pragma unroll
        for (int h = 0; h < 4; ++h) {
            float s[8]; float mx = -1e30f;
#pragma unroll
            for (int tt = 0; tt < 2; ++tt) { f32x4 acc = {0.f, 0.f, 0.f, 0.f}; acc = mfma16(kf[tt][0].v, qa[h][0].v, acc); acc = mfma16(kf[tt][1].v, qa[h][1].v, acc);
#pragma unroll
                for (int i = 0; i < 4; ++i) { const int dist = tq - (k0 + tt * 16 + fq * 4 + i); const float bb = NSA_BIAS(dist, h, 0); s[tt * 4 + i] = (acc[i] * 0.125f + bb) + ((dist < 512) ? 0.f : -1e30f); mx = fmaxf(mx, s[tt * 4 + i]); } }
            mx = red4_max(mx);
            const float mn = fmaxf(mw_[h], mx), alpha = __builtin_amdgcn_exp2f((mw_[h] - mn) * L2E); mw_[h] = mn;
            float p[8]; float ps = 0.f;
#pragma unroll
            for (int i = 0; i < 8; ++i) { p[i] = __builtin_amdgcn_exp2f((s[i] - fmaxf(mn, -1e20f)) * L2E); ps += p[i]; }
            lw[h] = lw[h] * alpha + ps;
            Frag pf; pf.w[0] = pk2(p[0], p[1]); pf.w[1] = pk2(p[2], p[3]); pf.w[2] = pk2(p[4], p[5]); pf.w[3] = pk2(p[6], p[7]);
#pragma unroll
            for (int dt = 0; dt < 4; ++dt) { ow[dt][h] = ow[dt][h] * alpha; ow[dt][h] = mfma16(vf[dt].v, pf.v, ow[dt][h]); }
            __builtin_amdgcn_sched_barrier(0);
        }
#pragma unroll
        for (int tt = 0; tt < 2; ++tt)
#pragma unroll
            for (int ks = 0; ks < 2; ++ks) kf[tt][ks].u = kn[tt][ks].u;
#pragma unroll
        for (int dt = 0; dt < 4; ++dt) vf[dt].u = vn[dt].u;
    }
#pragma unroll
    for (int h = 0; h < 4; ++h) { float t = lw[h]; t = red4_sum(t);
        const float gw_ = (1.0f / (1.0f + fexp(-bf2f(HB[(size_t)(tok0 + fr) * HBP + HB_NSA_G + 8 + h])))) / t;
#pragma unroll
        for (int dt = 0; dt < 4; ++dt) { const v2u a = *(const LAS v2u*)(outb + fr * 256 + h * 64 + dt * 16 + fq * 4);
            v2u w; w.x = pk2(bflo(a.x) + ow[dt][h][0] * gw_, bfhi(a.x) + ow[dt][h][1] * gw_); w.y = pk2(bflo(a.y) + ow[dt][h][2] * gw_, bfhi(a.y) + ow[dt][h][3] * gw_); *(v2u*)(XN + (size_t)(tok0 + fr) * DM + h * 64 + dt * 16 + fq * 4) = w; } }
    LDS_WAIT();
}

#define PEER_SU 64.0f
#define PEER_SV 8.0f
#define PEER_SX 16.0f
typedef float f32x2v __attribute__((ext_vector_type(2)));
__device__ __forceinline__ float gelu_erf(float x) { return 0.5f * x * (1.0f + erff(x * 0.70710678118654752f)); }
template<int MODE> __device__ __forceinline__ void peer_item(int it, int l, const Args& args, LAS unsigned char* wlds, int lane) {
    unsigned char* ws = args.ws; const bf16* QP = (const bf16*)(ws + WS_PEER_QP);
    const int tok0 = it * 16, fr = lane & 15, fq = lane >> 4;
    LAS unsigned short* eidx = (LAS unsigned short*)wlds; LAS float* egate = (LAS float*)(wlds + 4096); LAS float* tkv = (LAS float*)(wlds + 12288);
    LAS float* cbuf = (LAS float*)(wlds + 16384); LAS unsigned char* ctab = (LAS unsigned char*)(wlds + 16384 + 512);
    const bf16* keys = opaque((const bf16*)(ws + WS_PKEYS) + (size_t)l * 8 * 2 * 128 * 128);
    if (MODE & 1) {
    { int c = 0, ij = 0xFF;
#pragma unroll
      for (int i = 0; i < 16; ++i)
#pragma unroll
          for (int j = 0; j < 16; ++j) if ((i + 1) * (j + 1) <= 16) { ij = (c == lane) ? ((i << 4) | j) : ij; ++c; }
      ctab[lane] = (unsigned char)ij; }
    LDS_WAIT();
    Frag qb[4], ka[8][4];
#define PA_LOAD(pc_) do { const bf16* kb_ = keys + (size_t)(pc_) * 128 * 128 + lane * 8;     \
        _Pragma("unroll") for (int ks = 0; ks < 4; ++ks) qb[ks].u = *(const v4u*)(QP + (size_t)(tok0 + fr) * 2048 + (pc_) * 128 + ks * 32 + fq * 8); \
        _Pragma("unroll") for (int mt = 0; mt < 8; ++mt) _Pragma("unroll") for (int ks = 0; ks < 4; ++ks) ka[mt][ks].u = *(const v4u*)(kb_ + (mt * 4 + ks) * 512); } while (0)
    PA_LOAD(0);
    for (int pc = 0; pc < 16; ++pc) {
        const int p = pc >> 1, c = pc & 1;
        {
            float sc[32];
#pragma unroll
            for (int mt = 0; mt < 8; ++mt) { f32x4 acc = {0.f, 0.f, 0.f, 0.f};
#pragma unroll
                for (int ks = 0; ks < 4; ++ks) acc = mfma16(ka[mt][ks].v, qb[ks].v, acc);
#pragma unroll
                for (int i = 0; i < 4; ++i) sc[mt * 4 + i] = __uint_as_float((__float_as_uint(acc[i]) & 0xFFFFFF80u) | (unsigned)(mt * 16 + fq * 4 + i)); }
            { const int pn = (pc < 15) ? pc + 1 : 15; PA_LOAD(pn); }
            __builtin_amdgcn_sched_barrier(0);
#pragma unroll
            for (int k = 2; k <= 32; k <<= 1)
#pragma unroll
                for (int j = k >> 1; j > 0; j >>= 1)
#pragma unroll
                    for (int i = 0; i < 32; ++i) { const int l2 = i ^ j; if (l2 > i) { const float a = sc[i], b2 = sc[l2]; const bool desc = (i & k) == 0; sc[i] = desc ? fmaxf(a, b2) : fminf(a, b2); sc[l2] = desc ? fminf(a, b2) : fmaxf(a, b2); } }
            for (int r = 0; r < 16; ++r) { const float w = red4_max(sc[0]); const bool own = (sc[0] == w);
#pragma unroll
                for (int k = 0; k < 15; ++k) sc[k] = own ? sc[k + 1] : sc[k];
                sc[15] = own ? -3.0e38f : sc[15];
                tkv[c * 256 + fr * 16 + r] = w; }
        }
        if (c == 0) continue;
        LDS_WAIT();
        float cs[16];
#pragma unroll
        for (int r = 0; r < 13; ++r) { const int cid = 4 * r + fq; const int ij = ctab[cid];
            const float v1 = tkv[fr * 16 + (ij >> 4)], v2 = tkv[256 + fr * 16 + (ij & 15)];
            cs[r] = (ij == 0xFF) ? -3.0e38f : __uint_as_float((__float_as_uint(v1 + v2) & 0xFFFFFFC0u) | (unsigned)cid); }
        cs[13] = -3.0e38f; cs[14] = -3.0e38f; cs[15] = -3.0e38f;
#pragma unroll
        for (int k = 2; k <= 16; k <<= 1)
#pragma unroll
            for (int j = k >> 1; j > 0; j >>= 1)
#pragma unroll
                for (int i = 0; i < 16; ++i) { const int l2 = i ^ j; if (l2 > i) { const float a = cs[i], b2 = cs[l2]; const bool desc = (i & k) == 0; cs[i] = desc ? fmaxf(a, b2) : fminf(a, b2); cs[l2] = desc ? fminf(a, b2) : fmaxf(a, b2); } }
        float top0 = 0.f, den = 0.f;
        for (int rr = 0; rr < 16; ++rr) { const float w = red4_max(cs[0]); const bool own = (cs[0] == w);
#pragma unroll
            for (int k = 0; k < 15; ++k) cs[k] = own ? cs[k + 1] : cs[k];
            cs[15] = own ? -3.0e38f : cs[15];
            const int ij = ctab[__float_as_uint(w) & 63u];
            const int i1 = (int)(__float_as_uint(tkv[fr * 16 + (ij >> 4)]) & 127u), i2 = (int)(__float_as_uint(tkv[256 + fr * 16 + (ij & 15)]) & 127u);
            if (rr == 0) top0 = w;
            const float ex = __builtin_amdgcn_exp2f((w - top0) * 1.4426950408889634f); den += ex;
            eidx[fr * 128 + p * 16 + rr] = (unsigned short)(i1 * 128 + i2); egate[fr * 128 + p * 16 + rr] = ex; }
        LDS_WAIT();
        { const float rden = 1.0f / den;
#pragma unroll
          for (int rr = 0; rr < 16; ++rr) egate[fr * 128 + p * 16 + rr] *= rden; }
        LDS_WAIT();
    }
    }
    LDS_WAIT();
    if (!(MODE & 2)) return;
    const float* ngain = opaque((l + 1 < DEPTH) ? (args.in[I_N1G] + (l + 1) * DM) : args.in[I_FNG]);
    const unsigned char* U8 = (const unsigned char*)(ws + WS_PEER_U); const unsigned char* V8 = (const unsigned char*)(ws + WS_PEER_V); const unsigned char* X8 = (const unsigned char*)(ws + WS_PEER_X8);
#define PU_LOAD(S, ks_) do { XA[S] = *(const v4u*)(X8 + tok * DM + (ks_) * 64 + fq * 16); \
        _Pragma("unroll") for (int et = 0; et < 8; ++et) UB[S][et] = *(const v4u*)(U8 + (size_t)el[et] * DM + (ks_) * 64 + fq * 16); } while (0)
#define PU_MMA(S) do { const long xa0 = (long)(((unsigned long long)XA[S][1] << 32) | XA[S][0]), xa1 = (long)(((unsigned long long)XA[S][3] << 32) | XA[S][2]); \
        _Pragma("unroll") for (int et = 0; et < 8; ++et) { const long ub0 = (long)(((unsigned long long)UB[S][et][1] << 32) | UB[S][et][0]), ub1 = (long)(((unsigned long long)UB[S][et][3] << 32) | UB[S][et][2]); \
            acc[et] = __builtin_amdgcn_mfma_f32_16x16x32_fp8_fp8(xa0, ub0, acc[et], 0, 0, 0); acc[et] = __builtin_amdgcn_mfma_f32_16x16x32_fp8_fp8(xa1, ub1, acc[et], 0, 0, 0); } } while (0)
#define PV_LOAD(S, e_) do { _Pragma("unroll") for (int e2 = 0; e2 < 8; ++e2) { const int ex = eidx[t * 128 + (e_) + e2]; VV[S][e2] = *(const v4u*)(V8 + (size_t)ex * DM + lane * 16); } } while (0)
#define PV_FMA(S, e_) do { _Pragma("unroll") for (int e2 = 0; e2 < 8; ++e2) { const float ce = cbuf[(e_) + e2]; \
        _Pragma("unroll") for (int k = 0; k < 4; ++k) { const f32x2v lo2 = __builtin_amdgcn_cvt_pk_f32_fp8((int)VV[S][e2][k], false), hi2 = __builtin_amdgcn_cvt_pk_f32_fp8((int)VV[S][e2][k], true); \
            o[4 * k] += ce * lo2.x; o[4 * k + 1] += ce * lo2.y; o[4 * k + 2] += ce * hi2.x; o[4 * k + 3] += ce * hi2.y; } if (e2 & 1) __builtin_amdgcn_sched_barrier(0); } } while (0)
    for (int t = 0; t < 16; ++t) {
        const size_t tok = (size_t)(tok0 + t);
        const int lane_t = lane_id_v();
        const int lane = lane_t, fr = lane_t & 15, fq = lane_t >> 4;
        const int fr7 = fr & 7, hf = fr >> 3;
        v4u VV[2][8];
#pragma unroll
        for (int tp = 0; tp < 2; ++tp) {
            int el[8];
#pragma unroll
            for (int et = 0; et < 8; ++et) el[et] = eidx[t * 128 + (tp * 8 + et) * 8 + fr7];
            f32x4 acc[8];
#pragma unroll
            for (int et = 0; et < 8; ++et) acc[et] = (f32x4){0.f, 0.f, 0.f, 0.f};
#pragma unroll 2
            for (int ks = 0; ks < 8; ++ks) {
                v4u UB[8];
                const v4u XA = *(const v4u*)(X8 + tok * DM + ks * 128 + (fr & 1) * 64 + fq * 16);
#pragma unroll
                for (int et = 0; et < 8; ++et) UB[et] = *(const v4u*)(U8 + (size_t)el[et] * DM + ks * 128 + hf * 64 + fq * 16);
                const long xa0 = (long)(((unsigned long long)XA[1] << 32) | XA[0]), xa1 = (long)(((unsigned long long)XA[3] << 32) | XA[2]);
#pragma unroll
                for (int et = 0; et < 8; ++et) { const long ub0 = (long)(((unsigned long long)UB[et][1] << 32) | UB[et][0]), ub1 = (long)(((unsigned long long)UB[et][3] << 32) | UB[et][2]);
                    acc[et] = __builtin_amdgcn_mfma_f32_16x16x32_fp8_fp8(xa0, ub0, acc[et], 0, 0, 0); acc[et] = __builtin_amdgcn_mfma_f32_16x16x32_fp8_fp8(xa1, ub1, acc[et], 0, 0, 0); }
            }
            if (tp == 1) { PV_LOAD(0, 0); PV_LOAD(1, 8); }
#pragma unroll
            for (int et = 0; et < 8; ++et) { const float v = hf ? acc[et][1] : acc[et][0]; const float tv = v + dpp_mov<0x128>(v);     const int e = (tp * 8 + et) * 8 + fr7;
                const pg8::f32x2 gv_ = pg8::gelu_pk((pg8::f32x2){tv * (1.0f / (PEER_SX * PEER_SU)), 0.f});
                const float c = egate[t * 128 + e] * gv_.x * (1.0f / PEER_SV);
                cbuf[(fq == 0 && hf == 0) ? e : 192 + lane] = c; }
        }
        LDS_WAIT();
        float o[16];
#pragma unroll
        for (int k = 0; k < 16; ++k) o[k] = 0.f;
        for (int e = 0; e < 112; e += 16) {
            PV_FMA(0, e); PV_LOAD(0, e + 16);
            PV_FMA(1, e + 8); PV_LOAD(1, e + 24);
        }
        PV_FMA(0, 112); PV_FMA(1, 120);
        const int lane_e = lane_id_v();
        float* hrow = args.out + tok * DM + lane_e * 16; float ss = 0.f;
#pragma unroll
        for (int k4 = 0; k4 < 4; ++k4) { const f32x4 hv = *(const f32x4*)(hrow + 4 * k4);
#pragma unroll
            for (int k = 0; k < 4; ++k) { o[4 * k4 + k] += hv[k]; ss += o[4 * k4 + k] * o[4 * k4 + k]; } }
        const float rn = 1.0f / sqrtf(wave_sum(ss) * (1.f / DM) + NORM_EPS);
        const float* gp = ngain + lane_e * 16;
        if (l + 1 < DEPTH) {
#pragma unroll
            for (int k4 = 0; k4 < 4; ++k4) { f32x4 hv = {o[4 * k4], o[4 * k4 + 1], o[4 * k4 + 2], o[4 * k4 + 3]}; *(f32x4*)(hrow + 4 * k4) = hv; }
            bf16* xrow = (bf16*)(ws + WS_XN) + tok * DM + lane_e * 16; v4u w0, w1;
#pragma unroll
            for (int k = 0; k < 4; ++k) { w0[k] = pk2(o[2 * k] * rn * gp[2 * k], o[2 * k + 1] * rn * gp[2 * k + 1]); w1[k] = pk2(o[8 + 2 * k] * rn * gp[8 + 2 * k], o[8 + 2 * k + 1] * rn * gp[8 + 2 * k + 1]); }
            *(v4u*)xrow = w0; *(v4u*)(xrow + 8) = w1;
        } else {
#pragma unroll
            for (int k4 = 0; k4 < 4; ++k4) { f32x4 hv = {o[4 * k4] * rn * gp[4 * k4], o[4 * k4 + 1] * rn * gp[4 * k4 + 1], o[4 * k4 + 2] * rn * gp[4 * k4 + 2], o[4 * k4 + 3] * rn * gp[4 * k4 + 3]}; *(f32x4*)(hrow + 4 * k4) = hv; }
        }
        LDS_WAIT();
    }
}

#ifndef MK_SPLIT
#define MK_SPLIT 0
#endif

#define IN(k) (lo <= (k) && (k) < hi)
#define SEAM(k) do { if (IN(k) && IN((k) + 1)) xcd_barrier(bar, wave == 0 && lane_id_v() == 0); } while (0)
template <int l>
__device__ __forceinline__ void layer_phases(const Args& args, LAS unsigned char* lds, const XcdBarrier& bar, const int lo, const int hi, const int wave) {
    constexpr int G = GRID_WG; const int bx = blockIdx.x;
    const int gw = bx * NWAVES + wave, NGW = G * NWAVES, vw = wave * G + bx;
    unsigned char* ws = args.ws;
    unsigned* ctl = (unsigned*)(ws + WS_CTL);
    LAS unsigned char* wlds = lds + wave * WAVE_LDS;
    bf16* XN = (bf16*)(ws + WS_XN); bf16* HB = (bf16*)(ws + WS_HB);
    (void)gw; (void)NGW; (void)ctl; (void)wlds; (void)HB; (void)vw;
        const int pb = 1 + 8 * l;
        if (IN(pb + 0)) {
            const int lane = lane_id_v(); (void)lane;
            pg8::Gemm g{XN, (const bf16*)(ws + WS_WIN + l * WIN_L), M_TOK, N_IN_PAD, DM}; pg8::StaticOrder S; S.init(M_TOK, N_IN_PAD, G, bx);
            pg8::EpiHb E{HB, HBP, HBP};
            pg8::gemm_phase<pg8::EpiHb, pg8::StaticOrder, true, true>(lds, g, S, E, wave);
        }
        SEAM(pb + 0);
        if (IN(pb + 1)) {
            const int lane = lane_id_v(); (void)lane;
            { const int it = vw - 256; if (it >= 0 && it < 512) nsa_cmp_item(it, l, args, lane_id_v()); }
            for (int it = vw; it < 2048; it += NGW) { gdn_prep_item(it, l, args, wlds, lane_id_v()); }
            for (int it = vw; it < M_TOK / 16; it += NGW) { mla_prep_item(it, l, args, lane_id_v()); }
            for (int it = vw; it < 2048; it += NGW) { mlstm_prep_item(it, l, args, wlds, lane_id_v()); }
            { const int it = vw - 1024; if (it >= 0) nsa_vt_item(it, l, args, wlds, lane_id_v()); }
        }
        SEAM(pb + 1);
        if (IN(pb + 2)) {
            const int lane = lane_id_v(); (void)lane;
            nsa_lut_init(args.in[I_T5], (LAS float*)(wlds + 16384), lane);
            { const int it = vw - 256; if (it >= 0 && it < 64) gdn_scan_item(it, args, lane_id_v()); }
            { const int it = vw; if (it < 256) mlstm_scan_item(it, args, lane_id_v()); }
            for (int it = vw; it < 2048; it += NGW) { mla_attn_item(it & 15, 127 - (it >> 4), args, wlds, lane_id_v()); }
            { unsigned* qh = ctl + CW_Q + 64 * (l * 8 + (bx & 7));
              for (;;) { const int m = wave_pop(qh, lane_id_v()); if (m >= 256) break; const int j = 8 * m + (7 - (bx & 7)); nsa_item(j & 3, 511 - (j >> 2), l, args, wlds, lane_id_v()); } }
        }
        SEAM(pb + 2);
        if (IN(pb + 3)) {
            const int lane = lane_id_v(); (void)lane;
            for (int it = vw; it < 2048; it += NGW) { gdn_out_item(it, l, args, lane_id_v()); }
            for (int it = vw; it < 2048; it += NGW) { mlstm_out_item(it, l, args, wlds, lane_id_v()); }
            {
                const f32x4* su = (const f32x4*)(args.in[I_PEER_U] + (size_t)l * 16384 * DM); const f32x4* sv = (const f32x4*)(args.in[I_PEER_V] + (size_t)l * 16384 * DM);
                v4u* du = (v4u*)(ws + WS_PEER_U); v4u* dv = (v4u*)(ws + WS_PEER_V);
                unsigned* du32 = (unsigned*)du; unsigned* dv32 = (unsigned*)dv;
                for (size_t c = (size_t)gw; c < (size_t)16384 * DM / 1024; c += (size_t)NGW) {
                    f32x4 a[4], b2[4];
#pragma unroll
                    for (int q = 0; q < 4; ++q) { a[q] = su[c * 256 + q * 64 + lane]; b2[q] = sv[c * 256 + q * 64 + lane]; }
#pragma unroll
                    for (int q = 0; q < 4; ++q) {
                        int pa = __builtin_amdgcn_cvt_pk_fp8_f32(a[q][0] * PEER_SU, a[q][1] * PEER_SU, 0, false); pa = __builtin_amdgcn_cvt_pk_fp8_f32(a[q][2] * PEER_SU, a[q][3] * PEER_SU, pa, true);
                        int pb2 = __builtin_amdgcn_cvt_pk_fp8_f32(b2[q][0] * PEER_SV, b2[q][1] * PEER_SV, 0, false); pb2 = __builtin_amdgcn_cvt_pk_fp8_f32(b2[q][2] * PEER_SV, b2[q][3] * PEER_SV, pb2, true);
                        du32[c * 256 + q * 64 + lane] = (unsigned)pa; dv32[c * 256 + q * 64 + lane] = (unsigned)pb2; }
                }
            }
        }
        SEAM(pb + 3);
        if (IN(pb + 4)) {
            const int lane = lane_id_v(); (void)lane;
            pg8::Gemm g{XN, (const bf16*)(ws + WS_WOUT + l * WOUT_L), M_TOK, DM, DM}; pg8::StaticOrder S; S.init(M_TOK, DM, G, bx);
            pg8::EpiRes E{args.out, l == 0 ? args.in[I_X] : (const float*)args.out, DM};
            pg8::gemm_phase<pg8::EpiRes, pg8::StaticOrder, true, true>(lds, g, S, E, wave);
        }
        SEAM(pb + 4);
        if (IN(pb + 5)) {
            const int lane = lane_id_v(); (void)lane;
            {
                const float* g2 = args.in[I_N2G] + l * DM; unsigned char* X8 = ws + WS_PEER_X8;
                f32x4 gg[4];
#pragma unroll
                for (int j = 0; j < 4; ++j) gg[j] = ((const f32x4*)g2)[lane + 64 * j];
                for (int m0 = gw; m0 < M_TOK; m0 += 4 * NGW) {
                    f32x4 v[4][4]; float s[4];
#pragma unroll
                    for (int q = 0; q < 4; ++q) { const f32x4* xr = (const f32x4*)(args.out + (size_t)(m0 + q * NGW) * DM) + lane; s[q] = 0.f;
#pragma unroll
                        for (int j = 0; j < 4; ++j) { v[q][j] = xr[64 * j]; s[q] += (v[q][j].x * v[q][j].x + v[q][j].y * v[q][j].y) + (v[q][j].z * v[q][j].z + v[q][j].w * v[q][j].w); } }
#pragma unroll
                    for (int q = 0; q < 4; ++q) { const size_t m = (size_t)(m0 + q * NGW); const float r = 1.0f / sqrtf(wave_sum(s[q]) * (1.f / DM) + NORM_EPS);
#pragma unroll
                        for (int j = 0; j < 4; ++j) { const float y0 = v[q][j].x * r * gg[j].x, y1 = v[q][j].y * r * gg[j].y, y2 = v[q][j].z * r * gg[j].z, y3 = v[q][j].w * r * gg[j].w;
                            v2u o; o.x = pk2(y0, y1); o.y = pk2(y2, y3); ((v2u*)(XN + m * DM))[lane + 64 * j] = o;
                            int p8 = __builtin_amdgcn_cvt_pk_fp8_f32(y0 * PEER_SX, y1 * PEER_SX, 0, false); p8 = __builtin_amdgcn_cvt_pk_fp8_f32(y2 * PEER_SX, y3 * PEER_SX, p8, true);
                            ((int*)(X8 + m * DM))[lane + 64 * j] = p8; } }
                }
            }
        }
        SEAM(pb + 5);
        if (IN(pb + 6)) {
            const int lane = lane_id_v(); (void)lane;
            pg8::Gemm g{XN, (const bf16*)(ws + WS_WQ + l * WQ_L), M_TOK, 2048, DM}; pg8::StaticOrder S; S.init(M_TOK, 2048, G, bx);
            pg8::EpiBf16<0> E{(bf16*)(ws + WS_PEER_QP), 2048, nullptr, 0, 0, 1.f};
            pg8::gemm_phase<pg8::EpiBf16<0>, pg8::StaticOrder, true, true>(lds, g, S, E, wave);
        }
        SEAM(pb + 6);
        if (IN(pb + 7)) {
            const int lane = lane_id_v(); (void)lane;
            static_assert(G * NWAVES == M_TOK / 16, "one PEER item per wave");
            for (int it = vw; it < M_TOK / 16; it += NGW) { peer_item<1>(it, l, args, wlds, lane_id_v()); }
            for (int it = vw; it < M_TOK / 16; it += NGW) { peer_item<2>(it, l, args, wlds, lane_id_v()); }
        }
        SEAM(pb + 7);
}

__global__ void __launch_bounds__(NWAVES * 64, 2) fwd_kernel(Args args) {
    extern __shared__ __attribute__((aligned(16))) unsigned char lds_raw[];
    LAS unsigned char* lds = (LAS unsigned char*)lds_raw;
    volatile LAS unsigned* MISC = (volatile LAS unsigned*)(lds + MISC_OFF);
    const int wave = __builtin_amdgcn_readfirstlane((int)(threadIdx.x >> 6)); const int tid = wave * 64 + lane_id_v();
    constexpr int G = GRID_WG; const int bx = blockIdx.x;
    const int gw = bx * NWAVES + wave, NGW = G * NWAVES;
    unsigned char* ws = args.ws;
    unsigned* ctl = (unsigned*)(ws + WS_CTL);
    for (int u = tid; u < (LDS_BYTES - MISC_OFF) / 4; u += NWAVES * 64) MISC[u] = 0u;
    __syncthreads();
    XcdBarrier bar; bar.bar = ctl + CW_BAR; bar.x = 0; bar.st = nullptr;
    if (!MK_SPLIT) bar = xcd_barrier_post(ctl + CW_BAR, MISC + 8, tid == 0);
    const int lo = args.ph_lo, hi = args.ph_hi;
    LAS unsigned char* wlds = lds + wave * WAVE_LDS;
    bf16* XN = (bf16*)(ws + WS_XN); bf16* HB = (bf16*)(ws + WS_HB);

    if (IN(0)) {
        const int lane = lane_id_v();
        LAS float* scr = (LAS float*)wlds;
        constexpr int I_IN = (DM / 64) * (N_IN_PAD / 32), I_OUT = (DM / 64) * (DM / 32), I_Q = (DM / 64) * (2048 / 32);
        constexpr int I_UQ = (256 / 64) * (384 / 32), I_UKV = (128 / 64) * (512 / 32), I_CMP = (2048 / 64) * (64 / 32);
        constexpr int PER_L = I_IN + I_OUT + I_Q + I_UQ + I_UKV + 2 * I_CMP;
        for (int it = gw; it < DEPTH * PER_L; it += NGW) {
            const int l = it / PER_L; int r = it % PER_L;
            unsigned char* wsm = ws + WS_WSM + l * WSM_L;
            if (r < I_IN) { tr_item(args.in[I_WIN] + (size_t)l * DM * D_IN, D_IN, D_IN, MapHb(), (bf16*)(ws + WS_WIN + l * WIN_L), DM, scr, r / (N_IN_PAD / 32), r % (N_IN_PAD / 32), lane); continue; } r -= I_IN;
            if (r < I_OUT) { tr_item(args.in[I_WOUT] + (size_t)l * DM * DM, DM, DM, MapId(), (bf16*)(ws + WS_WOUT + l * WOUT_L), DM, scr, r / (DM / 32), r % (DM / 32), lane); continue; } r -= I_OUT;
            if (r < I_Q) { tr_item(args.in[I_PEER_WQ] + (size_t)l * DM * 2048, 2048, 2048, MapId(), (bf16*)(ws + WS_WQ + l * WQ_L), DM, scr, r / (2048 / 32), r % (2048 / 32), lane); continue; } r -= I_Q;
            if (r < I_UQ) { tr_item(args.in[I_MLA_WUQ] + (size_t)l * 256 * 384, 384, 384, MapId(), (bf16*)(wsm + WSM_UQ), 256, scr, r / (384 / 32), r % (384 / 32), lane); continue; } r -= I_UQ;
            if (r < I_UKV) { tr_item(args.in[I_MLA_WUKV] + (size_t)l * 128 * 512, 512, 512, MapId(), (bf16*)(wsm + WSM_UKV), 128, scr, r / (512 / 32), r % (512 / 32), lane); continue; } r -= I_UKV;
            if (r < I_CMP) { tr_item(args.in[I_CMPK] + (size_t)l * 2048 * 64, 64, 64, MapId(), (bf16*)(wsm + WSM_CK), 2048, scr, r / 2, r % 2, lane); continue; } r -= I_CMP;
            tr_item(args.in[I_CMPV] + (size_t)l * 2048 * 64, 64, 64, MapId(), (bf16*)(wsm + WSM_CV), 2048, scr, r / 2, r % 2, lane);
        }
        { const f32x4* ksrc = (const f32x4*)args.in[I_PEER_KEYS]; v2u* kdst = (v2u*)(ws + WS_PKEYS);
          for (int i = gw * 64 + lane; i < DEPTH * 16 * 128 * 128 / 4; i += NGW * 64) { const f32x4 a = ksrc[i]; v2u o; o.x = pk2(a[0], a[1]); o.y = pk2(a[2], a[3]);
              const int mat = i >> 12, m = (i >> 5) & 127, k4 = (i & 31) * 4;
              kdst[(size_t)mat * 4096 + ((((m >> 4) * 4 + (k4 >> 5)) * 64 + ((k4 >> 3) & 3) * 16 + (m & 15)) * 8 + (k4 & 7)) / 4] = o; } }
        for (int m0 = gw; m0 < M_TOK; m0 += 4 * NGW) {
            f32x4 v[4][4]; float s[4];
#pragma unroll
            for (int q = 0; q < 4; ++q) { const f32x4* xr = (const f32x4*)(args.in[I_X] + (size_t)(m0 + q * NGW) * DM) + lane; s[q] = 0.f;
#pragma unroll
                for (int j = 0; j < 4; ++j) { v[q][j] = xr[64 * j]; s[q] += (v[q][j].x * v[q][j].x + v[q][j].y * v[q][j].y) + (v[q][j].z * v[q][j].z + v[q][j].w * v[q][j].w); } }
#pragma unroll
            for (int q = 0; q < 4; ++q) { const float r = 1.0f / sqrtf(wave_sum(s[q]) * (1.f / DM) + NORM_EPS); v2u* o8 = (v2u*)(XN + (size_t)(m0 + q * NGW) * DM) + lane;
#pragma unroll
                for (int j = 0; j < 4; ++j) { const f32x4 gg = ((const f32x4*)args.in[I_N1G])[lane + 64 * j]; v2u o; o.x = pk2(v[q][j].x * r * gg.x, v[q][j].y * r * gg.y); o.y = pk2(v[q][j].z * r * gg.z, v[q][j].w * r * gg.w); o8[64 * j] = o; } }
        }
    }
    SEAM(0);

    layer_phases<0>(args, lds, bar, lo, hi, wave);
    layer_phases<1>(args, lds, bar, lo, hi, wave);
#undef IN
#undef SEAM
}

extern "C" void kernel_launch(void* const* d_in, const int* in_sizes, int n_in, void* d_out, int out_size, void* d_ws, size_t ws_size, hipStream_t stream) {
    static int grid = 0;
    if (grid == 0) {
        if (n_in != 26 || in_sizes[0] != M_TOK * DM || out_size != M_TOK * DM || ws_size < WS_END) { fprintf(stderr, "kernel_launch: unexpected shapes/workspace (n_in %d, ws %zu < %zu)\n", n_in, ws_size, (size_t)WS_END); grid = -1; return; }
        int dev = 0, cus = 0, per_cu = 0;
        if (hipGetDevice(&dev) != hipSuccess || hipDeviceGetAttribute(&cus, hipDeviceAttributeMultiprocessorCount, dev) != hipSuccess) { grid = -1; return; }
        if (hipFuncSetAttribute((const void*)fwd_kernel, hipFuncAttributeMaxDynamicSharedMemorySize, LDS_BYTES) != hipSuccess) { fprintf(stderr, "kernel_launch: hipFuncSetAttribute failed\n"); grid = -1; return; }
        if (hipOccupancyMaxActiveBlocksPerMultiprocessor(&per_cu, (const void*)fwd_kernel, NWAVES * 64, LDS_BYTES) != hipSuccess || per_cu < 1) { fprintf(stderr, "kernel_launch: occupancy query says %d blocks per CU\n", per_cu); }
        (void)hipGetLastError();
        if (cus < GRID_WG) { fprintf(stderr, "kernel_launch: %d CUs < %d workgroups: the grid would not be resident\n", cus, GRID_WG); grid = -1; return; }
        grid = GRID_WG;
    }
    if (grid < 0) return;
    if (hipMemsetAsync((char*)d_ws + WS_CTL, 0, CTL_ZERO_BYTES, stream) != hipSuccess) return;
    Args a{};
    for (int i = 0; i < 26; ++i) a.in[i] = (const float*)d_in[i];
    a.out = (float*)d_out; a.ws = (unsigned char*)d_ws;
#if MK_SPLIT
    for (int p = 0; p < N_PHASES; ++p) { a.ph_lo = p; a.ph_hi = p + 1; hipLaunchKernelGGL(fwd_kernel, dim3(grid), dim3(NWAVES * 64), LDS_BYTES, stream, a); }
#else
    a.ph_lo = 0; a.ph_hi = N_PHASES;
    hipLaunchKernelGGL(fwd_kernel, dim3(grid), dim3(NWAVES * 64), LDS_BYTES, stream, a);
#endif
    const hipError_t le = hipPeekAtLastError();
    if (le != hipSuccess) fprintf(stderr, "kernel_launch: launch failed: %s\n", hipGetErrorName(le));
}
```
